# Optimizing an MI355X kernel written in HIP

```python
import jax, jax.numpy as jnp
from jax import lax
import numpy as np

D_MODEL = 1024
BATCH = 4
SEQ = 8192
DEPTH = 2

N_MEM = 256
POOL_WINDOWS = (2, 4, 8, 16)
POOL_GROUPS = 4
POOL_GROUP_DIM = D_MODEL // 8
POOL_WIDTH = POOL_GROUPS * POOL_GROUP_DIM
RET_HEADS = 4
RET_DK = D_MODEL // 8
RET_DV = D_MODEL // 4
RET_QK_WIDTH = RET_HEADS * RET_DK
RET_V_WIDTH = RET_HEADS * RET_DV
RET_CHUNK = 128
ROPE_BASE = 10000.0
XATTN_HEADS = 4
XATTN_DH = D_MODEL // 8
XATTN_WIDTH = XATTN_HEADS * XATTN_DH
N_BRANCHES = 3
D_FF = 4 * D_MODEL
NORM_EPS = 1e-6
IN_SPLITS = (POOL_WIDTH, RET_QK_WIDTH, RET_QK_WIDTH, RET_V_WIDTH, RET_V_WIDTH, XATTN_WIDTH, N_BRANCHES * D_MODEL)
IN_COLS = sum(IN_SPLITS)
IN_OFFSETS = tuple(int(v) for v in np.cumsum(IN_SPLITS)[:-1])

kernel_name = "gated_pool_retention_memory_hybrid"


def rms_norm(x, g):
    xf = x.astype(jnp.float32)
    y = xf * lax.rsqrt(jnp.mean(xf * xf, axis=-1, keepdims=True) + NORM_EPS)
    return (y * g.astype(jnp.float32)).astype(x.dtype)


def pool_mixer(u, pool_w, pool_scale):
    B, S, _ = u.shape
    uf = u.astype(jnp.float32).reshape(B, S, POOL_GROUPS, POOL_GROUP_DIM)
    csum = jnp.cumsum(uf, axis=1)
    t = jnp.arange(S)
    outs = []
    for gi, w in enumerate(POOL_WINDOWS):
        cg = csum[:, :, gi]
        shifted = jnp.pad(cg, ((0, 0), (w, 0), (0, 0)))[:, :S]
        cnt = jnp.minimum(t + 1, w).astype(jnp.float32)[None, :, None]
        outs.append((cg - shifted) / cnt - uf[:, :, gi])
    d = jnp.stack(outs, axis=2).astype(u.dtype)
    y = jnp.einsum('bsgc,gcd->bsgd', d, pool_w).reshape(B, S, POOL_WIDTH)
    return y * pool_scale


def rotary(x, positions):
    half = x.shape[-1] // 2
    inv_freq = ROPE_BASE ** (-jnp.arange(half, dtype=jnp.float32) / half)
    ang = positions.astype(jnp.float32)[:, :, None] * inv_freq
    cos = jnp.cos(ang)[:, :, None, :]
    sin = jnp.sin(ang)[:, :, None, :]
    x1, x2 = x[..., :half], x[..., half:]
    return jnp.concatenate([x1 * cos - x2 * sin, x2 * cos + x1 * sin], axis=-1)


def retention(q, k, v, gate, positions, ret_norm_g):
    B, S, _ = q.shape
    dt = v.dtype
    N, C, H = S // RET_CHUNK, RET_CHUNK, RET_HEADS
    qf = rotary(q.astype(jnp.float32).reshape(B, S, H, RET_DK), positions)
    kf = rotary(k.astype(jnp.float32).reshape(B, S, H, RET_DK), positions) * (RET_DK ** -0.5)
    vf = v.astype(jnp.float32).reshape(B, S, H, RET_DV)
    qc = qf.reshape(B, N, C, H, RET_DK)
    kc = kf.reshape(B, N, C, H, RET_DK)
    vc = vf.reshape(B, N, C, H, RET_DV)

    log_gamma = jnp.log(1.0 - 2.0 ** (-5.0 - jnp.arange(H, dtype=jnp.float32)))
    idx = jnp.arange(C)
    diff = (idx[:, None] - idx[None, :]).astype(jnp.float32)
    causal = idx[:, None] >= idx[None, :]
    decay_mask = jnp.where(causal[None], jnp.exp(diff[None] * log_gamma[:, None, None]), 0.0)

    scores = jnp.einsum('bnihd,bnjhd->bnhij', qc, kc) * decay_mask[None, None]
    y_intra = jnp.einsum('bnhij,bnjhv->bnihv', scores, vc)

    idx_f = idx.astype(jnp.float32)
    k_dec = kc * jnp.exp((C - 1.0 - idx_f)[:, None] * log_gamma[None, :])[..., None]
    kv = jnp.einsum('bnjhd,bnjhv->bnhdv', k_dec, vc)
    chunk_decay = jnp.exp(C * log_gamma)[None, :, None, None]

    def step(state, kv_n):
        return chunk_decay * state + kv_n, state

    init = jnp.zeros((B, H, RET_DK, RET_DV), jnp.float32)
    _, s_prev = lax.scan(step, init, jnp.moveaxis(kv, 1, 0))
    s_prev = jnp.moveaxis(s_prev, 0, 1)
    q_dec = qc * jnp.exp((idx_f + 1.0)[:, None] * log_gamma[None, :])[..., None]
    y_inter = jnp.einsum('bnihd,bnhdv->bnihv', q_dec, s_prev)

    y = (y_intra + y_inter).reshape(B, S, H, RET_DV)
    y = y * lax.rsqrt(jnp.mean(y * y, axis=-1, keepdims=True) + NORM_EPS)
    y = y.reshape(B, S, RET_V_WIDTH) * ret_norm_g.astype(jnp.float32)
    return (jax.nn.silu(gate.astype(jnp.float32)) * y).astype(dt)


def memory_attention(q, mem_n, w_mem_kv):
    B, S, _ = q.shape
    M = mem_n.shape[1]
    kvm = mem_n @ w_mem_kv
    km = kvm[..., :XATTN_WIDTH].reshape(B, M, XATTN_HEADS, XATTN_DH)
    vm = kvm[..., XATTN_WIDTH:].reshape(B, M, XATTN_HEADS, XATTN_DH)
    qh = q.reshape(B, S, XATTN_HEADS, XATTN_DH)
    s = jnp.einsum('bshd,bmhd->bhsm', qh, km).astype(jnp.float32) * (XATTN_DH ** -0.5)
    p = jax.nn.softmax(s, axis=-1).astype(vm.dtype)
    return jnp.einsum('bhsm,bmhd->bshd', p, vm).reshape(B, S, XATTN_WIDTH)


def setup_inputs(seed: int = 0) -> dict:
    key = jax.random.key(seed)
    ks = jax.random.split(key, 20)
    f32 = jnp.float32

    def w(k, shape, fan_in):
        return jax.random.normal(k, shape, f32) * (fan_in ** -0.5)

    def gain(k, shape):
        return 1.0 + 0.02 * jax.random.normal(k, shape, f32)

    x = jax.random.normal(ks[0], (BATCH, SEQ, D_MODEL), f32)
    mem = jax.random.normal(ks[1], (BATCH, N_MEM, D_MODEL), f32)
    offsets = jax.random.randint(ks[2], (BATCH, 1), 0, 4096, dtype=jnp.int32)
    positions = (offsets + jnp.arange(SEQ, dtype=jnp.int32)[None, :]).astype(jnp.int32)
    return {
        "x": x,
        "mem": mem,
        "positions": positions,
        "norm_mix_g": gain(ks[3], (DEPTH, D_MODEL)),
        "w_in": w(ks[4], (DEPTH, D_MODEL, IN_COLS), D_MODEL),
        "pool_w": w(ks[5], (DEPTH, POOL_GROUPS, POOL_GROUP_DIM, POOL_GROUP_DIM), POOL_GROUP_DIM),
        "pool_scale": gain(ks[6], (DEPTH, POOL_WIDTH)),
        "ret_norm_g": gain(ks[7], (DEPTH, RET_V_WIDTH)),
        "mem_norm_g": gain(ks[8], (DEPTH, D_MODEL)),
        "w_mem_kv": w(ks[9], (DEPTH, D_MODEL, 2 * XATTN_WIDTH), D_MODEL),
        "w_up_pool": w(ks[10], (DEPTH, POOL_WIDTH, D_MODEL), POOL_WIDTH),
        "w_up_ret": w(ks[11], (DEPTH, RET_V_WIDTH, D_MODEL), RET_V_WIDTH),
        "w_up_mem": w(ks[12], (DEPTH, XATTN_WIDTH, D_MODEL), XATTN_WIDTH),
        "w_out": w(ks[13], (DEPTH, D_MODEL, D_MODEL), D_MODEL),
        "norm_mlp_g": gain(ks[14], (DEPTH, D_MODEL)),
        "w_mlp1": w(ks[15], (DEPTH, D_MODEL, D_FF), D_MODEL),
        "w_mlp2": w(ks[16], (DEPTH, D_FF, D_MODEL), D_FF),
        "final_norm_g": gain(ks[17], (D_MODEL,)),
    }


def reference(x, mem, positions, norm_mix_g, w_in, pool_w, pool_scale, ret_norm_g, mem_norm_g,
              w_mem_kv, w_up_pool, w_up_ret, w_up_mem, w_out, norm_mlp_g, w_mlp1, w_mlp2,
              final_norm_g):
    for l in range(DEPTH):
        h = rms_norm(x, norm_mix_g[l])
        proj = h @ w_in[l]
        pool_u, rq, rk, rv, rg, xq, gates = jnp.split(proj, IN_OFFSETS, axis=-1)
        y_pool = pool_mixer(pool_u, pool_w[l], pool_scale[l])
        y_ret = retention(rq, rk, rv, rg, positions, ret_norm_g[l])
        y_mem = memory_attention(xq, rms_norm(mem, mem_norm_g[l]), w_mem_kv[l])
        g_pool, g_ret, g_mem = jnp.split(jax.nn.sigmoid(gates), N_BRANCHES, axis=-1)
        merged = (g_pool * (y_pool @ w_up_pool[l])
                  + g_ret * (y_ret @ w_up_ret[l])
                  + g_mem * (y_mem @ w_up_mem[l]))
        x = x + merged @ w_out[l]
        h2 = rms_norm(x, norm_mlp_g[l])
        x = x + jnp.square(jax.nn.relu(h2 @ w_mlp1[l])) @ w_mlp2[l]
    return rms_norm(x, final_norm_g)
```

```cpp
#include <hip/hip_runtime.h>
#include <cstdio>
#include <cstdint>

#ifndef MK_SINGLE
#define MK_SINGLE 1
#endif
#ifndef PROBE_DUP
#define PROBE_DUP 0
#endif
#define REPS(k) (1 + ((PROBE_DUP >> (k)) & 1))
#ifndef USE_TR
#define USE_TR 1
#endif

#define LAS __attribute__((address_space(3)))
#define GAS __attribute__((address_space(1)))
typedef unsigned short bf16;
typedef short bf16x8 __attribute__((ext_vector_type(8)));
typedef short s16x4 __attribute__((ext_vector_type(4)));
typedef float f32x4 __attribute__((ext_vector_type(4)));
typedef float f32x2 __attribute__((ext_vector_type(2)));
typedef unsigned u32x4 __attribute__((ext_vector_type(4)));
typedef unsigned u32x2 __attribute__((ext_vector_type(2)));
typedef __bf16 bf16x2_t __attribute__((ext_vector_type(2)));
typedef short v4i16_t __attribute__((ext_vector_type(4)));

constexpr int DM = 1024, NB = 4, SEQ = 8192, T = NB * SEQ, TH = T / 2, NMEM = 256, DFF = 4096;
constexpr int INC = 7168;
constexpr int PLD = 4608;
constexpr int C_Q = 512, C_K = 1024, C_V = 1536, C_DP = 2560, C_G = 3072, C_XQ = 4096;
constexpr float EPS = 1e-6f;
constexpr float XQ_SCALE = 0.08838834764831845f * 1.4426950408889634f;
constexpr float K_SCALE = 0.08838834764831845f;

constexpr size_t MiB = 1u << 20;
constexpr size_t WS_CTL = 0, CTL_ZERO_BYTES = 1 * MiB;
constexpr size_t WS_COS = 2 * MiB, WS_SIN = 10 * MiB;
constexpr size_t WS_SSP = 18 * MiB;
constexpr size_t WS_MEMN = 20 * MiB;
constexpr size_t WS_KVMEM = 24 * MiB;
constexpr size_t WS_W = 32 * MiB, W_LAYER = 38 * MiB;
constexpr size_t WO_IN = 0, WO_UP = 14 * MiB, WO_OUT = 18 * MiB, WO_1 = 20 * MiB, WO_2 = 28 * MiB, WO_MKV = 36 * MiB;
constexpr size_t WS_XB = 108 * MiB;
constexpr size_t WS_MERGED = 172 * MiB;
constexpr size_t WS_PROJ = 204 * MiB;
constexpr size_t WS_KVN = 348 * MiB;
constexpr size_t WS_SPREV = 412 * MiB;
constexpr size_t WS_GATES = 348 * MiB;
constexpr size_t WS_U = 172 * MiB;
constexpr size_t WS_END = 444 * MiB;
static_assert(WS_W + 2 * W_LAYER <= WS_XB && WS_U + (size_t)T * DFF * 2 <= WS_END && WS_PROJ + (size_t)TH * PLD * 2 <= WS_KVN, "ws map");
constexpr int CW_TMO = 0, CW_BAR = 4096;

constexpr int RING_BYTES = 131072, SCRATCH_BYTES = 147456, LDSCTL_OFF = SCRATCH_BYTES, MISC_OFF = LDSCTL_OFF + 320, LDS_BYTES = SCRATCH_BYTES + 1024;

__device__ __forceinline__ unsigned cvtpk(float lo, float hi) { f32x2 v = {lo, hi}; bf16x2_t b = __builtin_convertvector(v, bf16x2_t); return __builtin_bit_cast(unsigned, b); }
__device__ __forceinline__ float bflo(unsigned u) { return __uint_as_float(u << 16); }
__device__ __forceinline__ float bfhi(unsigned u) { return __uint_as_float(u & 0xffff0000u); }
__device__ __forceinline__ f32x4 mfma16(bf16x8 a, bf16x8 b, f32x4 c) { return __builtin_amdgcn_mfma_f32_16x16x32_bf16(a, b, c, 0, 0, 0); }
#define SWZ_XOR(m) (((m) << 10) | 0x1f)
__device__ __forceinline__ float wave_sum(float v) {
    v += __int_as_float(__builtin_amdgcn_ds_swizzle(__float_as_int(v), SWZ_XOR(1)));
    v += __int_as_float(__builtin_amdgcn_ds_swizzle(__float_as_int(v), SWZ_XOR(2)));
    v += __int_as_float(__builtin_amdgcn_ds_swizzle(__float_as_int(v), SWZ_XOR(4)));
    v += __int_as_float(__builtin_amdgcn_ds_swizzle(__float_as_int(v), SWZ_XOR(8)));
    { auto r = __builtin_amdgcn_permlane16_swap(__float_as_uint(v), __float_as_uint(v), false, false); v = __uint_as_float(r[0]) + __uint_as_float(r[1]); }
    { auto r = __builtin_amdgcn_permlane32_swap(__float_as_uint(v), __float_as_uint(v), false, false); v = __uint_as_float(r[0]) + __uint_as_float(r[1]); }
    return v;
}
__device__ __forceinline__ float add_xor16(float v) { auto r = __builtin_amdgcn_permlane16_swap(__float_as_uint(v), __float_as_uint(v), false, false); return __uint_as_float(r[0]) + __uint_as_float(r[1]); }
__device__ __forceinline__ float add_xor32(float v) { auto r = __builtin_amdgcn_permlane32_swap(__float_as_uint(v), __float_as_uint(v), false, false); return __uint_as_float(r[0]) + __uint_as_float(r[1]); }
__device__ __forceinline__ float max_xor16(float v) { auto r = __builtin_amdgcn_permlane16_swap(__float_as_uint(v), __float_as_uint(v), false, false); return fmaxf(__uint_as_float(r[0]), __uint_as_float(r[1])); }
__device__ __forceinline__ float max_xor32(float v) { auto r = __builtin_amdgcn_permlane32_swap(__float_as_uint(v), __float_as_uint(v), false, false); return fmaxf(__uint_as_float(r[0]), __uint_as_float(r[1])); }
__device__ __forceinline__ float sigmoidf_(float x) { return 1.0f / (1.0f + __expf(-x)); }

namespace pg8 {
#define PG8_LAS __attribute__((address_space(3)))
typedef unsigned short bf16_t;
constexpr int BM = 256, BK = 64, HALF = 128, HTB = HALF * BK * 2, STAGE_BYTES = 8 * HTB, NXCD = 8, WGM = 8;
__host__ __device__ __forceinline__ int lds_byte(int r, int c) { const int st = (r >> 4) * 2 + (c >> 5), rr = r & 15, cc = c & 31, ob = rr * 64 + cc * 2; return st * 1024 + (ob ^ (((ob >> 9) & 1) << 5)); }
__host__ __device__ __forceinline__ void stage_rc(int b, int& R, int& C) { const int st = b / 1024, sb = b % 1024, swz = sb ^ (((sb >> 9) & 1) << 5); R = (st >> 1) * 16 + swz / 64; C = (st & 1) * 32 + (swz % 64) / 2; }
__host__ __device__ __forceinline__ int perm32(int rho) { const int n = rho >> 4, i = rho & 15; return 8 * (i >> 2) + 4 * n + (i & 3); }

struct Unit { int pm, pn; };
struct Gemm { const bf16_t* A; const bf16_t* Bt; };

template <int M_, int N_> struct StaticOrder {
    static constexpr int nM = M_ / BM, nN = N_ / BM, nwg = nM * nN;
    int G, c;
    __host__ __device__ void init(int G_, int c_) { G = G_; c = c_; }
    __host__ __device__ bool next(int i, Unit& u) const {
        const long L = (long)i * G + c; if (L >= nwg) return false;
        int wgid = (int)L; { const int q = nwg / NXCD, r = nwg % NXCD, xcd = wgid % NXCD, off = wgid / NXCD; wgid = (xcd < r ? xcd * (q + 1) : r * (q + 1) + (xcd - r) * q) + off; }
        const int nig = WGM * nN, gid = wgid / nig, fm = gid * WGM, gsz = (nM - fm) < WGM ? (nM - fm) : WGM;
        u.pm = fm + ((wgid % nig) % gsz); u.pn = (wgid % nig) / gsz; return true;
    }
    __device__ __forceinline__ void a_ready(const Unit&) const {}
    __device__ __forceinline__ void done(const Unit&) const {}
};

typedef f32x4 Acc[2][2][4][2];

template <int MODE> struct EpiBf {
    static constexpr bool PERM = true, AFTER_DRAIN = false, HOOK = false;
    bf16_t* O; int ldc; const float* cosT; const float* sinT; int t0; const float* ssp;
    __device__ __forceinline__ void hook(Acc&, const Unit&, int, int, int, int, int) const {}
    struct Pre { float rs[2][4]; };
    __device__ __forceinline__ Pre pre(const Unit& u, int wr, int fr, int fq) const {
        Pre p; const int row0 = u.pm * BM + wr * 64 + fr;
#pragma unroll
        for (int ai = 0; ai < 2; ++ai)
#pragma unroll
            for (int m = 0; m < 4; ++m) { p.rs[ai][m] = 1.0f;
                if (ssp) { const f32x4 v = *(const f32x4*)(ssp + (size_t)(t0 + row0 + ai * HALF + m * 16) * 16 + 4 * fq); float q = (v[0] + v[1]) + (v[2] + v[3]); q = add_xor16(q); q = add_xor32(q); p.rs[ai][m] = rsqrtf(q * (1.0f / DM) + EPS); } }
        return p;
    }
    __device__ __forceinline__ void operator()(const Acc& acc, const Unit& u, int wr, int wc, int fr, int fq, const Pre& pr) const {
        const int row0 = u.pm * BM + wr * 64 + fr;
        if (MODE == 2 && u.pn >= 2 && u.pn < 6) {
            const int sec = (u.pn < 4) ? C_Q : C_K, head = 2 * (u.pn & 1) + (wc >> 1), i0 = 32 * (wc & 1) + 8 * fq;
            const float ksc0 = (u.pn >= 4) ? K_SCALE : 1.0f;
            const int dcol = sec + head * 128 + i0;
#pragma unroll
            for (int ai = 0; ai < 2; ++ai)
#pragma unroll
                for (int m = 0; m < 4; ++m) {
                    const int row = row0 + ai * HALF + m * 16; const size_t tr = (size_t)(t0 + row) * 64 + i0; const float ksc = ksc0 * pr.rs[ai][m];
                    const f32x4 c0 = *(const f32x4*)(cosT + tr), c1 = *(const f32x4*)(cosT + tr + 4), s0 = *(const f32x4*)(sinT + tr), s1 = *(const f32x4*)(sinT + tr + 4);
                    const f32x4 a0 = acc[ai][0][m][0], a1 = acc[ai][0][m][1], b0 = acc[ai][1][m][0], b1 = acc[ai][1][m][1];
                    const f32x4 o10 = (a0 * c0 - b0 * s0) * ksc, o11 = (a1 * c1 - b1 * s1) * ksc, o20 = (b0 * c0 + a0 * s0) * ksc, o21 = (b1 * c1 + a1 * s1) * ksc;
                    bf16_t* rowp = O + (size_t)row * ldc + dcol;
                    u32x4 w1, w2; w1.x = cvtpk(o10[0], o10[1]); w1.y = cvtpk(o10[2], o10[3]); w1.z = cvtpk(o11[0], o11[1]); w1.w = cvtpk(o11[2], o11[3]);
                    w2.x = cvtpk(o20[0], o20[1]); w2.y = cvtpk(o20[2], o20[3]); w2.z = cvtpk(o21[0], o21[1]); w2.w = cvtpk(o21[2], o21[3]);
                    *(u32x4*)rowp = w1; *(u32x4*)(rowp + 64) = w2;
                }
            return;
        }
        int cbase = u.pn * BM; float sc = 1.0f;
        if (MODE == 2) { const int pn = u.pn; if (pn < 2) cbase = 256 * pn; else if (pn < 10) cbase = C_V + 256 * (pn - 6); else if (pn < 14) cbase = C_G + 256 * (pn - 10); else { cbase = C_XQ + 256 * (pn - 14); sc = XQ_SCALE; } }
        const int col0 = cbase + wc * 32 + 8 * fq;
#pragma unroll
        for (int ai = 0; ai < 2; ++ai)
#pragma unroll
            for (int m = 0; m < 4; ++m) { bf16_t* rowp = O + (size_t)(row0 + ai * HALF + m * 16) * ldc + col0;
#pragma unroll
                for (int bj = 0; bj < 2; ++bj) { f32x4 v0 = acc[ai][bj][m][0], v1 = acc[ai][bj][m][1];
                    { const float f = sc * pr.rs[ai][m]; v0 = v0 * f; v1 = v1 * f; }
                    if (MODE == 1) { v0 = __builtin_elementwise_max(v0, (f32x4){0.f, 0.f, 0.f, 0.f}); v1 = __builtin_elementwise_max(v1, (f32x4){0.f, 0.f, 0.f, 0.f}); v0 = v0 * v0; v1 = v1 * v1; }
                    u32x4 w; w.x = cvtpk(v0[0], v0[1]); w.y = cvtpk(v0[2], v0[3]); w.z = cvtpk(v1[0], v1[1]); w.w = cvtpk(v1[2], v1[3]);
                    *(u32x4*)(rowp + bj * HALF) = w; } }
    }
};
struct EpiRes {
    static constexpr bool PERM = true, AFTER_DRAIN = false, HOOK = false;
    struct Pre {};
    __device__ __forceinline__ Pre pre(const Unit&, int, int, int) const { return Pre{}; }
    bf16_t* X; float* ssp; bf16_t* dummy;
    __device__ __forceinline__ void hook(Acc&, const Unit&, int, int, int, int, int) const {}
    __device__ __forceinline__ void operator()(const Acc& acc, const Unit& u, int wr, int wc, int fr, int fq, const Pre&) const {
        const int row0 = u.pm * BM + wr * 64 + fr, col0 = u.pn * BM + wc * 32 + 8 * fq;
#pragma unroll
        for (int ai = 0; ai < 2; ++ai)
#pragma unroll
            for (int m = 0; m < 4; ++m) { const int row = row0 + ai * HALF + m * 16; const size_t off = (size_t)row * 1024 + col0; float q = 0.f;
#pragma unroll
                for (int bj = 0; bj < 2; ++bj) { const u32x4 b = *(const u32x4*)(X + off + bj * HALF);
                    f32x4 x0 = acc[ai][bj][m][0], x1 = acc[ai][bj][m][1];
                    x0[0] += bflo(b[0]); x0[1] += bfhi(b[0]); x0[2] += bflo(b[1]); x0[3] += bfhi(b[1]); x1[0] += bflo(b[2]); x1[1] += bfhi(b[2]); x1[2] += bflo(b[3]); x1[3] += bfhi(b[3]);
                    q += ((x0[0] * x0[0] + x0[1] * x0[1]) + (x0[2] * x0[2] + x0[3] * x0[3])) + ((x1[0] * x1[0] + x1[1] * x1[1]) + (x1[2] * x1[2] + x1[3] * x1[3]));
                    u32x4 w; w.x = cvtpk(x0[0], x0[1]); w.y = cvtpk(x0[2], x0[3]); w.z = cvtpk(x1[0], x1[1]); w.w = cvtpk(x1[2], x1[3]);
                    *(u32x4*)((dummy ? dummy : X) + off + bj * HALF) = w; }
                q = add_xor16(q); q = add_xor32(q);
                if (fq == 0 && !dummy) ssp[(size_t)row * 16 + 4 * u.pn + wc] = q; }
    }
};
struct EpiUp {
    static constexpr bool PERM = true, AFTER_DRAIN = false, HOOK = true;
    struct Pre {};
    __device__ __forceinline__ Pre pre(const Unit&, int, int, int) const { return Pre{}; }
    bf16_t* O; const bf16_t* G;
    __device__ __forceinline__ void hook(Acc& acc, const Unit& u, int t, int wr, int wc, int fr, int fq) const {
        if (t != 8 && t != 24) return;
        const int gsel = (t == 8) ? 0 : 1024;
        int fr_ = fr, fq_ = fq; asm volatile("" : "+v"(fr_), "+v"(fq_));
        const int row0 = u.pm * BM + wr * 64 + fr_, col0 = u.pn * BM + wc * 32 + 8 * fq_;
#pragma unroll
        for (int ai = 0; ai < 2; ++ai) {
            u32x4 ga[4][2], gb[4][2];
#pragma unroll
            for (int m = 0; m < 4; ++m) { const bf16_t* gp = G + (size_t)(row0 + ai * HALF + m * 16) * 3072 + gsel + col0;
#pragma unroll
                for (int bj = 0; bj < 2; ++bj) { ga[m][bj] = *(const u32x4*)(gp + bj * HALF); gb[m][bj] = *(const u32x4*)(gp + 1024 + bj * HALF); } }
#pragma unroll
            for (int m = 0; m < 4; ++m)
#pragma unroll
                for (int bj = 0; bj < 2; ++bj) { float r[8];
#pragma unroll
                    for (int e = 0; e < 4; ++e) { const float a0 = fminf(fmaxf(bflo(ga[m][bj][e]), -60.f), 60.f), a1 = fminf(fmaxf(bfhi(ga[m][bj][e]), -60.f), 60.f), b0 = fminf(fmaxf(bflo(gb[m][bj][e]), -60.f), 60.f), b1 = fminf(fmaxf(bfhi(gb[m][bj][e]), -60.f), 60.f);
                        r[2 * e] = (1.0f + __expf(-b0)) * __builtin_amdgcn_rcpf(1.0f + __expf(-a0)); r[2 * e + 1] = (1.0f + __expf(-b1)) * __builtin_amdgcn_rcpf(1.0f + __expf(-a1)); }
                    f32x4 v0 = acc[ai][bj][m][0], v1 = acc[ai][bj][m][1];
                    v0[0] *= r[0]; v0[1] *= r[1]; v0[2] *= r[2]; v0[3] *= r[3]; v1[0] *= r[4]; v1[1] *= r[5]; v1[2] *= r[6]; v1[3] *= r[7];
                    acc[ai][bj][m][0] = v0; acc[ai][bj][m][1] = v1; }
            asm volatile("" ::: "memory"); }
    }
    __device__ __forceinline__ void operator()(const Acc& acc, const Unit& u, int wr, int wc, int fr, int fq, const Pre&) const {
        const int row0 = u.pm * BM + wr * 64 + fr, col0 = u.pn * BM + wc * 32 + 8 * fq;
#pragma unroll
        for (int ai = 0; ai < 2; ++ai)
#pragma unroll
            for (int m = 0; m < 4; ++m) { const int row = row0 + ai * HALF + m * 16; const bf16_t* gp = G + (size_t)row * 3072 + 2048 + col0; bf16_t* rowp = O + (size_t)row * 1024 + col0;
#pragma unroll
                for (int bj = 0; bj < 2; ++bj) { const u32x4 gc = *(const u32x4*)(gp + bj * HALF);
                    const f32x4 v0 = acc[ai][bj][m][0], v1 = acc[ai][bj][m][1];
                    u32x4 w; w.x = cvtpk(v0[0] * sigmoidf_(bflo(gc[0])), v0[1] * sigmoidf_(bfhi(gc[0]))); w.y = cvtpk(v0[2] * sigmoidf_(bflo(gc[1])), v0[3] * sigmoidf_(bfhi(gc[1])));
                    w.z = cvtpk(v1[0] * sigmoidf_(bflo(gc[2])), v1[1] * sigmoidf_(bfhi(gc[2]))); w.w = cvtpk(v1[2] * sigmoidf_(bflo(gc[3])), v1[3] * sigmoidf_(bfhi(gc[3])));
                    *(u32x4*)(rowp + bj * HALF) = w; } }
    }
};

template <int K, int LDA, int LDB, class Epi, class Sched, bool ALIGN_EPI = true>
__device__ __forceinline__ void gemm_phase(PG8_LAS unsigned char* lds, const Gemm g, const Sched& S, const Epi& E) {
    int tid_ = threadIdx.x; asm volatile("" : "+v"(tid_));
    const int tid = tid_, wid = __builtin_amdgcn_readfirstlane(tid >> 6), lane = tid & 63, wr = wid >> 2, wc = wid & 3, fr = lane & 15, fq = lane >> 4;
    constexpr int nt = K / BK;
    unsigned voffA[2], voffB[2];
#pragma unroll
    for (int i = 0; i < 2; ++i) { int R, C; stage_rc(tid * 16 + i * 8192, R, C); const int Rb = Epi::PERM ? ((R & ~31) + perm32(R & 31)) : R;
        voffA[i] = (unsigned)(R * LDA + C) * 2u; voffB[i] = (unsigned)(Rb * LDB + C) * 2u; }
    constexpr size_t kstep = (size_t)(BK * 2);
    constexpr size_t hstepA = (size_t)HALF * LDA * 2, hstepB = (size_t)HALF * LDB * 2;
    constexpr size_t tstepA = 2 * hstepA, tstepB = 2 * hstepB;
    const unsigned ldsw = (unsigned)wid * 1024u;
    const int aoff = lds_byte(wr * 64 + fr, fq * 8), boff = lds_byte(wc * 32 + fr, fq * 8);
#define PG8_SA(b, h) (((b) * 2 + (h)) * HTB)
#define PG8_SB(b, h) ((4 + (b) * 2 + (h)) * HTB)
#define PG8_STAGE(bufoff, gbase, voff) do { _Pragma("unroll") for (int _i = 0; _i < 2; ++_i) \
        __builtin_amdgcn_global_load_lds((const unsigned*)((const char*)(gbase) + (voff)[_i]), (PG8_LAS unsigned*)(lds + (bufoff) + ldsw + _i * 8192), 16, 0, 0); } while (0)
#define PG8_LDA(dst, b, h) do { _Pragma("unroll") for (int m = 0; m < 4; ++m) _Pragma("unroll") for (int k = 0; k < 2; ++k) dst[m][k] = *(const PG8_LAS bf16x8*)(lds + PG8_SA(b, h) + aoff + m * 2048 + k * 1024); } while (0)
#define PG8_LDB(dst, b, h) do { _Pragma("unroll") for (int n = 0; n < 2; ++n) _Pragma("unroll") for (int k = 0; k < 2; ++k) dst[n][k] = *(const PG8_LAS bf16x8*)(lds + PG8_SB(b, h) + boff + n * 2048 + k * 1024); } while (0)
#define PG8_MMA(ai, bj, At, Bt) do { __builtin_amdgcn_s_setprio(1); _Pragma("unroll") for (int m = 0; m < 4; ++m) _Pragma("unroll") for (int n = 0; n < 2; ++n) _Pragma("unroll") for (int k = 0; k < 2; ++k) \
        acc[ai][bj][m][n] = __builtin_amdgcn_mfma_f32_16x16x32_bf16(Bt[n][k], At[m][k], acc[ai][bj][m][n], 0, 0, 0); __builtin_amdgcn_s_setprio(0); } while (0)
#define PG8_WAIT_V(n) asm volatile("s_waitcnt vmcnt(" #n ")" ::: "memory")
#define PG8_WAIT_L(n) asm volatile("s_waitcnt lgkmcnt(" #n ")" ::: "memory")
#define PG8_BAR __builtin_amdgcn_s_barrier()
#define PG8_SCHED __builtin_amdgcn_sched_barrier(0)
    Unit cur, nxt; int ui = 0;
    if (!S.next(0, cur)) return;
    Acc acc;
#pragma unroll
    for (int a = 0; a < 2; ++a)
#pragma unroll
        for (int b = 0; b < 2; ++b)
#pragma unroll
            for (int m = 0; m < 4; ++m)
#pragma unroll
                for (int n = 0; n < 2; ++n) acc[a][b][m][n] = (f32x4){0.f, 0.f, 0.f, 0.f};
    bf16x8 At[4][2], B0[2][2], B1[2][2];
    const char* cA = (const char*)g.A + (size_t)cur.pm * tstepA; const char* cB = (const char*)g.Bt + (size_t)cur.pn * tstepB;
    S.a_ready(cur);
    typename Epi::Pre pre = E.pre(cur, wr, fr, fq);
    PG8_STAGE(PG8_SB(0, 0), cB, voffB); PG8_STAGE(PG8_SB(0, 1), cB + hstepB, voffB); PG8_STAGE(PG8_SA(0, 0), cA, voffA); PG8_STAGE(PG8_SA(0, 1), cA + hstepA, voffA);
    if (wr == 1) PG8_BAR;
    PG8_WAIT_V(2); PG8_BAR;
    PG8_STAGE(PG8_SB(1, 0), cB + kstep, voffB); PG8_STAGE(PG8_SA(1, 0), cA + kstep, voffA); PG8_STAGE(PG8_SB(1, 1), cB + hstepB + kstep, voffB);
    PG8_WAIT_V(6); PG8_BAR;
    for (;;) {
        const bool has_next = S.next(ui + 1, nxt);
        const char* nA = has_next ? (const char*)g.A + (size_t)nxt.pm * tstepA : cA; const char* nB = has_next ? (const char*)g.Bt + (size_t)nxt.pn * tstepB : cB;
        for (int t = 0; t < nt; t += 2) {
            const bool last = (t == nt - 2);
            const char* a1 = cA + (size_t)(t + 1) * kstep;
            const char* a2 = last ? nA : cA + (size_t)(t + 2) * kstep; const char* b2 = last ? nB : cB + (size_t)(t + 2) * kstep;
            const char* a3 = a2 + kstep; const char* b3 = b2 + kstep;
            if (last && has_next) S.a_ready(nxt);
            if constexpr (Epi::HOOK) { E.hook(acc, cur, t, wr, wc, fr, fq); PG8_SCHED; }
            PG8_LDB(B0, 0, 0); PG8_LDB(B1, 0, 1); PG8_SCHED; PG8_LDA(At, 0, 0); PG8_STAGE(PG8_SA(1, 1), a1 + hstepA, voffA);
            PG8_WAIT_V(8); PG8_WAIT_L(0); PG8_BAR; PG8_MMA(0, 0, At, B0); PG8_MMA(0, 1, At, B1); PG8_BAR; PG8_SCHED;
            PG8_LDA(At, 0, 1); PG8_STAGE(PG8_SB(0, 0), b2, voffB); PG8_STAGE(PG8_SB(0, 1), b2 + hstepB, voffB); PG8_STAGE(PG8_SA(0, 0), a2, voffA);
            PG8_WAIT_V(8); PG8_WAIT_L(0); PG8_BAR; PG8_MMA(1, 0, At, B0); PG8_MMA(1, 1, At, B1); PG8_BAR; PG8_SCHED;
            PG8_LDB(B0, 1, 0); PG8_LDB(B1, 1, 1); PG8_SCHED; PG8_LDA(At, 1, 0); PG8_STAGE(PG8_SA(0, 1), a2 + hstepA, voffA);
            PG8_WAIT_V(8); PG8_WAIT_L(0); PG8_BAR; PG8_MMA(0, 0, At, B0); PG8_MMA(0, 1, At, B1); PG8_BAR; PG8_SCHED;
            PG8_LDA(At, 1, 1); PG8_STAGE(PG8_SB(1, 0), b3, voffB); PG8_STAGE(PG8_SB(1, 1), b3 + hstepB, voffB); PG8_STAGE(PG8_SA(1, 0), a3, voffA);
            PG8_WAIT_V(8); PG8_WAIT_L(0); PG8_BAR; PG8_MMA(1, 0, At, B0); PG8_MMA(1, 1, At, B1); PG8_BAR; PG8_SCHED;
        }
        if constexpr (ALIGN_EPI) { if (wr == 0) PG8_BAR; }
        E(acc, cur, wr, wc, fr, fq, pre); S.done(cur);
        if (!has_next) break;
#pragma unroll
        for (int a = 0; a < 2; ++a)
#pragma unroll
            for (int b = 0; b < 2; ++b)
#pragma unroll
                for (int m = 0; m < 4; ++m)
#pragma unroll
                    for (int n = 0; n < 2; ++n) acc[a][b][m][n] = (f32x4){0.f, 0.f, 0.f, 0.f};
        cur = nxt; cA = nA; cB = nB; ++ui;
        pre = E.pre(cur, wr, fr, fq);
        if constexpr (ALIGN_EPI) { if (wr == 1) PG8_BAR; }
    }
    PG8_WAIT_V(0);
    if constexpr (!ALIGN_EPI) { if (wr == 0) PG8_BAR; }
    PG8_BAR;
#undef PG8_SA
#undef PG8_SB
#undef PG8_STAGE
#undef PG8_LDA
#undef PG8_LDB
#undef PG8_MMA
#undef PG8_WAIT_V
#undef PG8_WAIT_L
#undef PG8_BAR
#undef PG8_SCHED
}
}

#define XB_TMO      128
#define XB_XCNT(j)  (256  + 64 * (j))
#define XB_XSUB(j)  (1280 + 64 * (j))
#define XB_XGEN(j)  (2304 + 64 * (j))
#define XB_TOP      3328
#define XB_TOPGEN   3392
#define XCD_BAR_WORDS 3456
#define XB_SPIN_CAP (1u << 18)
__device__ __forceinline__ unsigned xb_ld(unsigned* p)              { return __hip_atomic_load(p, __ATOMIC_RELAXED, __HIP_MEMORY_SCOPE_AGENT); }
__device__ __forceinline__ unsigned xb_add(unsigned* p, unsigned v) { return __hip_atomic_fetch_add(p, v, __ATOMIC_RELAXED, __HIP_MEMORY_SCOPE_AGENT); }
__device__ __forceinline__ unsigned xb_xcc_id() { return (unsigned)__builtin_amdgcn_s_getreg((3 << 11) | 20) & 0xFu; }
#define XB_SPIN(cond, bar) do { unsigned _sp = 0; while (cond) { __builtin_amdgcn_s_sleep(1); \
    if ((++_sp & 255u) == 0u) { if (xb_ld(&(bar)[XB_TMO])) break; if (_sp > XB_SPIN_CAP) { atomicAdd(&(bar)[XB_TMO], 1u); break; } } } } while (0)
struct XcdBarrier { unsigned* bar; unsigned x; volatile LAS unsigned* st; };
__device__ __forceinline__ XcdBarrier xcd_barrier_post(unsigned* bar, volatile LAS unsigned* st) {
    XcdBarrier b; b.bar = bar; b.x = xb_xcc_id(); b.st = st;
    if (threadIdx.x == 0) (void)xb_add(&bar[XB_XCNT(b.x)], 1u);
    return b;
}
__device__ __forceinline__ void xcd_barrier_complete(unsigned* bar, unsigned x, unsigned& nloc, unsigned& nx) {
    const unsigned G = gridDim.x * gridDim.y * gridDim.z;
    unsigned sum, cnt, mine, sp = 0u;
    for (;;) {
        sum = 0u; cnt = 0u; mine = 0u;
#pragma unroll
        for (unsigned j = 0; j < 16; ++j) { const unsigned c = xb_ld(&bar[XB_XCNT(j)]); sum += c; cnt += (c > 0u) ? 1u : 0u; mine = (j == x) ? c : mine; }
        if (sum == G) break;
        __builtin_amdgcn_s_sleep(1);
        if ((++sp & 255u) == 0u) { if (xb_ld(&bar[XB_TMO])) break; if (sp > XB_SPIN_CAP) { atomicAdd(&bar[XB_TMO], 1u); break; } }
    }
    nloc = mine > 0u ? mine : 1u; nx = cnt > 0u ? cnt : 1u;
}
__device__ __forceinline__ void xcd_barrier(const XcdBarrier& b) {
    asm volatile("s_waitcnt vmcnt(0)" ::: "memory");
    __syncthreads();
    if (threadIdx.x == 0) {
        unsigned* bar = b.bar;
        __builtin_amdgcn_s_waitcnt(0);
        unsigned nloc = b.st[0], nx = b.st[1];
        if (nloc == 0u) { xcd_barrier_complete(bar, b.x, nloc, nx); b.st[0] = nloc; b.st[1] = nx; }
        const unsigned old = xb_add(&bar[XB_XSUB(b.x)], 1u);
        const unsigned gen = old / nloc;
        if (old + 1u == (gen + 1u) * nloc) {
            __builtin_amdgcn_fence(__ATOMIC_RELEASE, "agent");
            asm volatile("s_waitcnt vmcnt(0)" ::: "memory");
            const unsigned og = xb_add(&bar[XB_TOP], 1u);
            const unsigned tg = og / nx;
            if (og + 1u == (tg + 1u) * nx) xb_add(&bar[XB_TOPGEN], 1u);
            else XB_SPIN(xb_ld(&bar[XB_TOPGEN]) == tg, bar);
            __builtin_amdgcn_fence(__ATOMIC_ACQUIRE, "agent");
            xb_add(&bar[XB_XGEN(b.x)], 1u);
            asm volatile("s_waitcnt vmcnt(0)" ::: "memory");
        } else {
            XB_SPIN(xb_ld(&bar[XB_XGEN(b.x)]) == gen, bar);
            __builtin_amdgcn_fence(__ATOMIC_ACQUIRE, "agent");
            asm volatile("s_waitcnt vmcnt(0)" ::: "memory");
        }
    }
    __syncthreads();
}

struct Args { const float* in[18]; float* out; unsigned char* ws; int ph_lo, ph_hi; };
struct Frame {
    LAS unsigned char* lds;
    int vcu, G;
    unsigned char* ws;
};
__device__ __forceinline__ int opaque_tid() { int t = threadIdx.x; asm volatile("" : "+v"(t)); return t; }
#define TID ((int)threadIdx.x)
#define WSP(T_, off) ((T_*)(F.ws + (off)))
#define LDS_WAIT() asm volatile("s_waitcnt lgkmcnt(0)" ::: "memory")

struct TrDesc { const float* W; const float* gain; bf16* dst; int Nsrc, srccol0, k0, Kdst; };
__device__ __forceinline__ void tr_load(const TrDesc& d, f32x4 (&v)[16], int lane) {
#pragma unroll
    for (int i = 0; i < 16; ++i) v[i] = *(const f32x4*)(d.W + (size_t)(d.k0 + 4 * i + (lane >> 4)) * d.Nsrc + d.srccol0 + 4 * (lane & 15));
}
__device__ __forceinline__ void tr_finish(const TrDesc& d, const f32x4 (&v)[16], LAS float* scr, int lane) {
#pragma unroll
    for (int i = 0; i < 16; ++i) { const int kk = 4 * i + (lane >> 4); f32x4 x = v[i]; if (d.gain) x = x * d.gain[d.k0 + kk]; *(LAS f32x4*)(scr + kk * 68 + 4 * (lane & 15)) = x; }
    LDS_WAIT(); asm volatile("" ::: "memory");
    const int c = lane & 7;
#pragma unroll
    for (int j = 0; j < 8; ++j) { const int n = (lane >> 3) + 8 * j; const LAS float* sp = scr + (8 * c) * 68 + n;
        u32x4 o; o.x = cvtpk(sp[0 * 68], sp[1 * 68]); o.y = cvtpk(sp[2 * 68], sp[3 * 68]); o.z = cvtpk(sp[4 * 68], sp[5 * 68]); o.w = cvtpk(sp[6 * 68], sp[7 * 68]);
        *(u32x4*)(d.dst + (size_t)n * d.Kdst + d.k0 + 8 * c) = o; }
    LDS_WAIT(); asm volatile("" ::: "memory");
}
__device__ __forceinline__ int in_srccol(int n0) {
    if (n0 < C_Q || n0 >= C_V) return n0;
    const int tile = n0 >> 8, within = n0 & 255, bj = within >> 7, w = within & 127, sec = (tile < 4) ? C_Q : C_K;
    return sec + (2 * (tile & 1) + (w >> 6)) * 128 + (w & 63) + 64 * bj;
}
__device__ __forceinline__ void rms_row_bf16(const float* xrow, bf16* orow, int lane) {
    const f32x4* xr = (const f32x4*)xrow + lane; f32x4 v[4]; float s = 0.f;
#pragma unroll
    for (int j = 0; j < 4; ++j) { v[j] = xr[64 * j]; s += (v[j].x * v[j].x + v[j].y * v[j].y) + (v[j].z * v[j].z + v[j].w * v[j].w); }
    const float r = rsqrtf(wave_sum(s) * (1.0f / DM) + EPS);
    u32x2* o = (u32x2*)orow + lane;
#pragma unroll
    for (int j = 0; j < 4; ++j) { u32x2 w; w.x = cvtpk(v[j].x * r, v[j].y * r); w.y = cvtpk(v[j].z * r, v[j].w * r); o[64 * j] = w; }
}
__device__ __forceinline__ void norm_rows(Frame& F, const float* X, bf16* XB, int nrows) {
    const int tid = opaque_tid(), lane = tid & 63, wave = __builtin_amdgcn_readfirstlane(tid >> 6), fr = lane & 15, fq = lane >> 4; (void)tid; (void)lane; (void)wave; (void)fr; (void)fq;
    const int gw = F.vcu * 8 + wave, NGW = F.G * 8;
    for (int m = gw; m < nrows; m += NGW) rms_row_bf16(X + (size_t)m * DM, XB + (size_t)m * DM, lane);
}
__device__ __forceinline__ void final_norm(Frame& F, float* out, const float* g) {
    const int tid = opaque_tid(), lane = tid & 63, wave = __builtin_amdgcn_readfirstlane(tid >> 6);
    const int gw = F.vcu * 8 + wave, NGW = F.G * 8;
    for (int m = gw; m < T; m += NGW) {
        const float* sp = WSP(float, WS_SSP) + (size_t)m * 16; float q = 0.f;
#pragma unroll
        for (int j = 0; j < 16; ++j) q += sp[j];
        const float r = rsqrtf(q * (1.0f / DM) + EPS);
        const u32x2* xr = (const u32x2*)(WSP(bf16, WS_XB) + (size_t)m * DM) + lane; f32x4* o = (f32x4*)(out + (size_t)m * DM) + lane;
#pragma unroll
        for (int j = 0; j < 4; ++j) { const u32x2 v = xr[64 * j]; const f32x4 gg = *((const f32x4*)g + lane + 64 * j);
            o[64 * j] = (f32x4){bflo(v.x) * r * gg.x, bfhi(v.x) * r * gg.y, bflo(v.y) * r * gg.z, bfhi(v.y) * r * gg.w}; }
    }
}

__device__ __forceinline__ void p0_prologue(Frame& F, const Args& A) {
    const int tid = opaque_tid(), lane = tid & 63, wave = __builtin_amdgcn_readfirstlane(tid >> 6);
    LAS float* scr = (LAS float*)(F.lds + wave * 17408);
    const int gw = F.vcu * 8 + wave, NGW = F.G * 8;
    constexpr int I_IN = 16 * 112, I_MKV = 16 * 16, I_UR = 16 * 16, I_UM = 8 * 16, I_OUT = 16 * 16, I_1 = 16 * 64, I_2 = 64 * 16;
    constexpr int PER_L = I_IN + I_MKV + I_UR + I_UM + I_OUT + I_1 + I_2;
#define TR_DESC(d, it_) do { const int l_ = (it_) / PER_L; int r_ = (it_) % PER_L; unsigned char* wl_ = F.ws + WS_W + (size_t)l_ * W_LAYER; \
        if (r_ < I_IN) { const int kb = r_ / 112, nb = r_ % 112; d = TrDesc{A.in[4] + (size_t)l_ * DM * INC, A.in[3] + l_ * DM, (bf16*)(wl_ + WO_IN) + (size_t)(64 * nb) * DM, INC, in_srccol(64 * nb), 64 * kb, DM}; } \
        else if ((r_ -= I_IN) < I_MKV) { const int kb = r_ / 16, nb = r_ % 16; d = TrDesc{A.in[9] + (size_t)l_ * DM * 1024, A.in[8] + l_ * DM, (bf16*)(wl_ + WO_MKV) + (size_t)(64 * nb) * DM, 1024, 64 * nb, 64 * kb, DM}; } \
        else if ((r_ -= I_MKV) < I_UR) { const int kb = r_ / 16, nb = r_ % 16; d = TrDesc{A.in[11] + (size_t)l_ * 1024 * DM, A.in[7] + l_ * 1024, (bf16*)(wl_ + WO_UP) + (size_t)(64 * nb) * 2048 + 512, DM, 64 * nb, 64 * kb, 2048}; } \
        else if ((r_ -= I_UR) < I_UM) { const int kb = r_ / 16, nb = r_ % 16; d = TrDesc{A.in[12] + (size_t)l_ * 512 * DM, nullptr, (bf16*)(wl_ + WO_UP) + (size_t)(64 * nb) * 2048 + 1536, DM, 64 * nb, 64 * kb, 2048}; } \
        else if ((r_ -= I_UM) < I_OUT) { const int kb = r_ / 16, nb = r_ % 16; d = TrDesc{A.in[13] + (size_t)l_ * DM * DM, nullptr, (bf16*)(wl_ + WO_OUT) + (size_t)(64 * nb) * DM, DM, 64 * nb, 64 * kb, DM}; } \
        else if ((r_ -= I_OUT) < I_1) { const int kb = r_ / 64, nb = r_ % 64; d = TrDesc{A.in[15] + (size_t)l_ * DM * DFF, A.in[14] + l_ * DM, (bf16*)(wl_ + WO_1) + (size_t)(64 * nb) * DM, DFF, 64 * nb, 64 * kb, DM}; } \
        else { r_ -= I_1; const int kb = r_ / 16, nb = r_ % 16; d = TrDesc{A.in[16] + (size_t)l_ * DFF * DM, nullptr, (bf16*)(wl_ + WO_2) + (size_t)(64 * nb) * DFF, DM, 64 * nb, 64 * kb, DFF}; } } while (0)
    {
        TrDesc dA, dB; f32x4 vA[16], vB[16];
        int it = gw;
        if (it < 2 * PER_L) { TR_DESC(dA, it); tr_load(dA, vA, lane); }
        while (it < 2 * PER_L) {
            const int itB = it + NGW;
            if (itB < 2 * PER_L) { TR_DESC(dB, itB); tr_load(dB, vB, lane); }
            tr_finish(dA, vA, scr, lane);
            if (itB >= 2 * PER_L) break;
            const int itA = itB + NGW;
            if (itA < 2 * PER_L) { TR_DESC(dA, itA); tr_load(dA, vA, lane); }
            tr_finish(dB, vB, scr, lane);
            it = itA;
        }
    }
#undef TR_DESC
    const int gt = F.vcu * 512 + tid, NT = F.G * 512;
    {
        const float inv = (float)exp2(-(double)(gt & 63) * (13.287712379549449 / 64.0));
        const int* pos = (const int*)A.in[2];
        for (int i = gt; i < T * 64; i += NT) {
            const float a = (float)pos[i >> 6] * inv;
            const double ad = (double)a, k = rint(ad * 0.15915494309189535), rr = ad - k * 6.283185307179586;
            const float rf = (float)rr;
            WSP(float, WS_COS)[i] = cosf(rf); WSP(float, WS_SIN)[i] = sinf(rf);
        }
    }
    for (int m = gw; m < T; m += NGW) {
        const f32x4* xr = (const f32x4*)(A.in[0] + (size_t)m * DM) + 2 * lane; float q = 0.f; u32x4* o = (u32x4*)(WSP(bf16, WS_XB) + (size_t)m * DM) + lane;
#pragma unroll
        for (int j = 0; j < 2; ++j) { const f32x4 v = xr[128 * j], v2 = xr[128 * j + 1]; q += ((v.x * v.x + v.y * v.y) + (v.z * v.z + v.w * v.w)) + ((v2.x * v2.x + v2.y * v2.y) + (v2.z * v2.z + v2.w * v2.w));
            u32x4 w; w.x = cvtpk(v.x, v.y); w.y = cvtpk(v.z, v.w); w.z = cvtpk(v2.x, v2.y); w.w = cvtpk(v2.z, v2.w); o[64 * j] = w; }
        q = wave_sum(q);
        if (lane < 16) WSP(float, WS_SSP)[(size_t)m * 16 + lane] = (lane == 0) ? q : 0.f;
    }
    norm_rows(F, A.in[1], WSP(bf16, WS_MEMN), NB * NMEM);
    __syncthreads();
    LAS float* PW = (LAS float*)F.lds;
    LAS float* WU = (LAS float*)(F.lds + 128 * 129 * 4);
    for (int it = F.vcu; it < 2 * 4 * 32; it += F.G) {
        const int l = it >> 7, g = (it >> 5) & 3, n0 = (it & 31) * 32;
        const float* pw = A.in[5] + ((size_t)l * 512 + g * 128) * 128; const float* ps = A.in[6] + l * 512 + g * 128; const float* wu = A.in[10] + ((size_t)l * 512 + g * 128) * DM + n0;
        for (int i = tid; i < 128 * 128; i += 512) { const int c = i >> 7, cp = i & 127; PW[c * 129 + cp] = pw[i] * ps[cp]; }
        for (int i = tid; i < 128 * 8; i += 512) { const int cp = i >> 3, q = i & 7; *(LAS f32x4*)(WU + cp * 32 + 4 * q) = *(const f32x4*)(wu + (size_t)cp * DM + 4 * q); }
        __syncthreads();
        const int c = tid & 127, nq = tid >> 7;
        f32x4 s0 = {0.f, 0.f, 0.f, 0.f}, s1 = {0.f, 0.f, 0.f, 0.f};
#pragma unroll 8
        for (int cp = 0; cp < 128; ++cp) { const float p = PW[c * 129 + cp]; s0 += p * *(LAS f32x4*)(WU + cp * 32 + 8 * nq); s1 += p * *(LAS f32x4*)(WU + cp * 32 + 8 * nq + 4); }
        bf16* dst = (bf16*)(F.ws + WS_W + (size_t)l * W_LAYER + WO_UP) + (size_t)(n0 + 8 * nq) * 2048 + g * 128 + c;
#pragma unroll
        for (int j = 0; j < 4; ++j) { dst[(size_t)j * 2048] = (bf16)(cvtpk(s0[j], 0.f) & 0xffffu); dst[(size_t)(4 + j) * 2048] = (bf16)(cvtpk(s1[j], 0.f) & 0xffffu); }
        __syncthreads();
    }
}

__device__ __forceinline__ bf16x8 frag_tr(LAS unsigned char* Tt, int ldb, int rowA, int rowB, int col0, int fr) {
#if USE_TR
    const int q = fr >> 2, p = fr & 3;
    const s16x4 lo = __builtin_bit_cast(s16x4, __builtin_amdgcn_ds_read_tr16_b64_v4i16((LAS v4i16_t*)(Tt + (rowA + q) * ldb + (col0 + 4 * p) * 2)));
    const s16x4 hi = __builtin_bit_cast(s16x4, __builtin_amdgcn_ds_read_tr16_b64_v4i16((LAS v4i16_t*)(Tt + (rowB + q) * ldb + (col0 + 4 * p) * 2)));
    return __builtin_shufflevector(lo, hi, 0, 1, 2, 3, 4, 5, 6, 7);
#else
    bf16x8 f;
#pragma unroll
    for (int e = 0; e < 4; ++e) { f[e] = *(LAS short*)(Tt + (rowA + e) * ldb + (col0 + fr) * 2); f[4 + e] = *(LAS short*)(Tt + (rowB + e) * ldb + (col0 + fr) * 2); }
    return f;
#endif
}
__device__ __forceinline__ bf16x8 pack8(const f32x4& a, const f32x4& b) { u32x4 w; w.x = cvtpk(a[0], a[1]); w.y = cvtpk(a[2], a[3]); w.z = cvtpk(b[0], b[1]); w.w = cvtpk(b[2], b[3]); return __builtin_bit_cast(bf16x8, w); }
__device__ __forceinline__ float log2gamma(int h) { return log2f(1.0f - exp2f(-5.0f - (float)h)); }

__device__ __forceinline__ void mem_kv_proj(Frame& F) {
    const int tid = opaque_tid(), lane = tid & 63, wave = __builtin_amdgcn_readfirstlane(tid >> 6), fr = lane & 15, fq = lane >> 4;
    LAS unsigned char* As = F.lds; LAS unsigned char* Bs = F.lds + 33792;
    const int wm = wave & 3, wn = wave >> 2;
    for (int it = F.vcu; it < 512; it += F.G) {
        const int l = it >> 8, tm = (it >> 4) & 15, tn = it & 15;
        const bf16* Ag = WSP(bf16, WS_MEMN) + (size_t)(tm * 64) * DM; const bf16* Bg = WSP(bf16, WS_W + (size_t)l * W_LAYER + WO_MKV) + (size_t)(tn * 64) * DM;
        f32x4 acc[2]; acc[0] = (f32x4){0.f, 0.f, 0.f, 0.f}; acc[1] = (f32x4){0.f, 0.f, 0.f, 0.f};
        for (int kc = 0; kc < 4; ++kc) {
            __syncthreads();
#pragma unroll
            for (int k = 0; k < 4; ++k) { const int c = tid + 512 * k, r = c >> 5, ch = c & 31;
                *(LAS u32x4*)(As + r * 528 + ch * 16) = *(const u32x4*)(Ag + (size_t)r * DM + kc * 256 + ch * 8);
                *(LAS u32x4*)(Bs + r * 528 + ch * 16) = *(const u32x4*)(Bg + (size_t)r * DM + kc * 256 + ch * 8); }
            __syncthreads();
#pragma unroll
            for (int ks = 0; ks < 8; ++ks) { const bf16x8 af = *(LAS bf16x8*)(As + (16 * wm + fr) * 528 + (32 * ks + 8 * fq) * 2);
#pragma unroll
                for (int c = 0; c < 2; ++c) acc[c] = mfma16(*(LAS bf16x8*)(Bs + (32 * wn + 16 * c + fr) * 528 + (32 * ks + 8 * fq) * 2), af, acc[c]); }
        }
        bf16* dst = WSP(bf16, WS_KVMEM) + (size_t)l * 1024 * 1024 + (size_t)(tm * 64 + 16 * wm + fr) * 1024 + tn * 64 + 32 * wn + 4 * fq;
#pragma unroll
        for (int c = 0; c < 2; ++c) { u32x2 w; w.x = cvtpk(acc[c][0], acc[c][1]); w.y = cvtpk(acc[c][2], acc[c][3]); *(u32x2*)(dst + 16 * c) = w; }
    }
    __syncthreads();
}

template <int W> __device__ __forceinline__ void pool_item(bf16* P, int tl0, int c0) {
    const int pos0 = tl0 & (SEQ - 1);
    u32x4 r[W + 7];
#pragma unroll
    for (int i = 0; i < W + 7; ++i) { r[i] = (u32x4){0u, 0u, 0u, 0u}; if (pos0 - (W - 1) + i >= 0) r[i] = *(const u32x4*)(P + (size_t)(tl0 - (W - 1) + i) * PLD + c0); }
    float s[8];
#pragma unroll
    for (int e = 0; e < 8; ++e) s[e] = 0.f;
#pragma unroll
    for (int i = 0; i < W - 1; ++i)
#pragma unroll
        for (int e = 0; e < 4; ++e) { s[2 * e] += bflo(r[i][e]); s[2 * e + 1] += bfhi(r[i][e]); }
#pragma unroll
    for (int tt = 0; tt < 8; ++tt) {
        const int pos = pos0 + tt; const float rc = 1.0f / (float)((pos + 1 < W) ? pos + 1 : W);
        float d[8];
#pragma unroll
        for (int e = 0; e < 4; ++e) { const float u0 = bflo(r[W - 1 + tt][e]), u1 = bfhi(r[W - 1 + tt][e]); s[2 * e] += u0; s[2 * e + 1] += u1; d[2 * e] = s[2 * e] * rc - u0; d[2 * e + 1] = s[2 * e + 1] * rc - u1; }
        u32x4 o; o.x = cvtpk(d[0], d[1]); o.y = cvtpk(d[2], d[3]); o.z = cvtpk(d[4], d[5]); o.w = cvtpk(d[6], d[7]);
        *(u32x4*)(P + (size_t)(tl0 + tt) * PLD + C_DP + c0) = o;
#pragma unroll
        for (int e = 0; e < 4; ++e) { s[2 * e] -= bflo(r[tt][e]); s[2 * e + 1] -= bfhi(r[tt][e]); }
    }
}
__device__ __forceinline__ void mix_pool(Frame& F) {
    const int tid = opaque_tid(), lane = tid & 63, wave = __builtin_amdgcn_readfirstlane(tid >> 6);
    bf16* P = WSP(bf16, WS_PROJ);
    const int gw = F.vcu * 8 + wave, NGW = F.G * 8;
    for (int it = gw; it < 4 * (TH / 32); it += NGW) {
        const int g = it & 3, tl0 = (it >> 2) * 32 + (lane >> 4) * 8, c0 = g * 128 + (lane & 15) * 8;
        if (g == 0) pool_item<2>(P, tl0, c0); else if (g == 1) pool_item<4>(P, tl0, c0); else if (g == 2) pool_item<8>(P, tl0, c0); else pool_item<16>(P, tl0, c0);
    }
}

__device__ __forceinline__ void mix_mem(Frame& F, int l, int hf, bool dummy) {
    const int tid = opaque_tid(), lane = tid & 63, wave = __builtin_amdgcn_readfirstlane(tid >> 6), fr = lane & 15, fq = lane >> 4; (void)tid; (void)lane; (void)wave; (void)fr; (void)fq;
    bf16* P = WSP(bf16, WS_PROJ);
    LAS unsigned char* Kt = F.lds; LAS unsigned char* Vt = F.lds + 69632;
    const int items = 8 * 64, ipw = (items + F.G - 1) / F.G;
    const int it_lo = F.vcu * ipw, it_hi = (it_lo + ipw < items) ? it_lo + ipw : items;
    int loaded = -1;
    for (int it = it_lo; it < it_hi; ++it) {
        const int combo = it >> 6, qt = it & 63, bl = combo >> 2, h = combo & 3;
        if (combo != loaded) {
            __syncthreads();
            const bf16* src = WSP(bf16, WS_KVMEM) + (size_t)l * 1024 * 1024 + (size_t)((2 * hf + bl) * NMEM) * 1024 + h * 128;
            for (int c = tid; c < 4096; c += 512) { const int key = c >> 4, ch = c & 15;
                *(LAS u32x4*)(Kt + key * 272 + ch * 16) = *(const u32x4*)(src + (size_t)key * 1024 + ch * 8);
                *(LAS u32x4*)(Vt + key * 272 + ch * 16) = *(const u32x4*)(src + (size_t)key * 1024 + 512 + ch * 8); }
            __syncthreads(); loaded = combo;
        }
        bf16* qp = P + (size_t)(bl * SEQ + qt * 128 + wave * 16 + fr) * PLD + C_XQ + h * 128;
        bf16x8 bq[4];
#pragma unroll
        for (int ks = 0; ks < 4; ++ks) bq[ks] = *(const bf16x8*)(qp + ks * 32 + fq * 8);
        f32x4 s[16];
#pragma unroll
        for (int kt = 0; kt < 16; ++kt) { s[kt] = (f32x4){0.f, 0.f, 0.f, 0.f};
#pragma unroll
            for (int ks = 0; ks < 4; ++ks) s[kt] = mfma16(*(LAS bf16x8*)(Kt + (16 * kt + fr) * 272 + (32 * ks + 8 * fq) * 2), bq[ks], s[kt]); }
        float mx = -3.0e38f;
#pragma unroll
        for (int kt = 0; kt < 16; ++kt) mx = fmaxf(fmaxf(fmaxf(s[kt][0], s[kt][1]), fmaxf(s[kt][2], s[kt][3])), mx);
        mx = max_xor16(mx); mx = max_xor32(mx);
        float lsum = 0.f;
#pragma unroll
        for (int kt = 0; kt < 16; ++kt)
#pragma unroll
            for (int r = 0; r < 4; ++r) { const float p = exp2f(s[kt][r] - mx); s[kt][r] = p; lsum += p; }
        lsum = add_xor16(lsum); lsum = add_xor32(lsum);
        const float rl = 1.0f / lsum;
        f32x4 o[8];
#pragma unroll
        for (int dt = 0; dt < 8; ++dt) o[dt] = (f32x4){0.f, 0.f, 0.f, 0.f};
#pragma unroll
        for (int kp = 0; kp < 8; ++kp) { const bf16x8 pf = pack8(s[2 * kp], s[2 * kp + 1]);
#pragma unroll
            for (int dt = 0; dt < 8; ++dt) o[dt] = mfma16(frag_tr(Vt, 272, 32 * kp + 4 * fq, 32 * kp + 16 + 4 * fq, 16 * dt, fr), pf, o[dt]); }
        bf16* op = (dummy ? WSP(bf16, WS_MERGED) + (size_t)(bl * SEQ + qt * 128 + wave * 16 + fr) * 512 + h * 128 : qp) + 16 * (fq & 1) + 4 * (fq & 2);
#pragma unroll
        for (int p = 0; p < 4; ++p) { const unsigned ax = cvtpk(o[2 * p][0] * rl, o[2 * p][1] * rl), ay = cvtpk(o[2 * p][2] * rl, o[2 * p][3] * rl), bx_ = cvtpk(o[2 * p + 1][0] * rl, o[2 * p + 1][1] * rl), by = cvtpk(o[2 * p + 1][2] * rl, o[2 * p + 1][3] * rl);
            auto rx = __builtin_amdgcn_permlane16_swap(ax, bx_, false, false); auto ry = __builtin_amdgcn_permlane16_swap(ay, by, false, false);
            u32x4 w; w.x = rx[0]; w.y = ry[0]; w.z = rx[1]; w.w = ry[1]; *(u32x4*)(op + 32 * p) = w; }
    }
    __syncthreads();
}

__device__ __forceinline__ void mix_kv(Frame& F) {
    const int tid = opaque_tid(), lane = tid & 63, wave = __builtin_amdgcn_readfirstlane(tid >> 6), fr = lane & 15, fq = lane >> 4; (void)tid; (void)lane; (void)wave; (void)fr; (void)fq;
    bf16* P = WSP(bf16, WS_PROJ);
    LAS unsigned char* Kd = F.lds; LAS unsigned char* Vt = F.lds + 34816;
    for (int un = F.vcu; un < 512; un += F.G) {
        const int h = un & 3, n = (un >> 2) & 63, bl = un >> 8; const size_t row0 = (size_t)bl * SEQ + n * 128; const float lg = log2gamma(h);
        __syncthreads();
        for (int c = tid; c < 2048; c += 512) { const int j = c >> 4, ch = c & 15; const u32x4 v = *(const u32x4*)(P + (row0 + j) * PLD + C_K + h * 128 + ch * 8); const float f = exp2f((float)(127 - j) * lg);
            u32x4 o; o.x = cvtpk(bflo(v.x) * f, bfhi(v.x) * f); o.y = cvtpk(bflo(v.y) * f, bfhi(v.y) * f); o.z = cvtpk(bflo(v.z) * f, bfhi(v.z) * f); o.w = cvtpk(bflo(v.w) * f, bfhi(v.w) * f);
            *(LAS u32x4*)(Kd + j * 272 + ch * 16) = o; }
        for (int c = tid; c < 4096; c += 512) { const int j = c >> 5, ch = c & 31; *(LAS u32x4*)(Vt + j * 528 + ch * 16) = *(const u32x4*)(P + (row0 + j) * PLD + C_V + h * 256 + ch * 8); }
        __syncthreads();
        f32x4 acc[8][2];
#pragma unroll
        for (int dt = 0; dt < 8; ++dt) { acc[dt][0] = (f32x4){0.f, 0.f, 0.f, 0.f}; acc[dt][1] = (f32x4){0.f, 0.f, 0.f, 0.f}; }
#pragma unroll
        for (int ks = 0; ks < 4; ++ks) { const int rA = 32 * ks + 8 * fq, rB = rA + 4;
            const bf16x8 bv0 = frag_tr(Vt, 528, rA, rB, 16 * (2 * wave), fr), bv1 = frag_tr(Vt, 528, rA, rB, 16 * (2 * wave + 1), fr);
#pragma unroll
            for (int dt = 0; dt < 8; ++dt) { const bf16x8 ad = frag_tr(Kd, 272, rA, rB, 16 * dt, fr); acc[dt][0] = mfma16(ad, bv0, acc[dt][0]); acc[dt][1] = mfma16(ad, bv1, acc[dt][1]); } }
        bf16* dst = WSP(bf16, WS_KVN) + (size_t)un * 32768 + 16 * (fq & 1) + 4 * (fq & 2);
#pragma unroll
        for (int vi = 0; vi < 2; ++vi)
#pragma unroll
            for (int p = 0; p < 4; ++p) { const f32x4 a = acc[2 * p][vi], b = acc[2 * p + 1][vi];
                const unsigned ax = cvtpk(a[0], a[1]), ay = cvtpk(a[2], a[3]), bx_ = cvtpk(b[0], b[1]), by = cvtpk(b[2], b[3]);
                auto rx = __builtin_amdgcn_permlane16_swap(ax, bx_, false, false); auto ry = __builtin_amdgcn_permlane16_swap(ay, by, false, false);
                u32x4 o; o.x = rx[0]; o.y = ry[0]; o.z = rx[1]; o.w = ry[1];
                *(u32x4*)(dst + (size_t)(16 * (2 * wave + vi) + fr) * 128 + 32 * p) = o; }
    }
    __syncthreads();
}

__device__ __forceinline__ void scan_states(Frame& F) {
    const int tid = opaque_tid(), lane = tid & 63, wave = __builtin_amdgcn_readfirstlane(tid >> 6), fr = lane & 15, fq = lane >> 4; (void)tid; (void)lane; (void)wave; (void)fr; (void)fq;
    const bf16* KV = WSP(bf16, WS_KVN); bf16* SP = WSP(bf16, WS_SPREV);
    if (tid < 256)
    for (int p = F.vcu * 256 + tid; p < 8 * 8192; p += F.G * 256) {
        const int blk = p >> 13, bl = blk >> 2, h = blk & 3, off = (p & 8191) * 4; const float cd = exp2f(128.0f * log2gamma(h));
        f32x4 st = {0.f, 0.f, 0.f, 0.f};
        for (int n0 = 0; n0 < 64; n0 += 8) {
            u32x2 kv[8];
#pragma unroll
            for (int j = 0; j < 8; ++j) kv[j] = *(const u32x2*)(KV + (size_t)((bl * 64 + n0 + j) * 4 + h) * 32768 + off);
#pragma unroll
            for (int j = 0; j < 8; ++j) { u32x2 w; w.x = cvtpk(st[0], st[1]); w.y = cvtpk(st[2], st[3]); *(u32x2*)(SP + (size_t)((bl * 64 + n0 + j) * 4 + h) * 32768 + off) = w;
                st = st * cd + (f32x4){bflo(kv[j].x), bfhi(kv[j].x), bflo(kv[j].y), bfhi(kv[j].y)}; }
        }
    }
}

__device__ __forceinline__ void ret_out(Frame& F, bool dummy) {
    const int tid = opaque_tid(), lane = tid & 63, wave = __builtin_amdgcn_readfirstlane(tid >> 6), fr = lane & 15, fq = lane >> 4; (void)tid; (void)lane; (void)wave; (void)fr; (void)fq;
    bf16* P = WSP(bf16, WS_PROJ);
    LAS unsigned char* Kt = F.lds; LAS unsigned char* Vt = F.lds + 34816; LAS unsigned char* Sp = F.lds + 102400;
    for (int un = F.vcu; un < 512; un += F.G) {
        const int h = un & 3, n = (un >> 2) & 63, bl = un >> 8; const size_t row0 = (size_t)bl * SEQ + n * 128; const float lg = log2gamma(h);
        const bf16* spg = WSP(bf16, WS_SPREV) + (size_t)un * 32768;
        const int i = wave * 16 + fr; const size_t trow = row0 + i;
        bf16x8 bq[4];
#pragma unroll
        for (int ks = 0; ks < 4; ++ks) bq[ks] = *(const bf16x8*)(P + trow * PLD + C_Q + h * 128 + ks * 32 + fq * 8);
        bf16* gp = P + trow * PLD + C_G + h * 256 + 4 * fq;
        __syncthreads();
        for (int c = tid; c < 2048; c += 512) { const int j = c >> 4, ch = c & 15;
            *(LAS u32x4*)(Kt + j * 272 + ch * 16) = *(const u32x4*)(P + (row0 + j) * PLD + C_K + h * 128 + ch * 8);
            *(LAS u32x4*)(Sp + j * 272 + ch * 16) = *(const u32x4*)(spg + (size_t)j * 128 + ch * 8); }
        for (int c = tid; c < 4096; c += 512) { const int j = c >> 5, ch = c & 31; *(LAS u32x4*)(Vt + j * 528 + ch * 16) = *(const u32x4*)(P + (row0 + j) * PLD + C_V + h * 256 + ch * 8); }
        u32x4 sp1[4];
#pragma unroll
        for (int k = 0; k < 4; ++k) { const int c = tid + 512 * k, j = c >> 4, ch = c & 15; sp1[k] = *(const u32x4*)(spg + (size_t)(128 + j) * 128 + ch * 8); }
        __syncthreads();
        f32x4 acc[16];
#pragma unroll
        for (int vt = 0; vt < 8; ++vt) { acc[vt] = (f32x4){0.f, 0.f, 0.f, 0.f};
#pragma unroll
            for (int ks = 0; ks < 4; ++ks) acc[vt] = mfma16(*(LAS bf16x8*)(Sp + (16 * vt + fr) * 272 + (32 * ks + 8 * fq) * 2), bq[ks], acc[vt]); }
        __syncthreads();
#pragma unroll
        for (int k = 0; k < 4; ++k) { const int c = tid + 512 * k, j = c >> 4, ch = c & 15; *(LAS u32x4*)(Sp + j * 272 + ch * 16) = sp1[k]; }
        __syncthreads();
#pragma unroll
        for (int vt = 8; vt < 16; ++vt) { acc[vt] = (f32x4){0.f, 0.f, 0.f, 0.f};
#pragma unroll
            for (int ks = 0; ks < 4; ++ks) acc[vt] = mfma16(*(LAS bf16x8*)(Sp + (16 * (vt - 8) + fr) * 272 + (32 * ks + 8 * fq) * 2), bq[ks], acc[vt]); }
        bf16* gq = P + trow * PLD + C_G + h * 256 + 16 * (fq & 1) + 4 * (fq & 2);
        u32x4 gl[8];
#pragma unroll
        for (int p = 0; p < 8; ++p) gl[p] = *(const u32x4*)(gq + 32 * p);
        const float fac = exp2f((float)(i + 1) * lg);
#pragma unroll
        for (int vt = 0; vt < 16; ++vt) acc[vt] = acc[vt] * fac;
        f32x4 s[8];
#pragma unroll
        for (int kt = 0; kt < 8; ++kt) { s[kt] = (f32x4){0.f, 0.f, 0.f, 0.f};
            if (kt <= wave) {
#pragma unroll
                for (int ks = 0; ks < 4; ++ks) s[kt] = mfma16(*(LAS bf16x8*)(Kt + (16 * kt + fr) * 272 + (32 * ks + 8 * fq) * 2), bq[ks], s[kt]);
#pragma unroll
                for (int r = 0; r < 4; ++r) { const int key = 16 * kt + 4 * fq + r; s[kt][r] = (key <= i) ? s[kt][r] * exp2f((float)(i - key) * lg) : 0.f; } } }
#pragma unroll
        for (int kp = 0; kp < 4; ++kp) if (2 * kp <= wave) { const bf16x8 pf = pack8(s[2 * kp], s[2 * kp + 1]);
#pragma unroll
            for (int vt = 0; vt < 16; ++vt) acc[vt] = mfma16(frag_tr(Vt, 528, 32 * kp + 4 * fq, 32 * kp + 16 + 4 * fq, 16 * vt, fr), pf, acc[vt]); }
        float ss = 0.f;
#pragma unroll
        for (int vt = 0; vt < 16; ++vt) ss += (acc[vt][0] * acc[vt][0] + acc[vt][1] * acc[vt][1]) + (acc[vt][2] * acc[vt][2] + acc[vt][3] * acc[vt][3]);
        ss = add_xor16(ss); ss = add_xor32(ss);
        const float rinv = rsqrtf(ss * (1.0f / 256.0f) + EPS);
#pragma unroll
        for (int p = 0; p < 8; ++p) {
            u32x2 g[2];
            { auto rx = __builtin_amdgcn_permlane16_swap(gl[p][0], gl[p][2], false, false); auto ry = __builtin_amdgcn_permlane16_swap(gl[p][1], gl[p][3], false, false);
              g[0].x = rx[0]; g[0].y = ry[0]; g[1].x = rx[1]; g[1].y = ry[1]; }
            u32x2 w[2];
#pragma unroll
            for (int j = 0; j < 2; ++j) { const int vt = 2 * p + j; const float g0 = bflo(g[j].x), g1 = bfhi(g[j].x), g2 = bflo(g[j].y), g3 = bfhi(g[j].y);
                w[j].x = cvtpk(acc[vt][0] * rinv * g0 * sigmoidf_(g0), acc[vt][1] * rinv * g1 * sigmoidf_(g1)); w[j].y = cvtpk(acc[vt][2] * rinv * g2 * sigmoidf_(g2), acc[vt][3] * rinv * g3 * sigmoidf_(g3)); }
            u32x4 o;
            { auto rx = __builtin_amdgcn_permlane16_swap(w[0].x, w[1].x, false, false); auto ry = __builtin_amdgcn_permlane16_swap(w[0].y, w[1].y, false, false);
              o.x = rx[0]; o.y = ry[0]; o.z = rx[1]; o.w = ry[1]; }
            *(u32x4*)((dummy ? WSP(bf16, WS_MERGED) + trow * 1024 + h * 256 + 16 * (fq & 1) + 4 * (fq & 2) : gq) + 32 * p) = o; }
    }
    __syncthreads();
}

constexpr int N_PHASES = 1 + 2 * 16 + 1;
__global__ void __launch_bounds__(512, 2) fwd_kernel(Args args) {
    extern __shared__ __attribute__((aligned(16))) unsigned char lds_raw[];
    Frame F;
    F.lds = (LAS unsigned char*)lds_raw;
    F.G = gridDim.x; { const int bx = blockIdx.x; F.vcu = (F.G % 8 == 0) ? (bx % 8) * (F.G / 8) + bx / 8 : bx; }
    F.ws = args.ws;
    const Args& A = args;
    for (int u = TID; u < (LDS_BYTES - LDSCTL_OFF) / 4; u += 512) ((LAS unsigned*)(F.lds + LDSCTL_OFF))[u] = 0u;
    __syncthreads();
    const int lo = args.ph_lo, hi = args.ph_hi;
    XcdBarrier bar; bar.bar = WSP(unsigned, WS_CTL) + CW_BAR; bar.x = 0; bar.st = nullptr;
    if (hi - lo > 1) bar = xcd_barrier_post(WSP(unsigned, WS_CTL) + CW_BAR, (volatile LAS unsigned*)(F.lds + MISC_OFF) + 8);
    int ph = 0;
#define RUN() (lo <= ph && ph < hi)
#define END_PHASE() do { if (RUN() && ph + 1 < hi) xcd_barrier(bar); ++ph; } while (0)
    const int bx = (int)blockIdx.x;

    if (RUN()) for (int rep = 0; rep < REPS(10); ++rep) { if (rep) xcd_barrier(bar); p0_prologue(F, A); }
    END_PHASE();
#pragma unroll 1
    for (int l = 0; l < 2; ++l) {
        unsigned char* wl = F.ws + WS_W + (size_t)l * W_LAYER;
#pragma unroll 1
        for (int hf = 0; hf < 2; ++hf) {
            const int t0 = hf * TH;
            if (RUN()) for (int rep = 0; rep < REPS(0); ++rep) { if (rep) xcd_barrier(bar);
                if (l == 0 && hf == 0) mem_kv_proj(F);
                pg8::Gemm g{WSP(bf16, WS_XB) + (size_t)t0 * DM, (const bf16*)(wl + WO_IN)};
                pg8::StaticOrder<TH, 4096> S; S.init(F.G, bx);
                pg8::EpiBf<2> E{WSP(bf16, WS_PROJ), PLD, WSP(float, WS_COS), WSP(float, WS_SIN), t0, WSP(float, WS_SSP)};
                pg8::gemm_phase<DM, DM, DM, pg8::EpiBf<2>, pg8::StaticOrder<TH, 4096>>(F.lds, g, S, E);
            }
            END_PHASE();
            if (RUN()) for (int rep = 0; rep < REPS(1); ++rep) { if (rep) xcd_barrier(bar); mix_pool(F); mix_mem(F, l, hf, rep != 0); mix_kv(F); }
            END_PHASE();
            if (RUN()) for (int rep = 0; rep < REPS(2); ++rep) { if (rep) xcd_barrier(bar); scan_states(F); }
            END_PHASE();
            if (RUN()) for (int rep = 0; rep < REPS(3); ++rep) { if (rep) xcd_barrier(bar); ret_out(F, rep != 0); }
            END_PHASE();
            if (RUN()) for (int rep = 0; rep < REPS(4); ++rep) { if (rep) xcd_barrier(bar);
                pg8::Gemm g{WSP(bf16, WS_XB) + (size_t)t0 * DM, (const bf16*)(wl + WO_IN) + (size_t)4096 * DM};
                pg8::StaticOrder<TH, 3072> S; S.init(F.G, bx);
                pg8::EpiBf<0> E{WSP(bf16, WS_GATES), 3072, nullptr, nullptr, t0, WSP(float, WS_SSP)};
                pg8::gemm_phase<DM, DM, DM, pg8::EpiBf<0>, pg8::StaticOrder<TH, 3072>>(F.lds, g, S, E);
            }
            END_PHASE();
            if (RUN()) for (int rep = 0; rep < REPS(5); ++rep) { if (rep) xcd_barrier(bar);
                pg8::Gemm g{WSP(bf16, WS_PROJ) + C_DP, (const bf16*)(wl + WO_UP)};
                pg8::StaticOrder<TH, DM> S; S.init(F.G, bx);
                pg8::EpiUp E{WSP(bf16, WS_MERGED), WSP(bf16, WS_GATES)};
                pg8::gemm_phase<2048, PLD, 2048, pg8::EpiUp, pg8::StaticOrder<TH, DM>>(F.lds, g, S, E);
            }
            END_PHASE();
            if (RUN()) for (int rep = 0; rep < REPS(6); ++rep) { if (rep) xcd_barrier(bar);
                pg8::Gemm g{WSP(bf16, WS_MERGED), (const bf16*)(wl + WO_OUT)};
                pg8::StaticOrder<TH, DM> S; S.init(F.G, bx);
                pg8::EpiRes E{WSP(bf16, WS_XB) + (size_t)t0 * DM, WSP(float, WS_SSP) + (size_t)t0 * 16, rep ? WSP(bf16, WS_KVN) : nullptr};
                pg8::gemm_phase<DM, DM, DM, pg8::EpiRes, pg8::StaticOrder<TH, DM>>(F.lds, g, S, E);
            }
            END_PHASE();
        }
        if (RUN()) for (int rep = 0; rep < REPS(8); ++rep) { if (rep) xcd_barrier(bar);
            pg8::Gemm g{WSP(bf16, WS_XB), (const bf16*)(wl + WO_1)};
            pg8::StaticOrder<T, DFF> S; S.init(F.G, bx);
            pg8::EpiBf<1> E{WSP(bf16, WS_U), DFF, nullptr, nullptr, 0, WSP(float, WS_SSP)};
            pg8::gemm_phase<DM, DM, DM, pg8::EpiBf<1>, pg8::StaticOrder<T, DFF>>(F.lds, g, S, E);
        }
        END_PHASE();
        if (RUN()) {
            pg8::Gemm g{WSP(bf16, WS_U), (const bf16*)(wl + WO_2)};
            pg8::StaticOrder<T, DM> S; S.init(F.G, bx);
            pg8::EpiRes E{WSP(bf16, WS_XB), WSP(float, WS_SSP), nullptr};
            pg8::gemm_phase<DFF, DFF, DFF, pg8::EpiRes, pg8::StaticOrder<T, DM>>(F.lds, g, S, E);
#if (PROBE_DUP >> 9) & 1
            xcd_barrier(bar);
            { pg8::StaticOrder<TH, DM> S2; S2.init(F.G, bx); pg8::EpiRes E2{WSP(bf16, WS_XB), WSP(float, WS_SSP), (bf16*)(F.ws + WS_END)};
              pg8::gemm_phase<DFF, DFF, DFF, pg8::EpiRes, pg8::StaticOrder<TH, DM>>(F.lds, g, S2, E2); }
#endif
        }
        END_PHASE();
        if (l == 1) { if (RUN()) final_norm(F, A.out, A.in[17]); END_PHASE(); }
#if (PROBE_DUP >> 12) & 1
        for (int rep = 0; rep < 8; ++rep) xcd_barrier(bar);
#endif
    }
#undef RUN
#undef END_PHASE
}

extern "C" void kernel_launch(void* const* d_in, const int* in_sizes, int n_in, void* d_out, int out_size, void* d_ws, size_t ws_size, hipStream_t stream) {
    static int grid = 0;
    if (grid == 0) {
        if (n_in != 18 || in_sizes[0] != T * DM || out_size != T * DM || ws_size < WS_END) { fprintf(stderr, "kernel_launch: unexpected shapes / workspace (n_in %d, ws %zu)\n", n_in, ws_size); grid = -1; return; }
        int dev = 0, cus = 0, per_cu = 0;
        if (hipGetDevice(&dev) != hipSuccess || hipDeviceGetAttribute(&cus, hipDeviceAttributeMultiprocessorCount, dev) != hipSuccess) { grid = -1; return; }
        if (hipFuncSetAttribute((const void*)fwd_kernel, hipFuncAttributeMaxDynamicSharedMemorySize, LDS_BYTES) != hipSuccess) { fprintf(stderr, "kernel_launch: hipFuncSetAttribute failed\n"); grid = -1; return; }
        if (hipOccupancyMaxActiveBlocksPerMultiprocessor(&per_cu, (const void*)fwd_kernel, 512, LDS_BYTES) != hipSuccess || per_cu < 1) { fprintf(stderr, "kernel_launch: occupancy query says %d\n", per_cu); (void)hipGetLastError(); grid = -1; return; }
        grid = cus;
    }
    if (grid < 0) return;
    (void)hipMemsetAsync((char*)d_ws + WS_CTL, 0, CTL_ZERO_BYTES, stream);
    Args a{};
    for (int i = 0; i < 18; ++i) a.in[i] = (const float*)d_in[i];
    a.out = (float*)d_out; a.ws = (unsigned char*)d_ws;
#if MK_SINGLE
    a.ph_lo = 0; a.ph_hi = N_PHASES;
    hipLaunchKernelGGL(fwd_kernel, dim3(grid), dim3(512), LDS_BYTES, stream, a);
#else
    for (int p = 0; p < N_PHASES; ++p) { a.ph_lo = p; a.ph_hi = p + 1; hipLaunchKernelGGL(fwd_kernel, dim3(grid), dim3(512), LDS_BYTES, stream, a); }
#endif
}
```

```cpp
#include <hip/hip_runtime.h>
#include <cstdio>
#include <cstdint>

#ifndef MK_SINGLE
#define MK_SINGLE 1
#endif
#ifndef PROBE_DUP
#define PROBE_DUP 0
#endif
#define REPS(k) (1 + ((PROBE_DUP >> (k)) & 1))
#ifndef USE_TR
#define USE_TR 1
#endif

#define LAS __attribute__((address_space(3)))
#define GAS __attribute__((address_space(1)))
typedef unsigned short bf16;
typedef short bf16x8 __attribute__((ext_vector_type(8)));
typedef short s16x4 __attribute__((ext_vector_type(4)));
typedef float f32x4 __attribute__((ext_vector_type(4)));
typedef float f32x2 __attribute__((ext_vector_type(2)));
typedef unsigned u32x4 __attribute__((ext_vector_type(4)));
typedef unsigned u32x2 __attribute__((ext_vector_type(2)));
typedef __bf16 bf16x2_t __attribute__((ext_vector_type(2)));
typedef short v4i16_t __attribute__((ext_vector_type(4)));

constexpr int DM = 1024, NB = 4, SEQ = 8192, T = NB * SEQ, TH = T / 2, NMEM = 256, DFF = 4096;
constexpr int INC = 7168;
constexpr int PLD = 4608;
constexpr int C_Q = 512, C_K = 1024, C_V = 1536, C_DP = 2560, C_G = 3072, C_XQ = 4096;
constexpr float EPS = 1e-6f;
constexpr float XQ_SCALE = 0.08838834764831845f * 1.4426950408889634f;
constexpr float K_SCALE = 0.08838834764831845f;

constexpr size_t MiB = 1u << 20;
constexpr size_t WS_CTL = 0, CTL_ZERO_BYTES = 1 * MiB;
constexpr size_t WS_COS = 2 * MiB, WS_SIN = 10 * MiB;
constexpr size_t WS_SSP = 18 * MiB;
constexpr size_t WS_MEMN = 20 * MiB;
constexpr size_t WS_KVMEM = 24 * MiB;
constexpr size_t WS_W = 32 * MiB, W_LAYER = 38 * MiB;
constexpr size_t WO_IN = 0, WO_UP = 14 * MiB, WO_OUT = 18 * MiB, WO_1 = 20 * MiB, WO_2 = 28 * MiB, WO_MKV = 36 * MiB;
constexpr size_t WS_XB = 108 * MiB;
constexpr size_t WS_MERGED = 172 * MiB;
constexpr size_t WS_PROJ = 204 * MiB;
constexpr size_t WS_KVN = 348 * MiB;
constexpr size_t WS_SPREV = 412 * MiB;
constexpr size_t WS_GATES = 348 * MiB;
constexpr size_t WS_U = 172 * MiB;
constexpr size_t WS_END = 444 * MiB;
static_assert(WS_W + 2 * W_LAYER <= WS_XB && WS_U + (size_t)T * DFF * 2 <= WS_END && WS_PROJ + (size_t)TH * PLD * 2 <= WS_KVN, "ws map");
constexpr int CW_TMO = 0, CW_BAR = 4096;

constexpr int RING_BYTES = 131072, SCRATCH_BYTES = 147456, LDSCTL_OFF = SCRATCH_BYTES, MISC_OFF = LDSCTL_OFF + 320, LDS_BYTES = SCRATCH_BYTES + 1024;

__device__ __forceinline__ unsigned cvtpk(float lo, float hi) { f32x2 v = {lo, hi}; bf16x2_t b = __builtin_convertvector(v, bf16x2_t); return __builtin_bit_cast(unsigned, b); }
__device__ __forceinline__ float bflo(unsigned u) { return __uint_as_float(u << 16); }
__device__ __forceinline__ float bfhi(unsigned u) { return __uint_as_float(u & 0xffff0000u); }
__device__ __forceinline__ f32x4 mfma16(bf16x8 a, bf16x8 b, f32x4 c) { return __builtin_amdgcn_mfma_f32_16x16x32_bf16(a, b, c, 0, 0, 0); }
#define SWZ_XOR(m) (((m) << 10) | 0x1f)
__device__ __forceinline__ float wave_sum(float v) {
    v += __int_as_float(__builtin_amdgcn_ds_swizzle(__float_as_int(v), SWZ_XOR(1)));
    v += __int_as_float(__builtin_amdgcn_ds_swizzle(__float_as_int(v), SWZ_XOR(2)));
    v += __int_as_float(__builtin_amdgcn_ds_swizzle(__float_as_int(v), SWZ_XOR(4)));
    v += __int_as_float(__builtin_amdgcn_ds_swizzle(__float_as_int(v), SWZ_XOR(8)));
    { auto r = __builtin_amdgcn_permlane16_swap(__float_as_uint(v), __float_as_uint(v), false, false); v = __uint_as_float(r[0]) + __uint_as_float(r[1]); }
    { auto r = __builtin_amdgcn_permlane32_swap(__float_as_uint(v), __float_as_uint(v), false, false); v = __uint_as_float(r[0]) + __uint_as_float(r[1]); }
    return v;
}
__device__ __forceinline__ float add_xor16(float v) { auto r = __builtin_amdgcn_permlane16_swap(__float_as_uint(v), __float_as_uint(v), false, false); return __uint_as_float(r[0]) + __uint_as_float(r[1]); }
__device__ __forceinline__ float add_xor32(float v) { auto r = __builtin_amdgcn_permlane32_swap(__float_as_uint(v), __float_as_uint(v), false, false); return __uint_as_float(r[0]) + __uint_as_float(r[1]); }
__device__ __forceinline__ float max_xor16(float v) { auto r = __builtin_amdgcn_permlane16_swap(__float_as_uint(v), __float_as_uint(v), false, false); return fmaxf(__uint_as_float(r[0]), __uint_as_float(r[1])); }
__device__ __forceinline__ float max_xor32(float v) { auto r = __builtin_amdgcn_permlane32_swap(__float_as_uint(v), __float_as_uint(v), false, false); return fmaxf(__uint_as_float(r[0]), __uint_as_float(r[1])); }
__device__ __forceinline__ float sigmoidf_(float x) { return 1.0f / (1.0f + __expf(-x)); }

namespace pg8 {
#define PG8_LAS __attribute__((address_space(3)))
typedef unsigned short bf16_t;
constexpr int BM = 256, BK = 64, HALF = 128, HTB = HALF * BK * 2, STAGE_BYTES = 8 * HTB, NXCD = 8, WGM = 8;
__host__ __device__ __forceinline__ int lds_byte(int r, int c) { const int st = (r >> 4) * 2 + (c >> 5), rr = r & 15, cc = c & 31, ob = rr * 64 + cc * 2; return st * 1024 + (ob ^ (((ob >> 9) & 1) << 5)); }
__host__ __device__ __forceinline__ void stage_rc(int b, int& R, int& C) { const int st = b / 1024, sb = b % 1024, swz = sb ^ (((sb >> 9) & 1) << 5); R = (st >> 1) * 16 + swz / 64; C = (st & 1) * 32 + (swz % 64) / 2; }
__host__ __device__ __forceinline__ int perm32(int rho) { const int n = rho >> 4, i = rho & 15; return 8 * (i >> 2) + 4 * n + (i & 3); }

struct Unit { int pm, pn; };
struct Gemm { const bf16_t* A; const bf16_t* Bt; };

template <int M_, int N_, bool REV = false> struct StaticOrder {
    static constexpr int nM = M_ / BM, nN = N_ / BM, nwg = nM * nN;
    int G, c;
    __host__ __device__ void init(int G_, int c_) { G = G_; c = c_; }
    __host__ __device__ bool next(int i, Unit& u) const {
        const int nr = nwg / G; const bool rev = REV && (nwg % G == 0);
        if (rev && i >= nr) return false;
        const long L = (long)(rev ? nr - 1 - i : i) * G + c; if (L >= nwg) return false;
        int wgid = (int)L; { const int q = nwg / NXCD, r = nwg % NXCD, xcd = wgid % NXCD, off = wgid / NXCD; wgid = (xcd < r ? xcd * (q + 1) : r * (q + 1) + (xcd - r) * q) + off; }
        const int nig = WGM * nN, gid = wgid / nig, fm = gid * WGM, gsz = (nM - fm) < WGM ? (nM - fm) : WGM;
        u.pm = fm + ((wgid % nig) % gsz); u.pn = (wgid % nig) / gsz; return true;
    }
    __device__ __forceinline__ void a_ready(const Unit&) const {}
    __device__ __forceinline__ void done(const Unit&) const {}
};

typedef f32x4 Acc[2][2][4][2];

template <int MODE> struct EpiBf {
    static constexpr bool PERM = true, AFTER_DRAIN = false, HOOK = false;
    bf16_t* O; int ldc; const float* cosT; const float* sinT; int t0; const float* ssp;
    __device__ __forceinline__ void hook(Acc&, const Unit&, int, int, int, int, int) const {}
    struct Pre { float rs[2][4]; };
    __device__ __forceinline__ Pre pre(const Unit& u, int wr, int fr, int fq) const {
        Pre p; const int row0 = u.pm * BM + wr * 64 + fr;
#pragma unroll
        for (int ai = 0; ai < 2; ++ai)
#pragma unroll
            for (int m = 0; m < 4; ++m) { p.rs[ai][m] = 1.0f;
                if (ssp) { const f32x4 v = *(const f32x4*)(ssp + (size_t)(t0 + row0 + ai * HALF + m * 16) * 16 + 4 * fq); float q = (v[0] + v[1]) + (v[2] + v[3]); q = add_xor16(q); q = add_xor32(q); p.rs[ai][m] = rsqrtf(q * (1.0f / DM) + EPS); } }
        return p;
    }
    __device__ __forceinline__ void operator()(const Acc& acc, const Unit& u, int wr, int wc, int fr, int fq, const Pre& pr) const {
        const int row0 = u.pm * BM + wr * 64 + fr;
        if (MODE == 2 && u.pn >= 2 && u.pn < 6) {
            const int sec = (u.pn < 4) ? C_Q : C_K, head = 2 * (u.pn & 1) + (wc >> 1), i0 = 32 * (wc & 1) + 8 * fq;
            const float ksc0 = (u.pn >= 4) ? K_SCALE : 1.0f;
            const int dcol = sec + head * 128 + i0;
#pragma unroll
            for (int ai = 0; ai < 2; ++ai)
#pragma unroll
                for (int m = 0; m < 4; ++m) {
                    const int row = row0 + ai * HALF + m * 16; const size_t tr = (size_t)(t0 + row) * 64 + i0; const float ksc = ksc0 * pr.rs[ai][m];
                    const f32x4 c0 = *(const f32x4*)(cosT + tr), c1 = *(const f32x4*)(cosT + tr + 4), s0 = *(const f32x4*)(sinT + tr), s1 = *(const f32x4*)(sinT + tr + 4);
                    const f32x4 a0 = acc[ai][0][m][0], a1 = acc[ai][0][m][1], b0 = acc[ai][1][m][0], b1 = acc[ai][1][m][1];
                    const f32x4 o10 = (a0 * c0 - b0 * s0) * ksc, o11 = (a1 * c1 - b1 * s1) * ksc, o20 = (b0 * c0 + a0 * s0) * ksc, o21 = (b1 * c1 + a1 * s1) * ksc;
                    bf16_t* rowp = O + (size_t)row * ldc + dcol;
                    u32x4 w1, w2; w1.x = cvtpk(o10[0], o10[1]); w1.y = cvtpk(o10[2], o10[3]); w1.z = cvtpk(o11[0], o11[1]); w1.w = cvtpk(o11[2], o11[3]);
                    w2.x = cvtpk(o20[0], o20[1]); w2.y = cvtpk(o20[2], o20[3]); w2.z = cvtpk(o21[0], o21[1]); w2.w = cvtpk(o21[2], o21[3]);
                    *(u32x4*)rowp = w1; *(u32x4*)(rowp + 64) = w2;
                }
            return;
        }
        int cbase = u.pn * BM; float sc = 1.0f;
        if (MODE == 2) { const int pn = u.pn; if (pn < 2) cbase = 256 * pn; else if (pn < 10) cbase = C_V + 256 * (pn - 6); else if (pn < 14) cbase = C_G + 256 * (pn - 10); else { cbase = C_XQ + 256 * (pn - 14); sc = XQ_SCALE; } }
        const int col0 = cbase + wc * 32 + 8 * fq;
#pragma unroll
        for (int ai = 0; ai < 2; ++ai)
#pragma unroll
            for (int m = 0; m < 4; ++m) { bf16_t* rowp = O + (size_t)(row0 + ai * HALF + m * 16) * ldc + col0;
#pragma unroll
                for (int bj = 0; bj < 2; ++bj) { f32x4 v0 = acc[ai][bj][m][0], v1 = acc[ai][bj][m][1];
                    { const float f = sc * pr.rs[ai][m]; v0 = v0 * f; v1 = v1 * f; }
                    if (MODE == 1) { v0 = __builtin_elementwise_max(v0, (f32x4){0.f, 0.f, 0.f, 0.f}); v1 = __builtin_elementwise_max(v1, (f32x4){0.f, 0.f, 0.f, 0.f}); v0 = v0 * v0; v1 = v1 * v1; }
                    u32x4 w; w.x = cvtpk(v0[0], v0[1]); w.y = cvtpk(v0[2], v0[3]); w.z = cvtpk(v1[0], v1[1]); w.w = cvtpk(v1[2], v1[3]);
                    *(u32x4*)(rowp + bj * HALF) = w; } }
    }
};
struct EpiRes {
    static constexpr bool PERM = true, AFTER_DRAIN = false, HOOK = false;
    struct Pre {};
    __device__ __forceinline__ Pre pre(const Unit&, int, int, int) const { return Pre{}; }
    bf16_t* X; float* ssp; bf16_t* dummy;
    __device__ __forceinline__ void hook(Acc&, const Unit&, int, int, int, int, int) const {}
    __device__ __forceinline__ void operator()(const Acc& acc, const Unit& u, int wr, int wc, int fr, int fq, const Pre&) const {
        const int row0 = u.pm * BM + wr * 64 + fr, col0 = u.pn * BM + wc * 32 + 8 * fq;
#pragma unroll
        for (int ai = 0; ai < 2; ++ai)
#pragma unroll
            for (int m = 0; m < 4; ++m) { const int row = row0 + ai * HALF + m * 16; const size_t off = (size_t)row * 1024 + col0; float q = 0.f;
#pragma unroll
                for (int bj = 0; bj < 2; ++bj) { const u32x4 b = *(const u32x4*)(X + off + bj * HALF);
                    f32x4 x0 = acc[ai][bj][m][0], x1 = acc[ai][bj][m][1];
                    x0[0] += bflo(b[0]); x0[1] += bfhi(b[0]); x0[2] += bflo(b[1]); x0[3] += bfhi(b[1]); x1[0] += bflo(b[2]); x1[1] += bfhi(b[2]); x1[2] += bflo(b[3]); x1[3] += bfhi(b[3]);
                    q += ((x0[0] * x0[0] + x0[1] * x0[1]) + (x0[2] * x0[2] + x0[3] * x0[3])) + ((x1[0] * x1[0] + x1[1] * x1[1]) + (x1[2] * x1[2] + x1[3] * x1[3]));
                    u32x4 w; w.x = cvtpk(x0[0], x0[1]); w.y = cvtpk(x0[2], x0[3]); w.z = cvtpk(x1[0], x1[1]); w.w = cvtpk(x1[2], x1[3]);
                    *(u32x4*)((dummy ? dummy : X) + off + bj * HALF) = w; }
                q = add_xor16(q); q = add_xor32(q);
                if (fq == 0 && !dummy) ssp[(size_t)row * 16 + 4 * u.pn + wc] = q; }
    }
};
struct EpiUp {
    static constexpr bool PERM = true, AFTER_DRAIN = false, HOOK = true;
    struct Pre {};
    __device__ __forceinline__ Pre pre(const Unit&, int, int, int) const { return Pre{}; }
    bf16_t* O; const bf16_t* G;
    __device__ __forceinline__ void hook(Acc& acc, const Unit& u, int t, int wr, int wc, int fr, int fq) const {
        if (t != 8 && t != 24) return;
        const int gsel = (t == 8) ? 0 : 1024;
        int fr_ = fr, fq_ = fq; asm volatile("" : "+v"(fr_), "+v"(fq_));
        const int row0 = u.pm * BM + wr * 64 + fr_, col0 = u.pn * BM + wc * 32 + 8 * fq_;
#pragma unroll
        for (int ai = 0; ai < 2; ++ai) {
            u32x4 ga[4][2], gb[4][2];
#pragma unroll
            for (int m = 0; m < 4; ++m) { const bf16_t* gp = G + (size_t)(row0 + ai * HALF + m * 16) * 3072 + gsel + col0;
#pragma unroll
                for (int bj = 0; bj < 2; ++bj) { ga[m][bj] = *(const u32x4*)(gp + bj * HALF); gb[m][bj] = *(const u32x4*)(gp + 1024 + bj * HALF); } }
#pragma unroll
            for (int m = 0; m < 4; ++m)
#pragma unroll
                for (int bj = 0; bj < 2; ++bj) { float r[8];
#pragma unroll
                    for (int e = 0; e < 4; ++e) { const float a0 = fminf(fmaxf(bflo(ga[m][bj][e]), -60.f), 60.f), a1 = fminf(fmaxf(bfhi(ga[m][bj][e]), -60.f), 60.f), b0 = fminf(fmaxf(bflo(gb[m][bj][e]), -60.f), 60.f), b1 = fminf(fmaxf(bfhi(gb[m][bj][e]), -60.f), 60.f);
                        r[2 * e] = (1.0f + __expf(-b0)) * __builtin_amdgcn_rcpf(1.0f + __expf(-a0)); r[2 * e + 1] = (1.0f + __expf(-b1)) * __builtin_amdgcn_rcpf(1.0f + __expf(-a1)); }
                    f32x4 v0 = acc[ai][bj][m][0], v1 = acc[ai][bj][m][1];
                    v0[0] *= r[0]; v0[1] *= r[1]; v0[2] *= r[2]; v0[3] *= r[3]; v1[0] *= r[4]; v1[1] *= r[5]; v1[2] *= r[6]; v1[3] *= r[7];
                    acc[ai][bj][m][0] = v0; acc[ai][bj][m][1] = v1; }
            asm volatile("" ::: "memory"); }
    }
    __device__ __forceinline__ void operator()(const Acc& acc, const Unit& u, int wr, int wc, int fr, int fq, const Pre&) const {
        const int row0 = u.pm * BM + wr * 64 + fr, col0 = u.pn * BM + wc * 32 + 8 * fq;
#pragma unroll
        for (int ai = 0; ai < 2; ++ai)
#pragma unroll
            for (int m = 0; m < 4; ++m) { const int row = row0 + ai * HALF + m * 16; const bf16_t* gp = G + (size_t)row * 3072 + 2048 + col0; bf16_t* rowp = O + (size_t)row * 1024 + col0;
#pragma unroll
                for (int bj = 0; bj < 2; ++bj) { const u32x4 gc = *(const u32x4*)(gp + bj * HALF);
                    const f32x4 v0 = acc[ai][bj][m][0], v1 = acc[ai][bj][m][1];
                    u32x4 w; w.x = cvtpk(v0[0] * sigmoidf_(bflo(gc[0])), v0[1] * sigmoidf_(bfhi(gc[0]))); w.y = cvtpk(v0[2] * sigmoidf_(bflo(gc[1])), v0[3] * sigmoidf_(bfhi(gc[1])));
                    w.z = cvtpk(v1[0] * sigmoidf_(bflo(gc[2])), v1[1] * sigmoidf_(bfhi(gc[2]))); w.w = cvtpk(v1[2] * sigmoidf_(bflo(gc[3])), v1[3] * sigmoidf_(bfhi(gc[3])));
                    *(u32x4*)(rowp + bj * HALF) = w; } }
    }
};

template <int K, int LDA, int LDB, class Epi, class Sched, bool ALIGN_EPI = true>
__device__ __forceinline__ void gemm_phase(PG8_LAS unsigned char* lds, const Gemm g, const Sched& S, const Epi& E) {
    int tid_ = threadIdx.x; asm volatile("" : "+v"(tid_));
    const int tid = tid_, wid = __builtin_amdgcn_readfirstlane(tid >> 6), lane = tid & 63, wr = wid >> 2, wc = wid & 3, fr = lane & 15, fq = lane >> 4;
    constexpr int nt = K / BK;
    unsigned voffA[2], voffB[2];
#pragma unroll
    for (int i = 0; i < 2; ++i) { int R, C; stage_rc(tid * 16 + i * 8192, R, C); const int Rb = Epi::PERM ? ((R & ~31) + perm32(R & 31)) : R;
        voffA[i] = (unsigned)(R * LDA + C) * 2u; voffB[i] = (unsigned)(Rb * LDB + C) * 2u; }
    constexpr size_t kstep = (size_t)(BK * 2);
    constexpr size_t hstepA = (size_t)HALF * LDA * 2, hstepB = (size_t)HALF * LDB * 2;
    constexpr size_t tstepA = 2 * hstepA, tstepB = 2 * hstepB;
    const unsigned ldsw = (unsigned)wid * 1024u;
    const int aoff = lds_byte(wr * 64 + fr, fq * 8), boff = lds_byte(wc * 32 + fr, fq * 8);
#define PG8_SA(b, h) (((b) * 2 + (h)) * HTB)
#define PG8_SB(b, h) ((4 + (b) * 2 + (h)) * HTB)
#define PG8_STAGE(bufoff, gbase, voff) do { _Pragma("unroll") for (int _i = 0; _i < 2; ++_i) \
        __builtin_amdgcn_global_load_lds((const unsigned*)((const char*)(gbase) + (voff)[_i]), (PG8_LAS unsigned*)(lds + (bufoff) + ldsw + _i * 8192), 16, 0, 0); } while (0)
#define PG8_LDA(dst, b, h) do { _Pragma("unroll") for (int m = 0; m < 4; ++m) _Pragma("unroll") for (int k = 0; k < 2; ++k) dst[m][k] = *(const PG8_LAS bf16x8*)(lds + PG8_SA(b, h) + aoff + m * 2048 + k * 1024); } while (0)
#define PG8_LDB(dst, b, h) do { _Pragma("unroll") for (int n = 0; n < 2; ++n) _Pragma("unroll") for (int k = 0; k < 2; ++k) dst[n][k] = *(const PG8_LAS bf16x8*)(lds + PG8_SB(b, h) + boff + n * 2048 + k * 1024); } while (0)
#define PG8_MMA(ai, bj, At, Bt) do { __builtin_amdgcn_s_setprio(1); _Pragma("unroll") for (int m = 0; m < 4; ++m) _Pragma("unroll") for (int n = 0; n < 2; ++n) _Pragma("unroll") for (int k = 0; k < 2; ++k) \
        acc[ai][bj][m][n] = __builtin_amdgcn_mfma_f32_16x16x32_bf16(Bt[n][k], At[m][k], acc[ai][bj][m][n], 0, 0, 0); __builtin_amdgcn_s_setprio(0); } while (0)
#define PG8_WAIT_V(n) asm volatile("s_waitcnt vmcnt(" #n ")" ::: "memory")
#define PG8_WAIT_L(n) asm volatile("s_waitcnt lgkmcnt(" #n ")" ::: "memory")
#define PG8_BAR __builtin_amdgcn_s_barrier()
#define PG8_SCHED __builtin_amdgcn_sched_barrier(0)
    Unit cur, nxt; int ui = 0;
    if (!S.next(0, cur)) return;
    Acc acc;
#pragma unroll
    for (int a = 0; a < 2; ++a)
#pragma unroll
        for (int b = 0; b < 2; ++b)
#pragma unroll
            for (int m = 0; m < 4; ++m)
#pragma unroll
                for (int n = 0; n < 2; ++n) acc[a][b][m][n] = (f32x4){0.f, 0.f, 0.f, 0.f};
    bf16x8 At[4][2], B0[2][2], B1[2][2];
    const char* cA = (const char*)g.A + (size_t)cur.pm * tstepA; const char* cB = (const char*)g.Bt + (size_t)cur.pn * tstepB;
    S.a_ready(cur);
    typename Epi::Pre pre = E.pre(cur, wr, fr, fq);
    PG8_STAGE(PG8_SB(0, 0), cB, voffB); PG8_STAGE(PG8_SB(0, 1), cB + hstepB, voffB); PG8_STAGE(PG8_SA(0, 0), cA, voffA); PG8_STAGE(PG8_SA(0, 1), cA + hstepA, voffA);
    if (wr == 1) PG8_BAR;
    PG8_WAIT_V(2); PG8_BAR;
    PG8_STAGE(PG8_SB(1, 0), cB + kstep, voffB); PG8_STAGE(PG8_SA(1, 0), cA + kstep, voffA); PG8_STAGE(PG8_SB(1, 1), cB + hstepB + kstep, voffB);
    PG8_WAIT_V(6); PG8_BAR;
    for (;;) {
        const bool has_next = S.next(ui + 1, nxt);
        const char* nA = has_next ? (const char*)g.A + (size_t)nxt.pm * tstepA : cA; const char* nB = has_next ? (const char*)g.Bt + (size_t)nxt.pn * tstepB : cB;
        for (int t = 0; t < nt; t += 2) {
            const bool last = (t == nt - 2);
            const char* a1 = cA + (size_t)(t + 1) * kstep;
            const char* a2 = last ? nA : cA + (size_t)(t + 2) * kstep; const char* b2 = last ? nB : cB + (size_t)(t + 2) * kstep;
            const char* a3 = a2 + kstep; const char* b3 = b2 + kstep;
            if (last && has_next) S.a_ready(nxt);
            if constexpr (Epi::HOOK) { E.hook(acc, cur, t, wr, wc, fr, fq); PG8_SCHED; }
            PG8_LDB(B0, 0, 0); PG8_LDB(B1, 0, 1); PG8_SCHED; PG8_LDA(At, 0, 0); PG8_STAGE(PG8_SA(1, 1), a1 + hstepA, voffA);
            PG8_WAIT_V(8); PG8_WAIT_L(0); PG8_BAR; PG8_MMA(0, 0, At, B0); PG8_MMA(0, 1, At, B1); PG8_BAR; PG8_SCHED;
            PG8_LDA(At, 0, 1); PG8_STAGE(PG8_SB(0, 0), b2, voffB); PG8_STAGE(PG8_SB(0, 1), b2 + hstepB, voffB); PG8_STAGE(PG8_SA(0, 0), a2, voffA);
            PG8_WAIT_V(8); PG8_WAIT_L(0); PG8_BAR; PG8_MMA(1, 0, At, B0); PG8_MMA(1, 1, At, B1); PG8_BAR; PG8_SCHED;
            PG8_LDB(B0, 1, 0); PG8_LDB(B1, 1, 1); PG8_SCHED; PG8_LDA(At, 1, 0); PG8_STAGE(PG8_SA(0, 1), a2 + hstepA, voffA);
            PG8_WAIT_V(8); PG8_WAIT_L(0); PG8_BAR; PG8_MMA(0, 0, At, B0); PG8_MMA(0, 1, At, B1); PG8_BAR; PG8_SCHED;
            PG8_LDA(At, 1, 1); PG8_STAGE(PG8_SB(1, 0), b3, voffB); PG8_STAGE(PG8_SB(1, 1), b3 + hstepB, voffB); PG8_STAGE(PG8_SA(1, 0), a3, voffA);
            PG8_WAIT_V(8); PG8_WAIT_L(0); PG8_BAR; PG8_MMA(1, 0, At, B0); PG8_MMA(1, 1, At, B1); PG8_BAR; PG8_SCHED;
        }
        if constexpr (ALIGN_EPI) { if (wr == 0) PG8_BAR; }
        E(acc, cur, wr, wc, fr, fq, pre); S.done(cur);
        if (!has_next) break;
#pragma unroll
        for (int a = 0; a < 2; ++a)
#pragma unroll
            for (int b = 0; b < 2; ++b)
#pragma unroll
                for (int m = 0; m < 4; ++m)
#pragma unroll
                    for (int n = 0; n < 2; ++n) acc[a][b][m][n] = (f32x4){0.f, 0.f, 0.f, 0.f};
        cur = nxt; cA = nA; cB = nB; ++ui;
        pre = E.pre(cur, wr, fr, fq);
        if constexpr (ALIGN_EPI) { if (wr == 1) PG8_BAR; }
    }
    PG8_WAIT_V(0);
    if constexpr (!ALIGN_EPI) { if (wr == 0) PG8_BAR; }
    PG8_BAR;
#undef PG8_SA
#undef PG8_SB
#undef PG8_STAGE
#undef PG8_LDA
#undef PG8_LDB
#undef PG8_MMA
#undef PG8_WAIT_V
#undef PG8_WAIT_L
#undef PG8_BAR
#undef PG8_SCHED
}
}

#define XB_TMO      128
#define XB_XCNT(j)  (256  + 64 * (j))
#define XB_XSUB(j)  (1280 + 64 * (j))
#define XB_XGEN(j)  (2304 + 64 * (j))
#define XB_TOP      3328
#define XB_TOPGEN   3392
#define XCD_BAR_WORDS 3456
#define XB_SPIN_CAP (1u << 18)
__device__ __forceinline__ unsigned xb_ld(unsigned* p)              { return __hip_atomic_load(p, __ATOMIC_RELAXED, __HIP_MEMORY_SCOPE_AGENT); }
__device__ __forceinline__ unsigned xb_add(unsigned* p, unsigned v) { return __hip_atomic_fetch_add(p, v, __ATOMIC_RELAXED, __HIP_MEMORY_SCOPE_AGENT); }
__device__ __forceinline__ unsigned xb_xcc_id() { return (unsigned)__builtin_amdgcn_s_getreg((3 << 11) | 20) & 0xFu; }
#define XB_SPIN(cond, bar) do { unsigned _sp = 0; while (cond) { __builtin_amdgcn_s_sleep(1); \
    if ((++_sp & 255u) == 0u) { if (xb_ld(&(bar)[XB_TMO])) break; if (_sp > XB_SPIN_CAP) { atomicAdd(&(bar)[XB_TMO], 1u); break; } } } } while (0)
struct XcdBarrier { unsigned* bar; unsigned x; volatile LAS unsigned* st; };
__device__ __forceinline__ XcdBarrier xcd_barrier_post(unsigned* bar, volatile LAS unsigned* st) {
    XcdBarrier b; b.bar = bar; b.x = xb_xcc_id(); b.st = st;
    if (threadIdx.x == 0) (void)xb_add(&bar[XB_XCNT(b.x)], 1u);
    return b;
}
__device__ __forceinline__ void xcd_barrier_complete(unsigned* bar, unsigned x, unsigned& nloc, unsigned& nx) {
    const unsigned G = gridDim.x * gridDim.y * gridDim.z;
    unsigned sum, cnt, mine, sp = 0u;
    for (;;) {
        sum = 0u; cnt = 0u; mine = 0u;
#pragma unroll
        for (unsigned j = 0; j < 16; ++j) { const unsigned c = xb_ld(&bar[XB_XCNT(j)]); sum += c; cnt += (c > 0u) ? 1u : 0u; mine = (j == x) ? c : mine; }
        if (sum == G) break;
        __builtin_amdgcn_s_sleep(1);
        if ((++sp & 255u) == 0u) { if (xb_ld(&bar[XB_TMO])) break; if (sp > XB_SPIN_CAP) { atomicAdd(&bar[XB_TMO], 1u); break; } }
    }
    nloc = mine > 0u ? mine : 1u; nx = cnt > 0u ? cnt : 1u;
}
__device__ __forceinline__ void xcd_barrier(const XcdBarrier& b) {
    asm volatile("s_waitcnt vmcnt(0)" ::: "memory");
    __syncthreads();
    if (threadIdx.x == 0) {
        unsigned* bar = b.bar;
        __builtin_amdgcn_s_waitcnt(0);
        unsigned nloc = b.st[0], nx = b.st[1];
        if (nloc == 0u) { xcd_barrier_complete(bar, b.x, nloc, nx); b.st[0] = nloc; b.st[1] = nx; }
        const unsigned old = xb_add(&bar[XB_XSUB(b.x)], 1u);
        const unsigned gen = old / nloc;
        if (old + 1u == (gen + 1u) * nloc) {
            __builtin_amdgcn_fence(__ATOMIC_RELEASE, "agent");
            asm volatile("s_waitcnt vmcnt(0)" ::: "memory");
            const unsigned og = xb_add(&bar[XB_TOP], 1u);
            const unsigned tg = og / nx;
            if (og + 1u == (tg + 1u) * nx) xb_add(&bar[XB_TOPGEN], 1u);
            else XB_SPIN(xb_ld(&bar[XB_TOPGEN]) == tg, bar);
            __builtin_amdgcn_fence(__ATOMIC_ACQUIRE, "agent");
            xb_add(&bar[XB_XGEN(b.x)], 1u);
            asm volatile("s_waitcnt vmcnt(0)" ::: "memory");
        } else {
            XB_SPIN(xb_ld(&bar[XB_XGEN(b.x)]) == gen, bar);
            __builtin_amdgcn_fence(__ATOMIC_ACQUIRE, "agent");
            asm volatile("s_waitcnt vmcnt(0)" ::: "memory");
        }
    }
    __syncthreads();
}

struct Args { const float* in[18]; float* out; unsigned char* ws; int ph_lo, ph_hi; };
struct Frame {
    LAS unsigned char* lds;
    int vcu, G;
    unsigned char* ws;
};
__device__ __forceinline__ int opaque_tid() { int t = threadIdx.x; asm volatile("" : "+v"(t)); return t; }
#define TID ((int)threadIdx.x)
#define WSP(T_, off) ((T_*)(F.ws + (off)))
#define LDS_WAIT() asm volatile("s_waitcnt lgkmcnt(0)" ::: "memory")

struct TrDesc { const float* W; const float* gain; bf16* dst; int Nsrc, srccol0, k0, Kdst; };
__device__ __forceinline__ void tr_load(const TrDesc& d, f32x4 (&v)[16], int lane) {
#pragma unroll
    for (int i = 0; i < 16; ++i) v[i] = *(const f32x4*)(d.W + (size_t)(d.k0 + 4 * i + (lane >> 4)) * d.Nsrc + d.srccol0 + 4 * (lane & 15));
}
__device__ __forceinline__ void tr_finish(const TrDesc& d, const f32x4 (&v)[16], LAS float* scr, int lane) {
#pragma unroll
    for (int i = 0; i < 16; ++i) { const int kk = 4 * i + (lane >> 4); f32x4 x = v[i]; if (d.gain) x = x * d.gain[d.k0 + kk]; *(LAS f32x4*)(scr + kk * 68 + 4 * (lane & 15)) = x; }
    LDS_WAIT(); asm volatile("" ::: "memory");
    const int c = lane & 7;
#pragma unroll
    for (int j = 0; j < 8; ++j) { const int n = (lane >> 3) + 8 * j; const LAS float* sp = scr + (8 * c) * 68 + n;
        u32x4 o; o.x = cvtpk(sp[0 * 68], sp[1 * 68]); o.y = cvtpk(sp[2 * 68], sp[3 * 68]); o.z = cvtpk(sp[4 * 68], sp[5 * 68]); o.w = cvtpk(sp[6 * 68], sp[7 * 68]);
        *(u32x4*)(d.dst + (size_t)n * d.Kdst + d.k0 + 8 * c) = o; }
    LDS_WAIT(); asm volatile("" ::: "memory");
}
__device__ __forceinline__ int in_srccol(int n0) {
    if (n0 < C_Q || n0 >= C_V) return n0;
    const int tile = n0 >> 8, within = n0 & 255, bj = within >> 7, w = within & 127, sec = (tile < 4) ? C_Q : C_K;
    return sec + (2 * (tile & 1) + (w >> 6)) * 128 + (w & 63) + 64 * bj;
}
__device__ __forceinline__ void rms_row_bf16(const float* xrow, bf16* orow, int lane) {
    const f32x4* xr = (const f32x4*)xrow + lane; f32x4 v[4]; float s = 0.f;
#pragma unroll
    for (int j = 0; j < 4; ++j) { v[j] = xr[64 * j]; s += (v[j].x * v[j].x + v[j].y * v[j].y) + (v[j].z * v[j].z + v[j].w * v[j].w); }
    const float r = rsqrtf(wave_sum(s) * (1.0f / DM) + EPS);
    u32x2* o = (u32x2*)orow + lane;
#pragma unroll
    for (int j = 0; j < 4; ++j) { u32x2 w; w.x = cvtpk(v[j].x * r, v[j].y * r); w.y = cvtpk(v[j].z * r, v[j].w * r); o[64 * j] = w; }
}
__device__ __forceinline__ void norm_rows(Frame& F, const float* X, bf16* XB, int nrows) {
    const int tid = opaque_tid(), lane = tid & 63, wave = __builtin_amdgcn_readfirstlane(tid >> 6), fr = lane & 15, fq = lane >> 4; (void)tid; (void)lane; (void)wave; (void)fr; (void)fq;
    const int gw = F.vcu * 8 + wave, NGW = F.G * 8;
    for (int m = gw; m < nrows; m += NGW) rms_row_bf16(X + (size_t)m * DM, XB + (size_t)m * DM, lane);
}
__device__ __forceinline__ void final_norm(Frame& F, float* out, const float* g) {
    const int tid = opaque_tid(), lane = tid & 63, wave = __builtin_amdgcn_readfirstlane(tid >> 6);
    const int gw = F.vcu * 8 + wave, NGW = F.G * 8;
    for (int m = gw; m < T; m += NGW) {
        const float* sp = WSP(float, WS_SSP) + (size_t)m * 16; float q = 0.f;
#pragma unroll
        for (int j = 0; j < 16; ++j) q += sp[j];
        const float r = rsqrtf(q * (1.0f / DM) + EPS);
        const u32x2* xr = (const u32x2*)(WSP(bf16, WS_XB) + (size_t)m * DM) + lane; f32x4* o = (f32x4*)(out + (size_t)m * DM) + lane;
#pragma unroll
        for (int j = 0; j < 4; ++j) { const u32x2 v = xr[64 * j]; const f32x4 gg = *((const f32x4*)g + lane + 64 * j);
            o[64 * j] = (f32x4){bflo(v.x) * r * gg.x, bfhi(v.x) * r * gg.y, bflo(v.y) * r * gg.z, bfhi(v.y) * r * gg.w}; }
    }
}

__device__ __forceinline__ void p0_prologue(Frame& F, const Args& A) {
    const int tid = opaque_tid(), lane = tid & 63, wave = __builtin_amdgcn_readfirstlane(tid >> 6);
    LAS float* scr = (LAS float*)(F.lds + wave * 17408);
    const int gw = F.vcu * 8 + wave, NGW = F.G * 8;
    constexpr int I_IN = 16 * 112, I_MKV = 16 * 16, I_UR = 16 * 16, I_UM = 8 * 16, I_OUT = 16 * 16, I_1 = 16 * 64, I_2 = 64 * 16;
    constexpr int PER_L = I_IN + I_MKV + I_UR + I_UM + I_OUT + I_1 + I_2;
#define TR_DESC(d, it_) do { const int l_ = (it_) / PER_L; int r_ = (it_) % PER_L; unsigned char* wl_ = F.ws + WS_W + (size_t)l_ * W_LAYER; \
        if (r_ < I_IN) { const int kb = r_ / 112, nb = r_ % 112; d = TrDesc{A.in[4] + (size_t)l_ * DM * INC, A.in[3] + l_ * DM, (bf16*)(wl_ + WO_IN) + (size_t)(64 * nb) * DM, INC, in_srccol(64 * nb), 64 * kb, DM}; } \
        else if ((r_ -= I_IN) < I_MKV) { const int kb = r_ / 16, nb = r_ % 16; d = TrDesc{A.in[9] + (size_t)l_ * DM * 1024, A.in[8] + l_ * DM, (bf16*)(wl_ + WO_MKV) + (size_t)(64 * nb) * DM, 1024, 64 * nb, 64 * kb, DM}; } \
        else if ((r_ -= I_MKV) < I_UR) { const int kb = r_ / 16, nb = r_ % 16; d = TrDesc{A.in[11] + (size_t)l_ * 1024 * DM, A.in[7] + l_ * 1024, (bf16*)(wl_ + WO_UP) + (size_t)(64 * nb) * 2048 + 512, DM, 64 * nb, 64 * kb, 2048}; } \
        else if ((r_ -= I_UR) < I_UM) { const int kb = r_ / 16, nb = r_ % 16; d = TrDesc{A.in[12] + (size_t)l_ * 512 * DM, nullptr, (bf16*)(wl_ + WO_UP) + (size_t)(64 * nb) * 2048 + 1536, DM, 64 * nb, 64 * kb, 2048}; } \
        else if ((r_ -= I_UM) < I_OUT) { const int kb = r_ / 16, nb = r_ % 16; d = TrDesc{A.in[13] + (size_t)l_ * DM * DM, nullptr, (bf16*)(wl_ + WO_OUT) + (size_t)(64 * nb) * DM, DM, 64 * nb, 64 * kb, DM}; } \
        else if ((r_ -= I_OUT) < I_1) { const int kb = r_ / 64, nb = r_ % 64; d = TrDesc{A.in[15] + (size_t)l_ * DM * DFF, A.in[14] + l_ * DM, (bf16*)(wl_ + WO_1) + (size_t)(64 * nb) * DM, DFF, 64 * nb, 64 * kb, DM}; } \
        else { r_ -= I_1; const int kb = r_ / 16, nb = r_ % 16; d = TrDesc{A.in[16] + (size_t)l_ * DFF * DM, nullptr, (bf16*)(wl_ + WO_2) + (size_t)(64 * nb) * DFF, DM, 64 * nb, 64 * kb, DFF}; } } while (0)
    {
        TrDesc dA, dB; f32x4 vA[16], vB[16];
        int it = gw;
        if (it < 2 * PER_L) { TR_DESC(dA, it); tr_load(dA, vA, lane); }
        while (it < 2 * PER_L) {
            const int itB = it + NGW;
            if (itB < 2 * PER_L) { TR_DESC(dB, itB); tr_load(dB, vB, lane); }
            tr_finish(dA, vA, scr, lane);
            if (itB >= 2 * PER_L) break;
            const int itA = itB + NGW;
            if (itA < 2 * PER_L) { TR_DESC(dA, itA); tr_load(dA, vA, lane); }
            tr_finish(dB, vB, scr, lane);
            it = itA;
        }
    }
#undef TR_DESC
    const int gt = F.vcu * 512 + tid, NT = F.G * 512;
    {
        const float inv = (float)exp2(-(double)(gt & 63) * (13.287712379549449 / 64.0));
        const int* pos = (const int*)A.in[2];
        for (int i = gt; i < T * 64; i += NT) {
            const float a = (float)pos[i >> 6] * inv;
            const double ad = (double)a, k = rint(ad * 0.15915494309189535), rr = ad - k * 6.283185307179586;
            const float rf = (float)rr;
            WSP(float, WS_COS)[i] = cosf(rf); WSP(float, WS_SIN)[i] = sinf(rf);
        }
    }
    for (int m = gw; m < T; m += NGW) {
        const f32x4* xr = (const f32x4*)(A.in[0] + (size_t)m * DM) + 2 * lane; float q = 0.f; u32x4* o = (u32x4*)(WSP(bf16, WS_XB) + (size_t)m * DM) + lane;
#pragma unroll
        for (int j = 0; j < 2; ++j) { const f32x4 v = xr[128 * j], v2 = xr[128 * j + 1]; q += ((v.x * v.x + v.y * v.y) + (v.z * v.z + v.w * v.w)) + ((v2.x * v2.x + v2.y * v2.y) + (v2.z * v2.z + v2.w * v2.w));
            u32x4 w; w.x = cvtpk(v.x, v.y); w.y = cvtpk(v.z, v.w); w.z = cvtpk(v2.x, v2.y); w.w = cvtpk(v2.z, v2.w); o[64 * j] = w; }
        q = wave_sum(q);
        if (lane < 16) WSP(float, WS_SSP)[(size_t)m * 16 + lane] = (lane == 0) ? q : 0.f;
    }
    norm_rows(F, A.in[1], WSP(bf16, WS_MEMN), NB * NMEM);
    __syncthreads();
    LAS float* PW = (LAS float*)F.lds;
    LAS float* WU = (LAS float*)(F.lds + 128 * 129 * 4);
    for (int it = F.vcu; it < 2 * 4 * 32; it += F.G) {
        const int l = it >> 7, g = (it >> 5) & 3, n0 = (it & 31) * 32;
        const float* pw = A.in[5] + ((size_t)l * 512 + g * 128) * 128; const float* ps = A.in[6] + l * 512 + g * 128; const float* wu = A.in[10] + ((size_t)l * 512 + g * 128) * DM + n0;
        for (int i = tid; i < 128 * 128; i += 512) { const int c = i >> 7, cp = i & 127; PW[c * 129 + cp] = pw[i] * ps[cp]; }
        for (int i = tid; i < 128 * 8; i += 512) { const int cp = i >> 3, q = i & 7; *(LAS f32x4*)(WU + cp * 32 + 4 * q) = *(const f32x4*)(wu + (size_t)cp * DM + 4 * q); }
        __syncthreads();
        const int c = tid & 127, nq = tid >> 7;
        f32x4 s0 = {0.f, 0.f, 0.f, 0.f}, s1 = {0.f, 0.f, 0.f, 0.f};
#pragma unroll 8
        for (int cp = 0; cp < 128; ++cp) { const float p = PW[c * 129 + cp]; s0 += p * *(LAS f32x4*)(WU + cp * 32 + 8 * nq); s1 += p * *(LAS f32x4*)(WU + cp * 32 + 8 * nq + 4); }
        bf16* dst = (bf16*)(F.ws + WS_W + (size_t)l * W_LAYER + WO_UP) + (size_t)(n0 + 8 * nq) * 2048 + g * 128 + c;
#pragma unroll
        for (int j = 0; j < 4; ++j) { dst[(size_t)j * 2048] = (bf16)(cvtpk(s0[j], 0.f) & 0xffffu); dst[(size_t)(4 + j) * 2048] = (bf16)(cvtpk(s1[j], 0.f) & 0xffffu); }
        __syncthreads();
    }
}

__device__ __forceinline__ bf16x8 frag_tr(LAS unsigned char* Tt, int ldb, int rowA, int rowB, int col0, int fr) {
#if USE_TR
    const int q = fr >> 2, p = fr & 3;
    const s16x4 lo = __builtin_bit_cast(s16x4, __builtin_amdgcn_ds_read_tr16_b64_v4i16((LAS v4i16_t*)(Tt + (rowA + q) * ldb + (col0 + 4 * p) * 2)));
    const s16x4 hi = __builtin_bit_cast(s16x4, __builtin_amdgcn_ds_read_tr16_b64_v4i16((LAS v4i16_t*)(Tt + (rowB + q) * ldb + (col0 + 4 * p) * 2)));
    return __builtin_shufflevector(lo, hi, 0, 1, 2, 3, 4, 5, 6, 7);
#else
    bf16x8 f;
#pragma unroll
    for (int e = 0; e < 4; ++e) { f[e] = *(LAS short*)(Tt + (rowA + e) * ldb + (col0 + fr) * 2); f[4 + e] = *(LAS short*)(Tt + (rowB + e) * ldb + (col0 + fr) * 2); }
    return f;
#endif
}
__device__ __forceinline__ bf16x8 pack8(const f32x4& a, const f32x4& b) { u32x4 w; w.x = cvtpk(a[0], a[1]); w.y = cvtpk(a[2], a[3]); w.z = cvtpk(b[0], b[1]); w.w = cvtpk(b[2], b[3]); return __builtin_bit_cast(bf16x8, w); }
__device__ __forceinline__ float log2gamma(int h) { return log2f(1.0f - exp2f(-5.0f - (float)h)); }

__device__ __forceinline__ void mem_kv_proj(Frame& F) {
    const int tid = opaque_tid(), lane = tid & 63, wave = __builtin_amdgcn_readfirstlane(tid >> 6), fr = lane & 15, fq = lane >> 4;
    LAS unsigned char* As = F.lds; LAS unsigned char* Bs = F.lds + 33792;
    const int wm = wave & 3, wn = wave >> 2;
    for (int it = F.vcu; it < 512; it += F.G) {
        const int l = it >> 8, tm = (it >> 4) & 15, tn = it & 15;
        const bf16* Ag = WSP(bf16, WS_MEMN) + (size_t)(tm * 64) * DM; const bf16* Bg = WSP(bf16, WS_W + (size_t)l * W_LAYER + WO_MKV) + (size_t)(tn * 64) * DM;
        f32x4 acc[2]; acc[0] = (f32x4){0.f, 0.f, 0.f, 0.f}; acc[1] = (f32x4){0.f, 0.f, 0.f, 0.f};
        for (int kc = 0; kc < 4; ++kc) {
            __syncthreads();
#pragma unroll
            for (int k = 0; k < 4; ++k) { const int c = tid + 512 * k, r = c >> 5, ch = c & 31;
                *(LAS u32x4*)(As + r * 528 + ch * 16) = *(const u32x4*)(Ag + (size_t)r * DM + kc * 256 + ch * 8);
                *(LAS u32x4*)(Bs + r * 528 + ch * 16) = *(const u32x4*)(Bg + (size_t)r * DM + kc * 256 + ch * 8); }
            __syncthreads();
#pragma unroll
            for (int ks = 0; ks < 8; ++ks) { const bf16x8 af = *(LAS bf16x8*)(As + (16 * wm + fr) * 528 + (32 * ks + 8 * fq) * 2);
#pragma unroll
                for (int c = 0; c < 2; ++c) acc[c] = mfma16(*(LAS bf16x8*)(Bs + (32 * wn + 16 * c + fr) * 528 + (32 * ks + 8 * fq) * 2), af, acc[c]); }
        }
        bf16* dst = WSP(bf16, WS_KVMEM) + (size_t)l * 1024 * 1024 + (size_t)(tm * 64 + 16 * wm + fr) * 1024 + tn * 64 + 32 * wn + 4 * fq;
#pragma unroll
        for (int c = 0; c < 2; ++c) { u32x2 w; w.x = cvtpk(acc[c][0], acc[c][1]); w.y = cvtpk(acc[c][2], acc[c][3]); *(u32x2*)(dst + 16 * c) = w; }
    }
    __syncthreads();
}

template <int W> __device__ __forceinline__ void pool_item(bf16* P, int tl0, int c0) {
    const int pos0 = tl0 & (SEQ - 1);
    u32x4 r[W + 7];
#pragma unroll
    for (int i = 0; i < W + 7; ++i) { r[i] = (u32x4){0u, 0u, 0u, 0u}; if (pos0 - (W - 1) + i >= 0) r[i] = *(const u32x4*)(P + (size_t)(tl0 - (W - 1) + i) * PLD + c0); }
    float s[8];
#pragma unroll
    for (int e = 0; e < 8; ++e) s[e] = 0.f;
#pragma unroll
    for (int i = 0; i < W - 1; ++i)
#pragma unroll
        for (int e = 0; e < 4; ++e) { s[2 * e] += bflo(r[i][e]); s[2 * e + 1] += bfhi(r[i][e]); }
#pragma unroll
    for (int tt = 0; tt < 8; ++tt) {
        const int pos = pos0 + tt; const float rc = 1.0f / (float)((pos + 1 < W) ? pos + 1 : W);
        float d[8];
#pragma unroll
        for (int e = 0; e < 4; ++e) { const float u0 = bflo(r[W - 1 + tt][e]), u1 = bfhi(r[W - 1 + tt][e]); s[2 * e] += u0; s[2 * e + 1] += u1; d[2 * e] = s[2 * e] * rc - u0; d[2 * e + 1] = s[2 * e + 1] * rc - u1; }
        u32x4 o; o.x = cvtpk(d[0], d[1]); o.y = cvtpk(d[2], d[3]); o.z = cvtpk(d[4], d[5]); o.w = cvtpk(d[6], d[7]);
        *(u32x4*)(P + (size_t)(tl0 + tt) * PLD + C_DP + c0) = o;
#pragma unroll
        for (int e = 0; e < 4; ++e) { s[2 * e] -= bflo(r[tt][e]); s[2 * e + 1] -= bfhi(r[tt][e]); }
    }
}
__device__ __forceinline__ void mix_pool(Frame& F) {
    const int tid = opaque_tid(), lane = tid & 63, wave = __builtin_amdgcn_readfirstlane(tid >> 6);
    bf16* P = WSP(bf16, WS_PROJ);
    const int gw = F.vcu * 8 + wave, NGW = F.G * 8;
    for (int it = gw; it < 4 * (TH / 32); it += NGW) {
        const int g = it & 3, tl0 = (it >> 2) * 32 + (lane >> 4) * 8, c0 = g * 128 + (lane & 15) * 8;
        if (g == 0) pool_item<2>(P, tl0, c0); else if (g == 1) pool_item<4>(P, tl0, c0); else if (g == 2) pool_item<8>(P, tl0, c0); else pool_item<16>(P, tl0, c0);
    }
}

__device__ __forceinline__ void mix_mem(Frame& F, int l, int hf, bool dummy) {
    const int tid = opaque_tid(), lane = tid & 63, wave = __builtin_amdgcn_readfirstlane(tid >> 6), fr = lane & 15, fq = lane >> 4; (void)tid; (void)lane; (void)wave; (void)fr; (void)fq;
    bf16* P = WSP(bf16, WS_PROJ);
    LAS unsigned char* Kt = F.lds; LAS unsigned char* Vt = F.lds + 69632;
    const int items = 8 * 64, ipw = (items + F.G - 1) / F.G;
    const int it_lo = F.vcu * ipw, it_hi = (it_lo + ipw < items) ? it_lo + ipw : items;
    int loaded = -1;
    for (int it = it_lo; it < it_hi; ++it) {
        const int combo = it >> 6, qt = it & 63, bl = combo >> 2, h = combo & 3;
        if (combo != loaded) {
            __syncthreads();
            const bf16* src = WSP(bf16, WS_KVMEM) + (size_t)l * 1024 * 1024 + (size_t)((2 * hf + bl) * NMEM) * 1024 + h * 128;
            for (int c = tid; c < 4096; c += 512) { const int key = c >> 4, ch = c & 15;
                *(LAS u32x4*)(Kt + key * 272 + ch * 16) = *(const u32x4*)(src + (size_t)key * 1024 + ch * 8);
                *(LAS u32x4*)(Vt + key * 272 + ch * 16) = *(const u32x4*)(src + (size_t)key * 1024 + 512 + ch * 8); }
            __syncthreads(); loaded = combo;
        }
        bf16* qp = P + (size_t)(bl * SEQ + qt * 128 + wave * 16 + fr) * PLD + C_XQ + h * 128;
        bf16x8 bq[4];
#pragma unroll
        for (int ks = 0; ks < 4; ++ks) bq[ks] = *(const bf16x8*)(qp + ks * 32 + fq * 8);
        f32x4 s[16];
#pragma unroll
        for (int kt = 0; kt < 16; ++kt) { s[kt] = (f32x4){0.f, 0.f, 0.f, 0.f};
#pragma unroll
            for (int ks = 0; ks < 4; ++ks) s[kt] = mfma16(*(LAS bf16x8*)(Kt + (16 * kt + fr) * 272 + (32 * ks + 8 * fq) * 2), bq[ks], s[kt]); }
        float mx = -3.0e38f;
#pragma unroll
        for (int kt = 0; kt < 16; ++kt) mx = fmaxf(fmaxf(fmaxf(s[kt][0], s[kt][1]), fmaxf(s[kt][2], s[kt][3])), mx);
        mx = max_xor16(mx); mx = max_xor32(mx);
        float lsum = 0.f;
#pragma unroll
        for (int kt = 0; kt < 16; ++kt)
#pragma unroll
            for (int r = 0; r < 4; ++r) { const float p = exp2f(s[kt][r] - mx); s[kt][r] = p; lsum += p; }
        lsum = add_xor16(lsum); lsum = add_xor32(lsum);
        const float rl = 1.0f / lsum;
        f32x4 o[8];
#pragma unroll
        for (int dt = 0; dt < 8; ++dt) o[dt] = (f32x4){0.f, 0.f, 0.f, 0.f};
#pragma unroll
        for (int kp = 0; kp < 8; ++kp) { const bf16x8 pf = pack8(s[2 * kp], s[2 * kp + 1]);
#pragma unroll
            for (int dt = 0; dt < 8; ++dt) o[dt] = mfma16(frag_tr(Vt, 272, 32 * kp + 4 * fq, 32 * kp + 16 + 4 * fq, 16 * dt, fr), pf, o[dt]); }
        bf16* op = (dummy ? WSP(bf16, WS_MERGED) + (size_t)(bl * SEQ + qt * 128 + wave * 16 + fr) * 512 + h * 128 : qp) + 16 * (fq & 1) + 4 * (fq & 2);
#pragma unroll
        for (int p = 0; p < 4; ++p) { const unsigned ax = cvtpk(o[2 * p][0] * rl, o[2 * p][1] * rl), ay = cvtpk(o[2 * p][2] * rl, o[2 * p][3] * rl), bx_ = cvtpk(o[2 * p + 1][0] * rl, o[2 * p + 1][1] * rl), by = cvtpk(o[2 * p + 1][2] * rl, o[2 * p + 1][3] * rl);
            auto rx = __builtin_amdgcn_permlane16_swap(ax, bx_, false, false); auto ry = __builtin_amdgcn_permlane16_swap(ay, by, false, false);
            u32x4 w; w.x = rx[0]; w.y = ry[0]; w.z = rx[1]; w.w = ry[1]; *(u32x4*)(op + 32 * p) = w; }
    }
    __syncthreads();
}

__device__ __forceinline__ void mix_kv(Frame& F) {
    const int tid = opaque_tid(), lane = tid & 63, wave = __builtin_amdgcn_readfirstlane(tid >> 6), fr = lane & 15, fq = lane >> 4; (void)tid; (void)lane; (void)wave; (void)fr; (void)fq;
    bf16* P = WSP(bf16, WS_PROJ);
    LAS unsigned char* Kd = F.lds; LAS unsigned char* Vt = F.lds + 34816;
    for (int un = F.vcu; un < 512; un += F.G) {
        const int h = un & 3, n = (un >> 2) & 63, bl = un >> 8; const size_t row0 = (size_t)bl * SEQ + n * 128; const float lg = log2gamma(h);
        __syncthreads();
        for (int c = tid; c < 2048; c += 512) { const int j = c >> 4, ch = c & 15; const u32x4 v = *(const u32x4*)(P + (row0 + j) * PLD + C_K + h * 128 + ch * 8); const float f = exp2f((float)(127 - j) * lg);
            u32x4 o; o.x = cvtpk(bflo(v.x) * f, bfhi(v.x) * f); o.y = cvtpk(bflo(v.y) * f, bfhi(v.y) * f); o.z = cvtpk(bflo(v.z) * f, bfhi(v.z) * f); o.w = cvtpk(bflo(v.w) * f, bfhi(v.w) * f);
            *(LAS u32x4*)(Kd + j * 272 + ch * 16) = o; }
        for (int c = tid; c < 4096; c += 512) { const int j = c >> 5, ch = c & 31; *(LAS u32x4*)(Vt + j * 528 + ch * 16) = *(const u32x4*)(P + (row0 + j) * PLD + C_V + h * 256 + ch * 8); }
        __syncthreads();
        f32x4 acc[8][2];
#pragma unroll
        for (int dt = 0; dt < 8; ++dt) { acc[dt][0] = (f32x4){0.f, 0.f, 0.f, 0.f}; acc[dt][1] = (f32x4){0.f, 0.f, 0.f, 0.f}; }
#pragma unroll
        for (int ks = 0; ks < 4; ++ks) { const int rA = 32 * ks + 8 * fq, rB = rA + 4;
            const bf16x8 bv0 = frag_tr(Vt, 528, rA, rB, 16 * (2 * wave), fr), bv1 = frag_tr(Vt, 528, rA, rB, 16 * (2 * wave + 1), fr);
#pragma unroll
            for (int dt = 0; dt < 8; ++dt) { const bf16x8 ad = frag_tr(Kd, 272, rA, rB, 16 * dt, fr); acc[dt][0] = mfma16(ad, bv0, acc[dt][0]); acc[dt][1] = mfma16(ad, bv1, acc[dt][1]); } }
        bf16* dst = WSP(bf16, WS_KVN) + (size_t)un * 32768 + 16 * (fq & 1) + 4 * (fq & 2);
#pragma unroll
        for (int vi = 0; vi < 2; ++vi)
#pragma unroll
            for (int p = 0; p < 4; ++p) { const f32x4 a = acc[2 * p][vi], b = acc[2 * p + 1][vi];
                const unsigned ax = cvtpk(a[0], a[1]), ay = cvtpk(a[2], a[3]), bx_ = cvtpk(b[0], b[1]), by = cvtpk(b[2], b[3]);
                auto rx = __builtin_amdgcn_permlane16_swap(ax, bx_, false, false); auto ry = __builtin_amdgcn_permlane16_swap(ay, by, false, false);
                u32x4 o; o.x = rx[0]; o.y = ry[0]; o.z = rx[1]; o.w = ry[1];
                *(u32x4*)(dst + (size_t)(16 * (2 * wave + vi) + fr) * 128 + 32 * p) = o; }
    }
    __syncthreads();
}

__device__ __forceinline__ void scan_states(Frame& F) {
    const int tid = opaque_tid(), lane = tid & 63, wave = __builtin_amdgcn_readfirstlane(tid >> 6), fr = lane & 15, fq = lane >> 4; (void)tid; (void)lane; (void)wave; (void)fr; (void)fq;
    const bf16* KV = WSP(bf16, WS_KVN); bf16* SP = WSP(bf16, WS_SPREV);
    if (tid < 256)
    for (int p = F.vcu * 256 + tid; p < 8 * 8192; p += F.G * 256) {
        const int blk = p >> 13, bl = blk >> 2, h = blk & 3, off = (p & 8191) * 4; const float cd = exp2f(128.0f * log2gamma(h));
        f32x4 st = {0.f, 0.f, 0.f, 0.f};
        for (int n0 = 0; n0 < 64; n0 += 8) {
            u32x2 kv[8];
#pragma unroll
            for (int j = 0; j < 8; ++j) kv[j] = *(const u32x2*)(KV + (size_t)((bl * 64 + n0 + j) * 4 + h) * 32768 + off);
#pragma unroll
            for (int j = 0; j < 8; ++j) { u32x2 w; w.x = cvtpk(st[0], st[1]); w.y = cvtpk(st[2], st[3]); *(u32x2*)(SP + (size_t)((bl * 64 + n0 + j) * 4 + h) * 32768 + off) = w;
                st = st * cd + (f32x4){bflo(kv[j].x), bfhi(kv[j].x), bflo(kv[j].y), bfhi(kv[j].y)}; }
        }
    }
}

__device__ __forceinline__ void ret_out(Frame& F, bool dummy) {
    const int tid = opaque_tid(), lane = tid & 63, wave = __builtin_amdgcn_readfirstlane(tid >> 6), fr = lane & 15, fq = lane >> 4; (void)tid; (void)lane; (void)wave; (void)fr; (void)fq;
    bf16* P = WSP(bf16, WS_PROJ);
    LAS unsigned char* Kt = F.lds; LAS unsigned char* Vt = F.lds + 34816; LAS unsigned char* Sp = F.lds + 102400;
    for (int un = F.vcu; un < 512; un += F.G) {
        const int h = un & 3, n = (un >> 2) & 63, bl = un >> 8; const size_t row0 = (size_t)bl * SEQ + n * 128; const float lg = log2gamma(h);
        const bf16* spg = WSP(bf16, WS_SPREV) + (size_t)un * 32768;
        const int i = wave * 16 + fr; const size_t trow = row0 + i;
        bf16x8 bq[4];
#pragma unroll
        for (int ks = 0; ks < 4; ++ks) bq[ks] = *(const bf16x8*)(P + trow * PLD + C_Q + h * 128 + ks * 32 + fq * 8);
        bf16* gp = P + trow * PLD + C_G + h * 256 + 4 * fq;
        __syncthreads();
        for (int c = tid; c < 2048; c += 512) { const int j = c >> 4, ch = c & 15;
            *(LAS u32x4*)(Kt + j * 272 + ch * 16) = *(const u32x4*)(P + (row0 + j) * PLD + C_K + h * 128 + ch * 8);
            *(LAS u32x4*)(Sp + j * 272 + ch * 16) = *(const u32x4*)(spg + (size_t)j * 128 + ch * 8); }
        for (int c = tid; c < 4096; c += 512) { const int j = c >> 5, ch = c & 31; *(LAS u32x4*)(Vt + j * 528 + ch * 16) = *(const u32x4*)(P + (row0 + j) * PLD + C_V + h * 256 + ch * 8); }
        u32x4 sp1[4];
#pragma unroll
        for (int k = 0; k < 4; ++k) { const int c = tid + 512 * k, j = c >> 4, ch = c & 15; sp1[k] = *(const u32x4*)(spg + (size_t)(128 + j) * 128 + ch * 8); }
        __syncthreads();
        f32x4 acc[16];
#pragma unroll
        for (int vt = 0; vt < 8; ++vt) { acc[vt] = (f32x4){0.f, 0.f, 0.f, 0.f};
#pragma unroll
            for (int ks = 0; ks < 4; ++ks) acc[vt] = mfma16(*(LAS bf16x8*)(Sp + (16 * vt + fr) * 272 + (32 * ks + 8 * fq) * 2), bq[ks], acc[vt]); }
        __syncthreads();
#pragma unroll
        for (int k = 0; k < 4; ++k) { const int c = tid + 512 * k, j = c >> 4, ch = c & 15; *(LAS u32x4*)(Sp + j * 272 + ch * 16) = sp1[k]; }
        __syncthreads();
#pragma unroll
        for (int vt = 8; vt < 16; ++vt) { acc[vt] = (f32x4){0.f, 0.f, 0.f, 0.f};
#pragma unroll
            for (int ks = 0; ks < 4; ++ks) acc[vt] = mfma16(*(LAS bf16x8*)(Sp + (16 * (vt - 8) + fr) * 272 + (32 * ks + 8 * fq) * 2), bq[ks], acc[vt]); }
        bf16* gq = P + trow * PLD + C_G + h * 256 + 16 * (fq & 1) + 4 * (fq & 2);
        u32x4 gl[8];
#pragma unroll
        for (int p = 0; p < 8; ++p) gl[p] = *(const u32x4*)(gq + 32 * p);
        const float fac = exp2f((float)(i + 1) * lg);
#pragma unroll
        for (int vt = 0; vt < 16; ++vt) acc[vt] = acc[vt] * fac;
        f32x4 s[8];
#pragma unroll
        for (int kt = 0; kt < 8; ++kt) { s[kt] = (f32x4){0.f, 0.f, 0.f, 0.f};
            if (kt <= wave) {
#pragma unroll
                for (int ks = 0; ks < 4; ++ks) s[kt] = mfma16(*(LAS bf16x8*)(Kt + (16 * kt + fr) * 272 + (32 * ks + 8 * fq) * 2), bq[ks], s[kt]);
#pragma unroll
                for (int r = 0; r < 4; ++r) { const int key = 16 * kt + 4 * fq + r; s[kt][r] = (key <= i) ? s[kt][r] * exp2f((float)(i - key) * lg) : 0.f; } } }
#pragma unroll
        for (int kp = 0; kp < 4; ++kp) if (2 * kp <= wave) { const bf16x8 pf = pack8(s[2 * kp], s[2 * kp + 1]);
#pragma unroll
            for (int vt = 0; vt < 16; ++vt) acc[vt] = mfma16(frag_tr(Vt, 528, 32 * kp + 4 * fq, 32 * kp + 16 + 4 * fq, 16 * vt, fr), pf, acc[vt]); }
        float ss = 0.f;
#pragma unroll
        for (int vt = 0; vt < 16; ++vt) ss += (acc[vt][0] * acc[vt][0] + acc[vt][1] * acc[vt][1]) + (acc[vt][2] * acc[vt][2] + acc[vt][3] * acc[vt][3]);
        ss = add_xor16(ss); ss = add_xor32(ss);
        const float rinv = rsqrtf(ss * (1.0f / 256.0f) + EPS);
#pragma unroll
        for (int p = 0; p < 8; ++p) {
            u32x2 g[2];
            { auto rx = __builtin_amdgcn_permlane16_swap(gl[p][0], gl[p][2], false, false); auto ry = __builtin_amdgcn_permlane16_swap(gl[p][1], gl[p][3], false, false);
              g[0].x = rx[0]; g[0].y = ry[0]; g[1].x = rx[1]; g[1].y = ry[1]; }
            u32x2 w[2];
#pragma unroll
            for (int j = 0; j < 2; ++j) { const int vt = 2 * p + j; const float g0 = bflo(g[j].x), g1 = bfhi(g[j].x), g2 = bflo(g[j].y), g3 = bfhi(g[j].y);
                w[j].x = cvtpk(acc[vt][0] * rinv * g0 * sigmoidf_(g0), acc[vt][1] * rinv * g1 * sigmoidf_(g1)); w[j].y = cvtpk(acc[vt][2] * rinv * g2 * sigmoidf_(g2), acc[vt][3] * rinv * g3 * sigmoidf_(g3)); }
            u32x4 o;
            { auto rx = __builtin_amdgcn_permlane16_swap(w[0].x, w[1].x, false, false); auto ry = __builtin_amdgcn_permlane16_swap(w[0].y, w[1].y, false, false);
              o.x = rx[0]; o.y = ry[0]; o.z = rx[1]; o.w = ry[1]; }
            *(u32x4*)((dummy ? WSP(bf16, WS_MERGED) + trow * 1024 + h * 256 + 16 * (fq & 1) + 4 * (fq & 2) : gq) + 32 * p) = o; }
    }
    __syncthreads();
}

constexpr int N_PHASES = 2 + 2 * 16 + 1;
__global__ void __launch_bounds__(512, 2) fwd_kernel(Args args) {
    extern __shared__ __attribute__((aligned(16))) unsigned char lds_raw[];
    Frame F;
    F.lds = (LAS unsigned char*)lds_raw;
    F.G = gridDim.x; { const int bx = blockIdx.x; F.vcu = (F.G % 8 == 0) ? (bx % 8) * (F.G / 8) + bx / 8 : bx; }
    F.ws = args.ws;
    const Args& A = args;
    for (int u = TID; u < (LDS_BYTES - LDSCTL_OFF) / 4; u += 512) ((LAS unsigned*)(F.lds + LDSCTL_OFF))[u] = 0u;
    __syncthreads();
    const int lo = args.ph_lo, hi = args.ph_hi;
    XcdBarrier bar; bar.bar = WSP(unsigned, WS_CTL) + CW_BAR; bar.x = 0; bar.st = nullptr;
    if (hi - lo > 1) bar = xcd_barrier_post(WSP(unsigned, WS_CTL) + CW_BAR, (volatile LAS unsigned*)(F.lds + MISC_OFF) + 8);
    int ph = 0;
#define RUN() (lo <= ph && ph < hi)
#define END_PHASE() do { if (RUN() && ph + 1 < hi) xcd_barrier(bar); ++ph; } while (0)
    const int bx = (int)blockIdx.x;

    if (RUN()) for (int rep = 0; rep < REPS(10); ++rep) { if (rep) xcd_barrier(bar); p0_prologue(F, A); }
    END_PHASE();
    if (RUN()) for (int rep = 0; rep < REPS(11); ++rep) { if (rep) xcd_barrier(bar); mem_kv_proj(F); }
    END_PHASE();
#pragma unroll 1
    for (int l = 0; l < 2; ++l) {
        unsigned char* wl = F.ws + WS_W + (size_t)l * W_LAYER;
#pragma unroll 1
        for (int hf = 0; hf < 2; ++hf) {
            const int t0 = hf * TH;
            if (RUN()) for (int rep = 0; rep < REPS(0); ++rep) { if (rep) xcd_barrier(bar);
                pg8::Gemm g{WSP(bf16, WS_XB) + (size_t)t0 * DM, (const bf16*)(wl + WO_IN)};
                pg8::StaticOrder<TH, 4096> S; S.init(F.G, bx);
                pg8::EpiBf<2> E{WSP(bf16, WS_PROJ), PLD, WSP(float, WS_COS), WSP(float, WS_SIN), t0, WSP(float, WS_SSP)};
                pg8::gemm_phase<DM, DM, DM, pg8::EpiBf<2>, pg8::StaticOrder<TH, 4096>>(F.lds, g, S, E);
            }
            END_PHASE();
            if (RUN()) for (int rep = 0; rep < REPS(1); ++rep) { if (rep) xcd_barrier(bar); mix_pool(F); mix_mem(F, l, hf, rep != 0); mix_kv(F); }
            END_PHASE();
            if (RUN()) for (int rep = 0; rep < REPS(2); ++rep) { if (rep) xcd_barrier(bar); scan_states(F); }
            END_PHASE();
            if (RUN()) for (int rep = 0; rep < REPS(3); ++rep) { if (rep) xcd_barrier(bar); ret_out(F, rep != 0); }
            END_PHASE();
            if (RUN()) for (int rep = 0; rep < REPS(4); ++rep) { if (rep) xcd_barrier(bar);
                pg8::Gemm g{WSP(bf16, WS_XB) + (size_t)t0 * DM, (const bf16*)(wl + WO_IN) + (size_t)4096 * DM};
                pg8::StaticOrder<TH, 3072> S; S.init(F.G, bx);
                pg8::EpiBf<0> E{WSP(bf16, WS_GATES), 3072, nullptr, nullptr, t0, WSP(float, WS_SSP)};
                pg8::gemm_phase<DM, DM, DM, pg8::EpiBf<0>, pg8::StaticOrder<TH, 3072>>(F.lds, g, S, E);
            }
            END_PHASE();
            if (RUN()) for (int rep = 0; rep < REPS(5); ++rep) { if (rep) xcd_barrier(bar);
                pg8::Gemm g{WSP(bf16, WS_PROJ) + C_DP, (const bf16*)(wl + WO_UP)};
                pg8::StaticOrder<TH, DM> S; S.init(F.G, bx);
                pg8::EpiUp E{WSP(bf16, WS_MERGED), WSP(bf16, WS_GATES)};
                pg8::gemm_phase<2048, PLD, 2048, pg8::EpiUp, pg8::StaticOrder<TH, DM>>(F.lds, g, S, E);
            }
            END_PHASE();
            if (RUN()) for (int rep = 0; rep < REPS(6); ++rep) { if (rep) xcd_barrier(bar);
                pg8::Gemm g{WSP(bf16, WS_MERGED), (const bf16*)(wl + WO_OUT)};
                pg8::StaticOrder<TH, DM> S; S.init(F.G, bx);
                pg8::EpiRes E{WSP(bf16, WS_XB) + (size_t)t0 * DM, WSP(float, WS_SSP) + (size_t)t0 * 16, rep ? WSP(bf16, WS_KVN) : nullptr};
                pg8::gemm_phase<DM, DM, DM, pg8::EpiRes, pg8::StaticOrder<TH, DM>>(F.lds, g, S, E);
            }
            END_PHASE();
        }
        if (RUN()) for (int rep = 0; rep < REPS(8); ++rep) { if (rep) xcd_barrier(bar);
            pg8::Gemm g{WSP(bf16, WS_XB), (const bf16*)(wl + WO_1)};
            pg8::StaticOrder<T, DFF> S; S.init(F.G, bx);
            pg8::EpiBf<1> E{WSP(bf16, WS_U), DFF, nullptr, nullptr, 0, WSP(float, WS_SSP)};
            pg8::gemm_phase<DM, DM, DM, pg8::EpiBf<1>, pg8::StaticOrder<T, DFF>>(F.lds, g, S, E);
        }
        END_PHASE();
        if (RUN()) {
            pg8::Gemm g{WSP(bf16, WS_U), (const bf16*)(wl + WO_2)};
            pg8::StaticOrder<T, DM, true> S; S.init(F.G, bx);
            pg8::EpiRes E{WSP(bf16, WS_XB), WSP(float, WS_SSP), nullptr};
            pg8::gemm_phase<DFF, DFF, DFF, pg8::EpiRes, pg8::StaticOrder<T, DM, true>>(F.lds, g, S, E);
#if (PROBE_DUP >> 9) & 1
            xcd_barrier(bar);
            { pg8::StaticOrder<TH, DM> S2; S2.init(F.G, bx); pg8::EpiRes E2{WSP(bf16, WS_XB), WSP(float, WS_SSP), (bf16*)(F.ws + WS_END)};
              pg8::gemm_phase<DFF, DFF, DFF, pg8::EpiRes, pg8::StaticOrder<TH, DM>>(F.lds, g, S2, E2); }
#endif
        }
        END_PHASE();
        if (l == 1) { if (RUN()) final_norm(F, A.out, A.in[17]); END_PHASE(); }
#if (PROBE_DUP >> 12) & 1
        for (int rep = 0; rep < 8; ++rep) xcd_barrier(bar);
#endif
    }
#undef RUN
#undef END_PHASE
}

extern "C" void kernel_launch(void* const* d_in, const int* in_sizes, int n_in, void* d_out, int out_size, void* d_ws, size_t ws_size, hipStream_t stream) {
    static int grid = 0;
    if (grid == 0) {
        if (n_in != 18 || in_sizes[0] != T * DM || out_size != T * DM || ws_size < WS_END) { fprintf(stderr, "kernel_launch: unexpected shapes / workspace (n_in %d, ws %zu)\n", n_in, ws_size); grid = -1; return; }
        int dev = 0, cus = 0, per_cu = 0;
        if (hipGetDevice(&dev) != hipSuccess || hipDeviceGetAttribute(&cus, hipDeviceAttributeMultiprocessorCount, dev) != hipSuccess) { grid = -1; return; }
        if (hipFuncSetAttribute((const void*)fwd_kernel, hipFuncAttributeMaxDynamicSharedMemorySize, LDS_BYTES) != hipSuccess) { fprintf(stderr, "kernel_launch: hipFuncSetAttribute failed\n"); grid = -1; return; }
        if (hipOccupancyMaxActiveBlocksPerMultiprocessor(&per_cu, (const void*)fwd_kernel, 512, LDS_BYTES) != hipSuccess || per_cu < 1) { fprintf(stderr, "kernel_launch: occupancy query says %d\n", per_cu); (void)hipGetLastError(); grid = -1; return; }
        grid = cus;
    }
    if (grid < 0) return;
    (void)hipMemsetAsync((char*)d_ws + WS_CTL, 0, CTL_ZERO_BYTES, stream);
    Args a{};
    for (int i = 0; i < 18; ++i) a.in[i] = (const float*)d_in[i];
    a.out = (float*)d_out; a.ws = (unsigned char*)d_ws;
#if MK_SINGLE
    a.ph_lo = 0; a.ph_hi = N_PHASES;
    hipLaunchKernelGGL(fwd_kernel, dim3(grid), dim3(512), LDS_BYTES, stream, a);
#else
    for (int p = 0; p < N_PHASES; ++p) { a.ph_lo = p; a.ph_hi = p + 1; hipLaunchKernelGGL(fwd_kernel, dim3(grid), dim3(512), LDS_BYTES, stream, a); }
#endif
}
```

```cpp
#include <hip/hip_runtime.h>
#include <cstdio>
#include <cstdint>

#ifndef MK_SINGLE
#define MK_SINGLE 1
#endif
#ifndef PROBE_DUP
#define PROBE_DUP 0
#endif
#define REPS(k) (1 + ((PROBE_DUP >> (k)) & 1))
#ifndef USE_TR
#define USE_TR 1
#endif

#define LAS __attribute__((address_space(3)))
#define GAS __attribute__((address_space(1)))
typedef unsigned short bf16;
typedef short bf16x8 __attribute__((ext_vector_type(8)));
typedef short s16x4 __attribute__((ext_vector_type(4)));
typedef float f32x4 __attribute__((ext_vector_type(4)));
typedef float f32x2 __attribute__((ext_vector_type(2)));
typedef unsigned u32x4 __attribute__((ext_vector_type(4)));
typedef unsigned u32x2 __attribute__((ext_vector_type(2)));
typedef __bf16 bf16x2_t __attribute__((ext_vector_type(2)));
typedef short v4i16_t __attribute__((ext_vector_type(4)));

constexpr int DM = 1024, NB = 4, SEQ = 8192, T = NB * SEQ, TH = T / 2, NMEM = 256, DFF = 4096;
constexpr int INC = 7168;
constexpr int PLD = 4608;
constexpr int C_Q = 512, C_K = 1024, C_V = 1536, C_DP = 2560, C_G = 3072, C_XQ = 4096;
constexpr float EPS = 1e-6f;
constexpr float XQ_SCALE = 0.08838834764831845f * 1.4426950408889634f;
constexpr float LOG2E = 1.4426950408889634f;
constexpr float K_SCALE = 0.08838834764831845f;

constexpr size_t MiB = 1u << 20;
constexpr size_t WS_CTL = 0, CTL_ZERO_BYTES = 1 * MiB;
constexpr size_t WS_COS = 2 * MiB, WS_SIN = 10 * MiB;
constexpr size_t WS_SSP = 18 * MiB;
constexpr size_t WS_MEMN = 20 * MiB;
constexpr size_t WS_KVMEM = 24 * MiB;
constexpr size_t WS_W = 32 * MiB, W_LAYER = 38 * MiB;
constexpr size_t WO_IN = 0, WO_UP = 14 * MiB, WO_OUT = 18 * MiB, WO_1 = 20 * MiB, WO_2 = 28 * MiB, WO_MKV = 36 * MiB;
constexpr size_t WS_XB = 108 * MiB;
constexpr size_t WS_MERGED = 172 * MiB;
constexpr size_t WS_PROJ = 204 * MiB;
constexpr size_t WS_KVN = 348 * MiB;
constexpr size_t WS_SPREV = 412 * MiB;
constexpr size_t WS_GATES = 348 * MiB;
constexpr size_t WS_U = 172 * MiB;
constexpr size_t WS_END = 444 * MiB;
static_assert(WS_W + 2 * W_LAYER <= WS_XB && WS_U + (size_t)T * DFF * 2 <= WS_END && WS_PROJ + (size_t)TH * PLD * 2 <= WS_KVN, "ws map");
constexpr int CW_TMO = 0, CW_BAR = 4096;

constexpr int RING_BYTES = 131072, SCRATCH_BYTES = 147456, LDSCTL_OFF = SCRATCH_BYTES, MISC_OFF = LDSCTL_OFF + 320, LDS_BYTES = SCRATCH_BYTES + 1024;

__device__ __forceinline__ unsigned cvtpk(float lo, float hi) { f32x2 v = {lo, hi}; bf16x2_t b = __builtin_convertvector(v, bf16x2_t); return __builtin_bit_cast(unsigned, b); }
__device__ __forceinline__ float bflo(unsigned u) { return __uint_as_float(u << 16); }
__device__ __forceinline__ float bfhi(unsigned u) { return __uint_as_float(u & 0xffff0000u); }
__device__ __forceinline__ f32x4 mfma16(bf16x8 a, bf16x8 b, f32x4 c) { return __builtin_amdgcn_mfma_f32_16x16x32_bf16(a, b, c, 0, 0, 0); }
#define SWZ_XOR(m) (((m) << 10) | 0x1f)
__device__ __forceinline__ float wave_sum(float v) {
    v += __int_as_float(__builtin_amdgcn_ds_swizzle(__float_as_int(v), SWZ_XOR(1)));
    v += __int_as_float(__builtin_amdgcn_ds_swizzle(__float_as_int(v), SWZ_XOR(2)));
    v += __int_as_float(__builtin_amdgcn_ds_swizzle(__float_as_int(v), SWZ_XOR(4)));
    v += __int_as_float(__builtin_amdgcn_ds_swizzle(__float_as_int(v), SWZ_XOR(8)));
    { auto r = __builtin_amdgcn_permlane16_swap(__float_as_uint(v), __float_as_uint(v), false, false); v = __uint_as_float(r[0]) + __uint_as_float(r[1]); }
    { auto r = __builtin_amdgcn_permlane32_swap(__float_as_uint(v), __float_as_uint(v), false, false); v = __uint_as_float(r[0]) + __uint_as_float(r[1]); }
    return v;
}
__device__ __forceinline__ float add_xor16(float v) { auto r = __builtin_amdgcn_permlane16_swap(__float_as_uint(v), __float_as_uint(v), false, false); return __uint_as_float(r[0]) + __uint_as_float(r[1]); }
__device__ __forceinline__ float add_xor32(float v) { auto r = __builtin_amdgcn_permlane32_swap(__float_as_uint(v), __float_as_uint(v), false, false); return __uint_as_float(r[0]) + __uint_as_float(r[1]); }
__device__ __forceinline__ float max_xor16(float v) { auto r = __builtin_amdgcn_permlane16_swap(__float_as_uint(v), __float_as_uint(v), false, false); return fmaxf(__uint_as_float(r[0]), __uint_as_float(r[1])); }
__device__ __forceinline__ float max_xor32(float v) { auto r = __builtin_amdgcn_permlane32_swap(__float_as_uint(v), __float_as_uint(v), false, false); return fmaxf(__uint_as_float(r[0]), __uint_as_float(r[1])); }
__device__ __forceinline__ float sigmoidf_(float x) { return 1.0f / (1.0f + __expf(-x)); }

namespace pg8 {
#define PG8_LAS __attribute__((address_space(3)))
typedef unsigned short bf16_t;
constexpr int BM = 256, BK = 64, HALF = 128, HTB = HALF * BK * 2, STAGE_BYTES = 8 * HTB, NXCD = 8, WGM = 8;
__host__ __device__ __forceinline__ int lds_byte(int r, int c) { const int st = (r >> 4) * 2 + (c >> 5), rr = r & 15, cc = c & 31, ob = rr * 64 + cc * 2; return st * 1024 + (ob ^ (((ob >> 9) & 1) << 5)); }
__host__ __device__ __forceinline__ void stage_rc(int b, int& R, int& C) { const int st = b / 1024, sb = b % 1024, swz = sb ^ (((sb >> 9) & 1) << 5); R = (st >> 1) * 16 + swz / 64; C = (st & 1) * 32 + (swz % 64) / 2; }
__host__ __device__ __forceinline__ int perm32(int rho) { const int n = rho >> 4, i = rho & 15; return 8 * (i >> 2) + 4 * n + (i & 3); }

struct Unit { int pm, pn; };
struct Gemm { const bf16_t* A; const bf16_t* Bt; };

template <int M_, int N_> struct StaticOrder {
    static constexpr int nM = M_ / BM, nN = N_ / BM, nwg = nM * nN;
    int G, c;
    __host__ __device__ void init(int G_, int c_) { G = G_; c = c_; }
    __host__ __device__ bool next(int i, Unit& u) const {
        const long L = (long)i * G + c; if (L >= nwg) return false;
        int wgid = (int)L; { const int q = nwg / NXCD, r = nwg % NXCD, xcd = wgid % NXCD, off = wgid / NXCD; wgid = (xcd < r ? xcd * (q + 1) : r * (q + 1) + (xcd - r) * q) + off; }
        const int nig = WGM * nN, gid = wgid / nig, fm = gid * WGM, gsz = (nM - fm) < WGM ? (nM - fm) : WGM;
        u.pm = fm + ((wgid % nig) % gsz); u.pn = (wgid % nig) / gsz; return true;
    }
    __device__ __forceinline__ void a_ready(const Unit&) const {}
    __device__ __forceinline__ void done(const Unit&) const {}
};

typedef f32x4 Acc[2][2][4][2];

template <int MODE> struct EpiBf {
    static constexpr bool PERM = true, AFTER_DRAIN = false, HOOK = false;
    bf16_t* O; int ldc; const float* cosT; const float* sinT; int t0; const float* ssp;
    __device__ __forceinline__ void hook(Acc&, const Unit&, int, int, int, int, int) const {}
    struct Pre { float rs[2][4]; };
    __device__ __forceinline__ Pre pre(const Unit& u, int wr, int fr, int fq) const {
        Pre p; const int row0 = u.pm * BM + wr * 64 + fr;
#pragma unroll
        for (int ai = 0; ai < 2; ++ai)
#pragma unroll
            for (int m = 0; m < 4; ++m) { p.rs[ai][m] = 1.0f;
                if (ssp) { const f32x4 v = *(const f32x4*)(ssp + (size_t)(t0 + row0 + ai * HALF + m * 16) * 16 + 4 * fq); float q = (v[0] + v[1]) + (v[2] + v[3]); q = add_xor16(q); q = add_xor32(q); p.rs[ai][m] = rsqrtf(q * (1.0f / DM) + EPS); } }
        return p;
    }
    __device__ __forceinline__ void operator()(const Acc& acc, const Unit& u, int wr, int wc, int fr, int fq, const Pre& pr) const {
        const int row0 = u.pm * BM + wr * 64 + fr;
        if (MODE == 2 && u.pn >= 2 && u.pn < 6) {
            const int sec = (u.pn < 4) ? C_Q : C_K, head = 2 * (u.pn & 1) + (wc >> 1), i0 = 32 * (wc & 1) + 8 * fq;
            const float ksc0 = (u.pn >= 4) ? K_SCALE : 1.0f;
            const int dcol = sec + head * 128 + i0;
#pragma unroll
            for (int ai = 0; ai < 2; ++ai)
#pragma unroll
                for (int m = 0; m < 4; ++m) {
                    const int row = row0 + ai * HALF + m * 16; const size_t tr = (size_t)(t0 + row) * 64 + i0; const float ksc = ksc0 * pr.rs[ai][m];
                    const f32x4 c0 = *(const f32x4*)(cosT + tr), c1 = *(const f32x4*)(cosT + tr + 4), s0 = *(const f32x4*)(sinT + tr), s1 = *(const f32x4*)(sinT + tr + 4);
                    const f32x4 a0 = acc[ai][0][m][0], a1 = acc[ai][0][m][1], b0 = acc[ai][1][m][0], b1 = acc[ai][1][m][1];
                    const f32x4 o10 = (a0 * c0 - b0 * s0) * ksc, o11 = (a1 * c1 - b1 * s1) * ksc, o20 = (b0 * c0 + a0 * s0) * ksc, o21 = (b1 * c1 + a1 * s1) * ksc;
                    bf16_t* rowp = O + (size_t)row * ldc + dcol;
                    u32x4 w1, w2; w1.x = cvtpk(o10[0], o10[1]); w1.y = cvtpk(o10[2], o10[3]); w1.z = cvtpk(o11[0], o11[1]); w1.w = cvtpk(o11[2], o11[3]);
                    w2.x = cvtpk(o20[0], o20[1]); w2.y = cvtpk(o20[2], o20[3]); w2.z = cvtpk(o21[0], o21[1]); w2.w = cvtpk(o21[2], o21[3]);
                    *(u32x4*)rowp = w1; *(u32x4*)(rowp + 64) = w2;
                }
            return;
        }
        int cbase = u.pn * BM; float sc = 1.0f;
        if (MODE == 2) { const int pn = u.pn; if (pn < 2) cbase = 256 * pn; else if (pn < 10) cbase = C_V + 256 * (pn - 6); else if (pn < 14) cbase = C_G + 256 * (pn - 10); else { cbase = C_XQ + 256 * (pn - 14); sc = XQ_SCALE; } }
        const int col0 = cbase + wc * 32 + 8 * fq;
#pragma unroll
        for (int ai = 0; ai < 2; ++ai)
#pragma unroll
            for (int m = 0; m < 4; ++m) { bf16_t* rowp = O + (size_t)(row0 + ai * HALF + m * 16) * ldc + col0;
#pragma unroll
                for (int bj = 0; bj < 2; ++bj) { f32x4 v0 = acc[ai][bj][m][0], v1 = acc[ai][bj][m][1];
                    { const float f = (MODE == 3 ? -LOG2E : sc) * pr.rs[ai][m]; v0 = v0 * f; v1 = v1 * f; }
                    if (MODE == 3) {
#pragma unroll
                        for (int e = 0; e < 4; ++e) { v0[e] = 1.0f + __builtin_amdgcn_exp2f(fminf(fmaxf(v0[e], -80.f), 80.f)); v1[e] = 1.0f + __builtin_amdgcn_exp2f(fminf(fmaxf(v1[e], -80.f), 80.f)); }
                        if (u.pn < 4) {
#pragma unroll
                            for (int e = 0; e < 4; ++e) { v0[e] = __builtin_amdgcn_rcpf(v0[e]); v1[e] = __builtin_amdgcn_rcpf(v1[e]); } } }
                    if (MODE == 1) { v0 = __builtin_elementwise_max(v0, (f32x4){0.f, 0.f, 0.f, 0.f}); v1 = __builtin_elementwise_max(v1, (f32x4){0.f, 0.f, 0.f, 0.f}); v0 = v0 * v0; v1 = v1 * v1; }
                    u32x4 w; w.x = cvtpk(v0[0], v0[1]); w.y = cvtpk(v0[2], v0[3]); w.z = cvtpk(v1[0], v1[1]); w.w = cvtpk(v1[2], v1[3]);
                    *(u32x4*)(rowp + bj * HALF) = w; } }
    }
};
struct EpiRes {
    static constexpr bool PERM = true, AFTER_DRAIN = false, HOOK = false;
    struct Pre {};
    __device__ __forceinline__ Pre pre(const Unit&, int, int, int) const { return Pre{}; }
    bf16_t* X; float* ssp; bf16_t* dummy;
    __device__ __forceinline__ void hook(Acc&, const Unit&, int, int, int, int, int) const {}
    __device__ __forceinline__ void operator()(const Acc& acc, const Unit& u, int wr, int wc, int fr, int fq, const Pre&) const {
        const int row0 = u.pm * BM + wr * 64 + fr, col0 = u.pn * BM + wc * 32 + 8 * fq;
#pragma unroll
        for (int ai = 0; ai < 2; ++ai)
#pragma unroll
            for (int m = 0; m < 4; ++m) { const int row = row0 + ai * HALF + m * 16; const size_t off = (size_t)row * 1024 + col0; float q = 0.f;
#pragma unroll
                for (int bj = 0; bj < 2; ++bj) { const u32x4 b = *(const u32x4*)(X + off + bj * HALF);
                    f32x4 x0 = acc[ai][bj][m][0], x1 = acc[ai][bj][m][1];
                    x0[0] += bflo(b[0]); x0[1] += bfhi(b[0]); x0[2] += bflo(b[1]); x0[3] += bfhi(b[1]); x1[0] += bflo(b[2]); x1[1] += bfhi(b[2]); x1[2] += bflo(b[3]); x1[3] += bfhi(b[3]);
                    q += ((x0[0] * x0[0] + x0[1] * x0[1]) + (x0[2] * x0[2] + x0[3] * x0[3])) + ((x1[0] * x1[0] + x1[1] * x1[1]) + (x1[2] * x1[2] + x1[3] * x1[3]));
                    u32x4 w; w.x = cvtpk(x0[0], x0[1]); w.y = cvtpk(x0[2], x0[3]); w.z = cvtpk(x1[0], x1[1]); w.w = cvtpk(x1[2], x1[3]);
                    *(u32x4*)((dummy ? dummy : X) + off + bj * HALF) = w; }
                q = add_xor16(q); q = add_xor32(q);
                if (fq == 0 && !dummy) ssp[(size_t)row * 16 + 4 * u.pn + wc] = q; }
    }
};
struct EpiUp {
    static constexpr bool PERM = true, AFTER_DRAIN = false, HOOK = true;
    struct Pre {};
    __device__ __forceinline__ Pre pre(const Unit&, int, int, int) const { return Pre{}; }
    bf16_t* O; const bf16_t* G;
    __device__ __forceinline__ void hook(Acc& acc, const Unit& u, int t, int wr, int wc, int fr, int fq) const {
        if (t != 8 && t != 24) return;
        const int gsel = (t == 8) ? 0 : 1024;
        int fr_ = fr, fq_ = fq; asm volatile("" : "+v"(fr_), "+v"(fq_));
        const int row0 = u.pm * BM + wr * 64 + fr_, col0 = u.pn * BM + wc * 32 + 8 * fq_;
#pragma unroll
        for (int ai = 0; ai < 2; ++ai) {
            u32x4 ga[4][2], gb[4][2];
#pragma unroll
            for (int m = 0; m < 4; ++m) { const bf16_t* gp = G + (size_t)(row0 + ai * HALF + m * 16) * 3072 + gsel + col0;
#pragma unroll
                for (int bj = 0; bj < 2; ++bj) { ga[m][bj] = *(const u32x4*)(gp + bj * HALF); gb[m][bj] = *(const u32x4*)(gp + 1024 + bj * HALF); } }
#pragma unroll
            for (int m = 0; m < 4; ++m)
#pragma unroll
                for (int bj = 0; bj < 2; ++bj) { float r[8];
#pragma unroll
                    for (int e = 0; e < 4; ++e) { const float a0 = bflo(ga[m][bj][e]), a1 = bfhi(ga[m][bj][e]), b0 = bflo(gb[m][bj][e]), b1 = bfhi(gb[m][bj][e]);
                        if (t == 8) { r[2 * e] = a0 * b0; r[2 * e + 1] = a1 * b1; }
                        else { r[2 * e] = b0 * __builtin_amdgcn_rcpf(a0); r[2 * e + 1] = b1 * __builtin_amdgcn_rcpf(a1); } }
                    f32x4 v0 = acc[ai][bj][m][0], v1 = acc[ai][bj][m][1];
                    v0[0] *= r[0]; v0[1] *= r[1]; v0[2] *= r[2]; v0[3] *= r[3]; v1[0] *= r[4]; v1[1] *= r[5]; v1[2] *= r[6]; v1[3] *= r[7];
                    acc[ai][bj][m][0] = v0; acc[ai][bj][m][1] = v1; }
            asm volatile("" ::: "memory"); }
    }
    __device__ __forceinline__ void operator()(const Acc& acc, const Unit& u, int wr, int wc, int fr, int fq, const Pre&) const {
        const int row0 = u.pm * BM + wr * 64 + fr, col0 = u.pn * BM + wc * 32 + 8 * fq;
#pragma unroll
        for (int ai = 0; ai < 2; ++ai)
#pragma unroll
            for (int m = 0; m < 4; ++m) { const int row = row0 + ai * HALF + m * 16; const bf16_t* gp = G + (size_t)row * 3072 + 2048 + col0; bf16_t* rowp = O + (size_t)row * 1024 + col0;
#pragma unroll
                for (int bj = 0; bj < 2; ++bj) { const u32x4 gc = *(const u32x4*)(gp + bj * HALF);
                    const f32x4 v0 = acc[ai][bj][m][0], v1 = acc[ai][bj][m][1];
#define UP_S3(x) __builtin_amdgcn_rcpf(x)
                    u32x4 w; w.x = cvtpk(v0[0] * UP_S3(bflo(gc[0])), v0[1] * UP_S3(bfhi(gc[0]))); w.y = cvtpk(v0[2] * UP_S3(bflo(gc[1])), v0[3] * UP_S3(bfhi(gc[1])));
                    w.z = cvtpk(v1[0] * UP_S3(bflo(gc[2])), v1[1] * UP_S3(bfhi(gc[2]))); w.w = cvtpk(v1[2] * UP_S3(bflo(gc[3])), v1[3] * UP_S3(bfhi(gc[3])));
#undef UP_S3
                    *(u32x4*)(rowp + bj * HALF) = w; } }
    }
};

template <int K, int LDA, int LDB, class Epi, class Sched, bool ALIGN_EPI = true>
__device__ __forceinline__ void gemm_phase(PG8_LAS unsigned char* lds, const Gemm g, const Sched& S, const Epi& E) {
    int tid_ = threadIdx.x; asm volatile("" : "+v"(tid_));
    const int tid = tid_, wid = __builtin_amdgcn_readfirstlane(tid >> 6), lane = tid & 63, wr = wid >> 2, wc = wid & 3, fr = lane & 15, fq = lane >> 4;
    constexpr int nt = K / BK;
    unsigned voffA[2], voffB[2];
#pragma unroll
    for (int i = 0; i < 2; ++i) { int R, C; stage_rc(tid * 16 + i * 8192, R, C); const int Rb = Epi::PERM ? ((R & ~31) + perm32(R & 31)) : R;
        voffA[i] = (unsigned)(R * LDA + C) * 2u; voffB[i] = (unsigned)(Rb * LDB + C) * 2u; }
    constexpr size_t kstep = (size_t)(BK * 2);
    constexpr size_t hstepA = (size_t)HALF * LDA * 2, hstepB = (size_t)HALF * LDB * 2;
    constexpr size_t tstepA = 2 * hstepA, tstepB = 2 * hstepB;
    const unsigned ldsw = (unsigned)wid * 1024u;
    const int aoff = lds_byte(wr * 64 + fr, fq * 8), boff = lds_byte(wc * 32 + fr, fq * 8);
#define PG8_SA(b, h) (((b) * 2 + (h)) * HTB)
#define PG8_SB(b, h) ((4 + (b) * 2 + (h)) * HTB)
#define PG8_STAGE(bufoff, gbase, voff) do { _Pragma("unroll") for (int _i = 0; _i < 2; ++_i) \
        __builtin_amdgcn_global_load_lds((const unsigned*)((const char*)(gbase) + (voff)[_i]), (PG8_LAS unsigned*)(lds + (bufoff) + ldsw + _i * 8192), 16, 0, 0); } while (0)
#define PG8_LDA(dst, b, h) do { _Pragma("unroll") for (int m = 0; m < 4; ++m) _Pragma("unroll") for (int k = 0; k < 2; ++k) dst[m][k] = *(const PG8_LAS bf16x8*)(lds + PG8_SA(b, h) + aoff + m * 2048 + k * 1024); } while (0)
#define PG8_LDB(dst, b, h) do { _Pragma("unroll") for (int n = 0; n < 2; ++n) _Pragma("unroll") for (int k = 0; k < 2; ++k) dst[n][k] = *(const PG8_LAS bf16x8*)(lds + PG8_SB(b, h) + boff + n * 2048 + k * 1024); } while (0)
#define PG8_MMA(ai, bj, At, Bt) do { __builtin_amdgcn_s_setprio(1); _Pragma("unroll") for (int m = 0; m < 4; ++m) _Pragma("unroll") for (int n = 0; n < 2; ++n) _Pragma("unroll") for (int k = 0; k < 2; ++k) \
        acc[ai][bj][m][n] = __builtin_amdgcn_mfma_f32_16x16x32_bf16(Bt[n][k], At[m][k], acc[ai][bj][m][n], 0, 0, 0); __builtin_amdgcn_s_setprio(0); } while (0)
#define PG8_WAIT_V(n) asm volatile("s_waitcnt vmcnt(" #n ")" ::: "memory")
#define PG8_WAIT_L(n) asm volatile("s_waitcnt lgkmcnt(" #n ")" ::: "memory")
#define PG8_BAR __builtin_amdgcn_s_barrier()
#define PG8_SCHED __builtin_amdgcn_sched_barrier(0)
    Unit cur, nxt; int ui = 0;
    if (!S.next(0, cur)) return;
    Acc acc;
#pragma unroll
    for (int a = 0; a < 2; ++a)
#pragma unroll
        for (int b = 0; b < 2; ++b)
#pragma unroll
            for (int m = 0; m < 4; ++m)
#pragma unroll
                for (int n = 0; n < 2; ++n) acc[a][b][m][n] = (f32x4){0.f, 0.f, 0.f, 0.f};
    bf16x8 At[4][2], B0[2][2], B1[2][2];
    const char* cA = (const char*)g.A + (size_t)cur.pm * tstepA; const char* cB = (const char*)g.Bt + (size_t)cur.pn * tstepB;
    S.a_ready(cur);
    typename Epi::Pre pre = E.pre(cur, wr, fr, fq);
    PG8_STAGE(PG8_SB(0, 0), cB, voffB); PG8_STAGE(PG8_SB(0, 1), cB + hstepB, voffB); PG8_STAGE(PG8_SA(0, 0), cA, voffA); PG8_STAGE(PG8_SA(0, 1), cA + hstepA, voffA);
    if (wr == 1) PG8_BAR;
    PG8_WAIT_V(2); PG8_BAR;
    PG8_STAGE(PG8_SB(1, 0), cB + kstep, voffB); PG8_STAGE(PG8_SA(1, 0), cA + kstep, voffA); PG8_STAGE(PG8_SB(1, 1), cB + hstepB + kstep, voffB);
    PG8_WAIT_V(6); PG8_BAR;
    for (;;) {
        const bool has_next = S.next(ui + 1, nxt);
        const char* nA = has_next ? (const char*)g.A + (size_t)nxt.pm * tstepA : cA; const char* nB = has_next ? (const char*)g.Bt + (size_t)nxt.pn * tstepB : cB;
        for (int t = 0; t < nt; t += 2) {
            const bool last = (t == nt - 2);
            const char* a1 = cA + (size_t)(t + 1) * kstep;
            const char* a2 = last ? nA : cA + (size_t)(t + 2) * kstep; const char* b2 = last ? nB : cB + (size_t)(t + 2) * kstep;
            const char* a3 = a2 + kstep; const char* b3 = b2 + kstep;
            if (last && has_next) S.a_ready(nxt);
            if constexpr (Epi::HOOK) { E.hook(acc, cur, t, wr, wc, fr, fq); PG8_SCHED; }
            PG8_LDB(B0, 0, 0); PG8_LDB(B1, 0, 1); PG8_SCHED; PG8_LDA(At, 0, 0); PG8_STAGE(PG8_SA(1, 1), a1 + hstepA, voffA);
            PG8_WAIT_V(8); PG8_WAIT_L(0); PG8_BAR; PG8_MMA(0, 0, At, B0); PG8_MMA(0, 1, At, B1); PG8_BAR; PG8_SCHED;
            PG8_LDA(At, 0, 1); PG8_STAGE(PG8_SB(0, 0), b2, voffB); PG8_STAGE(PG8_SB(0, 1), b2 + hstepB, voffB); PG8_STAGE(PG8_SA(0, 0), a2, voffA);
            PG8_WAIT_V(8); PG8_WAIT_L(0); PG8_BAR; PG8_MMA(1, 0, At, B0); PG8_MMA(1, 1, At, B1); PG8_BAR; PG8_SCHED;
            PG8_LDB(B0, 1, 0); PG8_LDB(B1, 1, 1); PG8_SCHED; PG8_LDA(At, 1, 0); PG8_STAGE(PG8_SA(0, 1), a2 + hstepA, voffA);
            PG8_WAIT_V(8); PG8_WAIT_L(0); PG8_BAR; PG8_MMA(0, 0, At, B0); PG8_MMA(0, 1, At, B1); PG8_BAR; PG8_SCHED;
            PG8_LDA(At, 1, 1); PG8_STAGE(PG8_SB(1, 0), b3, voffB); PG8_STAGE(PG8_SB(1, 1), b3 + hstepB, voffB); PG8_STAGE(PG8_SA(1, 0), a3, voffA);
            PG8_WAIT_V(8); PG8_WAIT_L(0); PG8_BAR; PG8_MMA(1, 0, At, B0); PG8_MMA(1, 1, At, B1); PG8_BAR; PG8_SCHED;
        }
        if constexpr (ALIGN_EPI) { if (wr == 0) PG8_BAR; }
        E(acc, cur, wr, wc, fr, fq, pre); S.done(cur);
        if (!has_next) break;
#pragma unroll
        for (int a = 0; a < 2; ++a)
#pragma unroll
            for (int b = 0; b < 2; ++b)
#pragma unroll
                for (int m = 0; m < 4; ++m)
#pragma unroll
                    for (int n = 0; n < 2; ++n) acc[a][b][m][n] = (f32x4){0.f, 0.f, 0.f, 0.f};
        cur = nxt; cA = nA; cB = nB; ++ui;
        pre = E.pre(cur, wr, fr, fq);
        if constexpr (ALIGN_EPI) { if (wr == 1) PG8_BAR; }
    }
    PG8_WAIT_V(0);
    if constexpr (!ALIGN_EPI) { if (wr == 0) PG8_BAR; }
    PG8_BAR;
#undef PG8_SA
#undef PG8_SB
#undef PG8_STAGE
#undef PG8_LDA
#undef PG8_LDB
#undef PG8_MMA
#undef PG8_WAIT_V
#undef PG8_WAIT_L
#undef PG8_BAR
#undef PG8_SCHED
}
}

#define XB_TMO      128
#define XB_XCNT(j)  (256  + 64 * (j))
#define XB_XSUB(j)  (1280 + 64 * (j))
#define XB_XGEN(j)  (2304 + 64 * (j))
#define XB_TOP      3328
#define XB_TOPGEN   3392
#define XCD_BAR_WORDS 3456
#define XB_SPIN_CAP (1u << 18)
__device__ __forceinline__ unsigned xb_ld(unsigned* p)              { return __hip_atomic_load(p, __ATOMIC_RELAXED, __HIP_MEMORY_SCOPE_AGENT); }
__device__ __forceinline__ unsigned xb_add(unsigned* p, unsigned v) { return __hip_atomic_fetch_add(p, v, __ATOMIC_RELAXED, __HIP_MEMORY_SCOPE_AGENT); }
__device__ __forceinline__ unsigned xb_xcc_id() { return (unsigned)__builtin_amdgcn_s_getreg((3 << 11) | 20) & 0xFu; }
#define XB_SPIN(cond, bar) do { unsigned _sp = 0; while (cond) { __builtin_amdgcn_s_sleep(1); \
    if ((++_sp & 255u) == 0u) { if (xb_ld(&(bar)[XB_TMO])) break; if (_sp > XB_SPIN_CAP) { atomicAdd(&(bar)[XB_TMO], 1u); break; } } } } while (0)
struct XcdBarrier { unsigned* bar; unsigned x; volatile LAS unsigned* st; };
__device__ __forceinline__ XcdBarrier xcd_barrier_post(unsigned* bar, volatile LAS unsigned* st) {
    XcdBarrier b; b.bar = bar; b.x = xb_xcc_id(); b.st = st;
    if (threadIdx.x == 0) (void)xb_add(&bar[XB_XCNT(b.x)], 1u);
    return b;
}
__device__ __forceinline__ void xcd_barrier_complete(unsigned* bar, unsigned x, unsigned& nloc, unsigned& nx) {
    const unsigned G = gridDim.x * gridDim.y * gridDim.z;
    unsigned sum, cnt, mine, sp = 0u;
    for (;;) {
        sum = 0u; cnt = 0u; mine = 0u;
#pragma unroll
        for (unsigned j = 0; j < 16; ++j) { const unsigned c = xb_ld(&bar[XB_XCNT(j)]); sum += c; cnt += (c > 0u) ? 1u : 0u; mine = (j == x) ? c : mine; }
        if (sum == G) break;
        __builtin_amdgcn_s_sleep(1);
        if ((++sp & 255u) == 0u) { if (xb_ld(&bar[XB_TMO])) break; if (sp > XB_SPIN_CAP) { atomicAdd(&bar[XB_TMO], 1u); break; } }
    }
    nloc = mine > 0u ? mine : 1u; nx = cnt > 0u ? cnt : 1u;
}
__device__ __forceinline__ void xcd_barrier(const XcdBarrier& b) {
    asm volatile("s_waitcnt vmcnt(0)" ::: "memory");
    __syncthreads();
    if (threadIdx.x == 0) {
        unsigned* bar = b.bar;
        __builtin_amdgcn_s_waitcnt(0);
        unsigned nloc = b.st[0], nx = b.st[1];
        if (nloc == 0u) { xcd_barrier_complete(bar, b.x, nloc, nx); b.st[0] = nloc; b.st[1] = nx; }
        const unsigned old = xb_add(&bar[XB_XSUB(b.x)], 1u);
        const unsigned gen = old / nloc;
        if (old + 1u == (gen + 1u) * nloc) {
            __builtin_amdgcn_fence(__ATOMIC_RELEASE, "agent");
            asm volatile("s_waitcnt vmcnt(0)" ::: "memory");
            const unsigned og = xb_add(&bar[XB_TOP], 1u);
            const unsigned tg = og / nx;
            if (og + 1u == (tg + 1u) * nx) xb_add(&bar[XB_TOPGEN], 1u);
            else XB_SPIN(xb_ld(&bar[XB_TOPGEN]) == tg, bar);
            __builtin_amdgcn_fence(__ATOMIC_ACQUIRE, "agent");
            xb_add(&bar[XB_XGEN(b.x)], 1u);
            asm volatile("s_waitcnt vmcnt(0)" ::: "memory");
        } else {
            XB_SPIN(xb_ld(&bar[XB_XGEN(b.x)]) == gen, bar);
            __builtin_amdgcn_fence(__ATOMIC_ACQUIRE, "agent");
            asm volatile("s_waitcnt vmcnt(0)" ::: "memory");
        }
    }
    __syncthreads();
}

struct Args { const float* in[18]; float* out; unsigned char* ws; int ph_lo, ph_hi; };
struct Frame {
    LAS unsigned char* lds;
    int vcu, G;
    unsigned char* ws;
};
__device__ __forceinline__ int opaque_tid() { int t = threadIdx.x; asm volatile("" : "+v"(t)); return t; }
#define TID ((int)threadIdx.x)
#define WSP(T_, off) ((T_*)(F.ws + (off)))
#define LDS_WAIT() asm volatile("s_waitcnt lgkmcnt(0)" ::: "memory")

struct TrDesc { const float* W; const float* gain; bf16* dst; int Nsrc, srccol0, k0, Kdst; };
__device__ __forceinline__ void tr_load(const TrDesc& d, f32x4 (&v)[16], int lane) {
#pragma unroll
    for (int i = 0; i < 16; ++i) v[i] = *(const f32x4*)(d.W + (size_t)(d.k0 + 4 * i + (lane >> 4)) * d.Nsrc + d.srccol0 + 4 * (lane & 15));
}
__device__ __forceinline__ void tr_finish(const TrDesc& d, const f32x4 (&v)[16], LAS float* scr, int lane) {
#pragma unroll
    for (int i = 0; i < 16; ++i) { const int kk = 4 * i + (lane >> 4); f32x4 x = v[i]; if (d.gain) x = x * d.gain[d.k0 + kk]; *(LAS f32x4*)(scr + kk * 68 + 4 * (lane & 15)) = x; }
    LDS_WAIT(); asm volatile("" ::: "memory");
    const int c = lane & 7;
#pragma unroll
    for (int j = 0; j < 8; ++j) { const int n = (lane >> 3) + 8 * j; const LAS float* sp = scr + (8 * c) * 68 + n;
        u32x4 o; o.x = cvtpk(sp[0 * 68], sp[1 * 68]); o.y = cvtpk(sp[2 * 68], sp[3 * 68]); o.z = cvtpk(sp[4 * 68], sp[5 * 68]); o.w = cvtpk(sp[6 * 68], sp[7 * 68]);
        *(u32x4*)(d.dst + (size_t)n * d.Kdst + d.k0 + 8 * c) = o; }
    LDS_WAIT(); asm volatile("" ::: "memory");
}
__device__ __forceinline__ int in_srccol(int n0) {
    if (n0 < C_Q || n0 >= C_V) return n0;
    const int tile = n0 >> 8, within = n0 & 255, bj = within >> 7, w = within & 127, sec = (tile < 4) ? C_Q : C_K;
    return sec + (2 * (tile & 1) + (w >> 6)) * 128 + (w & 63) + 64 * bj;
}
__device__ __forceinline__ void rms_row_bf16(const float* xrow, bf16* orow, int lane) {
    const f32x4* xr = (const f32x4*)xrow + lane; f32x4 v[4]; float s = 0.f;
#pragma unroll
    for (int j = 0; j < 4; ++j) { v[j] = xr[64 * j]; s += (v[j].x * v[j].x + v[j].y * v[j].y) + (v[j].z * v[j].z + v[j].w * v[j].w); }
    const float r = rsqrtf(wave_sum(s) * (1.0f / DM) + EPS);
    u32x2* o = (u32x2*)orow + lane;
#pragma unroll
    for (int j = 0; j < 4; ++j) { u32x2 w; w.x = cvtpk(v[j].x * r, v[j].y * r); w.y = cvtpk(v[j].z * r, v[j].w * r); o[64 * j] = w; }
}
__device__ __forceinline__ void norm_rows(Frame& F, const float* X, bf16* XB, int nrows) {
    const int tid = opaque_tid(), lane = tid & 63, wave = __builtin_amdgcn_readfirstlane(tid >> 6), fr = lane & 15, fq = lane >> 4; (void)tid; (void)lane; (void)wave; (void)fr; (void)fq;
    const int gw = F.vcu * 8 + wave, NGW = F.G * 8;
    for (int m = gw; m < nrows; m += NGW) rms_row_bf16(X + (size_t)m * DM, XB + (size_t)m * DM, lane);
}
__device__ __forceinline__ void final_norm(Frame& F, float* out, const float* g) {
    const int tid = opaque_tid(), lane = tid & 63, wave = __builtin_amdgcn_readfirstlane(tid >> 6);
    const int gw = F.vcu * 8 + wave, NGW = F.G * 8;
    for (int m = gw; m < T; m += NGW) {
        const float* sp = WSP(float, WS_SSP) + (size_t)m * 16; float q = 0.f;
#pragma unroll
        for (int j = 0; j < 16; ++j) q += sp[j];
        const float r = rsqrtf(q * (1.0f / DM) + EPS);
        const u32x2* xr = (const u32x2*)(WSP(bf16, WS_XB) + (size_t)m * DM) + lane; f32x4* o = (f32x4*)(out + (size_t)m * DM) + lane;
#pragma unroll
        for (int j = 0; j < 4; ++j) { const u32x2 v = xr[64 * j]; const f32x4 gg = *((const f32x4*)g + lane + 64 * j);
            o[64 * j] = (f32x4){bflo(v.x) * r * gg.x, bfhi(v.x) * r * gg.y, bflo(v.y) * r * gg.z, bfhi(v.y) * r * gg.w}; }
    }
}

__device__ __forceinline__ void p0_prologue(Frame& F, const Args& A) {
    const int tid = opaque_tid(), lane = tid & 63, wave = __builtin_amdgcn_readfirstlane(tid >> 6);
    LAS float* scr = (LAS float*)(F.lds + wave * 17408);
    const int gw = F.vcu * 8 + wave, NGW = F.G * 8;
    constexpr int I_IN = 16 * 112, I_MKV = 16 * 16, I_UR = 16 * 16, I_UM = 8 * 16, I_OUT = 16 * 16, I_1 = 16 * 64, I_2 = 64 * 16;
    constexpr int PER_L = I_IN + I_MKV + I_UR + I_UM + I_OUT + I_1 + I_2;
#define TR_DESC(d, it_) do { const int l_ = (it_) / PER_L; int r_ = (it_) % PER_L; unsigned char* wl_ = F.ws + WS_W + (size_t)l_ * W_LAYER; \
        if (r_ < I_IN) { const int kb = r_ / 112, nb = r_ % 112; d = TrDesc{A.in[4] + (size_t)l_ * DM * INC, A.in[3] + l_ * DM, (bf16*)(wl_ + WO_IN) + (size_t)(64 * nb) * DM, INC, in_srccol(64 * nb), 64 * kb, DM}; } \
        else if ((r_ -= I_IN) < I_MKV) { const int kb = r_ / 16, nb = r_ % 16; d = TrDesc{A.in[9] + (size_t)l_ * DM * 1024, A.in[8] + l_ * DM, (bf16*)(wl_ + WO_MKV) + (size_t)(64 * nb) * DM, 1024, 64 * nb, 64 * kb, DM}; } \
        else if ((r_ -= I_MKV) < I_UR) { const int kb = r_ / 16, nb = r_ % 16; d = TrDesc{A.in[11] + (size_t)l_ * 1024 * DM, A.in[7] + l_ * 1024, (bf16*)(wl_ + WO_UP) + (size_t)(64 * nb) * 2048 + 512, DM, 64 * nb, 64 * kb, 2048}; } \
        else if ((r_ -= I_UR) < I_UM) { const int kb = r_ / 16, nb = r_ % 16; d = TrDesc{A.in[12] + (size_t)l_ * 512 * DM, nullptr, (bf16*)(wl_ + WO_UP) + (size_t)(64 * nb) * 2048 + 1536, DM, 64 * nb, 64 * kb, 2048}; } \
        else if ((r_ -= I_UM) < I_OUT) { const int kb = r_ / 16, nb = r_ % 16; d = TrDesc{A.in[13] + (size_t)l_ * DM * DM, nullptr, (bf16*)(wl_ + WO_OUT) + (size_t)(64 * nb) * DM, DM, 64 * nb, 64 * kb, DM}; } \
        else if ((r_ -= I_OUT) < I_1) { const int kb = r_ / 64, nb = r_ % 64; d = TrDesc{A.in[15] + (size_t)l_ * DM * DFF, A.in[14] + l_ * DM, (bf16*)(wl_ + WO_1) + (size_t)(64 * nb) * DM, DFF, 64 * nb, 64 * kb, DM}; } \
        else { r_ -= I_1; const int kb = r_ / 16, nb = r_ % 16; d = TrDesc{A.in[16] + (size_t)l_ * DFF * DM, nullptr, (bf16*)(wl_ + WO_2) + (size_t)(64 * nb) * DFF, DM, 64 * nb, 64 * kb, DFF}; } } while (0)
    {
        TrDesc dA, dB; f32x4 vA[16], vB[16];
        int it = gw;
        if (it < 2 * PER_L) { TR_DESC(dA, it); tr_load(dA, vA, lane); }
        while (it < 2 * PER_L) {
            const int itB = it + NGW;
            if (itB < 2 * PER_L) { TR_DESC(dB, itB); tr_load(dB, vB, lane); }
            tr_finish(dA, vA, scr, lane);
            if (itB >= 2 * PER_L) break;
            const int itA = itB + NGW;
            if (itA < 2 * PER_L) { TR_DESC(dA, itA); tr_load(dA, vA, lane); }
            tr_finish(dB, vB, scr, lane);
            it = itA;
        }
    }
#undef TR_DESC
    const int gt = F.vcu * 512 + tid, NT = F.G * 512;
    {
        const float inv = (float)exp2(-(double)(gt & 63) * (13.287712379549449 / 64.0));
        const int* pos = (const int*)A.in[2];
        for (int i = gt; i < T * 64; i += NT) {
            const float a = (float)pos[i >> 6] * inv;
            const double ad = (double)a, k = rint(ad * 0.15915494309189535), rr = ad - k * 6.283185307179586;
            const float rf = (float)rr;
            WSP(float, WS_COS)[i] = cosf(rf); WSP(float, WS_SIN)[i] = sinf(rf);
        }
    }
    for (int m = gw; m < T; m += NGW) {
        const f32x4* xr = (const f32x4*)(A.in[0] + (size_t)m * DM) + 2 * lane; float q = 0.f; u32x4* o = (u32x4*)(WSP(bf16, WS_XB) + (size_t)m * DM) + lane;
#pragma unroll
        for (int j = 0; j < 2; ++j) { const f32x4 v = xr[128 * j], v2 = xr[128 * j + 1]; q += ((v.x * v.x + v.y * v.y) + (v.z * v.z + v.w * v.w)) + ((v2.x * v2.x + v2.y * v2.y) + (v2.z * v2.z + v2.w * v2.w));
            u32x4 w; w.x = cvtpk(v.x, v.y); w.y = cvtpk(v.z, v.w); w.z = cvtpk(v2.x, v2.y); w.w = cvtpk(v2.z, v2.w); o[64 * j] = w; }
        q = wave_sum(q);
        if (lane < 16) WSP(float, WS_SSP)[(size_t)m * 16 + lane] = (lane == 0) ? q : 0.f;
    }
    norm_rows(F, A.in[1], WSP(bf16, WS_MEMN), NB * NMEM);
    __syncthreads();
    LAS float* PW = (LAS float*)F.lds;
    LAS float* WU = (LAS float*)(F.lds + 128 * 129 * 4);
    for (int it = F.vcu; it < 2 * 4 * 32; it += F.G) {
        const int l = it >> 7, g = (it >> 5) & 3, n0 = (it & 31) * 32;
        const float* pw = A.in[5] + ((size_t)l * 512 + g * 128) * 128; const float* ps = A.in[6] + l * 512 + g * 128; const float* wu = A.in[10] + ((size_t)l * 512 + g * 128) * DM + n0;
        for (int i = tid; i < 128 * 128; i += 512) { const int c = i >> 7, cp = i & 127; PW[c * 129 + cp] = pw[i] * ps[cp]; }
        for (int i = tid; i < 128 * 8; i += 512) { const int cp = i >> 3, q = i & 7; *(LAS f32x4*)(WU + cp * 32 + 4 * q) = *(const f32x4*)(wu + (size_t)cp * DM + 4 * q); }
        __syncthreads();
        const int c = tid & 127, nq = tid >> 7;
        f32x4 s0 = {0.f, 0.f, 0.f, 0.f}, s1 = {0.f, 0.f, 0.f, 0.f};
#pragma unroll 8
        for (int cp = 0; cp < 128; ++cp) { const float p = PW[c * 129 + cp]; s0 += p * *(LAS f32x4*)(WU + cp * 32 + 8 * nq); s1 += p * *(LAS f32x4*)(WU + cp * 32 + 8 * nq + 4); }
        bf16* dst = (bf16*)(F.ws + WS_W + (size_t)l * W_LAYER + WO_UP) + (size_t)(n0 + 8 * nq) * 2048 + g * 128 + c;
#pragma unroll
        for (int j = 0; j < 4; ++j) { dst[(size_t)j * 2048] = (bf16)(cvtpk(s0[j], 0.f) & 0xffffu); dst[(size_t)(4 + j) * 2048] = (bf16)(cvtpk(s1[j], 0.f) & 0xffffu); }
        __syncthreads();
    }
}

__device__ __forceinline__ bf16x8 frag_tr(LAS unsigned char* Tt, int ldb, int rowA, int rowB, int col0, int fr) {
#if USE_TR
    const int q = fr >> 2, p = fr & 3;
    const s16x4 lo = __builtin_bit_cast(s16x4, __builtin_amdgcn_ds_read_tr16_b64_v4i16((LAS v4i16_t*)(Tt + (rowA + q) * ldb + (col0 + 4 * p) * 2)));
    const s16x4 hi = __builtin_bit_cast(s16x4, __builtin_amdgcn_ds_read_tr16_b64_v4i16((LAS v4i16_t*)(Tt + (rowB + q) * ldb + (col0 + 4 * p) * 2)));
    return __builtin_shufflevector(lo, hi, 0, 1, 2, 3, 4, 5, 6, 7);
#else
    bf16x8 f;
#pragma unroll
    for (int e = 0; e < 4; ++e) { f[e] = *(LAS short*)(Tt + (rowA + e) * ldb + (col0 + fr) * 2); f[4 + e] = *(LAS short*)(Tt + (rowB + e) * ldb + (col0 + fr) * 2); }
    return f;
#endif
}
__device__ __forceinline__ bf16x8 pack8(const f32x4& a, const f32x4& b) { u32x4 w; w.x = cvtpk(a[0], a[1]); w.y = cvtpk(a[2], a[3]); w.z = cvtpk(b[0], b[1]); w.w = cvtpk(b[2], b[3]); return __builtin_bit_cast(bf16x8, w); }
__device__ __forceinline__ float log2gamma(int h) { return log2f(1.0f - exp2f(-5.0f - (float)h)); }

__device__ __forceinline__ void mem_kv_proj(Frame& F) {
    const int tid = opaque_tid(), lane = tid & 63, wave = __builtin_amdgcn_readfirstlane(tid >> 6), fr = lane & 15, fq = lane >> 4;
    LAS unsigned char* As = F.lds; LAS unsigned char* Bs = F.lds + 33792;
    const int wm = wave & 3, wn = wave >> 2;
    for (int it = F.vcu; it < 512; it += F.G) {
        const int l = it >> 8, tm = (it >> 4) & 15, tn = it & 15;
        const bf16* Ag = WSP(bf16, WS_MEMN) + (size_t)(tm * 64) * DM; const bf16* Bg = WSP(bf16, WS_W + (size_t)l * W_LAYER + WO_MKV) + (size_t)(tn * 64) * DM;
        f32x4 acc[2]; acc[0] = (f32x4){0.f, 0.f, 0.f, 0.f}; acc[1] = (f32x4){0.f, 0.f, 0.f, 0.f};
        for (int kc = 0; kc < 4; ++kc) {
            __syncthreads();
#pragma unroll
            for (int k = 0; k < 4; ++k) { const int c = tid + 512 * k, r = c >> 5, ch = c & 31;
                *(LAS u32x4*)(As + r * 528 + ch * 16) = *(const u32x4*)(Ag + (size_t)r * DM + kc * 256 + ch * 8);
                *(LAS u32x4*)(Bs + r * 528 + ch * 16) = *(const u32x4*)(Bg + (size_t)r * DM + kc * 256 + ch * 8); }
            __syncthreads();
#pragma unroll
            for (int ks = 0; ks < 8; ++ks) { const bf16x8 af = *(LAS bf16x8*)(As + (16 * wm + fr) * 528 + (32 * ks + 8 * fq) * 2);
#pragma unroll
                for (int c = 0; c < 2; ++c) acc[c] = mfma16(*(LAS bf16x8*)(Bs + (32 * wn + 16 * c + fr) * 528 + (32 * ks + 8 * fq) * 2), af, acc[c]); }
        }
        bf16* dst = WSP(bf16, WS_KVMEM) + (size_t)l * 1024 * 1024 + (size_t)(tm * 64 + 16 * wm + fr) * 1024 + tn * 64 + 32 * wn + 4 * fq;
#pragma unroll
        for (int c = 0; c < 2; ++c) { u32x2 w; w.x = cvtpk(acc[c][0], acc[c][1]); w.y = cvtpk(acc[c][2], acc[c][3]); *(u32x2*)(dst + 16 * c) = w; }
    }
    __syncthreads();
}

template <int W> __device__ __forceinline__ void pool_item(bf16* P, int tl0, int c0) {
    const int pos0 = tl0 & (SEQ - 1);
    u32x4 r[W + 7];
#pragma unroll
    for (int i = 0; i < W + 7; ++i) { r[i] = (u32x4){0u, 0u, 0u, 0u}; if (pos0 - (W - 1) + i >= 0) r[i] = *(const u32x4*)(P + (size_t)(tl0 - (W - 1) + i) * PLD + c0); }
    float s[8];
#pragma unroll
    for (int e = 0; e < 8; ++e) s[e] = 0.f;
#pragma unroll
    for (int i = 0; i < W - 1; ++i)
#pragma unroll
        for (int e = 0; e < 4; ++e) { s[2 * e] += bflo(r[i][e]); s[2 * e + 1] += bfhi(r[i][e]); }
#pragma unroll
    for (int tt = 0; tt < 8; ++tt) {
        const int pos = pos0 + tt; const float rc = 1.0f / (float)((pos + 1 < W) ? pos + 1 : W);
        float d[8];
#pragma unroll
        for (int e = 0; e < 4; ++e) { const float u0 = bflo(r[W - 1 + tt][e]), u1 = bfhi(r[W - 1 + tt][e]); s[2 * e] += u0; s[2 * e + 1] += u1; d[2 * e] = s[2 * e] * rc - u0; d[2 * e + 1] = s[2 * e + 1] * rc - u1; }
        u32x4 o; o.x = cvtpk(d[0], d[1]); o.y = cvtpk(d[2], d[3]); o.z = cvtpk(d[4], d[5]); o.w = cvtpk(d[6], d[7]);
        *(u32x4*)(P + (size_t)(tl0 + tt) * PLD + C_DP + c0) = o;
#pragma unroll
        for (int e = 0; e < 4; ++e) { s[2 * e] -= bflo(r[tt][e]); s[2 * e + 1] -= bfhi(r[tt][e]); }
    }
}
__device__ __forceinline__ void mix_pool(Frame& F) {
    const int tid = opaque_tid(), lane = tid & 63, wave = __builtin_amdgcn_readfirstlane(tid >> 6);
    bf16* P = WSP(bf16, WS_PROJ);
    const int gw = F.vcu * 8 + wave, NGW = F.G * 8;
    for (int it = gw; it < 4 * (TH / 32); it += NGW) {
        const int g = it & 3, tl0 = (it >> 2) * 32 + (lane >> 4) * 8, c0 = g * 128 + (lane & 15) * 8;
        if (g == 0) pool_item<2>(P, tl0, c0); else if (g == 1) pool_item<4>(P, tl0, c0); else if (g == 2) pool_item<8>(P, tl0, c0); else pool_item<16>(P, tl0, c0);
    }
}

__device__ __forceinline__ void mix_mem(Frame& F, int l, int hf, bool dummy) {
    const int tid = opaque_tid(), lane = tid & 63, wave = __builtin_amdgcn_readfirstlane(tid >> 6), fr = lane & 15, fq = lane >> 4; (void)tid; (void)lane; (void)wave; (void)fr; (void)fq;
    bf16* P = WSP(bf16, WS_PROJ);
    LAS unsigned char* Kt = F.lds; LAS unsigned char* Vt = F.lds + 69632;
    const int items = 8 * 64, ipw = (items + F.G - 1) / F.G;
    const int it_lo = F.vcu * ipw, it_hi = (it_lo + ipw < items) ? it_lo + ipw : items;
    int loaded = -1;
    for (int it = it_lo; it < it_hi; ++it) {
        const int combo = it >> 6, qt = it & 63, bl = combo >> 2, h = combo & 3;
        if (combo != loaded) {
            __syncthreads();
            const bf16* src = WSP(bf16, WS_KVMEM) + (size_t)l * 1024 * 1024 + (size_t)((2 * hf + bl) * NMEM) * 1024 + h * 128;
            for (int c = tid; c < 4096; c += 512) { const int key = c >> 4, ch = c & 15;
                *(LAS u32x4*)(Kt + key * 272 + ch * 16) = *(const u32x4*)(src + (size_t)key * 1024 + ch * 8);
                *(LAS u32x4*)(Vt + key * 272 + ch * 16) = *(const u32x4*)(src + (size_t)key * 1024 + 512 + ch * 8); }
            __syncthreads(); loaded = combo;
        }
        bf16* qp = P + (size_t)(bl * SEQ + qt * 128 + wave * 16 + fr) * PLD + C_XQ + h * 128;
        bf16x8 bq[4];
#pragma unroll
        for (int ks = 0; ks < 4; ++ks) bq[ks] = *(const bf16x8*)(qp + ks * 32 + fq * 8);
        f32x4 s[16];
#pragma unroll
        for (int kt = 0; kt < 16; ++kt) { s[kt] = (f32x4){0.f, 0.f, 0.f, 0.f};
#pragma unroll
            for (int ks = 0; ks < 4; ++ks) s[kt] = mfma16(*(LAS bf16x8*)(Kt + (16 * kt + fr) * 272 + (32 * ks + 8 * fq) * 2), bq[ks], s[kt]); }
        float mx = -3.0e38f;
#pragma unroll
        for (int kt = 0; kt < 16; ++kt) mx = fmaxf(fmaxf(fmaxf(s[kt][0], s[kt][1]), fmaxf(s[kt][2], s[kt][3])), mx);
        mx = max_xor16(mx); mx = max_xor32(mx);
        float lsum = 0.f;
#pragma unroll
        for (int kt = 0; kt < 16; ++kt)
#pragma unroll
            for (int r = 0; r < 4; ++r) { const float p = exp2f(s[kt][r] - mx); s[kt][r] = p; lsum += p; }
        lsum = add_xor16(lsum); lsum = add_xor32(lsum);
        const float rl = 1.0f / lsum;
        f32x4 o[8];
#pragma unroll
        for (int dt = 0; dt < 8; ++dt) o[dt] = (f32x4){0.f, 0.f, 0.f, 0.f};
#pragma unroll
        for (int kp = 0; kp < 8; ++kp) { const bf16x8 pf = pack8(s[2 * kp], s[2 * kp + 1]);
#pragma unroll
            for (int dt = 0; dt < 8; ++dt) o[dt] = mfma16(frag_tr(Vt, 272, 32 * kp + 4 * fq, 32 * kp + 16 + 4 * fq, 16 * dt, fr), pf, o[dt]); }
        bf16* op = (dummy ? WSP(bf16, WS_MERGED) + (size_t)(bl * SEQ + qt * 128 + wave * 16 + fr) * 512 + h * 128 : qp) + 16 * (fq & 1) + 4 * (fq & 2);
#pragma unroll
        for (int p = 0; p < 4; ++p) { const unsigned ax = cvtpk(o[2 * p][0] * rl, o[2 * p][1] * rl), ay = cvtpk(o[2 * p][2] * rl, o[2 * p][3] * rl), bx_ = cvtpk(o[2 * p + 1][0] * rl, o[2 * p + 1][1] * rl), by = cvtpk(o[2 * p + 1][2] * rl, o[2 * p + 1][3] * rl);
            auto rx = __builtin_amdgcn_permlane16_swap(ax, bx_, false, false); auto ry = __builtin_amdgcn_permlane16_swap(ay, by, false, false);
            u32x4 w; w.x = rx[0]; w.y = ry[0]; w.z = rx[1]; w.w = ry[1]; *(u32x4*)(op + 32 * p) = w; }
    }
    __syncthreads();
}

__device__ __forceinline__ void mix_kv(Frame& F) {
    const int tid = opaque_tid(), lane = tid & 63, wave = __builtin_amdgcn_readfirstlane(tid >> 6), fr = lane & 15, fq = lane >> 4; (void)tid; (void)lane; (void)wave; (void)fr; (void)fq;
    bf16* P = WSP(bf16, WS_PROJ);
    LAS unsigned char* Kd = F.lds; LAS unsigned char* Vt = F.lds + 34816;
    for (int un = F.vcu; un < 512; un += F.G) {
        const int h = un & 3, n = (un >> 2) & 63, bl = un >> 8; const size_t row0 = (size_t)bl * SEQ + n * 128; const float lg = log2gamma(h);
        __syncthreads();
        for (int c = tid; c < 2048; c += 512) { const int j = c >> 4, ch = c & 15; const u32x4 v = *(const u32x4*)(P + (row0 + j) * PLD + C_K + h * 128 + ch * 8); const float f = exp2f((float)(127 - j) * lg);
            u32x4 o; o.x = cvtpk(bflo(v.x) * f, bfhi(v.x) * f); o.y = cvtpk(bflo(v.y) * f, bfhi(v.y) * f); o.z = cvtpk(bflo(v.z) * f, bfhi(v.z) * f); o.w = cvtpk(bflo(v.w) * f, bfhi(v.w) * f);
            *(LAS u32x4*)(Kd + j * 272 + ch * 16) = o; }
        for (int c = tid; c < 4096; c += 512) { const int j = c >> 5, ch = c & 31; *(LAS u32x4*)(Vt + j * 528 + ch * 16) = *(const u32x4*)(P + (row0 + j) * PLD + C_V + h * 256 + ch * 8); }
        __syncthreads();
        f32x4 acc[8][2];
#pragma unroll
        for (int dt = 0; dt < 8; ++dt) { acc[dt][0] = (f32x4){0.f, 0.f, 0.f, 0.f}; acc[dt][1] = (f32x4){0.f, 0.f, 0.f, 0.f}; }
#pragma unroll
        for (int ks = 0; ks < 4; ++ks) { const int rA = 32 * ks + 8 * fq, rB = rA + 4;
            const bf16x8 bv0 = frag_tr(Vt, 528, rA, rB, 16 * (2 * wave), fr), bv1 = frag_tr(Vt, 528, rA, rB, 16 * (2 * wave + 1), fr);
#pragma unroll
            for (int dt = 0; dt < 8; ++dt) { const bf16x8 ad = frag_tr(Kd, 272, rA, rB, 16 * dt, fr); acc[dt][0] = mfma16(ad, bv0, acc[dt][0]); acc[dt][1] = mfma16(ad, bv1, acc[dt][1]); } }
        bf16* dst = WSP(bf16, WS_KVN) + (size_t)un * 32768 + 16 * (fq & 1) + 4 * (fq & 2);
#pragma unroll
        for (int vi = 0; vi < 2; ++vi)
#pragma unroll
            for (int p = 0; p < 4; ++p) { const f32x4 a = acc[2 * p][vi], b = acc[2 * p + 1][vi];
                const unsigned ax = cvtpk(a[0], a[1]), ay = cvtpk(a[2], a[3]), bx_ = cvtpk(b[0], b[1]), by = cvtpk(b[2], b[3]);
                auto rx = __builtin_amdgcn_permlane16_swap(ax, bx_, false, false); auto ry = __builtin_amdgcn_permlane16_swap(ay, by, false, false);
                u32x4 o; o.x = rx[0]; o.y = ry[0]; o.z = rx[1]; o.w = ry[1];
                *(u32x4*)(dst + (size_t)(16 * (2 * wave + vi) + fr) * 128 + 32 * p) = o; }
    }
    __syncthreads();
}

__device__ __forceinline__ void scan_states(Frame& F) {
    const int tid = opaque_tid(), lane = tid & 63, wave = __builtin_amdgcn_readfirstlane(tid >> 6), fr = lane & 15, fq = lane >> 4; (void)tid; (void)lane; (void)wave; (void)fr; (void)fq;
    const bf16* KV = WSP(bf16, WS_KVN); bf16* SP = WSP(bf16, WS_SPREV);
    if (tid < 256)
    for (int p = F.vcu * 256 + tid; p < 8 * 8192; p += F.G * 256) {
        const int blk = p >> 13, bl = blk >> 2, h = blk & 3, off = (p & 8191) * 4; const float cd = exp2f(128.0f * log2gamma(h));
        f32x4 st = {0.f, 0.f, 0.f, 0.f};
        for (int n0 = 0; n0 < 64; n0 += 8) {
            u32x2 kv[8];
#pragma unroll
            for (int j = 0; j < 8; ++j) kv[j] = *(const u32x2*)(KV + (size_t)((bl * 64 + n0 + j) * 4 + h) * 32768 + off);
#pragma unroll
            for (int j = 0; j < 8; ++j) { u32x2 w; w.x = cvtpk(st[0], st[1]); w.y = cvtpk(st[2], st[3]); *(u32x2*)(SP + (size_t)((bl * 64 + n0 + j) * 4 + h) * 32768 + off) = w;
                st = st * cd + (f32x4){bflo(kv[j].x), bfhi(kv[j].x), bflo(kv[j].y), bfhi(kv[j].y)}; }
        }
    }
}

__device__ __forceinline__ void ret_out(Frame& F, bool dummy) {
    const int tid = opaque_tid(), lane = tid & 63, wave = __builtin_amdgcn_readfirstlane(tid >> 6), fr = lane & 15, fq = lane >> 4; (void)tid; (void)lane; (void)wave; (void)fr; (void)fq;
    bf16* P = WSP(bf16, WS_PROJ);
    LAS unsigned char* Kt = F.lds; LAS unsigned char* Vt = F.lds + 34816; LAS unsigned char* Sp = F.lds + 102400;
    for (int un = F.vcu; un < 512; un += F.G) {
        const int h = un & 3, n = (un >> 2) & 63, bl = un >> 8; const size_t row0 = (size_t)bl * SEQ + n * 128; const float lg = log2gamma(h);
        const bf16* spg = WSP(bf16, WS_SPREV) + (size_t)un * 32768;
        const int i = wave * 16 + fr; const size_t trow = row0 + i;
        bf16x8 bq[4];
#pragma unroll
        for (int ks = 0; ks < 4; ++ks) bq[ks] = *(const bf16x8*)(P + trow * PLD + C_Q + h * 128 + ks * 32 + fq * 8);
        bf16* gp = P + trow * PLD + C_G + h * 256 + 4 * fq;
        __syncthreads();
        for (int c = tid; c < 2048; c += 512) { const int j = c >> 4, ch = c & 15;
            *(LAS u32x4*)(Kt + j * 272 + ch * 16) = *(const u32x4*)(P + (row0 + j) * PLD + C_K + h * 128 + ch * 8);
            *(LAS u32x4*)(Sp + j * 272 + ch * 16) = *(const u32x4*)(spg + (size_t)j * 128 + ch * 8); }
        for (int c = tid; c < 4096; c += 512) { const int j = c >> 5, ch = c & 31; *(LAS u32x4*)(Vt + j * 528 + ch * 16) = *(const u32x4*)(P + (row0 + j) * PLD + C_V + h * 256 + ch * 8); }
        u32x4 sp1[4];
#pragma unroll
        for (int k = 0; k < 4; ++k) { const int c = tid + 512 * k, j = c >> 4, ch = c & 15; sp1[k] = *(const u32x4*)(spg + (size_t)(128 + j) * 128 + ch * 8); }
        __syncthreads();
        f32x4 acc[16];
#pragma unroll
        for (int vt = 0; vt < 8; ++vt) { acc[vt] = (f32x4){0.f, 0.f, 0.f, 0.f};
#pragma unroll
            for (int ks = 0; ks < 4; ++ks) acc[vt] = mfma16(*(LAS bf16x8*)(Sp + (16 * vt + fr) * 272 + (32 * ks + 8 * fq) * 2), bq[ks], acc[vt]); }
        __syncthreads();
#pragma unroll
        for (int k = 0; k < 4; ++k) { const int c = tid + 512 * k, j = c >> 4, ch = c & 15; *(LAS u32x4*)(Sp + j * 272 + ch * 16) = sp1[k]; }
        __syncthreads();
#pragma unroll
        for (int vt = 8; vt < 16; ++vt) { acc[vt] = (f32x4){0.f, 0.f, 0.f, 0.f};
#pragma unroll
            for (int ks = 0; ks < 4; ++ks) acc[vt] = mfma16(*(LAS bf16x8*)(Sp + (16 * (vt - 8) + fr) * 272 + (32 * ks + 8 * fq) * 2), bq[ks], acc[vt]); }
        bf16* gq = P + trow * PLD + C_G + h * 256 + 16 * (fq & 1) + 4 * (fq & 2);
        u32x4 gl[8];
#pragma unroll
        for (int p = 0; p < 8; ++p) gl[p] = *(const u32x4*)(gq + 32 * p);
        const float fac = exp2f((float)(i + 1) * lg);
#pragma unroll
        for (int vt = 0; vt < 16; ++vt) acc[vt] = acc[vt] * fac;
        f32x4 s[8];
#pragma unroll
        for (int kt = 0; kt < 8; ++kt) { s[kt] = (f32x4){0.f, 0.f, 0.f, 0.f};
            if (kt <= wave) {
#pragma unroll
                for (int ks = 0; ks < 4; ++ks) s[kt] = mfma16(*(LAS bf16x8*)(Kt + (16 * kt + fr) * 272 + (32 * ks + 8 * fq) * 2), bq[ks], s[kt]);
#pragma unroll
                for (int r = 0; r < 4; ++r) { const int key = 16 * kt + 4 * fq + r; s[kt][r] = (key <= i) ? s[kt][r] * exp2f((float)(i - key) * lg) : 0.f; } } }
#pragma unroll
        for (int kp = 0; kp < 4; ++kp) if (2 * kp <= wave) { const bf16x8 pf = pack8(s[2 * kp], s[2 * kp + 1]);
#pragma unroll
            for (int vt = 0; vt < 16; ++vt) acc[vt] = mfma16(frag_tr(Vt, 528, 32 * kp + 4 * fq, 32 * kp + 16 + 4 * fq, 16 * vt, fr), pf, acc[vt]); }
        float ss = 0.f;
#pragma unroll
        for (int vt = 0; vt < 16; ++vt) ss += (acc[vt][0] * acc[vt][0] + acc[vt][1] * acc[vt][1]) + (acc[vt][2] * acc[vt][2] + acc[vt][3] * acc[vt][3]);
        ss = add_xor16(ss); ss = add_xor32(ss);
        const float rinv = rsqrtf(ss * (1.0f / 256.0f) + EPS);
#pragma unroll
        for (int p = 0; p < 8; ++p) {
            u32x2 g[2];
            { auto rx = __builtin_amdgcn_permlane16_swap(gl[p][0], gl[p][2], false, false); auto ry = __builtin_amdgcn_permlane16_swap(gl[p][1], gl[p][3], false, false);
              g[0].x = rx[0]; g[0].y = ry[0]; g[1].x = rx[1]; g[1].y = ry[1]; }
            u32x2 w[2];
#pragma unroll
            for (int j = 0; j < 2; ++j) { const int vt = 2 * p + j; const float g0 = bflo(g[j].x), g1 = bfhi(g[j].x), g2 = bflo(g[j].y), g3 = bfhi(g[j].y);
                w[j].x = cvtpk(acc[vt][0] * rinv * g0 * sigmoidf_(g0), acc[vt][1] * rinv * g1 * sigmoidf_(g1)); w[j].y = cvtpk(acc[vt][2] * rinv * g2 * sigmoidf_(g2), acc[vt][3] * rinv * g3 * sigmoidf_(g3)); }
            u32x4 o;
            { auto rx = __builtin_amdgcn_permlane16_swap(w[0].x, w[1].x, false, false); auto ry = __builtin_amdgcn_permlane16_swap(w[0].y, w[1].y, false, false);
              o.x = rx[0]; o.y = ry[0]; o.z = rx[1]; o.w = ry[1]; }
            *(u32x4*)((dummy ? WSP(bf16, WS_MERGED) + trow * 1024 + h * 256 + 16 * (fq & 1) + 4 * (fq & 2) : gq) + 32 * p) = o; }
    }
    __syncthreads();
}

constexpr int N_PHASES = 2 + 2 * 16 + 1;
__global__ void __launch_bounds__(512, 2) fwd_kernel(Args args) {
    extern __shared__ __attribute__((aligned(16))) unsigned char lds_raw[];
    Frame F;
    F.lds = (LAS unsigned char*)lds_raw;
    F.G = gridDim.x; { const int bx = blockIdx.x; F.vcu = (F.G % 8 == 0) ? (bx % 8) * (F.G / 8) + bx / 8 : bx; }
    F.ws = args.ws;
    const Args& A = args;
    for (int u = TID; u < (LDS_BYTES - LDSCTL_OFF) / 4; u += 512) ((LAS unsigned*)(F.lds + LDSCTL_OFF))[u] = 0u;
    __syncthreads();
    const int lo = args.ph_lo, hi = args.ph_hi;
    XcdBarrier bar; bar.bar = WSP(unsigned, WS_CTL) + CW_BAR; bar.x = 0; bar.st = nullptr;
    if (hi - lo > 1) bar = xcd_barrier_post(WSP(unsigned, WS_CTL) + CW_BAR, (volatile LAS unsigned*)(F.lds + MISC_OFF) + 8);
    int ph = 0;
#define RUN() (lo <= ph && ph < hi)
#define END_PHASE() do { if (RUN() && ph + 1 < hi) xcd_barrier(bar); ++ph; } while (0)
    const int bx = (int)blockIdx.x;

    if (RUN()) for (int rep = 0; rep < REPS(10); ++rep) { if (rep) xcd_barrier(bar); p0_prologue(F, A); }
    END_PHASE();
    if (RUN()) for (int rep = 0; rep < REPS(11); ++rep) { if (rep) xcd_barrier(bar); mem_kv_proj(F); }
    END_PHASE();
#pragma unroll 1
    for (int l = 0; l < 2; ++l) {
        unsigned char* wl = F.ws + WS_W + (size_t)l * W_LAYER;
#pragma unroll 1
        for (int hf = 0; hf < 2; ++hf) {
            const int t0 = hf * TH;
            if (RUN()) for (int rep = 0; rep < REPS(0); ++rep) { if (rep) xcd_barrier(bar);
                pg8::Gemm g{WSP(bf16, WS_XB) + (size_t)t0 * DM, (const bf16*)(wl + WO_IN)};
                pg8::StaticOrder<TH, 4096> S; S.init(F.G, bx);
                pg8::EpiBf<2> E{WSP(bf16, WS_PROJ), PLD, WSP(float, WS_COS), WSP(float, WS_SIN), t0, WSP(float, WS_SSP)};
                pg8::gemm_phase<DM, DM, DM, pg8::EpiBf<2>, pg8::StaticOrder<TH, 4096>>(F.lds, g, S, E);
            }
            END_PHASE();
            if (RUN()) for (int rep = 0; rep < REPS(1); ++rep) { if (rep) xcd_barrier(bar); mix_pool(F); mix_mem(F, l, hf, rep != 0); mix_kv(F); }
            END_PHASE();
            if (RUN()) for (int rep = 0; rep < REPS(2); ++rep) { if (rep) xcd_barrier(bar); scan_states(F); }
            END_PHASE();
            if (RUN()) for (int rep = 0; rep < REPS(3); ++rep) { if (rep) xcd_barrier(bar); ret_out(F, rep != 0); }
            END_PHASE();
            if (RUN()) for (int rep = 0; rep < REPS(4); ++rep) { if (rep) xcd_barrier(bar);
                pg8::Gemm g{WSP(bf16, WS_XB) + (size_t)t0 * DM, (const bf16*)(wl + WO_IN) + (size_t)4096 * DM};
                pg8::StaticOrder<TH, 3072> S; S.init(F.G, bx);
                pg8::EpiBf<3> E{WSP(bf16, WS_GATES), 3072, nullptr, nullptr, t0, WSP(float, WS_SSP)};
                pg8::gemm_phase<DM, DM, DM, pg8::EpiBf<3>, pg8::StaticOrder<TH, 3072>>(F.lds, g, S, E);
            }
            END_PHASE();
            if (RUN()) for (int rep = 0; rep < REPS(5); ++rep) { if (rep) xcd_barrier(bar);
                pg8::Gemm g{WSP(bf16, WS_PROJ) + C_DP, (const bf16*)(wl + WO_UP)};
                pg8::StaticOrder<TH, DM> S; S.init(F.G, bx);
                pg8::EpiUp E{WSP(bf16, WS_MERGED), WSP(bf16, WS_GATES)};
                pg8::gemm_phase<2048, PLD, 2048, pg8::EpiUp, pg8::StaticOrder<TH, DM>>(F.lds, g, S, E);
            }
            END_PHASE();
            if (RUN()) for (int rep = 0; rep < REPS(6); ++rep) { if (rep) xcd_barrier(bar);
                pg8::Gemm g{WSP(bf16, WS_MERGED), (const bf16*)(wl + WO_OUT)};
                pg8::StaticOrder<TH, DM> S; S.init(F.G, bx);
                pg8::EpiRes E{WSP(bf16, WS_XB) + (size_t)t0 * DM, WSP(float, WS_SSP) + (size_t)t0 * 16, rep ? WSP(bf16, WS_KVN) : nullptr};
                pg8::gemm_phase<DM, DM, DM, pg8::EpiRes, pg8::StaticOrder<TH, DM>>(F.lds, g, S, E);
            }
            END_PHASE();
        }
        if (RUN()) for (int rep = 0; rep < REPS(8); ++rep) { if (rep) xcd_barrier(bar);
            pg8::Gemm g{WSP(bf16, WS_XB), (const bf16*)(wl + WO_1)};
            pg8::StaticOrder<T, DFF> S; S.init(F.G, bx);
            pg8::EpiBf<1> E{WSP(bf16, WS_U), DFF, nullptr, nullptr, 0, WSP(float, WS_SSP)};
            pg8::gemm_phase<DM, DM, DM, pg8::EpiBf<1>, pg8::StaticOrder<T, DFF>>(F.lds, g, S, E);
        }
        END_PHASE();
        if (RUN()) {
            pg8::Gemm g{WSP(bf16, WS_U), (const bf16*)(wl + WO_2)};
            pg8::StaticOrder<T, DM> S; S.init(F.G, bx);
            pg8::EpiRes E{WSP(bf16, WS_XB), WSP(float, WS_SSP), nullptr};
            pg8::gemm_phase<DFF, DFF, DFF, pg8::EpiRes, pg8::StaticOrder<T, DM>>(F.lds, g, S, E);
#if (PROBE_DUP >> 9) & 1
            xcd_barrier(bar);
            { pg8::StaticOrder<TH, DM> S2; S2.init(F.G, bx); pg8::EpiRes E2{WSP(bf16, WS_XB), WSP(float, WS_SSP), (bf16*)(F.ws + WS_END)};
              pg8::gemm_phase<DFF, DFF, DFF, pg8::EpiRes, pg8::StaticOrder<TH, DM>>(F.lds, g, S2, E2); }
#endif
        }
        END_PHASE();
        if (l == 1) { if (RUN()) final_norm(F, A.out, A.in[17]); END_PHASE(); }
#if (PROBE_DUP >> 12) & 1
        for (int rep = 0; rep < 8; ++rep) xcd_barrier(bar);
#endif
    }
#undef RUN
#undef END_PHASE
}

extern "C" void kernel_launch(void* const* d_in, const int* in_sizes, int n_in, void* d_out, int out_size, void* d_ws, size_t ws_size, hipStream_t stream) {
    static int grid = 0;
    if (grid == 0) {
        if (n_in != 18 || in_sizes[0] != T * DM || out_size != T * DM || ws_size < WS_END) { fprintf(stderr, "kernel_launch: unexpected shapes / workspace (n_in %d, ws %zu)\n", n_in, ws_size); grid = -1; return; }
        int dev = 0, cus = 0, per_cu = 0;
        if (hipGetDevice(&dev) != hipSuccess || hipDeviceGetAttribute(&cus, hipDeviceAttributeMultiprocessorCount, dev) != hipSuccess) { grid = -1; return; }
        if (hipFuncSetAttribute((const void*)fwd_kernel, hipFuncAttributeMaxDynamicSharedMemorySize, LDS_BYTES) != hipSuccess) { fprintf(stderr, "kernel_launch: hipFuncSetAttribute failed\n"); grid = -1; return; }
        if (hipOccupancyMaxActiveBlocksPerMultiprocessor(&per_cu, (const void*)fwd_kernel, 512, LDS_BYTES) != hipSuccess || per_cu < 1) { fprintf(stderr, "kernel_launch: occupancy query says %d\n", per_cu); (void)hipGetLastError(); grid = -1; return; }
        grid = cus;
    }
    if (grid < 0) return;
    (void)hipMemsetAsync((char*)d_ws + WS_CTL, 0, CTL_ZERO_BYTES, stream);
    Args a{};
    for (int i = 0; i < 18; ++i) a.in[i] = (const float*)d_in[i];
    a.out = (float*)d_out; a.ws = (unsigned char*)d_ws;
#if MK_SINGLE
    a.ph_lo = 0; a.ph_hi = N_PHASES;
    hipLaunchKernelGGL(fwd_kernel, dim3(grid), dim3(512), LDS_BYTES, stream, a);
#else
    for (int p = 0; p < N_PHASES; ++p) { a.ph_lo = p; a.ph_hi = p + 1; hipLaunchKernelGGL(fwd_kernel, dim3(grid), dim3(512), LDS_BYTES, stream, a); }
#endif
}
```

```cpp
#include <hip/hip_runtime.h>
#include <cstdio>
#include <cstdint>

#ifndef MK_SINGLE
#define MK_SINGLE 1
#endif
#ifndef PROBE_DUP
#define PROBE_DUP 0
#endif
#define REPS(k) (1 + ((PROBE_DUP >> (k)) & 1))
#ifndef USE_TR
#define USE_TR 1
#endif

#define LAS __attribute__((address_space(3)))
#define GAS __attribute__((address_space(1)))
typedef unsigned short bf16;
typedef short bf16x8 __attribute__((ext_vector_type(8)));
typedef short s16x4 __attribute__((ext_vector_type(4)));
typedef float f32x4 __attribute__((ext_vector_type(4)));
typedef float f32x2 __attribute__((ext_vector_type(2)));
typedef unsigned u32x4 __attribute__((ext_vector_type(4)));
typedef unsigned u32x2 __attribute__((ext_vector_type(2)));
typedef __bf16 bf16x2_t __attribute__((ext_vector_type(2)));
typedef short v4i16_t __attribute__((ext_vector_type(4)));

constexpr int DM = 1024, NB = 4, SEQ = 8192, T = NB * SEQ, TH = T / 2, NMEM = 256, DFF = 4096;
constexpr int INC = 7168;
constexpr int PLD = 4608;
constexpr int C_Q = 512, C_K = 1024, C_V = 1536, C_DP = 2560, C_G = 3072, C_XQ = 4096;
constexpr float EPS = 1e-6f;
constexpr float XQ_SCALE = 0.08838834764831845f * 1.4426950408889634f;
constexpr float LOG2E = 1.4426950408889634f;
constexpr float K_SCALE = 0.08838834764831845f;

constexpr size_t MiB = 1u << 20;
constexpr size_t WS_CTL = 0, CTL_ZERO_BYTES = 1 * MiB;
constexpr size_t WS_COS = 2 * MiB, WS_SIN = 10 * MiB;
constexpr size_t WS_SSP = 18 * MiB;
constexpr size_t WS_MEMN = 20 * MiB;
constexpr size_t WS_KVMEM = 24 * MiB;
constexpr size_t WS_W = 32 * MiB, W_LAYER = 38 * MiB;
constexpr size_t WO_IN = 0, WO_UP = 14 * MiB, WO_OUT = 18 * MiB, WO_1 = 20 * MiB, WO_2 = 28 * MiB, WO_MKV = 36 * MiB;
constexpr size_t WS_XB = 108 * MiB;
constexpr size_t WS_MERGED = 172 * MiB;
constexpr size_t WS_PROJ = 204 * MiB;
constexpr size_t WS_KVN = 348 * MiB;
constexpr size_t WS_SPREV = 412 * MiB;
constexpr size_t WS_GATES = 348 * MiB;
constexpr size_t WS_U = 172 * MiB;
constexpr size_t WS_END = 444 * MiB;
static_assert(WS_W + 2 * W_LAYER <= WS_XB && WS_U + (size_t)T * DFF * 2 <= WS_END && WS_PROJ + (size_t)TH * PLD * 2 <= WS_KVN, "ws map");
constexpr int CW_TMO = 0, CW_BAR = 4096;

constexpr int RING_BYTES = 131072, SCRATCH_BYTES = 147456, LDSCTL_OFF = SCRATCH_BYTES, MISC_OFF = LDSCTL_OFF + 320, LDS_BYTES = SCRATCH_BYTES + 1024;

__device__ __forceinline__ unsigned cvtpk(float lo, float hi) { f32x2 v = {lo, hi}; bf16x2_t b = __builtin_convertvector(v, bf16x2_t); return __builtin_bit_cast(unsigned, b); }
__device__ __forceinline__ float bflo(unsigned u) { return __uint_as_float(u << 16); }
__device__ __forceinline__ float bfhi(unsigned u) { return __uint_as_float(u & 0xffff0000u); }
__device__ __forceinline__ f32x4 mfma16(bf16x8 a, bf16x8 b, f32x4 c) { return __builtin_amdgcn_mfma_f32_16x16x32_bf16(a, b, c, 0, 0, 0); }
#define SWZ_XOR(m) (((m) << 10) | 0x1f)
__device__ __forceinline__ float wave_sum(float v) {
    v += __int_as_float(__builtin_amdgcn_ds_swizzle(__float_as_int(v), SWZ_XOR(1)));
    v += __int_as_float(__builtin_amdgcn_ds_swizzle(__float_as_int(v), SWZ_XOR(2)));
    v += __int_as_float(__builtin_amdgcn_ds_swizzle(__float_as_int(v), SWZ_XOR(4)));
    v += __int_as_float(__builtin_amdgcn_ds_swizzle(__float_as_int(v), SWZ_XOR(8)));
    { auto r = __builtin_amdgcn_permlane16_swap(__float_as_uint(v), __float_as_uint(v), false, false); v = __uint_as_float(r[0]) + __uint_as_float(r[1]); }
    { auto r = __builtin_amdgcn_permlane32_swap(__float_as_uint(v), __float_as_uint(v), false, false); v = __uint_as_float(r[0]) + __uint_as_float(r[1]); }
    return v;
}
__device__ __forceinline__ float add_xor16(float v) { auto r = __builtin_amdgcn_permlane16_swap(__float_as_uint(v), __float_as_uint(v), false, false); return __uint_as_float(r[0]) + __uint_as_float(r[1]); }
__device__ __forceinline__ float add_xor32(float v) { auto r = __builtin_amdgcn_permlane32_swap(__float_as_uint(v), __float_as_uint(v), false, false); return __uint_as_float(r[0]) + __uint_as_float(r[1]); }
__device__ __forceinline__ float max_xor16(float v) { auto r = __builtin_amdgcn_permlane16_swap(__float_as_uint(v), __float_as_uint(v), false, false); return fmaxf(__uint_as_float(r[0]), __uint_as_float(r[1])); }
__device__ __forceinline__ float max_xor32(float v) { auto r = __builtin_amdgcn_permlane32_swap(__float_as_uint(v), __float_as_uint(v), false, false); return fmaxf(__uint_as_float(r[0]), __uint_as_float(r[1])); }
__device__ __forceinline__ float sigmoidf_(float x) { return 1.0f / (1.0f + __expf(-x)); }

namespace pg8 {
#define PG8_LAS __attribute__((address_space(3)))
typedef unsigned short bf16_t;
constexpr int BM = 256, BK = 64, HALF = 128, HTB = HALF * BK * 2, STAGE_BYTES = 8 * HTB, NXCD = 8, WGM = 8;
__host__ __device__ __forceinline__ int lds_byte(int r, int c) { const int st = (r >> 4) * 2 + (c >> 5), rr = r & 15, cc = c & 31, ob = rr * 64 + cc * 2; return st * 1024 + (ob ^ (((ob >> 9) & 1) << 5)); }
__host__ __device__ __forceinline__ void stage_rc(int b, int& R, int& C) { const int st = b / 1024, sb = b % 1024, swz = sb ^ (((sb >> 9) & 1) << 5); R = (st >> 1) * 16 + swz / 64; C = (st & 1) * 32 + (swz % 64) / 2; }
__host__ __device__ __forceinline__ int perm32(int rho) { const int n = rho >> 4, i = rho & 15; return 8 * (i >> 2) + 4 * n + (i & 3); }

struct Unit { int pm, pn; };
struct Gemm { const bf16_t* A; const bf16_t* Bt; };

template <int M_, int N_> struct StaticOrder {
    static constexpr int nM = M_ / BM, nN = N_ / BM, nwg = nM * nN;
    int G, c;
    __host__ __device__ void init(int G_, int c_) { G = G_; c = c_; }
    __host__ __device__ bool next(int i, Unit& u) const {
        const long L = (long)i * G + c; if (L >= nwg) return false;
        int wgid = (int)L; { const int q = nwg / NXCD, r = nwg % NXCD, xcd = wgid % NXCD, off = wgid / NXCD; wgid = (xcd < r ? xcd * (q + 1) : r * (q + 1) + (xcd - r) * q) + off; }
        const int nig = WGM * nN, gid = wgid / nig, fm = gid * WGM, gsz = (nM - fm) < WGM ? (nM - fm) : WGM;
        u.pm = fm + ((wgid % nig) % gsz); u.pn = (wgid % nig) / gsz; return true;
    }
    __device__ __forceinline__ void a_ready(const Unit&) const {}
    __device__ __forceinline__ void done(const Unit&) const {}
};

typedef f32x4 Acc[2][2][4][2];

template <int MODE> struct EpiBf {
    static constexpr bool PERM = true, AFTER_DRAIN = false, HOOK = false, EARLY_PRE = (MODE != 2);
    bf16_t* O; int ldc; const float* cosT; const float* sinT; int t0; const float* ssp;
    __device__ __forceinline__ void hook(Acc&, const Unit&, int, int, int, int, int) const {}
    struct Pre { float rs[2][4]; };
    struct Raw { f32x4 v[2][4]; };
    __device__ __forceinline__ Raw pre_load(const Unit& u, int wr, int fr, int fq) const {
        Raw r; const float* p = ssp + (size_t)(t0 + u.pm * BM + wr * 64 + fr) * 16 + 4 * fq;
#pragma unroll
        for (int ai = 0; ai < 2; ++ai)
#pragma unroll
            for (int m = 0; m < 4; ++m) r.v[ai][m] = *(const f32x4*)(p + (size_t)(ai * HALF + m * 16) * 16);
        __builtin_amdgcn_sched_barrier(0);
        return r;
    }
    __device__ __forceinline__ Pre pre_finish(const Raw& r) const {
        Pre p;
#pragma unroll
        for (int ai = 0; ai < 2; ++ai)
#pragma unroll
            for (int m = 0; m < 4; ++m) { const f32x4 v = r.v[ai][m]; float q = (v[0] + v[1]) + (v[2] + v[3]); q = add_xor16(q); q = add_xor32(q); p.rs[ai][m] = rsqrtf(q * (1.0f / DM) + EPS); }
        return p;
    }
    __device__ __forceinline__ void operator()(const Acc& acc, const Unit& u, int wr, int wc, int fr, int fq, const Pre& pr) const {
        const int row0 = u.pm * BM + wr * 64 + fr;
        if (MODE == 2 && u.pn >= 2 && u.pn < 6) {
            const int sec = (u.pn < 4) ? C_Q : C_K, head = 2 * (u.pn & 1) + (wc >> 1), i0 = 32 * (wc & 1) + 8 * fq;
            const float ksc0 = (u.pn >= 4) ? K_SCALE : 1.0f;
            const int dcol = sec + head * 128 + i0;
#pragma unroll
            for (int am = 0; am < 8; am += 2) {
                f32x4 cs[2][4];
#pragma unroll
                for (int j = 0; j < 2; ++j) { const size_t tr = (size_t)(t0 + row0 + ((am + j) >> 2) * HALF + ((am + j) & 3) * 16) * 64 + i0;
                    cs[j][0] = *(const f32x4*)(cosT + tr); cs[j][1] = *(const f32x4*)(cosT + tr + 4); cs[j][2] = *(const f32x4*)(sinT + tr); cs[j][3] = *(const f32x4*)(sinT + tr + 4); }
                __builtin_amdgcn_sched_barrier(0);
#pragma unroll
                for (int j = 0; j < 2; ++j) { const int ai = (am + j) >> 2, m = (am + j) & 3;
                    const int row = row0 + ai * HALF + m * 16; const float ksc = ksc0 * pr.rs[ai][m];
                    const f32x4 c0 = cs[j][0], c1 = cs[j][1], s0 = cs[j][2], s1 = cs[j][3];
                    const f32x4 a0 = acc[ai][0][m][0], a1 = acc[ai][0][m][1], b0 = acc[ai][1][m][0], b1 = acc[ai][1][m][1];
                    const f32x4 o10 = (a0 * c0 - b0 * s0) * ksc, o11 = (a1 * c1 - b1 * s1) * ksc, o20 = (b0 * c0 + a0 * s0) * ksc, o21 = (b1 * c1 + a1 * s1) * ksc;
                    bf16_t* rowp = O + (size_t)row * ldc + dcol;
                    u32x4 w1, w2; w1.x = cvtpk(o10[0], o10[1]); w1.y = cvtpk(o10[2], o10[3]); w1.z = cvtpk(o11[0], o11[1]); w1.w = cvtpk(o11[2], o11[3]);
                    w2.x = cvtpk(o20[0], o20[1]); w2.y = cvtpk(o20[2], o20[3]); w2.z = cvtpk(o21[0], o21[1]); w2.w = cvtpk(o21[2], o21[3]);
                    *(u32x4*)rowp = w1; *(u32x4*)(rowp + 64) = w2;
                }
                __builtin_amdgcn_sched_barrier(0); }
            return;
        }
        int cbase = u.pn * BM; float sc = 1.0f;
        if (MODE == 2) { const int pn = u.pn; if (pn < 2) cbase = 256 * pn; else if (pn < 10) cbase = C_V + 256 * (pn - 6); else if (pn < 14) cbase = C_G + 256 * (pn - 10); else { cbase = C_XQ + 256 * (pn - 14); sc = XQ_SCALE; } }
        const int col0 = cbase + wc * 32 + 8 * fq;
#pragma unroll
        for (int ai = 0; ai < 2; ++ai)
#pragma unroll
            for (int m = 0; m < 4; ++m) { bf16_t* rowp = O + (size_t)(row0 + ai * HALF + m * 16) * ldc + col0;
#pragma unroll
                for (int bj = 0; bj < 2; ++bj) { f32x4 v0 = acc[ai][bj][m][0], v1 = acc[ai][bj][m][1];
                    { const float f = (MODE == 3 ? -LOG2E : sc) * pr.rs[ai][m]; v0 = v0 * f; v1 = v1 * f; }
                    if (MODE == 3) {
#pragma unroll
                        for (int e = 0; e < 4; ++e) { v0[e] = 1.0f + __builtin_amdgcn_exp2f(fminf(fmaxf(v0[e], -80.f), 80.f)); v1[e] = 1.0f + __builtin_amdgcn_exp2f(fminf(fmaxf(v1[e], -80.f), 80.f)); }
                        if (u.pn < 4) {
#pragma unroll
                            for (int e = 0; e < 4; ++e) { v0[e] = __builtin_amdgcn_rcpf(v0[e]); v1[e] = __builtin_amdgcn_rcpf(v1[e]); } } }
                    if (MODE == 1) { v0 = __builtin_elementwise_max(v0, (f32x4){0.f, 0.f, 0.f, 0.f}); v1 = __builtin_elementwise_max(v1, (f32x4){0.f, 0.f, 0.f, 0.f}); v0 = v0 * v0; v1 = v1 * v1; }
                    u32x4 w; w.x = cvtpk(v0[0], v0[1]); w.y = cvtpk(v0[2], v0[3]); w.z = cvtpk(v1[0], v1[1]); w.w = cvtpk(v1[2], v1[3]);
                    *(u32x4*)(rowp + bj * HALF) = w; } }
    }
};
struct EpiRes {
    static constexpr bool PERM = true, AFTER_DRAIN = false, HOOK = false, EARLY_PRE = false;
    struct Pre {}; struct Raw {};
    __device__ __forceinline__ Raw pre_load(const Unit&, int, int, int) const { return Raw{}; }
    __device__ __forceinline__ Pre pre_finish(const Raw&) const { return Pre{}; }
    bf16_t* X; float* ssp; bf16_t* dummy;
    __device__ __forceinline__ void hook(Acc&, const Unit&, int, int, int, int, int) const {}
    __device__ __forceinline__ void operator()(const Acc& acc, const Unit& u, int wr, int wc, int fr, int fq, const Pre&) const {
        const unsigned loff = (unsigned)((wr * 64 + fr) * 1024 + u.pn * BM + wc * 32 + 8 * fq);
        const bf16_t* Xu = X + (size_t)u.pm * BM * 1024; bf16_t* Yu = (dummy ? dummy : X) + (size_t)u.pm * BM * 1024;
        u32x4 xb[2][4][2];
#pragma unroll
        for (int ai = 0; ai < 2; ++ai)
#pragma unroll
            for (int m = 0; m < 4; ++m)
#pragma unroll
                for (int bj = 0; bj < 2; ++bj) xb[ai][m][bj] = *(const u32x4*)(Xu + (size_t)(ai * HALF + m * 16) * 1024 + loff + bj * HALF);
        __builtin_amdgcn_sched_barrier(0);
#pragma unroll
        for (int ai = 0; ai < 2; ++ai)
#pragma unroll
            for (int m = 0; m < 4; ++m) { float q = 0.f;
#pragma unroll
                for (int bj = 0; bj < 2; ++bj) { const u32x4 b = xb[ai][m][bj];
                    f32x4 x0 = acc[ai][bj][m][0], x1 = acc[ai][bj][m][1];
                    x0[0] += bflo(b[0]); x0[1] += bfhi(b[0]); x0[2] += bflo(b[1]); x0[3] += bfhi(b[1]); x1[0] += bflo(b[2]); x1[1] += bfhi(b[2]); x1[2] += bflo(b[3]); x1[3] += bfhi(b[3]);
                    q += ((x0[0] * x0[0] + x0[1] * x0[1]) + (x0[2] * x0[2] + x0[3] * x0[3])) + ((x1[0] * x1[0] + x1[1] * x1[1]) + (x1[2] * x1[2] + x1[3] * x1[3]));
                    u32x4 w; w.x = cvtpk(x0[0], x0[1]); w.y = cvtpk(x0[2], x0[3]); w.z = cvtpk(x1[0], x1[1]); w.w = cvtpk(x1[2], x1[3]);
                    *(u32x4*)(Yu + (size_t)(ai * HALF + m * 16) * 1024 + loff + bj * HALF) = w; }
                q = add_xor16(q); q = add_xor32(q);
                if (fq == 0 && !dummy) ssp[(size_t)(u.pm * BM + wr * 64 + fr + ai * HALF + m * 16) * 16 + 4 * u.pn + wc] = q; }
    }
};
struct EpiUp {
    static constexpr bool PERM = true, AFTER_DRAIN = false, HOOK = true, EARLY_PRE = false;
    struct Pre {}; struct Raw {};
    __device__ __forceinline__ Raw pre_load(const Unit&, int, int, int) const { return Raw{}; }
    __device__ __forceinline__ Pre pre_finish(const Raw&) const { return Pre{}; }
    bf16_t* O; const bf16_t* G;
    __device__ __forceinline__ void hook(Acc& acc, const Unit& u, int t, int wr, int wc, int fr, int fq) const {
        if (t != 8 && t != 24) return;
        const int gsel = (t == 8) ? 0 : 1024;
        int fr_ = fr, fq_ = fq; asm volatile("" : "+v"(fr_), "+v"(fq_));
        const int row0 = u.pm * BM + wr * 64 + fr_, col0 = u.pn * BM + wc * 32 + 8 * fq_;
        const bf16_t* gbase = G + (size_t)row0 * 3072 + gsel + col0;
        u32x4 ga[4][2], gb[4][2];
#pragma unroll
        for (int m = 0; m < 4; ++m)
#pragma unroll
            for (int bj = 0; bj < 2; ++bj) { const bf16_t* gp = gbase + (size_t)(m * 16) * 3072 + bj * HALF; ga[m][bj] = *(const u32x4*)gp; gb[m][bj] = *(const u32x4*)(gp + 1024); }
        __builtin_amdgcn_sched_barrier(0);
#pragma unroll
        for (int ai = 0; ai < 2; ++ai)
#pragma unroll
            for (int m = 0; m < 4; ++m)
#pragma unroll
                for (int bj = 0; bj < 2; ++bj) { float r[8];
#pragma unroll
                    for (int e = 0; e < 4; ++e) { const float a0 = bflo(ga[m][bj][e]), a1 = bfhi(ga[m][bj][e]), b0 = bflo(gb[m][bj][e]), b1 = bfhi(gb[m][bj][e]);
                        if (t == 8) { r[2 * e] = a0 * b0; r[2 * e + 1] = a1 * b1; }
                        else { r[2 * e] = b0 * __builtin_amdgcn_rcpf(a0); r[2 * e + 1] = b1 * __builtin_amdgcn_rcpf(a1); } }
                    if (ai == 0) { const bf16_t* gp = gbase + (size_t)(HALF + m * 16) * 3072 + bj * HALF; ga[m][bj] = *(const u32x4*)gp; gb[m][bj] = *(const u32x4*)(gp + 1024); }
                    f32x4 v0 = acc[ai][bj][m][0], v1 = acc[ai][bj][m][1];
                    v0[0] *= r[0]; v0[1] *= r[1]; v0[2] *= r[2]; v0[3] *= r[3]; v1[0] *= r[4]; v1[1] *= r[5]; v1[2] *= r[6]; v1[3] *= r[7];
                    acc[ai][bj][m][0] = v0; acc[ai][bj][m][1] = v1;
                    __builtin_amdgcn_sched_barrier(0); }
    }
    __device__ __forceinline__ void operator()(const Acc& acc, const Unit& u, int wr, int wc, int fr, int fq, const Pre&) const {
        const int row0 = u.pm * BM + wr * 64 + fr, col0 = u.pn * BM + wc * 32 + 8 * fq;
        u32x4 g3[2][4][2];
#pragma unroll
        for (int ai = 0; ai < 2; ++ai)
#pragma unroll
            for (int m = 0; m < 4; ++m)
#pragma unroll
                for (int bj = 0; bj < 2; ++bj) g3[ai][m][bj] = *(const u32x4*)(G + (size_t)(row0 + ai * HALF + m * 16) * 3072 + 2048 + col0 + bj * HALF);
        __builtin_amdgcn_sched_barrier(0);
#pragma unroll
        for (int ai = 0; ai < 2; ++ai)
#pragma unroll
            for (int m = 0; m < 4; ++m) { const int row = row0 + ai * HALF + m * 16; bf16_t* rowp = O + (size_t)row * 1024 + col0;
#pragma unroll
                for (int bj = 0; bj < 2; ++bj) { const u32x4 gc = g3[ai][m][bj];
                    const f32x4 v0 = acc[ai][bj][m][0], v1 = acc[ai][bj][m][1];
#define UP_S3(x) __builtin_amdgcn_rcpf(x)
                    u32x4 w; w.x = cvtpk(v0[0] * UP_S3(bflo(gc[0])), v0[1] * UP_S3(bfhi(gc[0]))); w.y = cvtpk(v0[2] * UP_S3(bflo(gc[1])), v0[3] * UP_S3(bfhi(gc[1])));
                    w.z = cvtpk(v1[0] * UP_S3(bflo(gc[2])), v1[1] * UP_S3(bfhi(gc[2]))); w.w = cvtpk(v1[2] * UP_S3(bflo(gc[3])), v1[3] * UP_S3(bfhi(gc[3])));
#undef UP_S3
                    *(u32x4*)(rowp + bj * HALF) = w; } }
    }
};

template <int K, int LDA, int LDB, class Epi, class Sched, bool ALIGN_EPI = true>
__device__ __forceinline__ void gemm_phase(PG8_LAS unsigned char* lds, const Gemm g, const Sched& S, const Epi& E) {
    int tid_ = threadIdx.x; asm volatile("" : "+v"(tid_));
    const int tid = tid_, wid = __builtin_amdgcn_readfirstlane(tid >> 6), lane = tid & 63, wr = wid >> 2, wc = wid & 3, fr = lane & 15, fq = lane >> 4;
    constexpr int nt = K / BK;
    unsigned voffA[2], voffB[2];
#pragma unroll
    for (int i = 0; i < 2; ++i) { int R, C; stage_rc(tid * 16 + i * 8192, R, C); const int Rb = Epi::PERM ? ((R & ~31) + perm32(R & 31)) : R;
        voffA[i] = (unsigned)(R * LDA + C) * 2u; voffB[i] = (unsigned)(Rb * LDB + C) * 2u; }
    constexpr size_t kstep = (size_t)(BK * 2);
    constexpr size_t hstepA = (size_t)HALF * LDA * 2, hstepB = (size_t)HALF * LDB * 2;
    constexpr size_t tstepA = 2 * hstepA, tstepB = 2 * hstepB;
    const unsigned ldsw = (unsigned)wid * 1024u;
    const int aoff = lds_byte(wr * 64 + fr, fq * 8), boff = lds_byte(wc * 32 + fr, fq * 8);
#define PG8_SA(b, h) (((b) * 2 + (h)) * HTB)
#define PG8_SB(b, h) ((4 + (b) * 2 + (h)) * HTB)
#define PG8_STAGE(bufoff, gbase, voff) do { _Pragma("unroll") for (int _i = 0; _i < 2; ++_i) \
        __builtin_amdgcn_global_load_lds((const unsigned*)((const char*)(gbase) + (voff)[_i]), (PG8_LAS unsigned*)(lds + (bufoff) + ldsw + _i * 8192), 16, 0, 0); } while (0)
#define PG8_LDA(dst, b, h) do { _Pragma("unroll") for (int m = 0; m < 4; ++m) _Pragma("unroll") for (int k = 0; k < 2; ++k) dst[m][k] = *(const PG8_LAS bf16x8*)(lds + PG8_SA(b, h) + aoff + m * 2048 + k * 1024); } while (0)
#define PG8_LDB(dst, b, h) do { _Pragma("unroll") for (int n = 0; n < 2; ++n) _Pragma("unroll") for (int k = 0; k < 2; ++k) dst[n][k] = *(const PG8_LAS bf16x8*)(lds + PG8_SB(b, h) + boff + n * 2048 + k * 1024); } while (0)
#define PG8_MMA(ai, bj, At, Bt) do { __builtin_amdgcn_s_setprio(1); _Pragma("unroll") for (int m = 0; m < 4; ++m) _Pragma("unroll") for (int n = 0; n < 2; ++n) _Pragma("unroll") for (int k = 0; k < 2; ++k) \
        acc[ai][bj][m][n] = __builtin_amdgcn_mfma_f32_16x16x32_bf16(Bt[n][k], At[m][k], acc[ai][bj][m][n], 0, 0, 0); __builtin_amdgcn_s_setprio(0); } while (0)
#define PG8_WAIT_V(n) asm volatile("s_waitcnt vmcnt(" #n ")" ::: "memory")
#define PG8_WAIT_L(n) asm volatile("s_waitcnt lgkmcnt(" #n ")" ::: "memory")
#define PG8_BAR __builtin_amdgcn_s_barrier()
#define PG8_SCHED __builtin_amdgcn_sched_barrier(0)
    Unit cur, nxt; int ui = 0;
    if (!S.next(0, cur)) return;
    Acc acc;
#pragma unroll
    for (int a = 0; a < 2; ++a)
#pragma unroll
        for (int b = 0; b < 2; ++b)
#pragma unroll
            for (int m = 0; m < 4; ++m)
#pragma unroll
                for (int n = 0; n < 2; ++n) acc[a][b][m][n] = (f32x4){0.f, 0.f, 0.f, 0.f};
    bf16x8 At[4][2], B0[2][2], B1[2][2];
    const char* cA = (const char*)g.A + (size_t)cur.pm * tstepA; const char* cB = (const char*)g.Bt + (size_t)cur.pn * tstepB;
    S.a_ready(cur);
    typename Epi::Pre pre = E.pre_finish(E.pre_load(cur, wr, fr, fq));
    PG8_STAGE(PG8_SB(0, 0), cB, voffB); PG8_STAGE(PG8_SB(0, 1), cB + hstepB, voffB); PG8_STAGE(PG8_SA(0, 0), cA, voffA); PG8_STAGE(PG8_SA(0, 1), cA + hstepA, voffA);
    if (wr == 1) PG8_BAR;
    PG8_WAIT_V(2); PG8_BAR;
    PG8_STAGE(PG8_SB(1, 0), cB + kstep, voffB); PG8_STAGE(PG8_SA(1, 0), cA + kstep, voffA); PG8_STAGE(PG8_SB(1, 1), cB + hstepB + kstep, voffB);
    PG8_WAIT_V(6); PG8_BAR;
    for (;;) {
        const bool has_next = S.next(ui + 1, nxt);
        const char* nA = has_next ? (const char*)g.A + (size_t)nxt.pm * tstepA : cA; const char* nB = has_next ? (const char*)g.Bt + (size_t)nxt.pn * tstepB : cB;
        for (int t = 0; t < nt; t += 2) {
            const bool last = (t == nt - 2);
            const char* a1 = cA + (size_t)(t + 1) * kstep;
            const char* a2 = last ? nA : cA + (size_t)(t + 2) * kstep; const char* b2 = last ? nB : cB + (size_t)(t + 2) * kstep;
            const char* a3 = a2 + kstep; const char* b3 = b2 + kstep;
            if (last && has_next) S.a_ready(nxt);
            if constexpr (Epi::HOOK) { E.hook(acc, cur, t, wr, wc, fr, fq); PG8_SCHED; }
            PG8_LDB(B0, 0, 0); PG8_LDB(B1, 0, 1); PG8_SCHED; PG8_LDA(At, 0, 0); PG8_STAGE(PG8_SA(1, 1), a1 + hstepA, voffA);
            PG8_WAIT_V(8); PG8_WAIT_L(0); PG8_BAR; PG8_MMA(0, 0, At, B0); PG8_MMA(0, 1, At, B1); PG8_BAR; PG8_SCHED;
            PG8_LDA(At, 0, 1); PG8_STAGE(PG8_SB(0, 0), b2, voffB); PG8_STAGE(PG8_SB(0, 1), b2 + hstepB, voffB); PG8_STAGE(PG8_SA(0, 0), a2, voffA);
            PG8_WAIT_V(8); PG8_WAIT_L(0); PG8_BAR; PG8_MMA(1, 0, At, B0); PG8_MMA(1, 1, At, B1); PG8_BAR; PG8_SCHED;
            PG8_LDB(B0, 1, 0); PG8_LDB(B1, 1, 1); PG8_SCHED; PG8_LDA(At, 1, 0); PG8_STAGE(PG8_SA(0, 1), a2 + hstepA, voffA);
            PG8_WAIT_V(8); PG8_WAIT_L(0); PG8_BAR; PG8_MMA(0, 0, At, B0); PG8_MMA(0, 1, At, B1); PG8_BAR; PG8_SCHED;
            PG8_LDA(At, 1, 1); PG8_STAGE(PG8_SB(1, 0), b3, voffB); PG8_STAGE(PG8_SB(1, 1), b3 + hstepB, voffB); PG8_STAGE(PG8_SA(1, 0), a3, voffA);
            PG8_WAIT_V(8); PG8_WAIT_L(0); PG8_BAR; PG8_MMA(1, 0, At, B0); PG8_MMA(1, 1, At, B1); PG8_BAR; PG8_SCHED;
        }
        if constexpr (ALIGN_EPI) { if (wr == 0) PG8_BAR; }
        typename Epi::Raw raw;
        if constexpr (Epi::EARLY_PRE) raw = E.pre_load(has_next ? nxt : cur, wr, fr, fq);
        E(acc, cur, wr, wc, fr, fq, pre); S.done(cur);
        if (!has_next) break;
        if constexpr (!Epi::EARLY_PRE) raw = E.pre_load(nxt, wr, fr, fq);
#pragma unroll
        for (int a = 0; a < 2; ++a)
#pragma unroll
            for (int b = 0; b < 2; ++b)
#pragma unroll
                for (int m = 0; m < 4; ++m)
#pragma unroll
                    for (int n = 0; n < 2; ++n) acc[a][b][m][n] = (f32x4){0.f, 0.f, 0.f, 0.f};
        cur = nxt; cA = nA; cB = nB; ++ui;
        pre = E.pre_finish(raw);
        if constexpr (ALIGN_EPI) { if (wr == 1) PG8_BAR; }
    }
    PG8_WAIT_V(0);
    if constexpr (!ALIGN_EPI) { if (wr == 0) PG8_BAR; }
    PG8_BAR;
#undef PG8_SA
#undef PG8_SB
#undef PG8_STAGE
#undef PG8_LDA
#undef PG8_LDB
#undef PG8_MMA
#undef PG8_WAIT_V
#undef PG8_WAIT_L
#undef PG8_BAR
#undef PG8_SCHED
}
}

#define XB_TMO      128
#define XB_XCNT(j)  (256  + 64 * (j))
#define XB_XSUB(j)  (1280 + 64 * (j))
#define XB_XGEN(j)  (2304 + 64 * (j))
#define XB_TOP      3328
#define XB_TOPGEN   3392
#define XCD_BAR_WORDS 3456
#define XB_SPIN_CAP (1u << 18)
__device__ __forceinline__ unsigned xb_ld(unsigned* p)              { return __hip_atomic_load(p, __ATOMIC_RELAXED, __HIP_MEMORY_SCOPE_AGENT); }
__device__ __forceinline__ unsigned xb_add(unsigned* p, unsigned v) { return __hip_atomic_fetch_add(p, v, __ATOMIC_RELAXED, __HIP_MEMORY_SCOPE_AGENT); }
__device__ __forceinline__ unsigned xb_xcc_id() { return (unsigned)__builtin_amdgcn_s_getreg((3 << 11) | 20) & 0xFu; }
#define XB_SPIN(cond, bar) do { unsigned _sp = 0; while (cond) { __builtin_amdgcn_s_sleep(1); \
    if ((++_sp & 255u) == 0u) { if (xb_ld(&(bar)[XB_TMO])) break; if (_sp > XB_SPIN_CAP) { atomicAdd(&(bar)[XB_TMO], 1u); break; } } } } while (0)
struct XcdBarrier { unsigned* bar; unsigned x; volatile LAS unsigned* st; };
__device__ __forceinline__ XcdBarrier xcd_barrier_post(unsigned* bar, volatile LAS unsigned* st) {
    XcdBarrier b; b.bar = bar; b.x = xb_xcc_id(); b.st = st;
    if (threadIdx.x == 0) (void)xb_add(&bar[XB_XCNT(b.x)], 1u);
    return b;
}
__device__ __forceinline__ void xcd_barrier_complete(unsigned* bar, unsigned x, unsigned& nloc, unsigned& nx) {
    const unsigned G = gridDim.x * gridDim.y * gridDim.z;
    unsigned sum, cnt, mine, sp = 0u;
    for (;;) {
        sum = 0u; cnt = 0u; mine = 0u;
#pragma unroll
        for (unsigned j = 0; j < 16; ++j) { const unsigned c = xb_ld(&bar[XB_XCNT(j)]); sum += c; cnt += (c > 0u) ? 1u : 0u; mine = (j == x) ? c : mine; }
        if (sum == G) break;
        __builtin_amdgcn_s_sleep(1);
        if ((++sp & 255u) == 0u) { if (xb_ld(&bar[XB_TMO])) break; if (sp > XB_SPIN_CAP) { atomicAdd(&bar[XB_TMO], 1u); break; } }
    }
    nloc = mine > 0u ? mine : 1u; nx = cnt > 0u ? cnt : 1u;
}
__device__ __forceinline__ void xcd_barrier(const XcdBarrier& b) {
    asm volatile("s_waitcnt vmcnt(0)" ::: "memory");
    __syncthreads();
    if (threadIdx.x == 0) {
        unsigned* bar = b.bar;
        __builtin_amdgcn_s_waitcnt(0);
        unsigned nloc = b.st[0], nx = b.st[1];
        if (nloc == 0u) { xcd_barrier_complete(bar, b.x, nloc, nx); b.st[0] = nloc; b.st[1] = nx; }
        const unsigned old = xb_add(&bar[XB_XSUB(b.x)], 1u);
        const unsigned gen = old / nloc;
        if (old + 1u == (gen + 1u) * nloc) {
            __builtin_amdgcn_fence(__ATOMIC_RELEASE, "agent");
            asm volatile("s_waitcnt vmcnt(0)" ::: "memory");
            const unsigned og = xb_add(&bar[XB_TOP], 1u);
            const unsigned tg = og / nx;
            if (og + 1u == (tg + 1u) * nx) xb_add(&bar[XB_TOPGEN], 1u);
            else XB_SPIN(xb_ld(&bar[XB_TOPGEN]) == tg, bar);
            __builtin_amdgcn_fence(__ATOMIC_ACQUIRE, "agent");
            xb_add(&bar[XB_XGEN(b.x)], 1u);
            asm volatile("s_waitcnt vmcnt(0)" ::: "memory");
        } else {
            XB_SPIN(xb_ld(&bar[XB_XGEN(b.x)]) == gen, bar);
            __builtin_amdgcn_fence(__ATOMIC_ACQUIRE, "agent");
            asm volatile("s_waitcnt vmcnt(0)" ::: "memory");
        }
    }
    __syncthreads();
}

struct Args { const float* in[18]; float* out; unsigned char* ws; int ph_lo, ph_hi; };
struct Frame {
    LAS unsigned char* lds;
    int vcu, G;
    unsigned char* ws;
};
__device__ __forceinline__ int opaque_tid() { int t = threadIdx.x; asm volatile("" : "+v"(t)); return t; }
#define TID ((int)threadIdx.x)
#define WSP(T_, off) ((T_*)(F.ws + (off)))
#define LDS_WAIT() asm volatile("s_waitcnt lgkmcnt(0)" ::: "memory")

struct TrDesc { const float* W; const float* gain; bf16* dst; int Nsrc, srccol0, k0, Kdst; };
__device__ __forceinline__ void tr_load(const TrDesc& d, f32x4 (&v)[16], int lane) {
#pragma unroll
    for (int i = 0; i < 16; ++i) v[i] = *(const f32x4*)(d.W + (size_t)(d.k0 + 4 * i + (lane >> 4)) * d.Nsrc + d.srccol0 + 4 * (lane & 15));
}
__device__ __forceinline__ void tr_finish(const TrDesc& d, const f32x4 (&v)[16], LAS float* scr, int lane) {
#pragma unroll
    for (int i = 0; i < 16; ++i) { const int kk = 4 * i + (lane >> 4); f32x4 x = v[i]; if (d.gain) x = x * d.gain[d.k0 + kk]; *(LAS f32x4*)(scr + kk * 68 + 4 * (lane & 15)) = x; }
    LDS_WAIT(); asm volatile("" ::: "memory");
    const int c = lane & 7;
#pragma unroll
    for (int j = 0; j < 8; ++j) { const int n = (lane >> 3) + 8 * j; const LAS float* sp = scr + (8 * c) * 68 + n;
        u32x4 o; o.x = cvtpk(sp[0 * 68], sp[1 * 68]); o.y = cvtpk(sp[2 * 68], sp[3 * 68]); o.z = cvtpk(sp[4 * 68], sp[5 * 68]); o.w = cvtpk(sp[6 * 68], sp[7 * 68]);
        *(u32x4*)(d.dst + (size_t)n * d.Kdst + d.k0 + 8 * c) = o; }
    LDS_WAIT(); asm volatile("" ::: "memory");
}
__device__ __forceinline__ int in_srccol(int n0) {
    if (n0 < C_Q || n0 >= C_V) return n0;
    const int tile = n0 >> 8, within = n0 & 255, bj = within >> 7, w = within & 127, sec = (tile < 4) ? C_Q : C_K;
    return sec + (2 * (tile & 1) + (w >> 6)) * 128 + (w & 63) + 64 * bj;
}
__device__ __forceinline__ void rms_row_bf16(const float* xrow, bf16* orow, int lane) {
    const f32x4* xr = (const f32x4*)xrow + lane; f32x4 v[4]; float s = 0.f;
#pragma unroll
    for (int j = 0; j < 4; ++j) { v[j] = xr[64 * j]; s += (v[j].x * v[j].x + v[j].y * v[j].y) + (v[j].z * v[j].z + v[j].w * v[j].w); }
    const float r = rsqrtf(wave_sum(s) * (1.0f / DM) + EPS);
    u32x2* o = (u32x2*)orow + lane;
#pragma unroll
    for (int j = 0; j < 4; ++j) { u32x2 w; w.x = cvtpk(v[j].x * r, v[j].y * r); w.y = cvtpk(v[j].z * r, v[j].w * r); o[64 * j] = w; }
}
__device__ __forceinline__ void norm_rows(Frame& F, const float* X, bf16* XB, int nrows) {
    const int tid = opaque_tid(), lane = tid & 63, wave = __builtin_amdgcn_readfirstlane(tid >> 6), fr = lane & 15, fq = lane >> 4; (void)tid; (void)lane; (void)wave; (void)fr; (void)fq;
    const int gw = F.vcu * 8 + wave, NGW = F.G * 8;
    for (int m = gw; m < nrows; m += NGW) rms_row_bf16(X + (size_t)m * DM, XB + (size_t)m * DM, lane);
}
__device__ __forceinline__ void final_norm(Frame& F, float* out, const float* g) {
    const int tid = opaque_tid(), lane = tid & 63, wave = __builtin_amdgcn_readfirstlane(tid >> 6);
    const int gw = F.vcu * 8 + wave, NGW = F.G * 8;
    for (int m = gw; m < T; m += NGW) {
        const float* sp = WSP(float, WS_SSP) + (size_t)m * 16; float q = 0.f;
#pragma unroll
        for (int j = 0; j < 16; ++j) q += sp[j];
        const float r = rsqrtf(q * (1.0f / DM) + EPS);
        const u32x2* xr = (const u32x2*)(WSP(bf16, WS_XB) + (size_t)m * DM) + lane; f32x4* o = (f32x4*)(out + (size_t)m * DM) + lane;
#pragma unroll
        for (int j = 0; j < 4; ++j) { const u32x2 v = xr[64 * j]; const f32x4 gg = *((const f32x4*)g + lane + 64 * j);
            o[64 * j] = (f32x4){bflo(v.x) * r * gg.x, bfhi(v.x) * r * gg.y, bflo(v.y) * r * gg.z, bfhi(v.y) * r * gg.w}; }
    }
}

__device__ __forceinline__ void p0_prologue(Frame& F, const Args& A) {
    const int tid = opaque_tid(), lane = tid & 63, wave = __builtin_amdgcn_readfirstlane(tid >> 6);
    LAS float* scr = (LAS float*)(F.lds + wave * 17408);
    const int gw = F.vcu * 8 + wave, NGW = F.G * 8;
    constexpr int I_IN = 16 * 112, I_MKV = 16 * 16, I_UR = 16 * 16, I_UM = 8 * 16, I_OUT = 16 * 16, I_1 = 16 * 64, I_2 = 64 * 16;
    constexpr int PER_L = I_IN + I_MKV + I_UR + I_UM + I_OUT + I_1 + I_2;
#define TR_DESC(d, it_) do { const int l_ = (it_) / PER_L; int r_ = (it_) % PER_L; unsigned char* wl_ = F.ws + WS_W + (size_t)l_ * W_LAYER; \
        if (r_ < I_IN) { const int kb = r_ / 112, nb = r_ % 112; d = TrDesc{A.in[4] + (size_t)l_ * DM * INC, A.in[3] + l_ * DM, (bf16*)(wl_ + WO_IN) + (size_t)(64 * nb) * DM, INC, in_srccol(64 * nb), 64 * kb, DM}; } \
        else if ((r_ -= I_IN) < I_MKV) { const int kb = r_ / 16, nb = r_ % 16; d = TrDesc{A.in[9] + (size_t)l_ * DM * 1024, A.in[8] + l_ * DM, (bf16*)(wl_ + WO_MKV) + (size_t)(64 * nb) * DM, 1024, 64 * nb, 64 * kb, DM}; } \
        else if ((r_ -= I_MKV) < I_UR) { const int kb = r_ / 16, nb = r_ % 16; d = TrDesc{A.in[11] + (size_t)l_ * 1024 * DM, A.in[7] + l_ * 1024, (bf16*)(wl_ + WO_UP) + (size_t)(64 * nb) * 2048 + 512, DM, 64 * nb, 64 * kb, 2048}; } \
        else if ((r_ -= I_UR) < I_UM) { const int kb = r_ / 16, nb = r_ % 16; d = TrDesc{A.in[12] + (size_t)l_ * 512 * DM, nullptr, (bf16*)(wl_ + WO_UP) + (size_t)(64 * nb) * 2048 + 1536, DM, 64 * nb, 64 * kb, 2048}; } \
        else if ((r_ -= I_UM) < I_OUT) { const int kb = r_ / 16, nb = r_ % 16; d = TrDesc{A.in[13] + (size_t)l_ * DM * DM, nullptr, (bf16*)(wl_ + WO_OUT) + (size_t)(64 * nb) * DM, DM, 64 * nb, 64 * kb, DM}; } \
        else if ((r_ -= I_OUT) < I_1) { const int kb = r_ / 64, nb = r_ % 64; d = TrDesc{A.in[15] + (size_t)l_ * DM * DFF, A.in[14] + l_ * DM, (bf16*)(wl_ + WO_1) + (size_t)(64 * nb) * DM, DFF, 64 * nb, 64 * kb, DM}; } \
        else { r_ -= I_1; const int kb = r_ / 16, nb = r_ % 16; d = TrDesc{A.in[16] + (size_t)l_ * DFF * DM, nullptr, (bf16*)(wl_ + WO_2) + (size_t)(64 * nb) * DFF, DM, 64 * nb, 64 * kb, DFF}; } } while (0)
    {
        TrDesc dA, dB; f32x4 vA[16], vB[16];
        int it = gw;
        if (it < 2 * PER_L) { TR_DESC(dA, it); tr_load(dA, vA, lane); }
        while (it < 2 * PER_L) {
            const int itB = it + NGW;
            if (itB < 2 * PER_L) { TR_DESC(dB, itB); tr_load(dB, vB, lane); }
            tr_finish(dA, vA, scr, lane);
            if (itB >= 2 * PER_L) break;
            const int itA = itB + NGW;
            if (itA < 2 * PER_L) { TR_DESC(dA, itA); tr_load(dA, vA, lane); }
            tr_finish(dB, vB, scr, lane);
            it = itA;
        }
    }
#undef TR_DESC
    const int gt = F.vcu * 512 + tid, NT = F.G * 512;
    {
        const float inv = (float)exp2(-(double)(gt & 63) * (13.287712379549449 / 64.0));
        const int* pos = (const int*)A.in[2];
        for (int i = gt; i < T * 64; i += NT) {
            const float a = (float)pos[i >> 6] * inv;
            const double ad = (double)a, k = rint(ad * 0.15915494309189535), rr = ad - k * 6.283185307179586;
            const float rf = (float)rr;
            WSP(float, WS_COS)[i] = cosf(rf); WSP(float, WS_SIN)[i] = sinf(rf);
        }
    }
    for (int m = gw; m < T; m += NGW) {
        const f32x4* xr = (const f32x4*)(A.in[0] + (size_t)m * DM) + 2 * lane; float q = 0.f; u32x4* o = (u32x4*)(WSP(bf16, WS_XB) + (size_t)m * DM) + lane;
#pragma unroll
        for (int j = 0; j < 2; ++j) { const f32x4 v = xr[128 * j], v2 = xr[128 * j + 1]; q += ((v.x * v.x + v.y * v.y) + (v.z * v.z + v.w * v.w)) + ((v2.x * v2.x + v2.y * v2.y) + (v2.z * v2.z + v2.w * v2.w));
            u32x4 w; w.x = cvtpk(v.x, v.y); w.y = cvtpk(v.z, v.w); w.z = cvtpk(v2.x, v2.y); w.w = cvtpk(v2.z, v2.w); o[64 * j] = w; }
        q = wave_sum(q);
        if (lane < 16) WSP(float, WS_SSP)[(size_t)m * 16 + lane] = (lane == 0) ? q : 0.f;
    }
    norm_rows(F, A.in[1], WSP(bf16, WS_MEMN), NB * NMEM);
    __syncthreads();
    LAS float* PW = (LAS float*)F.lds;
    LAS float* WU = (LAS float*)(F.lds + 128 * 129 * 4);
    for (int it = F.vcu; it < 2 * 4 * 32; it += F.G) {
        const int l = it >> 7, g = (it >> 5) & 3, n0 = (it & 31) * 32;
        const float* pw = A.in[5] + ((size_t)l * 512 + g * 128) * 128; const float* ps = A.in[6] + l * 512 + g * 128; const float* wu = A.in[10] + ((size_t)l * 512 + g * 128) * DM + n0;
        for (int i = tid; i < 128 * 128; i += 512) { const int c = i >> 7, cp = i & 127; PW[c * 129 + cp] = pw[i] * ps[cp]; }
        for (int i = tid; i < 128 * 8; i += 512) { const int cp = i >> 3, q = i & 7; *(LAS f32x4*)(WU + cp * 32 + 4 * q) = *(const f32x4*)(wu + (size_t)cp * DM + 4 * q); }
        __syncthreads();
        const int c = tid & 127, nq = tid >> 7;
        f32x4 s0 = {0.f, 0.f, 0.f, 0.f}, s1 = {0.f, 0.f, 0.f, 0.f};
#pragma unroll 8
        for (int cp = 0; cp < 128; ++cp) { const float p = PW[c * 129 + cp]; s0 += p * *(LAS f32x4*)(WU + cp * 32 + 8 * nq); s1 += p * *(LAS f32x4*)(WU + cp * 32 + 8 * nq + 4); }
        bf16* dst = (bf16*)(F.ws + WS_W + (size_t)l * W_LAYER + WO_UP) + (size_t)(n0 + 8 * nq) * 2048 + g * 128 + c;
#pragma unroll
        for (int j = 0; j < 4; ++j) { dst[(size_t)j * 2048] = (bf16)(cvtpk(s0[j], 0.f) & 0xffffu); dst[(size_t)(4 + j) * 2048] = (bf16)(cvtpk(s1[j], 0.f) & 0xffffu); }
        __syncthreads();
    }
}

__device__ __forceinline__ bf16x8 frag_tr(LAS unsigned char* Tt, int ldb, int rowA, int rowB, int col0, int fr) {
#if USE_TR
    const int q = fr >> 2, p = fr & 3;
    const s16x4 lo = __builtin_bit_cast(s16x4, __builtin_amdgcn_ds_read_tr16_b64_v4i16((LAS v4i16_t*)(Tt + (rowA + q) * ldb + (col0 + 4 * p) * 2)));
    const s16x4 hi = __builtin_bit_cast(s16x4, __builtin_amdgcn_ds_read_tr16_b64_v4i16((LAS v4i16_t*)(Tt + (rowB + q) * ldb + (col0 + 4 * p) * 2)));
    return __builtin_shufflevector(lo, hi, 0, 1, 2, 3, 4, 5, 6, 7);
#else
    bf16x8 f;
#pragma unroll
    for (int e = 0; e < 4; ++e) { f[e] = *(LAS short*)(Tt + (rowA + e) * ldb + (col0 + fr) * 2); f[4 + e] = *(LAS short*)(Tt + (rowB + e) * ldb + (col0 + fr) * 2); }
    return f;
#endif
}
__device__ __forceinline__ bf16x8 pack8(const f32x4& a, const f32x4& b) { u32x4 w; w.x = cvtpk(a[0], a[1]); w.y = cvtpk(a[2], a[3]); w.z = cvtpk(b[0], b[1]); w.w = cvtpk(b[2], b[3]); return __builtin_bit_cast(bf16x8, w); }
__device__ __forceinline__ float log2gamma(int h) { return log2f(1.0f - exp2f(-5.0f - (float)h)); }

__device__ __forceinline__ void mem_kv_proj(Frame& F) {
    const int tid = opaque_tid(), lane = tid & 63, wave = __builtin_amdgcn_readfirstlane(tid >> 6), fr = lane & 15, fq = lane >> 4;
    LAS unsigned char* As = F.lds; LAS unsigned char* Bs = F.lds + 33792;
    const int wm = wave & 3, wn = wave >> 2;
    for (int it = F.vcu; it < 512; it += F.G) {
        const int l = it >> 8, tm = (it >> 4) & 15, tn = it & 15;
        const bf16* Ag = WSP(bf16, WS_MEMN) + (size_t)(tm * 64) * DM; const bf16* Bg = WSP(bf16, WS_W + (size_t)l * W_LAYER + WO_MKV) + (size_t)(tn * 64) * DM;
        f32x4 acc[2]; acc[0] = (f32x4){0.f, 0.f, 0.f, 0.f}; acc[1] = (f32x4){0.f, 0.f, 0.f, 0.f};
        for (int kc = 0; kc < 4; ++kc) {
            __syncthreads();
#pragma unroll
            for (int k = 0; k < 4; ++k) { const int c = tid + 512 * k, r = c >> 5, ch = c & 31;
                *(LAS u32x4*)(As + r * 528 + ch * 16) = *(const u32x4*)(Ag + (size_t)r * DM + kc * 256 + ch * 8);
                *(LAS u32x4*)(Bs + r * 528 + ch * 16) = *(const u32x4*)(Bg + (size_t)r * DM + kc * 256 + ch * 8); }
            __syncthreads();
#pragma unroll
            for (int ks = 0; ks < 8; ++ks) { const bf16x8 af = *(LAS bf16x8*)(As + (16 * wm + fr) * 528 + (32 * ks + 8 * fq) * 2);
#pragma unroll
                for (int c = 0; c < 2; ++c) acc[c] = mfma16(*(LAS bf16x8*)(Bs + (32 * wn + 16 * c + fr) * 528 + (32 * ks + 8 * fq) * 2), af, acc[c]); }
        }
        bf16* dst = WSP(bf16, WS_KVMEM) + (size_t)l * 1024 * 1024 + (size_t)(tm * 64 + 16 * wm + fr) * 1024 + tn * 64 + 32 * wn + 4 * fq;
#pragma unroll
        for (int c = 0; c < 2; ++c) { u32x2 w; w.x = cvtpk(acc[c][0], acc[c][1]); w.y = cvtpk(acc[c][2], acc[c][3]); *(u32x2*)(dst + 16 * c) = w; }
    }
    __syncthreads();
}

template <int W> __device__ __forceinline__ void pool_item(bf16* P, int tl0, int c0) {
    const int pos0 = tl0 & (SEQ - 1);
    u32x4 r[W + 7];
#pragma unroll
    for (int i = 0; i < W + 7; ++i) { r[i] = (u32x4){0u, 0u, 0u, 0u}; if (pos0 - (W - 1) + i >= 0) r[i] = *(const u32x4*)(P + (size_t)(tl0 - (W - 1) + i) * PLD + c0); }
    float s[8];
#pragma unroll
    for (int e = 0; e < 8; ++e) s[e] = 0.f;
#pragma unroll
    for (int i = 0; i < W - 1; ++i)
#pragma unroll
        for (int e = 0; e < 4; ++e) { s[2 * e] += bflo(r[i][e]); s[2 * e + 1] += bfhi(r[i][e]); }
#pragma unroll
    for (int tt = 0; tt < 8; ++tt) {
        const int pos = pos0 + tt; const float rc = 1.0f / (float)((pos + 1 < W) ? pos + 1 : W);
        float d[8];
#pragma unroll
        for (int e = 0; e < 4; ++e) { const float u0 = bflo(r[W - 1 + tt][e]), u1 = bfhi(r[W - 1 + tt][e]); s[2 * e] += u0; s[2 * e + 1] += u1; d[2 * e] = s[2 * e] * rc - u0; d[2 * e + 1] = s[2 * e + 1] * rc - u1; }
        u32x4 o; o.x = cvtpk(d[0], d[1]); o.y = cvtpk(d[2], d[3]); o.z = cvtpk(d[4], d[5]); o.w = cvtpk(d[6], d[7]);
        *(u32x4*)(P + (size_t)(tl0 + tt) * PLD + C_DP + c0) = o;
#pragma unroll
        for (int e = 0; e < 4; ++e) { s[2 * e] -= bflo(r[tt][e]); s[2 * e + 1] -= bfhi(r[tt][e]); }
    }
}
__device__ __forceinline__ void mix_pool(Frame& F) {
    const int tid = opaque_tid(), lane = tid & 63, wave = __builtin_amdgcn_readfirstlane(tid >> 6);
    bf16* P = WSP(bf16, WS_PROJ);
    const int gw = F.vcu * 8 + wave, NGW = F.G * 8;
    for (int it = gw; it < 4 * (TH / 32); it += NGW) {
        const int g = it & 3, tl0 = (it >> 2) * 32 + (lane >> 4) * 8, c0 = g * 128 + (lane & 15) * 8;
        if (g == 0) pool_item<2>(P, tl0, c0); else if (g == 1) pool_item<4>(P, tl0, c0); else if (g == 2) pool_item<8>(P, tl0, c0); else pool_item<16>(P, tl0, c0);
    }
}

__device__ __forceinline__ void mix_mem(Frame& F, int l, int hf, bool dummy) {
    const int tid = opaque_tid(), lane = tid & 63, wave = __builtin_amdgcn_readfirstlane(tid >> 6), fr = lane & 15, fq = lane >> 4; (void)tid; (void)lane; (void)wave; (void)fr; (void)fq;
    bf16* P = WSP(bf16, WS_PROJ);
    LAS unsigned char* Kt = F.lds; LAS unsigned char* Vt = F.lds + 69632;
    const int items = 8 * 64, ipw = (items + F.G - 1) / F.G;
    const int it_lo = F.vcu * ipw, it_hi = (it_lo + ipw < items) ? it_lo + ipw : items;
    int loaded = -1;
    for (int it = it_lo; it < it_hi; ++it) {
        const int combo = it >> 6, qt = it & 63, bl = combo >> 2, h = combo & 3;
        if (combo != loaded) {
            __syncthreads();
            const bf16* src = WSP(bf16, WS_KVMEM) + (size_t)l * 1024 * 1024 + (size_t)((2 * hf + bl) * NMEM) * 1024 + h * 128;
            for (int c = tid; c < 4096; c += 512) { const int key = c >> 4, ch = c & 15;
                *(LAS u32x4*)(Kt + key * 272 + ch * 16) = *(const u32x4*)(src + (size_t)key * 1024 + ch * 8);
                *(LAS u32x4*)(Vt + key * 272 + ch * 16) = *(const u32x4*)(src + (size_t)key * 1024 + 512 + ch * 8); }
            __syncthreads(); loaded = combo;
        }
        bf16* qp = P + (size_t)(bl * SEQ + qt * 128 + wave * 16 + fr) * PLD + C_XQ + h * 128;
        bf16x8 bq[4];
#pragma unroll
        for (int ks = 0; ks < 4; ++ks) bq[ks] = *(const bf16x8*)(qp + ks * 32 + fq * 8);
        f32x4 s[16];
#pragma unroll
        for (int kt = 0; kt < 16; ++kt) { s[kt] = (f32x4){0.f, 0.f, 0.f, 0.f};
#pragma unroll
            for (int ks = 0; ks < 4; ++ks) s[kt] = mfma16(*(LAS bf16x8*)(Kt + (16 * kt + fr) * 272 + (32 * ks + 8 * fq) * 2), bq[ks], s[kt]); }
        float mx = -3.0e38f;
#pragma unroll
        for (int kt = 0; kt < 16; ++kt) mx = fmaxf(fmaxf(fmaxf(s[kt][0], s[kt][1]), fmaxf(s[kt][2], s[kt][3])), mx);
        mx = max_xor16(mx); mx = max_xor32(mx);
        float lsum = 0.f;
#pragma unroll
        for (int kt = 0; kt < 16; ++kt)
#pragma unroll
            for (int r = 0; r < 4; ++r) { const float p = exp2f(s[kt][r] - mx); s[kt][r] = p; lsum += p; }
        lsum = add_xor16(lsum); lsum = add_xor32(lsum);
        const float rl = 1.0f / lsum;
        f32x4 o[8];
#pragma unroll
        for (int dt = 0; dt < 8; ++dt) o[dt] = (f32x4){0.f, 0.f, 0.f, 0.f};
#pragma unroll
        for (int kp = 0; kp < 8; ++kp) { const bf16x8 pf = pack8(s[2 * kp], s[2 * kp + 1]);
#pragma unroll
            for (int dt = 0; dt < 8; ++dt) o[dt] = mfma16(frag_tr(Vt, 272, 32 * kp + 4 * fq, 32 * kp + 16 + 4 * fq, 16 * dt, fr), pf, o[dt]); }
        bf16* op = (dummy ? WSP(bf16, WS_MERGED) + (size_t)(bl * SEQ + qt * 128 + wave * 16 + fr) * 512 + h * 128 : qp) + 16 * (fq & 1) + 4 * (fq & 2);
#pragma unroll
        for (int p = 0; p < 4; ++p) { const unsigned ax = cvtpk(o[2 * p][0] * rl, o[2 * p][1] * rl), ay = cvtpk(o[2 * p][2] * rl, o[2 * p][3] * rl), bx_ = cvtpk(o[2 * p + 1][0] * rl, o[2 * p + 1][1] * rl), by = cvtpk(o[2 * p + 1][2] * rl, o[2 * p + 1][3] * rl);
            auto rx = __builtin_amdgcn_permlane16_swap(ax, bx_, false, false); auto ry = __builtin_amdgcn_permlane16_swap(ay, by, false, false);
            u32x4 w; w.x = rx[0]; w.y = ry[0]; w.z = rx[1]; w.w = ry[1]; *(u32x4*)(op + 32 * p) = w; }
    }
    __syncthreads();
}

__device__ __forceinline__ void mix_kv(Frame& F) {
    const int tid = opaque_tid(), lane = tid & 63, wave = __builtin_amdgcn_readfirstlane(tid >> 6), fr = lane & 15, fq = lane >> 4; (void)tid; (void)lane; (void)wave; (void)fr; (void)fq;
    bf16* P = WSP(bf16, WS_PROJ);
    LAS unsigned char* Kd = F.lds; LAS unsigned char* Vt = F.lds + 34816;
    for (int un = F.vcu; un < 512; un += F.G) {
        const int h = un & 3, n = (un >> 2) & 63, bl = un >> 8; const size_t row0 = (size_t)bl * SEQ + n * 128; const float lg = log2gamma(h);
        __syncthreads();
        for (int c = tid; c < 2048; c += 512) { const int j = c >> 4, ch = c & 15; const u32x4 v = *(const u32x4*)(P + (row0 + j) * PLD + C_K + h * 128 + ch * 8); const float f = exp2f((float)(127 - j) * lg);
            u32x4 o; o.x = cvtpk(bflo(v.x) * f, bfhi(v.x) * f); o.y = cvtpk(bflo(v.y) * f, bfhi(v.y) * f); o.z = cvtpk(bflo(v.z) * f, bfhi(v.z) * f); o.w = cvtpk(bflo(v.w) * f, bfhi(v.w) * f);
            *(LAS u32x4*)(Kd + j * 272 + ch * 16) = o; }
        for (int c = tid; c < 4096; c += 512) { const int j = c >> 5, ch = c & 31; *(LAS u32x4*)(Vt + j * 528 + ch * 16) = *(const u32x4*)(P + (row0 + j) * PLD + C_V + h * 256 + ch * 8); }
        __syncthreads();
        f32x4 acc[8][2];
#pragma unroll
        for (int dt = 0; dt < 8; ++dt) { acc[dt][0] = (f32x4){0.f, 0.f, 0.f, 0.f}; acc[dt][1] = (f32x4){0.f, 0.f, 0.f, 0.f}; }
#pragma unroll
        for (int ks = 0; ks < 4; ++ks) { const int rA = 32 * ks + 8 * fq, rB = rA + 4;
            const bf16x8 bv0 = frag_tr(Vt, 528, rA, rB, 16 * (2 * wave), fr), bv1 = frag_tr(Vt, 528, rA, rB, 16 * (2 * wave + 1), fr);
#pragma unroll
            for (int dt = 0; dt < 8; ++dt) { const bf16x8 ad = frag_tr(Kd, 272, rA, rB, 16 * dt, fr); acc[dt][0] = mfma16(ad, bv0, acc[dt][0]); acc[dt][1] = mfma16(ad, bv1, acc[dt][1]); } }
        bf16* dst = WSP(bf16, WS_KVN) + (size_t)un * 32768 + 16 * (fq & 1) + 4 * (fq & 2);
#pragma unroll
        for (int vi = 0; vi < 2; ++vi)
#pragma unroll
            for (int p = 0; p < 4; ++p) { const f32x4 a = acc[2 * p][vi], b = acc[2 * p + 1][vi];
                const unsigned ax = cvtpk(a[0], a[1]), ay = cvtpk(a[2], a[3]), bx_ = cvtpk(b[0], b[1]), by = cvtpk(b[2], b[3]);
                auto rx = __builtin_amdgcn_permlane16_swap(ax, bx_, false, false); auto ry = __builtin_amdgcn_permlane16_swap(ay, by, false, false);
                u32x4 o; o.x = rx[0]; o.y = ry[0]; o.z = rx[1]; o.w = ry[1];
                *(u32x4*)(dst + (size_t)(16 * (2 * wave + vi) + fr) * 128 + 32 * p) = o; }
    }
    __syncthreads();
}

__device__ __forceinline__ void scan_states(Frame& F) {
    const int tid = opaque_tid(), lane = tid & 63, wave = __builtin_amdgcn_readfirstlane(tid >> 6), fr = lane & 15, fq = lane >> 4; (void)tid; (void)lane; (void)wave; (void)fr; (void)fq;
    const bf16* KV = WSP(bf16, WS_KVN); bf16* SP = WSP(bf16, WS_SPREV);
    if (tid < 256)
    for (int p = F.vcu * 256 + tid; p < 8 * 8192; p += F.G * 256) {
        const int blk = p >> 13, bl = blk >> 2, h = blk & 3, off = (p & 8191) * 4; const float cd = exp2f(128.0f * log2gamma(h));
        f32x4 st = {0.f, 0.f, 0.f, 0.f};
        for (int n0 = 0; n0 < 64; n0 += 8) {
            u32x2 kv[8];
#pragma unroll
            for (int j = 0; j < 8; ++j) kv[j] = *(const u32x2*)(KV + (size_t)((bl * 64 + n0 + j) * 4 + h) * 32768 + off);
#pragma unroll
            for (int j = 0; j < 8; ++j) { u32x2 w; w.x = cvtpk(st[0], st[1]); w.y = cvtpk(st[2], st[3]); *(u32x2*)(SP + (size_t)((bl * 64 + n0 + j) * 4 + h) * 32768 + off) = w;
                st = st * cd + (f32x4){bflo(kv[j].x), bfhi(kv[j].x), bflo(kv[j].y), bfhi(kv[j].y)}; }
        }
    }
}

__device__ __forceinline__ void ret_out(Frame& F, bool dummy) {
    const int tid = opaque_tid(), lane = tid & 63, wave = __builtin_amdgcn_readfirstlane(tid >> 6), fr = lane & 15, fq = lane >> 4; (void)tid; (void)lane; (void)wave; (void)fr; (void)fq;
    bf16* P = WSP(bf16, WS_PROJ);
    LAS unsigned char* Kt = F.lds; LAS unsigned char* Vt = F.lds + 34816; LAS unsigned char* Sp = F.lds + 102400;
    for (int un = F.vcu; un < 512; un += F.G) {
        const int h = un & 3, n = (un >> 2) & 63, bl = un >> 8; const size_t row0 = (size_t)bl * SEQ + n * 128; const float lg = log2gamma(h);
        const bf16* spg = WSP(bf16, WS_SPREV) + (size_t)un * 32768;
        const int i = wave * 16 + fr; const size_t trow = row0 + i;
        bf16x8 bq[4];
#pragma unroll
        for (int ks = 0; ks < 4; ++ks) bq[ks] = *(const bf16x8*)(P + trow * PLD + C_Q + h * 128 + ks * 32 + fq * 8);
        bf16* gp = P + trow * PLD + C_G + h * 256 + 4 * fq;
        __syncthreads();
        for (int c = tid; c < 2048; c += 512) { const int j = c >> 4, ch = c & 15;
            *(LAS u32x4*)(Kt + j * 272 + ch * 16) = *(const u32x4*)(P + (row0 + j) * PLD + C_K + h * 128 + ch * 8);
            *(LAS u32x4*)(Sp + j * 272 + ch * 16) = *(const u32x4*)(spg + (size_t)j * 128 + ch * 8); }
        for (int c = tid; c < 4096; c += 512) { const int j = c >> 5, ch = c & 31; *(LAS u32x4*)(Vt + j * 528 + ch * 16) = *(const u32x4*)(P + (row0 + j) * PLD + C_V + h * 256 + ch * 8); }
        u32x4 sp1[4];
#pragma unroll
        for (int k = 0; k < 4; ++k) { const int c = tid + 512 * k, j = c >> 4, ch = c & 15; sp1[k] = *(const u32x4*)(spg + (size_t)(128 + j) * 128 + ch * 8); }
        __syncthreads();
        f32x4 acc[16];
#pragma unroll
        for (int vt = 0; vt < 8; ++vt) { acc[vt] = (f32x4){0.f, 0.f, 0.f, 0.f};
#pragma unroll
            for (int ks = 0; ks < 4; ++ks) acc[vt] = mfma16(*(LAS bf16x8*)(Sp + (16 * vt + fr) * 272 + (32 * ks + 8 * fq) * 2), bq[ks], acc[vt]); }
        __syncthreads();
#pragma unroll
        for (int k = 0; k < 4; ++k) { const int c = tid + 512 * k, j = c >> 4, ch = c & 15; *(LAS u32x4*)(Sp + j * 272 + ch * 16) = sp1[k]; }
        __syncthreads();
#pragma unroll
        for (int vt = 8; vt < 16; ++vt) { acc[vt] = (f32x4){0.f, 0.f, 0.f, 0.f};
#pragma unroll
            for (int ks = 0; ks < 4; ++ks) acc[vt] = mfma16(*(LAS bf16x8*)(Sp + (16 * (vt - 8) + fr) * 272 + (32 * ks + 8 * fq) * 2), bq[ks], acc[vt]); }
        bf16* gq = P + trow * PLD + C_G + h * 256 + 16 * (fq & 1) + 4 * (fq & 2);
        u32x4 gl[8];
#pragma unroll
        for (int p = 0; p < 8; ++p) gl[p] = *(const u32x4*)(gq + 32 * p);
        const float fac = exp2f((float)(i + 1) * lg);
#pragma unroll
        for (int vt = 0; vt < 16; ++vt) acc[vt] = acc[vt] * fac;
        f32x4 s[8];
#pragma unroll
        for (int kt = 0; kt < 8; ++kt) { s[kt] = (f32x4){0.f, 0.f, 0.f, 0.f};
            if (kt <= wave) {
#pragma unroll
                for (int ks = 0; ks < 4; ++ks) s[kt] = mfma16(*(LAS bf16x8*)(Kt + (16 * kt + fr) * 272 + (32 * ks + 8 * fq) * 2), bq[ks], s[kt]);
#pragma unroll
                for (int r = 0; r < 4; ++r) { const int key = 16 * kt + 4 * fq + r; s[kt][r] = (key <= i) ? s[kt][r] * exp2f((float)(i - key) * lg) : 0.f; } } }
#pragma unroll
        for (int kp = 0; kp < 4; ++kp) if (2 * kp <= wave) { const bf16x8 pf = pack8(s[2 * kp], s[2 * kp + 1]);
#pragma unroll
            for (int vt = 0; vt < 16; ++vt) acc[vt] = mfma16(frag_tr(Vt, 528, 32 * kp + 4 * fq, 32 * kp + 16 + 4 * fq, 16 * vt, fr), pf, acc[vt]); }
        float ss = 0.f;
#pragma unroll
        for (int vt = 0; vt < 16; ++vt) ss += (acc[vt][0] * acc[vt][0] + acc[vt][1] * acc[vt][1]) + (acc[vt][2] * acc[vt][2] + acc[vt][3] * acc[vt][3]);
        ss = add_xor16(ss); ss = add_xor32(ss);
        const float rinv = rsqrtf(ss * (1.0f / 256.0f) + EPS);
#pragma unroll
        for (int p = 0; p < 8; ++p) {
            u32x2 g[2];
            { auto rx = __builtin_amdgcn_permlane16_swap(gl[p][0], gl[p][2], false, false); auto ry = __builtin_amdgcn_permlane16_swap(gl[p][1], gl[p][3], false, false);
              g[0].x = rx[0]; g[0].y = ry[0]; g[1].x = rx[1]; g[1].y = ry[1]; }
            u32x2 w[2];
#pragma unroll
            for (int j = 0; j < 2; ++j) { const int vt = 2 * p + j; const float g0 = bflo(g[j].x), g1 = bfhi(g[j].x), g2 = bflo(g[j].y), g3 = bfhi(g[j].y);
                w[j].x = cvtpk(acc[vt][0] * rinv * g0 * sigmoidf_(g0), acc[vt][1] * rinv * g1 * sigmoidf_(g1)); w[j].y = cvtpk(acc[vt][2] * rinv * g2 * sigmoidf_(g2), acc[vt][3] * rinv * g3 * sigmoidf_(g3)); }
            u32x4 o;
            { auto rx = __builtin_amdgcn_permlane16_swap(w[0].x, w[1].x, false, false); auto ry = __builtin_amdgcn_permlane16_swap(w[0].y, w[1].y, false, false);
              o.x = rx[0]; o.y = ry[0]; o.z = rx[1]; o.w = ry[1]; }
            *(u32x4*)((dummy ? WSP(bf16, WS_MERGED) + trow * 1024 + h * 256 + 16 * (fq & 1) + 4 * (fq & 2) : gq) + 32 * p) = o; }
    }
    __syncthreads();
}

constexpr int N_PHASES = 2 + 2 * 16 + 1;
__global__ void __launch_bounds__(512, 2) fwd_kernel(Args args) {
    extern __shared__ __attribute__((aligned(16))) unsigned char lds_raw[];
    Frame F;
    F.lds = (LAS unsigned char*)lds_raw;
    F.G = gridDim.x; { const int bx = blockIdx.x; F.vcu = (F.G % 8 == 0) ? (bx % 8) * (F.G / 8) + bx / 8 : bx; }
    F.ws = args.ws;
    const Args& A = args;
    for (int u = TID; u < (LDS_BYTES - LDSCTL_OFF) / 4; u += 512) ((LAS unsigned*)(F.lds + LDSCTL_OFF))[u] = 0u;
    __syncthreads();
    const int lo = args.ph_lo, hi = args.ph_hi;
    XcdBarrier bar; bar.bar = WSP(unsigned, WS_CTL) + CW_BAR; bar.x = 0; bar.st = nullptr;
    if (hi - lo > 1) bar = xcd_barrier_post(WSP(unsigned, WS_CTL) + CW_BAR, (volatile LAS unsigned*)(F.lds + MISC_OFF) + 8);
    int ph = 0;
#define RUN() (lo <= ph && ph < hi)
#define END_PHASE() do { if (RUN() && ph + 1 < hi) xcd_barrier(bar); ++ph; } while (0)
    const int bx = (int)blockIdx.x;

    if (RUN()) for (int rep = 0; rep < REPS(10); ++rep) { if (rep) xcd_barrier(bar); p0_prologue(F, A); }
    END_PHASE();
    if (RUN()) for (int rep = 0; rep < REPS(11); ++rep) { if (rep) xcd_barrier(bar); mem_kv_proj(F); }
    END_PHASE();
#pragma unroll 1
    for (int l = 0; l < 2; ++l) {
        unsigned char* wl = F.ws + WS_W + (size_t)l * W_LAYER;
#pragma unroll 1
        for (int hf = 0; hf < 2; ++hf) {
            const int t0 = hf * TH;
            if (RUN()) for (int rep = 0; rep < REPS(0); ++rep) { if (rep) xcd_barrier(bar);
                pg8::Gemm g{WSP(bf16, WS_XB) + (size_t)t0 * DM, (const bf16*)(wl + WO_IN)};
                pg8::StaticOrder<TH, 4096> S; S.init(F.G, bx);
                pg8::EpiBf<2> E{WSP(bf16, WS_PROJ), PLD, WSP(float, WS_COS), WSP(float, WS_SIN), t0, WSP(float, WS_SSP)};
                pg8::gemm_phase<DM, DM, DM, pg8::EpiBf<2>, pg8::StaticOrder<TH, 4096>>(F.lds, g, S, E);
            }
            END_PHASE();
            if (RUN()) for (int rep = 0; rep < REPS(1); ++rep) { if (rep) xcd_barrier(bar); mix_pool(F); mix_mem(F, l, hf, rep != 0); mix_kv(F); }
            END_PHASE();
            if (RUN()) for (int rep = 0; rep < REPS(2); ++rep) { if (rep) xcd_barrier(bar); scan_states(F); }
            END_PHASE();
            if (RUN()) for (int rep = 0; rep < REPS(3); ++rep) { if (rep) xcd_barrier(bar); ret_out(F, rep != 0); }
            END_PHASE();
            if (RUN()) for (int rep = 0; rep < REPS(4); ++rep) { if (rep) xcd_barrier(bar);
                pg8::Gemm g{WSP(bf16, WS_XB) + (size_t)t0 * DM, (const bf16*)(wl + WO_IN) + (size_t)4096 * DM};
                pg8::StaticOrder<TH, 3072> S; S.init(F.G, bx);
                pg8::EpiBf<3> E{WSP(bf16, WS_GATES), 3072, nullptr, nullptr, t0, WSP(float, WS_SSP)};
                pg8::gemm_phase<DM, DM, DM, pg8::EpiBf<3>, pg8::StaticOrder<TH, 3072>>(F.lds, g, S, E);
            }
            END_PHASE();
            if (RUN()) for (int rep = 0; rep < REPS(5); ++rep) { if (rep) xcd_barrier(bar);
                pg8::Gemm g{WSP(bf16, WS_PROJ) + C_DP, (const bf16*)(wl + WO_UP)};
                pg8::StaticOrder<TH, DM> S; S.init(F.G, bx);
                pg8::EpiUp E{WSP(bf16, WS_MERGED), WSP(bf16, WS_GATES)};
                pg8::gemm_phase<2048, PLD, 2048, pg8::EpiUp, pg8::StaticOrder<TH, DM>>(F.lds, g, S, E);
            }
            END_PHASE();
            if (RUN()) for (int rep = 0; rep < REPS(6); ++rep) { if (rep) xcd_barrier(bar);
                pg8::Gemm g{WSP(bf16, WS_MERGED), (const bf16*)(wl + WO_OUT)};
                pg8::StaticOrder<TH, DM> S; S.init(F.G, bx);
                pg8::EpiRes E{WSP(bf16, WS_XB) + (size_t)t0 * DM, WSP(float, WS_SSP) + (size_t)t0 * 16, rep ? WSP(bf16, WS_KVN) : nullptr};
                pg8::gemm_phase<DM, DM, DM, pg8::EpiRes, pg8::StaticOrder<TH, DM>>(F.lds, g, S, E);
            }
            END_PHASE();
        }
        if (RUN()) for (int rep = 0; rep < REPS(8); ++rep) { if (rep) xcd_barrier(bar);
            pg8::Gemm g{WSP(bf16, WS_XB), (const bf16*)(wl + WO_1)};
            pg8::StaticOrder<T, DFF> S; S.init(F.G, bx);
            pg8::EpiBf<1> E{WSP(bf16, WS_U), DFF, nullptr, nullptr, 0, WSP(float, WS_SSP)};
            pg8::gemm_phase<DM, DM, DM, pg8::EpiBf<1>, pg8::StaticOrder<T, DFF>>(F.lds, g, S, E);
        }
        END_PHASE();
        if (RUN()) {
            pg8::Gemm g{WSP(bf16, WS_U), (const bf16*)(wl + WO_2)};
            pg8::StaticOrder<T, DM> S; S.init(F.G, bx);
            pg8::EpiRes E{WSP(bf16, WS_XB), WSP(float, WS_SSP), nullptr};
            pg8::gemm_phase<DFF, DFF, DFF, pg8::EpiRes, pg8::StaticOrder<T, DM>>(F.lds, g, S, E);
#if (PROBE_DUP >> 9) & 1
            xcd_barrier(bar);
            { pg8::StaticOrder<TH, DM> S2; S2.init(F.G, bx); pg8::EpiRes E2{WSP(bf16, WS_XB), WSP(float, WS_SSP), (bf16*)(F.ws + WS_END)};
              pg8::gemm_phase<DFF, DFF, DFF, pg8::EpiRes, pg8::StaticOrder<TH, DM>>(F.lds, g, S2, E2); }
#endif
        }
        END_PHASE();
        if (l == 1) { if (RUN()) final_norm(F, A.out, A.in[17]); END_PHASE(); }
#if (PROBE_DUP >> 12) & 1
        for (int rep = 0; rep < 8; ++rep) xcd_barrier(bar);
#endif
    }
#undef RUN
#undef END_PHASE
}

extern "C" void kernel_launch(void* const* d_in, const int* in_sizes, int n_in, void* d_out, int out_size, void* d_ws, size_t ws_size, hipStream_t stream) {
    static int grid = 0;
    if (grid == 0) {
        if (n_in != 18 || in_sizes[0] != T * DM || out_size != T * DM || ws_size < WS_END) { fprintf(stderr, "kernel_launch: unexpected shapes / workspace (n_in %d, ws %zu)\n", n_in, ws_size); grid = -1; return; }
        int dev = 0, cus = 0, per_cu = 0;
        if (hipGetDevice(&dev) != hipSuccess || hipDeviceGetAttribute(&cus, hipDeviceAttributeMultiprocessorCount, dev) != hipSuccess) { grid = -1; return; }
        if (hipFuncSetAttribute((const void*)fwd_kernel, hipFuncAttributeMaxDynamicSharedMemorySize, LDS_BYTES) != hipSuccess) { fprintf(stderr, "kernel_launch: hipFuncSetAttribute failed\n"); grid = -1; return; }
        if (hipOccupancyMaxActiveBlocksPerMultiprocessor(&per_cu, (const void*)fwd_kernel, 512, LDS_BYTES) != hipSuccess || per_cu < 1) { fprintf(stderr, "kernel_launch: occupancy query says %d\n", per_cu); (void)hipGetLastError(); grid = -1; return; }
        grid = cus;
    }
    if (grid < 0) return;
    (void)hipMemsetAsync((char*)d_ws + WS_CTL, 0, CTL_ZERO_BYTES, stream);
    Args a{};
    for (int i = 0; i < 18; ++i) a.in[i] = (const float*)d_in[i];
    a.out = (float*)d_out; a.ws = (unsigned char*)d_ws;
#if MK_SINGLE
    a.ph_lo = 0; a.ph_hi = N_PHASES;
    hipLaunchKernelGGL(fwd_kernel, dim3(grid), dim3(512), LDS_BYTES, stream, a);
#else
    for (int p = 0; p < N_PHASES; ++p) { a.ph_lo = p; a.ph_hi = p + 1; hipLaunchKernelGGL(fwd_kernel, dim3(grid), dim3(512), LDS_BYTES, stream, a); }
#endif
}
```

```cpp
#include <hip/hip_runtime.h>
#include <cstdio>
#include <cstdint>

#ifndef MK_SINGLE
#define MK_SINGLE 1
#endif
#ifndef PROBE_DUP
#define PROBE_DUP 0
#endif
#define REPS(k) (1 + ((PROBE_DUP >> (k)) & 1))
#ifndef USE_TR
#define USE_TR 1
#endif

#define LAS __attribute__((address_space(3)))
#define GAS __attribute__((address_space(1)))
typedef unsigned short bf16;
typedef short bf16x8 __attribute__((ext_vector_type(8)));
typedef short s16x4 __attribute__((ext_vector_type(4)));
typedef float f32x4 __attribute__((ext_vector_type(4)));
typedef float f32x2 __attribute__((ext_vector_type(2)));
typedef unsigned u32x4 __attribute__((ext_vector_type(4)));
typedef unsigned u32x2 __attribute__((ext_vector_type(2)));
typedef __bf16 bf16x2_t __attribute__((ext_vector_type(2)));
typedef short v4i16_t __attribute__((ext_vector_type(4)));

constexpr int DM = 1024, NB = 4, SEQ = 8192, T = NB * SEQ, TH = T / 2, NMEM = 256, DFF = 4096;
constexpr int INC = 7168;
constexpr int PLD = 4608;
constexpr int C_Q = 512, C_K = 1024, C_V = 1536, C_DP = 2560, C_G = 3072, C_XQ = 4096;
constexpr float EPS = 1e-6f;
constexpr float XQ_SCALE = 0.08838834764831845f * 1.4426950408889634f;
constexpr float LOG2E = 1.4426950408889634f;
constexpr float K_SCALE = 0.08838834764831845f;

constexpr size_t MiB = 1u << 20;
constexpr size_t WS_CTL = 0, CTL_ZERO_BYTES = 1 * MiB;
constexpr size_t WS_COS = 2 * MiB, WS_SIN = 10 * MiB;
constexpr size_t WS_SSP = 18 * MiB;
constexpr size_t WS_MEMN = 20 * MiB;
constexpr size_t WS_KVMEM = 24 * MiB;
constexpr size_t WS_W = 32 * MiB, W_LAYER = 38 * MiB;
constexpr size_t WO_IN = 0, WO_UP = 14 * MiB, WO_OUT = 18 * MiB, WO_1 = 20 * MiB, WO_2 = 28 * MiB, WO_MKV = 36 * MiB;
constexpr size_t WS_XB = 108 * MiB;
constexpr size_t WS_MERGED = 172 * MiB;
constexpr size_t WS_PROJ = 204 * MiB;
constexpr size_t WS_KVN = 348 * MiB;
constexpr size_t WS_SPREV = 412 * MiB;
constexpr size_t WS_GATES = 348 * MiB;
constexpr size_t WS_U = 172 * MiB;
constexpr size_t WS_END = 444 * MiB;
static_assert(WS_W + 2 * W_LAYER <= WS_XB && WS_U + (size_t)T * DFF * 2 <= WS_END && WS_PROJ + (size_t)TH * PLD * 2 <= WS_KVN, "ws map");
constexpr int CW_TMO = 0, CW_BAR = 4096;

constexpr int RING_BYTES = 131072, SCRATCH_BYTES = 147456, LDSCTL_OFF = SCRATCH_BYTES, MISC_OFF = LDSCTL_OFF + 320, LDS_BYTES = SCRATCH_BYTES + 1024;

__device__ __forceinline__ unsigned cvtpk(float lo, float hi) { f32x2 v = {lo, hi}; bf16x2_t b = __builtin_convertvector(v, bf16x2_t); return __builtin_bit_cast(unsigned, b); }
__device__ __forceinline__ float bflo(unsigned u) { return __uint_as_float(u << 16); }
__device__ __forceinline__ float bfhi(unsigned u) { return __uint_as_float(u & 0xffff0000u); }
__device__ __forceinline__ f32x4 mfma16(bf16x8 a, bf16x8 b, f32x4 c) { return __builtin_amdgcn_mfma_f32_16x16x32_bf16(a, b, c, 0, 0, 0); }
#define SWZ_XOR(m) (((m) << 10) | 0x1f)
__device__ __forceinline__ float wave_sum(float v) {
    v += __int_as_float(__builtin_amdgcn_ds_swizzle(__float_as_int(v), SWZ_XOR(1)));
    v += __int_as_float(__builtin_amdgcn_ds_swizzle(__float_as_int(v), SWZ_XOR(2)));
    v += __int_as_float(__builtin_amdgcn_ds_swizzle(__float_as_int(v), SWZ_XOR(4)));
    v += __int_as_float(__builtin_amdgcn_ds_swizzle(__float_as_int(v), SWZ_XOR(8)));
    { auto r = __builtin_amdgcn_permlane16_swap(__float_as_uint(v), __float_as_uint(v), false, false); v = __uint_as_float(r[0]) + __uint_as_float(r[1]); }
    { auto r = __builtin_amdgcn_permlane32_swap(__float_as_uint(v), __float_as_uint(v), false, false); v = __uint_as_float(r[0]) + __uint_as_float(r[1]); }
    return v;
}
__device__ __forceinline__ float add_xor16(float v) { auto r = __builtin_amdgcn_permlane16_swap(__float_as_uint(v), __float_as_uint(v), false, false); return __uint_as_float(r[0]) + __uint_as_float(r[1]); }
__device__ __forceinline__ float add_xor32(float v) { auto r = __builtin_amdgcn_permlane32_swap(__float_as_uint(v), __float_as_uint(v), false, false); return __uint_as_float(r[0]) + __uint_as_float(r[1]); }
__device__ __forceinline__ float max_xor16(float v) { auto r = __builtin_amdgcn_permlane16_swap(__float_as_uint(v), __float_as_uint(v), false, false); return fmaxf(__uint_as_float(r[0]), __uint_as_float(r[1])); }
__device__ __forceinline__ float max_xor32(float v) { auto r = __builtin_amdgcn_permlane32_swap(__float_as_uint(v), __float_as_uint(v), false, false); return fmaxf(__uint_as_float(r[0]), __uint_as_float(r[1])); }
__device__ __forceinline__ float sigmoidf_(float x) { return 1.0f / (1.0f + __expf(-x)); }

namespace pg8 {
#define PG8_LAS __attribute__((address_space(3)))
typedef unsigned short bf16_t;
constexpr int BM = 256, BK = 64, HALF = 128, HTB = HALF * BK * 2, STAGE_BYTES = 8 * HTB, NXCD = 8, WGM = 8;
__host__ __device__ __forceinline__ int lds_byte(int r, int c) { const int st = (r >> 4) * 2 + (c >> 5), rr = r & 15, cc = c & 31, ob = rr * 64 + cc * 2; return st * 1024 + (ob ^ (((ob >> 9) & 1) << 5)); }
__host__ __device__ __forceinline__ void stage_rc(int b, int& R, int& C) { const int st = b / 1024, sb = b % 1024, swz = sb ^ (((sb >> 9) & 1) << 5); R = (st >> 1) * 16 + swz / 64; C = (st & 1) * 32 + (swz % 64) / 2; }
__host__ __device__ __forceinline__ int perm32(int rho) { const int n = rho >> 4, i = rho & 15; return 8 * (i >> 2) + 4 * n + (i & 3); }

struct Unit { int pm, pn; };
struct Gemm { const bf16_t* A; const bf16_t* Bt; };

template <int M_, int N_> struct StaticOrder {
    static constexpr int nM = M_ / BM, nN = N_ / BM, nwg = nM * nN;
    int G, c;
    __host__ __device__ void init(int G_, int c_) { G = G_; c = c_; }
    __host__ __device__ bool next(int i, Unit& u) const {
        const long L = (long)i * G + c; if (L >= nwg) return false;
        int wgid = (int)L; { const int q = nwg / NXCD, r = nwg % NXCD, xcd = wgid % NXCD, off = wgid / NXCD; wgid = (xcd < r ? xcd * (q + 1) : r * (q + 1) + (xcd - r) * q) + off; }
        const int nig = WGM * nN, gid = wgid / nig, fm = gid * WGM, gsz = (nM - fm) < WGM ? (nM - fm) : WGM;
        u.pm = fm + ((wgid % nig) % gsz); u.pn = (wgid % nig) / gsz; return true;
    }
    __device__ __forceinline__ void a_ready(const Unit&) const {}
    __device__ __forceinline__ void done(const Unit&) const {}
};

typedef f32x4 Acc[2][2][4][2];

template <int MODE> struct EpiBf {
    static constexpr bool PERM = true, AFTER_DRAIN = false, HOOK = false, EARLY_PRE = (MODE != 2);
    bf16_t* O; int ldc; const float* cosT; const float* sinT; int t0; const float* ssp;
    __device__ __forceinline__ void hook(Acc&, const Unit&, int, int, int, int, int) const {}
    struct Pre { float rs[2][4]; };
    struct Raw { f32x4 v[2][4]; };
    __device__ __forceinline__ Raw pre_load(const Unit& u, int wr, int fr, int fq) const {
        Raw r; const float* p = ssp + (size_t)(t0 + u.pm * BM + wr * 64) * 16 + (unsigned)(fr * 16 + 4 * fq);
#pragma unroll
        for (int ai = 0; ai < 2; ++ai)
#pragma unroll
            for (int m = 0; m < 4; ++m) r.v[ai][m] = *(const f32x4*)(p + (size_t)(ai * HALF + m * 16) * 16);
        __builtin_amdgcn_sched_barrier(0);
        return r;
    }
    __device__ __forceinline__ Pre pre_finish(const Raw& r) const {
        Pre p;
#pragma unroll
        for (int ai = 0; ai < 2; ++ai)
#pragma unroll
            for (int m = 0; m < 4; ++m) { const f32x4 v = r.v[ai][m]; float q = (v[0] + v[1]) + (v[2] + v[3]); q = add_xor16(q); q = add_xor32(q); p.rs[ai][m] = rsqrtf(q * (1.0f / DM) + EPS); }
        return p;
    }
    __device__ __forceinline__ Pre operator()(const Acc& acc, const Unit& u, const Unit& un, int wr, int wc, int fr_in, int fq_in, const Pre& pr) const {
        int fr = fr_in, fq = fq_in; asm volatile("" : "+v"(fr), "+v"(fq));
        if (MODE == 2 && u.pn >= 2 && u.pn < 6) {
            const int sec = (u.pn < 4) ? C_Q : C_K, head = 2 * (u.pn & 1) + (wc >> 1);
            const float ksc0 = (u.pn >= 4) ? K_SCALE : 1.0f;
            const int rowu = u.pm * BM + wr * 64, dcolu = sec + head * 128 + 32 * (wc & 1);
            const unsigned toff = (unsigned)(fr * 64 + 8 * fq), ooff = (unsigned)(fr * ldc + 8 * fq);
#pragma unroll
            for (int am = 0; am < 8; am += 2) {
                f32x4 cs[2][4];
#pragma unroll
                for (int j = 0; j < 2; ++j) { const size_t tr = (size_t)(t0 + rowu + ((am + j) >> 2) * HALF + ((am + j) & 3) * 16) * 64 + 32 * (wc & 1); const float* cp = cosT + tr; const float* sp = sinT + tr;
                    cs[j][0] = *(const f32x4*)(cp + toff); cs[j][1] = *(const f32x4*)(cp + toff + 4); cs[j][2] = *(const f32x4*)(sp + toff); cs[j][3] = *(const f32x4*)(sp + toff + 4); }
                __builtin_amdgcn_sched_barrier(0);
#pragma unroll
                for (int j = 0; j < 2; ++j) { const int ai = (am + j) >> 2, m = (am + j) & 3;
                    const float ksc = ksc0 * pr.rs[ai][m];
                    const f32x4 c0 = cs[j][0], c1 = cs[j][1], s0 = cs[j][2], s1 = cs[j][3];
                    const f32x4 a0 = acc[ai][0][m][0], a1 = acc[ai][0][m][1], b0 = acc[ai][1][m][0], b1 = acc[ai][1][m][1];
                    const f32x4 o10 = (a0 * c0 - b0 * s0) * ksc, o11 = (a1 * c1 - b1 * s1) * ksc, o20 = (b0 * c0 + a0 * s0) * ksc, o21 = (b1 * c1 + a1 * s1) * ksc;
                    bf16_t* rowp = O + (size_t)(rowu + ai * HALF + m * 16) * ldc + dcolu;
                    u32x4 w1, w2; w1.x = cvtpk(o10[0], o10[1]); w1.y = cvtpk(o10[2], o10[3]); w1.z = cvtpk(o11[0], o11[1]); w1.w = cvtpk(o11[2], o11[3]);
                    w2.x = cvtpk(o20[0], o20[1]); w2.y = cvtpk(o20[2], o20[3]); w2.z = cvtpk(o21[0], o21[1]); w2.w = cvtpk(o21[2], o21[3]);
                    *(u32x4*)(rowp + ooff) = w1; *(u32x4*)(rowp + ooff + 64) = w2;
                }
                __builtin_amdgcn_sched_barrier(0); }
            return pre_finish(pre_load(un, wr, fr, fq));
        }
        int cbase = u.pn * BM; float sc = 1.0f;
        if (MODE == 2) { const int pn = u.pn; if (pn < 2) cbase = 256 * pn; else if (pn < 10) cbase = C_V + 256 * (pn - 6); else if (pn < 14) cbase = C_G + 256 * (pn - 10); else { cbase = C_XQ + 256 * (pn - 14); sc = XQ_SCALE; } }
        const unsigned loff = (unsigned)(fr * ldc + 8 * fq);
        const Raw raw = pre_load(un, wr, fr, fq);
        const bool inv = u.pn < 4;
        Pre pn;
#pragma unroll
        for (int ai = 0; ai < 2; ++ai) {
            u32x4 w[4][2];
#pragma unroll
            for (int m = 0; m < 4; ++m)
#pragma unroll
                for (int bj = 0; bj < 2; ++bj) { f32x4 v0 = acc[ai][bj][m][0], v1 = acc[ai][bj][m][1];
                    { const float f = (MODE == 3 ? -LOG2E : sc) * pr.rs[ai][m]; v0 = v0 * f; v1 = v1 * f; }
                    if (MODE == 3) {
#pragma unroll
                        for (int e = 0; e < 4; ++e) { v0[e] = 1.0f + __builtin_amdgcn_exp2f(fminf(fmaxf(v0[e], -80.f), 80.f)); v1[e] = 1.0f + __builtin_amdgcn_exp2f(fminf(fmaxf(v1[e], -80.f), 80.f)); }
                        if (inv) {
#pragma unroll
                            for (int e = 0; e < 4; ++e) { v0[e] = __builtin_amdgcn_rcpf(v0[e]); v1[e] = __builtin_amdgcn_rcpf(v1[e]); } } }
                    if (MODE == 1) { v0 = __builtin_elementwise_max(v0, (f32x4){0.f, 0.f, 0.f, 0.f}); v1 = __builtin_elementwise_max(v1, (f32x4){0.f, 0.f, 0.f, 0.f}); v0 = v0 * v0; v1 = v1 * v1; }
                    w[m][bj].x = cvtpk(v0[0], v0[1]); w[m][bj].y = cvtpk(v0[2], v0[3]); w[m][bj].z = cvtpk(v1[0], v1[1]); w[m][bj].w = cvtpk(v1[2], v1[3]); }
            if (ai == 0) pn = pre_finish(raw);
            __builtin_amdgcn_sched_barrier(0);
#pragma unroll
            for (int m = 0; m < 4; ++m) { bf16_t* rowu = O + (size_t)(u.pm * BM + wr * 64 + ai * HALF + m * 16) * ldc + cbase + wc * 32;
#pragma unroll
                for (int bj = 0; bj < 2; ++bj) *(u32x4*)(rowu + loff + bj * HALF) = w[m][bj]; }
            __builtin_amdgcn_sched_barrier(0); }
        return pn;
    }
};
struct EpiRes {
    static constexpr bool PERM = true, AFTER_DRAIN = false, HOOK = false, EARLY_PRE = false;
    struct Pre {}; struct Raw {};
    __device__ __forceinline__ Raw pre_load(const Unit&, int, int, int) const { return Raw{}; }
    __device__ __forceinline__ Pre pre_finish(const Raw&) const { return Pre{}; }
    bf16_t* X; float* ssp; bf16_t* dummy;
    __device__ __forceinline__ void hook(Acc&, const Unit&, int, int, int, int, int) const {}
    __device__ __forceinline__ Pre operator()(const Acc& acc, const Unit& u, const Unit&, int wr, int wc, int fr, int fq, const Pre&) const {
        const unsigned loff = (unsigned)((wr * 64 + fr) * 1024 + u.pn * BM + wc * 32 + 8 * fq);
        const bf16_t* Xu = X + (size_t)u.pm * BM * 1024; bf16_t* Yu = (dummy ? dummy : X) + (size_t)u.pm * BM * 1024;
        u32x4 xb[2][4][2];
#pragma unroll
        for (int ai = 0; ai < 2; ++ai)
#pragma unroll
            for (int m = 0; m < 4; ++m)
#pragma unroll
                for (int bj = 0; bj < 2; ++bj) xb[ai][m][bj] = *(const u32x4*)(Xu + (size_t)(ai * HALF + m * 16) * 1024 + loff + bj * HALF);
        __builtin_amdgcn_sched_barrier(0);
#pragma unroll
        for (int ai = 0; ai < 2; ++ai)
#pragma unroll
            for (int m = 0; m < 4; ++m) { float q = 0.f;
#pragma unroll
                for (int bj = 0; bj < 2; ++bj) { const u32x4 b = xb[ai][m][bj];
                    f32x4 x0 = acc[ai][bj][m][0], x1 = acc[ai][bj][m][1];
                    x0[0] += bflo(b[0]); x0[1] += bfhi(b[0]); x0[2] += bflo(b[1]); x0[3] += bfhi(b[1]); x1[0] += bflo(b[2]); x1[1] += bfhi(b[2]); x1[2] += bflo(b[3]); x1[3] += bfhi(b[3]);
                    q += ((x0[0] * x0[0] + x0[1] * x0[1]) + (x0[2] * x0[2] + x0[3] * x0[3])) + ((x1[0] * x1[0] + x1[1] * x1[1]) + (x1[2] * x1[2] + x1[3] * x1[3]));
                    u32x4 w; w.x = cvtpk(x0[0], x0[1]); w.y = cvtpk(x0[2], x0[3]); w.z = cvtpk(x1[0], x1[1]); w.w = cvtpk(x1[2], x1[3]);
                    *(u32x4*)(Yu + (size_t)(ai * HALF + m * 16) * 1024 + loff + bj * HALF) = w; }
                q = add_xor16(q); q = add_xor32(q);
                if (fq == 0 && !dummy) ssp[(size_t)(u.pm * BM + wr * 64 + fr + ai * HALF + m * 16) * 16 + 4 * u.pn + wc] = q; }
        return Pre{};
    }
};
struct EpiUp {
    static constexpr bool PERM = true, AFTER_DRAIN = false, HOOK = true, EARLY_PRE = false;
    struct Pre {}; struct Raw {};
    __device__ __forceinline__ Raw pre_load(const Unit&, int, int, int) const { return Raw{}; }
    __device__ __forceinline__ Pre pre_finish(const Raw&) const { return Pre{}; }
    bf16_t* O; const bf16_t* G;
    __device__ __forceinline__ void hook(Acc& acc, const Unit& u, int t, int wr, int wc, int fr, int fq) const {
        if (t != 8 && t != 24) return;
        const int gsel = (t == 8) ? 0 : 1024;
        int fr_ = fr, fq_ = fq; asm volatile("" : "+v"(fr_), "+v"(fq_));
        const int row0 = u.pm * BM + wr * 64 + fr_, col0 = u.pn * BM + wc * 32 + 8 * fq_;
        const bf16_t* gbase = G + (size_t)row0 * 3072 + gsel + col0;
        u32x4 ga[4][2], gb[4][2];
#pragma unroll
        for (int m = 0; m < 4; ++m)
#pragma unroll
            for (int bj = 0; bj < 2; ++bj) { const bf16_t* gp = gbase + (size_t)(m * 16) * 3072 + bj * HALF; ga[m][bj] = *(const u32x4*)gp; gb[m][bj] = *(const u32x4*)(gp + 1024); }
        __builtin_amdgcn_sched_barrier(0);
#pragma unroll
        for (int ai = 0; ai < 2; ++ai)
#pragma unroll
            for (int m = 0; m < 4; ++m)
#pragma unroll
                for (int bj = 0; bj < 2; ++bj) { float r[8];
#pragma unroll
                    for (int e = 0; e < 4; ++e) { const float a0 = bflo(ga[m][bj][e]), a1 = bfhi(ga[m][bj][e]), b0 = bflo(gb[m][bj][e]), b1 = bfhi(gb[m][bj][e]);
                        if (t == 8) { r[2 * e] = a0 * b0; r[2 * e + 1] = a1 * b1; }
                        else { r[2 * e] = b0 * __builtin_amdgcn_rcpf(a0); r[2 * e + 1] = b1 * __builtin_amdgcn_rcpf(a1); } }
                    if (ai == 0) { const bf16_t* gp = gbase + (size_t)(HALF + m * 16) * 3072 + bj * HALF; ga[m][bj] = *(const u32x4*)gp; gb[m][bj] = *(const u32x4*)(gp + 1024); }
                    f32x4 v0 = acc[ai][bj][m][0], v1 = acc[ai][bj][m][1];
                    v0[0] *= r[0]; v0[1] *= r[1]; v0[2] *= r[2]; v0[3] *= r[3]; v1[0] *= r[4]; v1[1] *= r[5]; v1[2] *= r[6]; v1[3] *= r[7];
                    acc[ai][bj][m][0] = v0; acc[ai][bj][m][1] = v1;
                    __builtin_amdgcn_sched_barrier(0); }
    }
    __device__ __forceinline__ Pre operator()(const Acc& acc, const Unit& u, const Unit&, int wr, int wc, int fr, int fq, const Pre&) const {
        const int row0 = u.pm * BM + wr * 64 + fr, col0 = u.pn * BM + wc * 32 + 8 * fq;
        u32x4 g3[2][4][2];
#pragma unroll
        for (int ai = 0; ai < 2; ++ai)
#pragma unroll
            for (int m = 0; m < 4; ++m)
#pragma unroll
                for (int bj = 0; bj < 2; ++bj) g3[ai][m][bj] = *(const u32x4*)(G + (size_t)(row0 + ai * HALF + m * 16) * 3072 + 2048 + col0 + bj * HALF);
        __builtin_amdgcn_sched_barrier(0);
#pragma unroll
        for (int ai = 0; ai < 2; ++ai)
#pragma unroll
            for (int m = 0; m < 4; ++m) { const int row = row0 + ai * HALF + m * 16; bf16_t* rowp = O + (size_t)row * 1024 + col0;
#pragma unroll
                for (int bj = 0; bj < 2; ++bj) { const u32x4 gc = g3[ai][m][bj];
                    const f32x4 v0 = acc[ai][bj][m][0], v1 = acc[ai][bj][m][1];
#define UP_S3(x) __builtin_amdgcn_rcpf(x)
                    u32x4 w; w.x = cvtpk(v0[0] * UP_S3(bflo(gc[0])), v0[1] * UP_S3(bfhi(gc[0]))); w.y = cvtpk(v0[2] * UP_S3(bflo(gc[1])), v0[3] * UP_S3(bfhi(gc[1])));
                    w.z = cvtpk(v1[0] * UP_S3(bflo(gc[2])), v1[1] * UP_S3(bfhi(gc[2]))); w.w = cvtpk(v1[2] * UP_S3(bflo(gc[3])), v1[3] * UP_S3(bfhi(gc[3])));
#undef UP_S3
                    *(u32x4*)(rowp + bj * HALF) = w; } }
        return Pre{};
    }
};

template <int K, int LDA, int LDB, class Epi, class Sched, bool ALIGN_EPI = true>
__device__ __forceinline__ void gemm_phase(PG8_LAS unsigned char* lds, const Gemm g, const Sched& S, const Epi& E) {
    int tid_ = threadIdx.x; asm volatile("" : "+v"(tid_));
    const int tid = tid_, wid = __builtin_amdgcn_readfirstlane(tid >> 6), lane = tid & 63, wr = wid >> 2, wc = wid & 3, fr = lane & 15, fq = lane >> 4;
    constexpr int nt = K / BK;
    unsigned voffA[2], voffB[2];
#pragma unroll
    for (int i = 0; i < 2; ++i) { int R, C; stage_rc(tid * 16 + i * 8192, R, C); const int Rb = Epi::PERM ? ((R & ~31) + perm32(R & 31)) : R;
        voffA[i] = (unsigned)(R * LDA + C) * 2u; voffB[i] = (unsigned)(Rb * LDB + C) * 2u; }
    constexpr size_t kstep = (size_t)(BK * 2);
    constexpr size_t hstepA = (size_t)HALF * LDA * 2, hstepB = (size_t)HALF * LDB * 2;
    constexpr size_t tstepA = 2 * hstepA, tstepB = 2 * hstepB;
    const unsigned ldsw = (unsigned)wid * 1024u;
    const int aoff = lds_byte(wr * 64 + fr, fq * 8), boff = lds_byte(wc * 32 + fr, fq * 8);
#define PG8_SA(b, h) (((b) * 2 + (h)) * HTB)
#define PG8_SB(b, h) ((4 + (b) * 2 + (h)) * HTB)
#define PG8_STAGE(bufoff, gbase, voff) do { _Pragma("unroll") for (int _i = 0; _i < 2; ++_i) \
        __builtin_amdgcn_global_load_lds((const unsigned*)((const char*)(gbase) + (voff)[_i]), (PG8_LAS unsigned*)(lds + (bufoff) + ldsw + _i * 8192), 16, 0, 0); } while (0)
#define PG8_LDA(dst, b, h) do { _Pragma("unroll") for (int m = 0; m < 4; ++m) _Pragma("unroll") for (int k = 0; k < 2; ++k) dst[m][k] = *(const PG8_LAS bf16x8*)(lds + PG8_SA(b, h) + aoff + m * 2048 + k * 1024); } while (0)
#define PG8_LDB(dst, b, h) do { _Pragma("unroll") for (int n = 0; n < 2; ++n) _Pragma("unroll") for (int k = 0; k < 2; ++k) dst[n][k] = *(const PG8_LAS bf16x8*)(lds + PG8_SB(b, h) + boff + n * 2048 + k * 1024); } while (0)
#define PG8_MMA(ai, bj, At, Bt) do { __builtin_amdgcn_s_setprio(1); _Pragma("unroll") for (int m = 0; m < 4; ++m) _Pragma("unroll") for (int n = 0; n < 2; ++n) _Pragma("unroll") for (int k = 0; k < 2; ++k) \
        acc[ai][bj][m][n] = __builtin_amdgcn_mfma_f32_16x16x32_bf16(Bt[n][k], At[m][k], acc[ai][bj][m][n], 0, 0, 0); __builtin_amdgcn_s_setprio(0); } while (0)
#define PG8_WAIT_V(n) asm volatile("s_waitcnt vmcnt(" #n ")" ::: "memory")
#define PG8_WAIT_L(n) asm volatile("s_waitcnt lgkmcnt(" #n ")" ::: "memory")
#define PG8_BAR __builtin_amdgcn_s_barrier()
#define PG8_SCHED __builtin_amdgcn_sched_barrier(0)
    Unit cur, nxt; int ui = 0;
    if (!S.next(0, cur)) return;
    Acc acc;
#pragma unroll
    for (int a = 0; a < 2; ++a)
#pragma unroll
        for (int b = 0; b < 2; ++b)
#pragma unroll
            for (int m = 0; m < 4; ++m)
#pragma unroll
                for (int n = 0; n < 2; ++n) acc[a][b][m][n] = (f32x4){0.f, 0.f, 0.f, 0.f};
    bf16x8 At[4][2], B0[2][2], B1[2][2];
    const char* cA = (const char*)g.A + (size_t)cur.pm * tstepA; const char* cB = (const char*)g.Bt + (size_t)cur.pn * tstepB;
    S.a_ready(cur);
    typename Epi::Pre pre = E.pre_finish(E.pre_load(cur, wr, fr, fq));
    PG8_STAGE(PG8_SB(0, 0), cB, voffB); PG8_STAGE(PG8_SB(0, 1), cB + hstepB, voffB); PG8_STAGE(PG8_SA(0, 0), cA, voffA); PG8_STAGE(PG8_SA(0, 1), cA + hstepA, voffA);
    if (wr == 1) PG8_BAR;
    PG8_WAIT_V(2); PG8_BAR;
    PG8_STAGE(PG8_SB(1, 0), cB + kstep, voffB); PG8_STAGE(PG8_SA(1, 0), cA + kstep, voffA); PG8_STAGE(PG8_SB(1, 1), cB + hstepB + kstep, voffB);
    PG8_WAIT_V(6); PG8_BAR;
    for (;;) {
        const bool has_next = S.next(ui + 1, nxt);
        const char* nA = has_next ? (const char*)g.A + (size_t)nxt.pm * tstepA : cA; const char* nB = has_next ? (const char*)g.Bt + (size_t)nxt.pn * tstepB : cB;
        for (int t = 0; t < nt; t += 2) {
            const bool last = (t == nt - 2);
            const char* a1 = cA + (size_t)(t + 1) * kstep;
            const char* a2 = last ? nA : cA + (size_t)(t + 2) * kstep; const char* b2 = last ? nB : cB + (size_t)(t + 2) * kstep;
            const char* a3 = a2 + kstep; const char* b3 = b2 + kstep;
            if (last && has_next) S.a_ready(nxt);
            if constexpr (Epi::HOOK) { E.hook(acc, cur, t, wr, wc, fr, fq); PG8_SCHED; }
            PG8_LDB(B0, 0, 0); PG8_LDB(B1, 0, 1); PG8_SCHED; PG8_LDA(At, 0, 0); PG8_STAGE(PG8_SA(1, 1), a1 + hstepA, voffA);
            PG8_WAIT_V(8); PG8_WAIT_L(0); PG8_BAR; PG8_MMA(0, 0, At, B0); PG8_MMA(0, 1, At, B1); PG8_BAR; PG8_SCHED;
            PG8_LDA(At, 0, 1); PG8_STAGE(PG8_SB(0, 0), b2, voffB); PG8_STAGE(PG8_SB(0, 1), b2 + hstepB, voffB); PG8_STAGE(PG8_SA(0, 0), a2, voffA);
            PG8_WAIT_V(8); PG8_WAIT_L(0); PG8_BAR; PG8_MMA(1, 0, At, B0); PG8_MMA(1, 1, At, B1); PG8_BAR; PG8_SCHED;
            PG8_LDB(B0, 1, 0); PG8_LDB(B1, 1, 1); PG8_SCHED; PG8_LDA(At, 1, 0); PG8_STAGE(PG8_SA(0, 1), a2 + hstepA, voffA);
            PG8_WAIT_V(8); PG8_WAIT_L(0); PG8_BAR; PG8_MMA(0, 0, At, B0); PG8_MMA(0, 1, At, B1); PG8_BAR; PG8_SCHED;
            PG8_LDA(At, 1, 1); PG8_STAGE(PG8_SB(1, 0), b3, voffB); PG8_STAGE(PG8_SB(1, 1), b3 + hstepB, voffB); PG8_STAGE(PG8_SA(1, 0), a3, voffA);
            PG8_WAIT_V(8); PG8_WAIT_L(0); PG8_BAR; PG8_MMA(1, 0, At, B0); PG8_MMA(1, 1, At, B1); PG8_BAR; PG8_SCHED;
        }
        if constexpr (ALIGN_EPI) { if (wr == 0) PG8_BAR; }
        pre = E(acc, cur, has_next ? nxt : cur, wr, wc, fr, fq, pre); S.done(cur); PG8_SCHED;
        if (!has_next) break;
#pragma unroll
        for (int a = 0; a < 2; ++a)
#pragma unroll
            for (int b = 0; b < 2; ++b)
#pragma unroll
                for (int m = 0; m < 4; ++m)
#pragma unroll
                    for (int n = 0; n < 2; ++n) acc[a][b][m][n] = (f32x4){0.f, 0.f, 0.f, 0.f};
        cur = nxt; cA = nA; cB = nB; ++ui;
        if constexpr (ALIGN_EPI) { if (wr == 1) PG8_BAR; }
    }
    PG8_WAIT_V(0);
    if constexpr (!ALIGN_EPI) { if (wr == 0) PG8_BAR; }
    PG8_BAR;
#undef PG8_SA
#undef PG8_SB
#undef PG8_STAGE
#undef PG8_LDA
#undef PG8_LDB
#undef PG8_MMA
#undef PG8_WAIT_V
#undef PG8_WAIT_L
#undef PG8_BAR
#undef PG8_SCHED
}
}

#define XB_TMO      128
#define XB_XCNT(j)  (256  + 64 * (j))
#define XB_XSUB(j)  (1280 + 64 * (j))
#define XB_XGEN(j)  (2304 + 64 * (j))
#define XB_TOP      3328
#define XB_TOPGEN   3392
#define XCD_BAR_WORDS 3456
#define XB_SPIN_CAP (1u << 18)
__device__ __forceinline__ unsigned xb_ld(unsigned* p)              { return __hip_atomic_load(p, __ATOMIC_RELAXED, __HIP_MEMORY_SCOPE_AGENT); }
__device__ __forceinline__ unsigned xb_add(unsigned* p, unsigned v) { return __hip_atomic_fetch_add(p, v, __ATOMIC_RELAXED, __HIP_MEMORY_SCOPE_AGENT); }
__device__ __forceinline__ unsigned xb_xcc_id() { return (unsigned)__builtin_amdgcn_s_getreg((3 << 11) | 20) & 0xFu; }
#define XB_SPIN(cond, bar) do { unsigned _sp = 0; while (cond) { __builtin_amdgcn_s_sleep(1); \
    if ((++_sp & 255u) == 0u) { if (xb_ld(&(bar)[XB_TMO])) break; if (_sp > XB_SPIN_CAP) { atomicAdd(&(bar)[XB_TMO], 1u); break; } } } } while (0)
struct XcdBarrier { unsigned* bar; unsigned x; volatile LAS unsigned* st; };
__device__ __forceinline__ XcdBarrier xcd_barrier_post(unsigned* bar, volatile LAS unsigned* st) {
    XcdBarrier b; b.bar = bar; b.x = xb_xcc_id(); b.st = st;
    if (threadIdx.x == 0) (void)xb_add(&bar[XB_XCNT(b.x)], 1u);
    return b;
}
__device__ __forceinline__ void xcd_barrier_complete(unsigned* bar, unsigned x, unsigned& nloc, unsigned& nx) {
    const unsigned G = gridDim.x * gridDim.y * gridDim.z;
    unsigned sum, cnt, mine, sp = 0u;
    for (;;) {
        sum = 0u; cnt = 0u; mine = 0u;
#pragma unroll
        for (unsigned j = 0; j < 16; ++j) { const unsigned c = xb_ld(&bar[XB_XCNT(j)]); sum += c; cnt += (c > 0u) ? 1u : 0u; mine = (j == x) ? c : mine; }
        if (sum == G) break;
        __builtin_amdgcn_s_sleep(1);
        if ((++sp & 255u) == 0u) { if (xb_ld(&bar[XB_TMO])) break; if (sp > XB_SPIN_CAP) { atomicAdd(&bar[XB_TMO], 1u); break; } }
    }
    nloc = mine > 0u ? mine : 1u; nx = cnt > 0u ? cnt : 1u;
}
__device__ __forceinline__ void xcd_barrier(const XcdBarrier& b) {
    asm volatile("s_waitcnt vmcnt(0)" ::: "memory");
    __syncthreads();
    if (threadIdx.x == 0) {
        unsigned* bar = b.bar;
        __builtin_amdgcn_s_waitcnt(0);
        unsigned nloc = b.st[0], nx = b.st[1];
        if (nloc == 0u) { xcd_barrier_complete(bar, b.x, nloc, nx); b.st[0] = nloc; b.st[1] = nx; }
        const unsigned old = xb_add(&bar[XB_XSUB(b.x)], 1u);
        const unsigned gen = old / nloc;
        if (old + 1u == (gen + 1u) * nloc) {
            __builtin_amdgcn_fence(__ATOMIC_RELEASE, "agent");
            asm volatile("s_waitcnt vmcnt(0)" ::: "memory");
            const unsigned og = xb_add(&bar[XB_TOP], 1u);
            const unsigned tg = og / nx;
            if (og + 1u == (tg + 1u) * nx) xb_add(&bar[XB_TOPGEN], 1u);
            else XB_SPIN(xb_ld(&bar[XB_TOPGEN]) == tg, bar);
            __builtin_amdgcn_fence(__ATOMIC_ACQUIRE, "agent");
            xb_add(&bar[XB_XGEN(b.x)], 1u);
            asm volatile("s_waitcnt vmcnt(0)" ::: "memory");
        } else {
            XB_SPIN(xb_ld(&bar[XB_XGEN(b.x)]) == gen, bar);
            __builtin_amdgcn_fence(__ATOMIC_ACQUIRE, "agent");
            asm volatile("s_waitcnt vmcnt(0)" ::: "memory");
        }
    }
    __syncthreads();
}

struct Args { const float* in[18]; float* out; unsigned char* ws; int ph_lo, ph_hi; };
struct Frame {
    LAS unsigned char* lds;
    int vcu, G;
    unsigned char* ws;
};
__device__ __forceinline__ int opaque_tid() { int t = threadIdx.x; asm volatile("" : "+v"(t)); return t; }
#define TID ((int)threadIdx.x)
#define WSP(T_, off) ((T_*)(F.ws + (off)))
#define LDS_WAIT() asm volatile("s_waitcnt lgkmcnt(0)" ::: "memory")

struct TrDesc { const float* W; const float* gain; bf16* dst; int Nsrc, srccol0, k0, Kdst; };
__device__ __forceinline__ void tr_load(const TrDesc& d, f32x4 (&v)[16], int lane) {
#pragma unroll
    for (int i = 0; i < 16; ++i) v[i] = *(const f32x4*)(d.W + (size_t)(d.k0 + 4 * i + (lane >> 4)) * d.Nsrc + d.srccol0 + 4 * (lane & 15));
}
__device__ __forceinline__ void tr_finish(const TrDesc& d, const f32x4 (&v)[16], LAS float* scr, int lane) {
#pragma unroll
    for (int i = 0; i < 16; ++i) { const int kk = 4 * i + (lane >> 4); f32x4 x = v[i]; if (d.gain) x = x * d.gain[d.k0 + kk]; *(LAS f32x4*)(scr + kk * 68 + 4 * (lane & 15)) = x; }
    LDS_WAIT(); asm volatile("" ::: "memory");
    const int c = lane & 7;
#pragma unroll
    for (int j = 0; j < 8; ++j) { const int n = (lane >> 3) + 8 * j; const LAS float* sp = scr + (8 * c) * 68 + n;
        u32x4 o; o.x = cvtpk(sp[0 * 68], sp[1 * 68]); o.y = cvtpk(sp[2 * 68], sp[3 * 68]); o.z = cvtpk(sp[4 * 68], sp[5 * 68]); o.w = cvtpk(sp[6 * 68], sp[7 * 68]);
        *(u32x4*)(d.dst + (size_t)n * d.Kdst + d.k0 + 8 * c) = o; }
    LDS_WAIT(); asm volatile("" ::: "memory");
}
__device__ __forceinline__ int in_srccol(int n0) {
    if (n0 < C_Q || n0 >= C_V) return n0;
    const int tile = n0 >> 8, within = n0 & 255, bj = within >> 7, w = within & 127, sec = (tile < 4) ? C_Q : C_K;
    return sec + (2 * (tile & 1) + (w >> 6)) * 128 + (w & 63) + 64 * bj;
}
__device__ __forceinline__ void rms_row_bf16(const float* xrow, bf16* orow, int lane) {
    const f32x4* xr = (const f32x4*)xrow + lane; f32x4 v[4]; float s = 0.f;
#pragma unroll
    for (int j = 0; j < 4; ++j) { v[j] = xr[64 * j]; s += (v[j].x * v[j].x + v[j].y * v[j].y) + (v[j].z * v[j].z + v[j].w * v[j].w); }
    const float r = rsqrtf(wave_sum(s) * (1.0f / DM) + EPS);
    u32x2* o = (u32x2*)orow + lane;
#pragma unroll
    for (int j = 0; j < 4; ++j) { u32x2 w; w.x = cvtpk(v[j].x * r, v[j].y * r); w.y = cvtpk(v[j].z * r, v[j].w * r); o[64 * j] = w; }
}
__device__ __forceinline__ void norm_rows(Frame& F, const float* X, bf16* XB, int nrows) {
    const int tid = opaque_tid(), lane = tid & 63, wave = __builtin_amdgcn_readfirstlane(tid >> 6), fr = lane & 15, fq = lane >> 4; (void)tid; (void)lane; (void)wave; (void)fr; (void)fq;
    const int gw = F.vcu * 8 + wave, NGW = F.G * 8;
    for (int m = gw; m < nrows; m += NGW) rms_row_bf16(X + (size_t)m * DM, XB + (size_t)m * DM, lane);
}
__device__ __forceinline__ void final_norm(Frame& F, float* out, const float* g) {
    const int tid = opaque_tid(), lane = tid & 63, wave = __builtin_amdgcn_readfirstlane(tid >> 6);
    const int gw = F.vcu * 8 + wave, NGW = F.G * 8;
    f32x4 gg[4];
#pragma unroll
    for (int j = 0; j < 4; ++j) gg[j] = *((const f32x4*)g + lane + 64 * j);
    for (int m = gw * 4; m < T; m += NGW * 4) {
        float p = WSP(float, WS_SSP)[(size_t)m * 16 + lane];
        u32x2 v[4][4];
#pragma unroll
        for (int r = 0; r < 4; ++r)
#pragma unroll
            for (int j = 0; j < 4; ++j) v[r][j] = ((const u32x2*)(WSP(bf16, WS_XB) + (size_t)(m + r) * DM) + lane)[64 * j];
        __builtin_amdgcn_sched_barrier(0);
        p += __int_as_float(__builtin_amdgcn_ds_swizzle(__float_as_int(p), SWZ_XOR(1)));
        p += __int_as_float(__builtin_amdgcn_ds_swizzle(__float_as_int(p), SWZ_XOR(2)));
        p += __int_as_float(__builtin_amdgcn_ds_swizzle(__float_as_int(p), SWZ_XOR(4)));
        p += __int_as_float(__builtin_amdgcn_ds_swizzle(__float_as_int(p), SWZ_XOR(8)));
        const float rinv = rsqrtf(p * (1.0f / DM) + EPS);
#pragma unroll
        for (int r = 0; r < 4; ++r) { const float rr = __int_as_float(__builtin_amdgcn_readlane(__float_as_int(rinv), 16 * r)); f32x4* o = (f32x4*)(out + (size_t)(m + r) * DM) + lane;
#pragma unroll
            for (int j = 0; j < 4; ++j) { const u32x2 x = v[r][j]; o[64 * j] = (f32x4){bflo(x.x) * rr * gg[j].x, bfhi(x.x) * rr * gg[j].y, bflo(x.y) * rr * gg[j].z, bfhi(x.y) * rr * gg[j].w}; } }
    }
}

__device__ __forceinline__ void p0_prologue(Frame& F, const Args& A) {
    const int tid = opaque_tid(), lane = tid & 63, wave = __builtin_amdgcn_readfirstlane(tid >> 6);
    LAS float* scr = (LAS float*)(F.lds + wave * 17408);
    const int gw = F.vcu * 8 + wave, NGW = F.G * 8;
    constexpr int I_IN = 16 * 112, I_MKV = 16 * 16, I_UR = 16 * 16, I_UM = 8 * 16, I_OUT = 16 * 16, I_1 = 16 * 64, I_2 = 64 * 16;
    constexpr int PER_L = I_IN + I_MKV + I_UR + I_UM + I_OUT + I_1 + I_2;
#define TR_DESC(d, it_) do { const int l_ = (it_) / PER_L; int r_ = (it_) % PER_L; unsigned char* wl_ = F.ws + WS_W + (size_t)l_ * W_LAYER; \
        if (r_ < I_IN) { const int kb = r_ / 112, nb = r_ % 112; d = TrDesc{A.in[4] + (size_t)l_ * DM * INC, A.in[3] + l_ * DM, (bf16*)(wl_ + WO_IN) + (size_t)(64 * nb) * DM, INC, in_srccol(64 * nb), 64 * kb, DM}; } \
        else if ((r_ -= I_IN) < I_MKV) { const int kb = r_ / 16, nb = r_ % 16; d = TrDesc{A.in[9] + (size_t)l_ * DM * 1024, A.in[8] + l_ * DM, (bf16*)(wl_ + WO_MKV) + (size_t)(64 * nb) * DM, 1024, 64 * nb, 64 * kb, DM}; } \
        else if ((r_ -= I_MKV) < I_UR) { const int kb = r_ / 16, nb = r_ % 16; d = TrDesc{A.in[11] + (size_t)l_ * 1024 * DM, A.in[7] + l_ * 1024, (bf16*)(wl_ + WO_UP) + (size_t)(64 * nb) * 2048 + 512, DM, 64 * nb, 64 * kb, 2048}; } \
        else if ((r_ -= I_UR) < I_UM) { const int kb = r_ / 16, nb = r_ % 16; d = TrDesc{A.in[12] + (size_t)l_ * 512 * DM, nullptr, (bf16*)(wl_ + WO_UP) + (size_t)(64 * nb) * 2048 + 1536, DM, 64 * nb, 64 * kb, 2048}; } \
        else if ((r_ -= I_UM) < I_OUT) { const int kb = r_ / 16, nb = r_ % 16; d = TrDesc{A.in[13] + (size_t)l_ * DM * DM, nullptr, (bf16*)(wl_ + WO_OUT) + (size_t)(64 * nb) * DM, DM, 64 * nb, 64 * kb, DM}; } \
        else if ((r_ -= I_OUT) < I_1) { const int kb = r_ / 64, nb = r_ % 64; d = TrDesc{A.in[15] + (size_t)l_ * DM * DFF, A.in[14] + l_ * DM, (bf16*)(wl_ + WO_1) + (size_t)(64 * nb) * DM, DFF, 64 * nb, 64 * kb, DM}; } \
        else { r_ -= I_1; const int kb = r_ / 16, nb = r_ % 16; d = TrDesc{A.in[16] + (size_t)l_ * DFF * DM, nullptr, (bf16*)(wl_ + WO_2) + (size_t)(64 * nb) * DFF, DM, 64 * nb, 64 * kb, DFF}; } } while (0)
    {
        TrDesc dA, dB; f32x4 vA[16], vB[16];
        int it = gw;
        if (it < 2 * PER_L) { TR_DESC(dA, it); tr_load(dA, vA, lane); }
        while (it < 2 * PER_L) {
            const int itB = it + NGW;
            if (itB < 2 * PER_L) { TR_DESC(dB, itB); tr_load(dB, vB, lane); }
            tr_finish(dA, vA, scr, lane);
            if (itB >= 2 * PER_L) break;
            const int itA = itB + NGW;
            if (itA < 2 * PER_L) { TR_DESC(dA, itA); tr_load(dA, vA, lane); }
            tr_finish(dB, vB, scr, lane);
            it = itA;
        }
    }
#undef TR_DESC
    const int gt = F.vcu * 512 + tid, NT = F.G * 512;
    {
        const float inv = (float)exp2(-(double)(gt & 63) * (13.287712379549449 / 64.0));
        const int* pos = (const int*)A.in[2];
        for (int i = gt; i < T * 64; i += NT) {
            const float a = (float)pos[i >> 6] * inv;
            const double ad = (double)a, k = rint(ad * 0.15915494309189535), rr = ad - k * 6.283185307179586;
            const float rf = (float)rr;
            WSP(float, WS_COS)[i] = cosf(rf); WSP(float, WS_SIN)[i] = sinf(rf);
        }
    }
    for (int m = gw * 4; m < T; m += NGW * 4) {
        f32x4 v[4][4];
#pragma unroll
        for (int r = 0; r < 4; ++r) { const f32x4* xr = (const f32x4*)(A.in[0] + (size_t)(m + r) * DM) + 2 * lane;
#pragma unroll
            for (int j = 0; j < 2; ++j) { v[r][2 * j] = xr[128 * j]; v[r][2 * j + 1] = xr[128 * j + 1]; } }
        __builtin_amdgcn_sched_barrier(0);
#pragma unroll
        for (int r = 0; r < 4; ++r) { float q = 0.f; u32x4* o = (u32x4*)(WSP(bf16, WS_XB) + (size_t)(m + r) * DM) + lane;
#pragma unroll
            for (int j = 0; j < 2; ++j) { const f32x4 a = v[r][2 * j], b2 = v[r][2 * j + 1]; q += ((a.x * a.x + a.y * a.y) + (a.z * a.z + a.w * a.w)) + ((b2.x * b2.x + b2.y * b2.y) + (b2.z * b2.z + b2.w * b2.w));
                u32x4 w; w.x = cvtpk(a.x, a.y); w.y = cvtpk(a.z, a.w); w.z = cvtpk(b2.x, b2.y); w.w = cvtpk(b2.z, b2.w); o[64 * j] = w; }
            q = wave_sum(q);
            if (lane < 16) WSP(float, WS_SSP)[(size_t)(m + r) * 16 + lane] = (lane == 0) ? q : 0.f; }
    }
    norm_rows(F, A.in[1], WSP(bf16, WS_MEMN), NB * NMEM);
    __syncthreads();
    LAS float* PW = (LAS float*)F.lds;
    LAS float* WU = (LAS float*)(F.lds + 128 * 129 * 4);
    for (int it = F.vcu; it < 2 * 4 * 32; it += F.G) {
        const int l = it >> 7, g = (it >> 5) & 3, n0 = (it & 31) * 32;
        const float* pw = A.in[5] + ((size_t)l * 512 + g * 128) * 128; const float* ps = A.in[6] + l * 512 + g * 128; const float* wu = A.in[10] + ((size_t)l * 512 + g * 128) * DM + n0;
        for (int i = tid; i < 128 * 128; i += 512) { const int c = i >> 7, cp = i & 127; PW[c * 129 + cp] = pw[i] * ps[cp]; }
        for (int i = tid; i < 128 * 8; i += 512) { const int cp = i >> 3, q = i & 7; *(LAS f32x4*)(WU + cp * 32 + 4 * q) = *(const f32x4*)(wu + (size_t)cp * DM + 4 * q); }
        __syncthreads();
        const int c = tid & 127, nq = tid >> 7;
        f32x4 s0 = {0.f, 0.f, 0.f, 0.f}, s1 = {0.f, 0.f, 0.f, 0.f};
#pragma unroll 8
        for (int cp = 0; cp < 128; ++cp) { const float p = PW[c * 129 + cp]; s0 += p * *(LAS f32x4*)(WU + cp * 32 + 8 * nq); s1 += p * *(LAS f32x4*)(WU + cp * 32 + 8 * nq + 4); }
        bf16* dst = (bf16*)(F.ws + WS_W + (size_t)l * W_LAYER + WO_UP) + (size_t)(n0 + 8 * nq) * 2048 + g * 128 + c;
#pragma unroll
        for (int j = 0; j < 4; ++j) { dst[(size_t)j * 2048] = (bf16)(cvtpk(s0[j], 0.f) & 0xffffu); dst[(size_t)(4 + j) * 2048] = (bf16)(cvtpk(s1[j], 0.f) & 0xffffu); }
        __syncthreads();
    }
}

__device__ __forceinline__ bf16x8 frag_tr(LAS unsigned char* Tt, int ldb, int rowA, int rowB, int col0, int fr) {
#if USE_TR
    const int q = fr >> 2, p = fr & 3;
    const s16x4 lo = __builtin_bit_cast(s16x4, __builtin_amdgcn_ds_read_tr16_b64_v4i16((LAS v4i16_t*)(Tt + (rowA + q) * ldb + (col0 + 4 * p) * 2)));
    const s16x4 hi = __builtin_bit_cast(s16x4, __builtin_amdgcn_ds_read_tr16_b64_v4i16((LAS v4i16_t*)(Tt + (rowB + q) * ldb + (col0 + 4 * p) * 2)));
    return __builtin_shufflevector(lo, hi, 0, 1, 2, 3, 4, 5, 6, 7);
#else
    bf16x8 f;
#pragma unroll
    for (int e = 0; e < 4; ++e) { f[e] = *(LAS short*)(Tt + (rowA + e) * ldb + (col0 + fr) * 2); f[4 + e] = *(LAS short*)(Tt + (rowB + e) * ldb + (col0 + fr) * 2); }
    return f;
#endif
}
__device__ __forceinline__ bf16x8 pack8(const f32x4& a, const f32x4& b) { u32x4 w; w.x = cvtpk(a[0], a[1]); w.y = cvtpk(a[2], a[3]); w.z = cvtpk(b[0], b[1]); w.w = cvtpk(b[2], b[3]); return __builtin_bit_cast(bf16x8, w); }
__device__ __forceinline__ float log2gamma(int h) { return log2f(1.0f - exp2f(-5.0f - (float)h)); }

__device__ __forceinline__ void mem_kv_proj(Frame& F) {
    const int tid = opaque_tid(), lane = tid & 63, wave = __builtin_amdgcn_readfirstlane(tid >> 6), fr = lane & 15, fq = lane >> 4;
    LAS unsigned char* As = F.lds; LAS unsigned char* Bs = F.lds + 33792;
    const int wm = wave & 3, wn = wave >> 2;
    for (int it = F.vcu; it < 512; it += F.G) {
        const int l = it >> 8, tm = (it >> 4) & 15, tn = it & 15;
        const bf16* Ag = WSP(bf16, WS_MEMN) + (size_t)(tm * 64) * DM; const bf16* Bg = WSP(bf16, WS_W + (size_t)l * W_LAYER + WO_MKV) + (size_t)(tn * 64) * DM;
        f32x4 acc[2]; acc[0] = (f32x4){0.f, 0.f, 0.f, 0.f}; acc[1] = (f32x4){0.f, 0.f, 0.f, 0.f};
        for (int kc = 0; kc < 4; ++kc) {
            __syncthreads();
#pragma unroll
            for (int k = 0; k < 4; ++k) { const int c = tid + 512 * k, r = c >> 5, ch = c & 31;
                *(LAS u32x4*)(As + r * 528 + ch * 16) = *(const u32x4*)(Ag + (size_t)r * DM + kc * 256 + ch * 8);
                *(LAS u32x4*)(Bs + r * 528 + ch * 16) = *(const u32x4*)(Bg + (size_t)r * DM + kc * 256 + ch * 8); }
            __syncthreads();
#pragma unroll
            for (int ks = 0; ks < 8; ++ks) { const bf16x8 af = *(LAS bf16x8*)(As + (16 * wm + fr) * 528 + (32 * ks + 8 * fq) * 2);
#pragma unroll
                for (int c = 0; c < 2; ++c) acc[c] = mfma16(*(LAS bf16x8*)(Bs + (32 * wn + 16 * c + fr) * 528 + (32 * ks + 8 * fq) * 2), af, acc[c]); }
        }
        bf16* dst = WSP(bf16, WS_KVMEM) + (size_t)l * 1024 * 1024 + (size_t)(tm * 64 + 16 * wm + fr) * 1024 + tn * 64 + 32 * wn + 4 * fq;
#pragma unroll
        for (int c = 0; c < 2; ++c) { u32x2 w; w.x = cvtpk(acc[c][0], acc[c][1]); w.y = cvtpk(acc[c][2], acc[c][3]); *(u32x2*)(dst + 16 * c) = w; }
    }
    __syncthreads();
}

template <int W> __device__ __forceinline__ void pool_item(bf16* P, int tl0, int c0) {
    const int pos0 = tl0 & (SEQ - 1);
    u32x4 r[W + 7];
#pragma unroll
    for (int i = 0; i < W + 7; ++i) { r[i] = (u32x4){0u, 0u, 0u, 0u}; if (pos0 - (W - 1) + i >= 0) r[i] = *(const u32x4*)(P + (size_t)(tl0 - (W - 1) + i) * PLD + c0); }
    float s[8];
#pragma unroll
    for (int e = 0; e < 8; ++e) s[e] = 0.f;
#pragma unroll
    for (int i = 0; i < W - 1; ++i)
#pragma unroll
        for (int e = 0; e < 4; ++e) { s[2 * e] += bflo(r[i][e]); s[2 * e + 1] += bfhi(r[i][e]); }
#pragma unroll
    for (int tt = 0; tt < 8; ++tt) {
        const int pos = pos0 + tt; const float rc = 1.0f / (float)((pos + 1 < W) ? pos + 1 : W);
        float d[8];
#pragma unroll
        for (int e = 0; e < 4; ++e) { const float u0 = bflo(r[W - 1 + tt][e]), u1 = bfhi(r[W - 1 + tt][e]); s[2 * e] += u0; s[2 * e + 1] += u1; d[2 * e] = s[2 * e] * rc - u0; d[2 * e + 1] = s[2 * e + 1] * rc - u1; }
        u32x4 o; o.x = cvtpk(d[0], d[1]); o.y = cvtpk(d[2], d[3]); o.z = cvtpk(d[4], d[5]); o.w = cvtpk(d[6], d[7]);
        *(u32x4*)(P + (size_t)(tl0 + tt) * PLD + C_DP + c0) = o;
#pragma unroll
        for (int e = 0; e < 4; ++e) { s[2 * e] -= bflo(r[tt][e]); s[2 * e + 1] -= bfhi(r[tt][e]); }
    }
}
__device__ __forceinline__ void mix_pool(Frame& F) {
    const int tid = opaque_tid(), lane = tid & 63, wave = __builtin_amdgcn_readfirstlane(tid >> 6);
    bf16* P = WSP(bf16, WS_PROJ);
    const int gw = F.vcu * 8 + wave, NGW = F.G * 8;
    for (int it = gw; it < 4 * (TH / 32); it += NGW) {
        const int g = it & 3, tl0 = (it >> 2) * 32 + (lane >> 4) * 8, c0 = g * 128 + (lane & 15) * 8;
        if (g == 0) pool_item<2>(P, tl0, c0); else if (g == 1) pool_item<4>(P, tl0, c0); else if (g == 2) pool_item<8>(P, tl0, c0); else pool_item<16>(P, tl0, c0);
    }
}

__device__ __forceinline__ void mix_mem(Frame& F, int l, int hf, bool dummy) {
    const int tid = opaque_tid(), lane = tid & 63, wave = __builtin_amdgcn_readfirstlane(tid >> 6), fr = lane & 15, fq = lane >> 4; (void)tid; (void)lane; (void)wave; (void)fr; (void)fq;
    bf16* P = WSP(bf16, WS_PROJ);
    LAS unsigned char* Kt = F.lds; LAS unsigned char* Vt = F.lds + 69632;
    const int items = 8 * 64, ipw = (items + F.G - 1) / F.G;
    const int it_lo = F.vcu * ipw, it_hi = (it_lo + ipw < items) ? it_lo + ipw : items;
    int loaded = -1;
    for (int it = it_lo; it < it_hi; ++it) {
        const int combo = it >> 6, qt = it & 63, bl = combo >> 2, h = combo & 3;
        if (combo != loaded) {
            __syncthreads();
            const bf16* src = WSP(bf16, WS_KVMEM) + (size_t)l * 1024 * 1024 + (size_t)((2 * hf + bl) * NMEM) * 1024 + h * 128;
            for (int c = tid; c < 4096; c += 512) { const int key = c >> 4, ch = c & 15;
                *(LAS u32x4*)(Kt + key * 272 + ch * 16) = *(const u32x4*)(src + (size_t)key * 1024 + ch * 8);
                *(LAS u32x4*)(Vt + key * 272 + ch * 16) = *(const u32x4*)(src + (size_t)key * 1024 + 512 + ch * 8); }
            __syncthreads(); loaded = combo;
        }
        bf16* qp = P + (size_t)(bl * SEQ + qt * 128 + wave * 16 + fr) * PLD + C_XQ + h * 128;
        bf16x8 bq[4];
#pragma unroll
        for (int ks = 0; ks < 4; ++ks) bq[ks] = *(const bf16x8*)(qp + ks * 32 + fq * 8);
        f32x4 s[16];
#pragma unroll
        for (int kt = 0; kt < 16; ++kt) { s[kt] = (f32x4){0.f, 0.f, 0.f, 0.f};
#pragma unroll
            for (int ks = 0; ks < 4; ++ks) s[kt] = mfma16(*(LAS bf16x8*)(Kt + (16 * kt + fr) * 272 + (32 * ks + 8 * fq) * 2), bq[ks], s[kt]); }
        float mx = -3.0e38f;
#pragma unroll
        for (int kt = 0; kt < 16; ++kt) mx = fmaxf(fmaxf(fmaxf(s[kt][0], s[kt][1]), fmaxf(s[kt][2], s[kt][3])), mx);
        mx = max_xor16(mx); mx = max_xor32(mx);
        float lsum = 0.f;
#pragma unroll
        for (int kt = 0; kt < 16; ++kt)
#pragma unroll
            for (int r = 0; r < 4; ++r) { const float p = exp2f(s[kt][r] - mx); s[kt][r] = p; lsum += p; }
        lsum = add_xor16(lsum); lsum = add_xor32(lsum);
        const float rl = 1.0f / lsum;
        f32x4 o[8];
#pragma unroll
        for (int dt = 0; dt < 8; ++dt) o[dt] = (f32x4){0.f, 0.f, 0.f, 0.f};
#pragma unroll
        for (int kp = 0; kp < 8; ++kp) { const bf16x8 pf = pack8(s[2 * kp], s[2 * kp + 1]);
#pragma unroll
            for (int dt = 0; dt < 8; ++dt) o[dt] = mfma16(frag_tr(Vt, 272, 32 * kp + 4 * fq, 32 * kp + 16 + 4 * fq, 16 * dt, fr), pf, o[dt]); }
        bf16* op = (dummy ? WSP(bf16, WS_MERGED) + (size_t)(bl * SEQ + qt * 128 + wave * 16 + fr) * 512 + h * 128 : qp) + 16 * (fq & 1) + 4 * (fq & 2);
#pragma unroll
        for (int p = 0; p < 4; ++p) { const unsigned ax = cvtpk(o[2 * p][0] * rl, o[2 * p][1] * rl), ay = cvtpk(o[2 * p][2] * rl, o[2 * p][3] * rl), bx_ = cvtpk(o[2 * p + 1][0] * rl, o[2 * p + 1][1] * rl), by = cvtpk(o[2 * p + 1][2] * rl, o[2 * p + 1][3] * rl);
            auto rx = __builtin_amdgcn_permlane16_swap(ax, bx_, false, false); auto ry = __builtin_amdgcn_permlane16_swap(ay, by, false, false);
            u32x4 w; w.x = rx[0]; w.y = ry[0]; w.z = rx[1]; w.w = ry[1]; *(u32x4*)(op + 32 * p) = w; }
    }
    __syncthreads();
}

__device__ __forceinline__ void mix_kv(Frame& F) {
    const int tid = opaque_tid(), lane = tid & 63, wave = __builtin_amdgcn_readfirstlane(tid >> 6), fr = lane & 15, fq = lane >> 4; (void)tid; (void)lane; (void)wave; (void)fr; (void)fq;
    bf16* P = WSP(bf16, WS_PROJ);
    LAS unsigned char* Kd = F.lds; LAS unsigned char* Vt = F.lds + 34816;
    for (int un = F.vcu; un < 512; un += F.G) {
        const int h = un & 3, n = (un >> 2) & 63, bl = un >> 8; const size_t row0 = (size_t)bl * SEQ + n * 128; const float lg = log2gamma(h);
        __syncthreads();
        for (int c = tid; c < 2048; c += 512) { const int j = c >> 4, ch = c & 15; const u32x4 v = *(const u32x4*)(P + (row0 + j) * PLD + C_K + h * 128 + ch * 8); const float f = exp2f((float)(127 - j) * lg);
            u32x4 o; o.x = cvtpk(bflo(v.x) * f, bfhi(v.x) * f); o.y = cvtpk(bflo(v.y) * f, bfhi(v.y) * f); o.z = cvtpk(bflo(v.z) * f, bfhi(v.z) * f); o.w = cvtpk(bflo(v.w) * f, bfhi(v.w) * f);
            *(LAS u32x4*)(Kd + j * 272 + ch * 16) = o; }
        for (int c = tid; c < 4096; c += 512) { const int j = c >> 5, ch = c & 31; *(LAS u32x4*)(Vt + j * 528 + ch * 16) = *(const u32x4*)(P + (row0 + j) * PLD + C_V + h * 256 + ch * 8); }
        __syncthreads();
        f32x4 acc[8][2];
#pragma unroll
        for (int dt = 0; dt < 8; ++dt) { acc[dt][0] = (f32x4){0.f, 0.f, 0.f, 0.f}; acc[dt][1] = (f32x4){0.f, 0.f, 0.f, 0.f}; }
#pragma unroll
        for (int ks = 0; ks < 4; ++ks) { const int rA = 32 * ks + 8 * fq, rB = rA + 4;
            const bf16x8 bv0 = frag_tr(Vt, 528, rA, rB, 16 * (2 * wave), fr), bv1 = frag_tr(Vt, 528, rA, rB, 16 * (2 * wave + 1), fr);
#pragma unroll
            for (int dt = 0; dt < 8; ++dt) { const bf16x8 ad = frag_tr(Kd, 272, rA, rB, 16 * dt, fr); acc[dt][0] = mfma16(ad, bv0, acc[dt][0]); acc[dt][1] = mfma16(ad, bv1, acc[dt][1]); } }
        bf16* dst = WSP(bf16, WS_KVN) + (size_t)un * 32768 + 16 * (fq & 1) + 4 * (fq & 2);
#pragma unroll
        for (int vi = 0; vi < 2; ++vi)
#pragma unroll
            for (int p = 0; p < 4; ++p) { const f32x4 a = acc[2 * p][vi], b = acc[2 * p + 1][vi];
                const unsigned ax = cvtpk(a[0], a[1]), ay = cvtpk(a[2], a[3]), bx_ = cvtpk(b[0], b[1]), by = cvtpk(b[2], b[3]);
                auto rx = __builtin_amdgcn_permlane16_swap(ax, bx_, false, false); auto ry = __builtin_amdgcn_permlane16_swap(ay, by, false, false);
                u32x4 o; o.x = rx[0]; o.y = ry[0]; o.z = rx[1]; o.w = ry[1];
                *(u32x4*)(dst + (size_t)(16 * (2 * wave + vi) + fr) * 128 + 32 * p) = o; }
    }
    __syncthreads();
}

__device__ __forceinline__ void scan_states(Frame& F) {
    const int tid = opaque_tid(), lane = tid & 63, wave = __builtin_amdgcn_readfirstlane(tid >> 6), fr = lane & 15, fq = lane >> 4; (void)tid; (void)lane; (void)wave; (void)fr; (void)fq;
    const bf16* KV = WSP(bf16, WS_KVN); bf16* SP = WSP(bf16, WS_SPREV);
    if (tid < 256)
    for (int p = F.vcu * 256 + tid; p < 8 * 8192; p += F.G * 256) {
        const int blk = p >> 13, bl = blk >> 2, h = blk & 3, off = (p & 8191) * 4; const float cd = exp2f(128.0f * log2gamma(h));
        f32x4 st = {0.f, 0.f, 0.f, 0.f};
        for (int n0 = 0; n0 < 64; n0 += 8) {
            u32x2 kv[8];
#pragma unroll
            for (int j = 0; j < 8; ++j) kv[j] = *(const u32x2*)(KV + (size_t)((bl * 64 + n0 + j) * 4 + h) * 32768 + off);
#pragma unroll
            for (int j = 0; j < 8; ++j) { u32x2 w; w.x = cvtpk(st[0], st[1]); w.y = cvtpk(st[2], st[3]); *(u32x2*)(SP + (size_t)((bl * 64 + n0 + j) * 4 + h) * 32768 + off) = w;
                st = st * cd + (f32x4){bflo(kv[j].x), bfhi(kv[j].x), bflo(kv[j].y), bfhi(kv[j].y)}; }
        }
    }
}

__device__ __forceinline__ void ret_out(Frame& F, bool dummy) {
    const int tid = opaque_tid(), lane = tid & 63, wave = __builtin_amdgcn_readfirstlane(tid >> 6), fr = lane & 15, fq = lane >> 4; (void)tid; (void)lane; (void)wave; (void)fr; (void)fq;
    bf16* P = WSP(bf16, WS_PROJ);
    LAS unsigned char* Kt = F.lds; LAS unsigned char* Vt = F.lds + 34816; LAS unsigned char* Sp = F.lds + 102400;
    for (int un = F.vcu; un < 512; un += F.G) {
        const int h = un & 3, n = (un >> 2) & 63, bl = un >> 8; const size_t row0 = (size_t)bl * SEQ + n * 128; const float lg = log2gamma(h);
        const bf16* spg = WSP(bf16, WS_SPREV) + (size_t)un * 32768;
        const int i = wave * 16 + fr; const size_t trow = row0 + i;
        bf16x8 bq[4];
#pragma unroll
        for (int ks = 0; ks < 4; ++ks) bq[ks] = *(const bf16x8*)(P + trow * PLD + C_Q + h * 128 + ks * 32 + fq * 8);
        bf16* gp = P + trow * PLD + C_G + h * 256 + 4 * fq;
        __syncthreads();
        for (int c = tid; c < 2048; c += 512) { const int j = c >> 4, ch = c & 15;
            *(LAS u32x4*)(Kt + j * 272 + ch * 16) = *(const u32x4*)(P + (row0 + j) * PLD + C_K + h * 128 + ch * 8);
            *(LAS u32x4*)(Sp + j * 272 + ch * 16) = *(const u32x4*)(spg + (size_t)j * 128 + ch * 8); }
        for (int c = tid; c < 4096; c += 512) { const int j = c >> 5, ch = c & 31; *(LAS u32x4*)(Vt + j * 528 + ch * 16) = *(const u32x4*)(P + (row0 + j) * PLD + C_V + h * 256 + ch * 8); }
        u32x4 sp1[4];
#pragma unroll
        for (int k = 0; k < 4; ++k) { const int c = tid + 512 * k, j = c >> 4, ch = c & 15; sp1[k] = *(const u32x4*)(spg + (size_t)(128 + j) * 128 + ch * 8); }
        __syncthreads();
        f32x4 acc[16];
#pragma unroll
        for (int vt = 0; vt < 8; ++vt) { acc[vt] = (f32x4){0.f, 0.f, 0.f, 0.f};
#pragma unroll
            for (int ks = 0; ks < 4; ++ks) acc[vt] = mfma16(*(LAS bf16x8*)(Sp + (16 * vt + fr) * 272 + (32 * ks + 8 * fq) * 2), bq[ks], acc[vt]); }
        __syncthreads();
#pragma unroll
        for (int k = 0; k < 4; ++k) { const int c = tid + 512 * k, j = c >> 4, ch = c & 15; *(LAS u32x4*)(Sp + j * 272 + ch * 16) = sp1[k]; }
        __syncthreads();
#pragma unroll
        for (int vt = 8; vt < 16; ++vt) { acc[vt] = (f32x4){0.f, 0.f, 0.f, 0.f};
#pragma unroll
            for (int ks = 0; ks < 4; ++ks) acc[vt] = mfma16(*(LAS bf16x8*)(Sp + (16 * (vt - 8) + fr) * 272 + (32 * ks + 8 * fq) * 2), bq[ks], acc[vt]); }
        bf16* gq = P + trow * PLD + C_G + h * 256 + 16 * (fq & 1) + 4 * (fq & 2);
        u32x4 gl[8];
#pragma unroll
        for (int p = 0; p < 8; ++p) gl[p] = *(const u32x4*)(gq + 32 * p);
        const float fac = exp2f((float)(i + 1) * lg);
#pragma unroll
        for (int vt = 0; vt < 16; ++vt) acc[vt] = acc[vt] * fac;
        f32x4 s[8];
#pragma unroll
        for (int kt = 0; kt < 8; ++kt) { s[kt] = (f32x4){0.f, 0.f, 0.f, 0.f};
            if (kt <= wave) {
#pragma unroll
                for (int ks = 0; ks < 4; ++ks) s[kt] = mfma16(*(LAS bf16x8*)(Kt + (16 * kt + fr) * 272 + (32 * ks + 8 * fq) * 2), bq[ks], s[kt]);
#pragma unroll
                for (int r = 0; r < 4; ++r) { const int key = 16 * kt + 4 * fq + r; s[kt][r] = (key <= i) ? s[kt][r] * exp2f((float)(i - key) * lg) : 0.f; } } }
#pragma unroll
        for (int kp = 0; kp < 4; ++kp) if (2 * kp <= wave) { const bf16x8 pf = pack8(s[2 * kp], s[2 * kp + 1]);
#pragma unroll
            for (int vt = 0; vt < 16; ++vt) acc[vt] = mfma16(frag_tr(Vt, 528, 32 * kp + 4 * fq, 32 * kp + 16 + 4 * fq, 16 * vt, fr), pf, acc[vt]); }
        float ss = 0.f;
#pragma unroll
        for (int vt = 0; vt < 16; ++vt) ss += (acc[vt][0] * acc[vt][0] + acc[vt][1] * acc[vt][1]) + (acc[vt][2] * acc[vt][2] + acc[vt][3] * acc[vt][3]);
        ss = add_xor16(ss); ss = add_xor32(ss);
        const float rinv = rsqrtf(ss * (1.0f / 256.0f) + EPS);
#pragma unroll
        for (int p = 0; p < 8; ++p) {
            u32x2 g[2];
            { auto rx = __builtin_amdgcn_permlane16_swap(gl[p][0], gl[p][2], false, false); auto ry = __builtin_amdgcn_permlane16_swap(gl[p][1], gl[p][3], false, false);
              g[0].x = rx[0]; g[0].y = ry[0]; g[1].x = rx[1]; g[1].y = ry[1]; }
            u32x2 w[2];
#pragma unroll
            for (int j = 0; j < 2; ++j) { const int vt = 2 * p + j; const float g0 = bflo(g[j].x), g1 = bfhi(g[j].x), g2 = bflo(g[j].y), g3 = bfhi(g[j].y);
                w[j].x = cvtpk(acc[vt][0] * rinv * g0 * sigmoidf_(g0), acc[vt][1] * rinv * g1 * sigmoidf_(g1)); w[j].y = cvtpk(acc[vt][2] * rinv * g2 * sigmoidf_(g2), acc[vt][3] * rinv * g3 * sigmoidf_(g3)); }
            u32x4 o;
            { auto rx = __builtin_amdgcn_permlane16_swap(w[0].x, w[1].x, false, false); auto ry = __builtin_amdgcn_permlane16_swap(w[0].y, w[1].y, false, false);
              o.x = rx[0]; o.y = ry[0]; o.z = rx[1]; o.w = ry[1]; }
            *(u32x4*)((dummy ? WSP(bf16, WS_MERGED) + trow * 1024 + h * 256 + 16 * (fq & 1) + 4 * (fq & 2) : gq) + 32 * p) = o; }
    }
    __syncthreads();
}

constexpr int N_PHASES = 2 + 2 * 16 + 1;
__global__ void __launch_bounds__(512, 2) fwd_kernel(Args args) {
    extern __shared__ __attribute__((aligned(16))) unsigned char lds_raw[];
    Frame F;
    F.lds = (LAS unsigned char*)lds_raw;
    F.G = gridDim.x; { const int bx = blockIdx.x; F.vcu = (F.G % 8 == 0) ? (bx % 8) * (F.G / 8) + bx / 8 : bx; }
    F.ws = args.ws;
    const Args& A = args;
    for (int u = TID; u < (LDS_BYTES - LDSCTL_OFF) / 4; u += 512) ((LAS unsigned*)(F.lds + LDSCTL_OFF))[u] = 0u;
    __syncthreads();
    const int lo = args.ph_lo, hi = args.ph_hi;
    XcdBarrier bar; bar.bar = WSP(unsigned, WS_CTL) + CW_BAR; bar.x = 0; bar.st = nullptr;
    if (hi - lo > 1) bar = xcd_barrier_post(WSP(unsigned, WS_CTL) + CW_BAR, (volatile LAS unsigned*)(F.lds + MISC_OFF) + 8);
    int ph = 0;
#define RUN() (lo <= ph && ph < hi)
#define END_PHASE() do { if (RUN() && ph + 1 < hi) xcd_barrier(bar); ++ph; } while (0)
    const int bx = (int)blockIdx.x;

    if (RUN()) for (int rep = 0; rep < REPS(10); ++rep) { if (rep) xcd_barrier(bar); p0_prologue(F, A); }
    END_PHASE();
    if (RUN()) for (int rep = 0; rep < REPS(11); ++rep) { if (rep) xcd_barrier(bar); mem_kv_proj(F); }
    END_PHASE();
#pragma unroll 1
    for (int l = 0; l < 2; ++l) {
        unsigned char* wl = F.ws + WS_W + (size_t)l * W_LAYER;
#pragma unroll 1
        for (int hf = 0; hf < 2; ++hf) {
            const int t0 = hf * TH;
            if (RUN()) for (int rep = 0; rep < REPS(0); ++rep) { if (rep) xcd_barrier(bar);
                pg8::Gemm g{WSP(bf16, WS_XB) + (size_t)t0 * DM, (const bf16*)(wl + WO_IN)};
                pg8::StaticOrder<TH, 4096> S; S.init(F.G, bx);
                pg8::EpiBf<2> E{WSP(bf16, WS_PROJ), PLD, WSP(float, WS_COS), WSP(float, WS_SIN), t0, WSP(float, WS_SSP)};
                pg8::gemm_phase<DM, DM, DM, pg8::EpiBf<2>, pg8::StaticOrder<TH, 4096>>(F.lds, g, S, E);
            }
            END_PHASE();
            if (RUN()) for (int rep = 0; rep < REPS(1); ++rep) { if (rep) xcd_barrier(bar); mix_pool(F); mix_mem(F, l, hf, rep != 0); mix_kv(F); }
            END_PHASE();
            if (RUN()) for (int rep = 0; rep < REPS(2); ++rep) { if (rep) xcd_barrier(bar); scan_states(F); }
            END_PHASE();
            if (RUN()) for (int rep = 0; rep < REPS(3); ++rep) { if (rep) xcd_barrier(bar); ret_out(F, rep != 0); }
            END_PHASE();
            if (RUN()) for (int rep = 0; rep < REPS(4); ++rep) { if (rep) xcd_barrier(bar);
                pg8::Gemm g{WSP(bf16, WS_XB) + (size_t)t0 * DM, (const bf16*)(wl + WO_IN) + (size_t)4096 * DM};
                pg8::StaticOrder<TH, 3072> S; S.init(F.G, bx);
                pg8::EpiBf<3> E{WSP(bf16, WS_GATES), 3072, nullptr, nullptr, t0, WSP(float, WS_SSP)};
                pg8::gemm_phase<DM, DM, DM, pg8::EpiBf<3>, pg8::StaticOrder<TH, 3072>>(F.lds, g, S, E);
            }
            END_PHASE();
            if (RUN()) for (int rep = 0; rep < REPS(5); ++rep) { if (rep) xcd_barrier(bar);
                pg8::Gemm g{WSP(bf16, WS_PROJ) + C_DP, (const bf16*)(wl + WO_UP)};
                pg8::StaticOrder<TH, DM> S; S.init(F.G, bx);
                pg8::EpiUp E{WSP(bf16, WS_MERGED), WSP(bf16, WS_GATES)};
                pg8::gemm_phase<2048, PLD, 2048, pg8::EpiUp, pg8::StaticOrder<TH, DM>>(F.lds, g, S, E);
            }
            END_PHASE();
            if (RUN()) for (int rep = 0; rep < REPS(6); ++rep) { if (rep) xcd_barrier(bar);
                pg8::Gemm g{WSP(bf16, WS_MERGED), (const bf16*)(wl + WO_OUT)};
                pg8::StaticOrder<TH, DM> S; S.init(F.G, bx);
                pg8::EpiRes E{WSP(bf16, WS_XB) + (size_t)t0 * DM, WSP(float, WS_SSP) + (size_t)t0 * 16, rep ? WSP(bf16, WS_KVN) : nullptr};
                pg8::gemm_phase<DM, DM, DM, pg8::EpiRes, pg8::StaticOrder<TH, DM>>(F.lds, g, S, E);
            }
            END_PHASE();
        }
        if (RUN()) for (int rep = 0; rep < REPS(8); ++rep) { if (rep) xcd_barrier(bar);
            pg8::Gemm g{WSP(bf16, WS_XB), (const bf16*)(wl + WO_1)};
            pg8::StaticOrder<T, DFF> S; S.init(F.G, bx);
            pg8::EpiBf<1> E{WSP(bf16, WS_U), DFF, nullptr, nullptr, 0, WSP(float, WS_SSP)};
            pg8::gemm_phase<DM, DM, DM, pg8::EpiBf<1>, pg8::StaticOrder<T, DFF>>(F.lds, g, S, E);
        }
        END_PHASE();
        if (RUN()) {
            pg8::Gemm g{WSP(bf16, WS_U), (const bf16*)(wl + WO_2)};
            pg8::StaticOrder<T, DM> S; S.init(F.G, bx);
            pg8::EpiRes E{WSP(bf16, WS_XB), WSP(float, WS_SSP), nullptr};
            pg8::gemm_phase<DFF, DFF, DFF, pg8::EpiRes, pg8::StaticOrder<T, DM>>(F.lds, g, S, E);
#if (PROBE_DUP >> 9) & 1
            xcd_barrier(bar);
            { pg8::StaticOrder<TH, DM> S2; S2.init(F.G, bx); pg8::EpiRes E2{WSP(bf16, WS_XB), WSP(float, WS_SSP), (bf16*)(F.ws + WS_END)};
              pg8::gemm_phase<DFF, DFF, DFF, pg8::EpiRes, pg8::StaticOrder<TH, DM>>(F.lds, g, S2, E2); }
#endif
        }
        END_PHASE();
        if (l == 1) { if (RUN()) final_norm(F, A.out, A.in[17]); END_PHASE(); }
#if (PROBE_DUP >> 12) & 1
        for (int rep = 0; rep < 8; ++rep) xcd_barrier(bar);
#endif
    }
#undef RUN
#undef END_PHASE
}

extern "C" void kernel_launch(void* const* d_in, const int* in_sizes, int n_in, void* d_out, int out_size, void* d_ws, size_t ws_size, hipStream_t stream) {
    static int grid = 0;
    if (grid == 0) {
        if (n_in != 18 || in_sizes[0] != T * DM || out_size != T * DM || ws_size < WS_END) { fprintf(stderr, "kernel_launch: unexpected shapes / workspace (n_in %d, ws %zu)\n", n_in, ws_size); grid = -1; return; }
        int dev = 0, cus = 0, per_cu = 0;
        if (hipGetDevice(&dev) != hipSuccess || hipDeviceGetAttribute(&cus, hipDeviceAttributeMultiprocessorCount, dev) != hipSuccess) { grid = -1; return; }
        if (hipFuncSetAttribute((const void*)fwd_kernel, hipFuncAttributeMaxDynamicSharedMemorySize, LDS_BYTES) != hipSuccess) { fprintf(stderr, "kernel_launch: hipFuncSetAttribute failed\n"); grid = -1; return; }
        if (hipOccupancyMaxActiveBlocksPerMultiprocessor(&per_cu, (const void*)fwd_kernel, 512, LDS_BYTES) != hipSuccess || per_cu < 1) { fprintf(stderr, "kernel_launch: occupancy query says %d\n", per_cu); (void)hipGetLastError(); grid = -1; return; }
        grid = cus;
    }
    if (grid < 0) return;
    (void)hipMemsetAsync((char*)d_ws + WS_CTL, 0, CTL_ZERO_BYTES, stream);
    Args a{};
    for (int i = 0; i < 18; ++i) a.in[i] = (const float*)d_in[i];
    a.out = (float*)d_out; a.ws = (unsigned char*)d_ws;
#if MK_SINGLE
    a.ph_lo = 0; a.ph_hi = N_PHASES;
    hipLaunchKernelGGL(fwd_kernel, dim3(grid), dim3(512), LDS_BYTES, stream, a);
#else
    for (int p = 0; p < N_PHASES; ++p) { a.ph_lo = p; a.ph_hi = p + 1; hipLaunchKernelGGL(fwd_kernel, dim3(grid), dim3(512), LDS_BYTES, stream, a); }
#endif
}
```

```cpp
#include <hip/hip_runtime.h>
#include <cstdio>
#include <cstdint>

#ifndef MK_SINGLE
#define MK_SINGLE 1
#endif
#ifndef PROBE_DUP
#define PROBE_DUP 0
#endif
#define REPS(k) (1 + ((PROBE_DUP >> (k)) & 1))
#ifndef USE_TR
#define USE_TR 1
#endif

#define LAS __attribute__((address_space(3)))
#define GAS __attribute__((address_space(1)))
typedef unsigned short bf16;
typedef short bf16x8 __attribute__((ext_vector_type(8)));
typedef short s16x4 __attribute__((ext_vector_type(4)));
typedef float f32x4 __attribute__((ext_vector_type(4)));
typedef float f32x2 __attribute__((ext_vector_type(2)));
typedef unsigned u32x4 __attribute__((ext_vector_type(4)));
typedef unsigned u32x2 __attribute__((ext_vector_type(2)));
typedef __bf16 bf16x2_t __attribute__((ext_vector_type(2)));
typedef short v4i16_t __attribute__((ext_vector_type(4)));

constexpr int DM = 1024, NB = 4, SEQ = 8192, T = NB * SEQ, TH = T / 2, NMEM = 256, DFF = 4096;
constexpr int INC = 7168;
constexpr int PLD = 4608;
constexpr int C_Q = 512, C_K = 1024, C_V = 1536, C_DP = 2560, C_G = 3072, C_XQ = 4096;
constexpr float EPS = 1e-6f;
constexpr float XQ_SCALE = 0.08838834764831845f * 1.4426950408889634f;
constexpr float LOG2E = 1.4426950408889634f;
constexpr float K_SCALE = 0.08838834764831845f;

constexpr size_t MiB = 1u << 20;
constexpr size_t WS_CTL = 0, CTL_ZERO_BYTES = 1 * MiB;
constexpr size_t WS_COS = 2 * MiB, WS_SIN = 10 * MiB;
constexpr size_t WS_SSP = 18 * MiB;
constexpr size_t WS_MEMN = 20 * MiB;
constexpr size_t WS_KVMEM = 24 * MiB;
constexpr size_t WS_W = 32 * MiB, W_LAYER = 38 * MiB;
constexpr size_t WO_IN = 0, WO_UP = 14 * MiB, WO_OUT = 18 * MiB, WO_1 = 20 * MiB, WO_2 = 28 * MiB, WO_MKV = 36 * MiB;
constexpr size_t WS_XB = 108 * MiB;
constexpr size_t WS_MERGED = 172 * MiB;
constexpr size_t WS_PROJ = 204 * MiB;
constexpr size_t WS_KVN = 348 * MiB;
constexpr size_t WS_SPREV = 412 * MiB;
constexpr size_t WS_GATES = 348 * MiB;
constexpr size_t WS_U = 172 * MiB;
constexpr size_t WS_END = 444 * MiB;
static_assert(WS_W + 2 * W_LAYER <= WS_XB && WS_U + (size_t)T * DFF * 2 <= WS_END && WS_PROJ + (size_t)TH * PLD * 2 <= WS_KVN, "ws map");
constexpr int CW_TMO = 0, CW_BAR = 4096;

constexpr int RING_BYTES = 131072, SCRATCH_BYTES = 147456, LDSCTL_OFF = SCRATCH_BYTES, MISC_OFF = LDSCTL_OFF + 320, LDS_BYTES = SCRATCH_BYTES + 1024;

__device__ __forceinline__ unsigned cvtpk(float lo, float hi) { f32x2 v = {lo, hi}; bf16x2_t b = __builtin_convertvector(v, bf16x2_t); return __builtin_bit_cast(unsigned, b); }
__device__ __forceinline__ float bflo(unsigned u) { return __uint_as_float(u << 16); }
__device__ __forceinline__ float bfhi(unsigned u) { return __uint_as_float(u & 0xffff0000u); }
__device__ __forceinline__ f32x4 mfma16(bf16x8 a, bf16x8 b, f32x4 c) { return __builtin_amdgcn_mfma_f32_16x16x32_bf16(a, b, c, 0, 0, 0); }
#define SWZ_XOR(m) (((m) << 10) | 0x1f)
__device__ __forceinline__ float wave_sum(float v) {
    v += __int_as_float(__builtin_amdgcn_ds_swizzle(__float_as_int(v), SWZ_XOR(1)));
    v += __int_as_float(__builtin_amdgcn_ds_swizzle(__float_as_int(v), SWZ_XOR(2)));
    v += __int_as_float(__builtin_amdgcn_ds_swizzle(__float_as_int(v), SWZ_XOR(4)));
    v += __int_as_float(__builtin_amdgcn_ds_swizzle(__float_as_int(v), SWZ_XOR(8)));
    { auto r = __builtin_amdgcn_permlane16_swap(__float_as_uint(v), __float_as_uint(v), false, false); v = __uint_as_float(r[0]) + __uint_as_float(r[1]); }
    { auto r = __builtin_amdgcn_permlane32_swap(__float_as_uint(v), __float_as_uint(v), false, false); v = __uint_as_float(r[0]) + __uint_as_float(r[1]); }
    return v;
}
__device__ __forceinline__ float add_xor16(float v) { auto r = __builtin_amdgcn_permlane16_swap(__float_as_uint(v), __float_as_uint(v), false, false); return __uint_as_float(r[0]) + __uint_as_float(r[1]); }
__device__ __forceinline__ float add_xor32(float v) { auto r = __builtin_amdgcn_permlane32_swap(__float_as_uint(v), __float_as_uint(v), false, false); return __uint_as_float(r[0]) + __uint_as_float(r[1]); }
__device__ __forceinline__ float max_xor16(float v) { auto r = __builtin_amdgcn_permlane16_swap(__float_as_uint(v), __float_as_uint(v), false, false); return fmaxf(__uint_as_float(r[0]), __uint_as_float(r[1])); }
__device__ __forceinline__ float max_xor32(float v) { auto r = __builtin_amdgcn_permlane32_swap(__float_as_uint(v), __float_as_uint(v), false, false); return fmaxf(__uint_as_float(r[0]), __uint_as_float(r[1])); }
__device__ __forceinline__ float sigmoidf_(float x) { return 1.0f / (1.0f + __expf(-x)); }

namespace pg8 {
#define PG8_LAS __attribute__((address_space(3)))
typedef unsigned short bf16_t;
constexpr int BM = 256, BK = 64, HALF = 128, HTB = HALF * BK * 2, STAGE_BYTES = 8 * HTB, NXCD = 8, WGM = 8;
__host__ __device__ __forceinline__ int lds_byte(int r, int c) { const int st = (r >> 4) * 2 + (c >> 5), rr = r & 15, cc = c & 31, ob = rr * 64 + cc * 2; return st * 1024 + (ob ^ (((ob >> 9) & 1) << 5)); }
__host__ __device__ __forceinline__ void stage_rc(int b, int& R, int& C) { const int st = b / 1024, sb = b % 1024, swz = sb ^ (((sb >> 9) & 1) << 5); R = (st >> 1) * 16 + swz / 64; C = (st & 1) * 32 + (swz % 64) / 2; }
__host__ __device__ __forceinline__ int perm32(int rho) { const int n = rho >> 4, i = rho & 15; return 8 * (i >> 2) + 4 * n + (i & 3); }

struct Unit { int pm, pn; };
struct Gemm { const bf16_t* A; const bf16_t* Bt; };

template <int M_, int N_> struct StaticOrder {
    static constexpr int nM = M_ / BM, nN = N_ / BM, nwg = nM * nN;
    int G, c;
    __host__ __device__ void init(int G_, int c_) { G = G_; c = c_; }
    __host__ __device__ bool next(int i, Unit& u) const {
        const long L = (long)i * G + c; if (L >= nwg) return false;
        int wgid = (int)L; { const int q = nwg / NXCD, r = nwg % NXCD, xcd = wgid % NXCD, off = wgid / NXCD; wgid = (xcd < r ? xcd * (q + 1) : r * (q + 1) + (xcd - r) * q) + off; }
        const int nig = WGM * nN, gid = wgid / nig, fm = gid * WGM, gsz = (nM - fm) < WGM ? (nM - fm) : WGM;
        u.pm = fm + ((wgid % nig) % gsz); u.pn = (wgid % nig) / gsz; return true;
    }
    __device__ __forceinline__ void a_ready(const Unit&) const {}
    __device__ __forceinline__ void done(const Unit&) const {}
};

typedef f32x4 Acc[2][2][4][2];

template <int MODE> struct EpiBf {
    static constexpr bool PERM = true, AFTER_DRAIN = false, HOOK = false, EARLY_PRE = (MODE != 2);
    bf16_t* O; int ldc; const float* cosT; const float* sinT; int t0; const float* ssp;
    __device__ __forceinline__ void hook(Acc&, const Unit&, int, int, int, int, int) const {}
    struct Pre { float rs[2][4]; };
    struct Raw { f32x4 v[2][4]; };
    __device__ __forceinline__ Raw pre_load(const Unit& u, int wr, int fr, int fq) const {
        Raw r; const float* p = ssp + (size_t)(t0 + u.pm * BM + wr * 64) * 16 + (unsigned)(fr * 16 + 4 * fq);
#pragma unroll
        for (int ai = 0; ai < 2; ++ai)
#pragma unroll
            for (int m = 0; m < 4; ++m) r.v[ai][m] = *(const f32x4*)(p + (size_t)(ai * HALF + m * 16) * 16);
        __builtin_amdgcn_sched_barrier(0);
        return r;
    }
    __device__ __forceinline__ Pre pre_finish(const Raw& r) const {
        Pre p;
#pragma unroll
        for (int ai = 0; ai < 2; ++ai)
#pragma unroll
            for (int m = 0; m < 4; ++m) { const f32x4 v = r.v[ai][m]; float q = (v[0] + v[1]) + (v[2] + v[3]); q = add_xor16(q); q = add_xor32(q); p.rs[ai][m] = rsqrtf(q * (1.0f / DM) + EPS); }
        return p;
    }
    __device__ __forceinline__ Pre operator()(const Acc& acc, const Unit& u, const Unit& un, int wr, int wc, int fr_in, int fq_in, const Pre& pr) const {
        int fr = fr_in, fq = fq_in; asm volatile("" : "+v"(fr), "+v"(fq));
        if (MODE == 2 && u.pn >= 2 && u.pn < 6) {
            const int sec = (u.pn < 4) ? C_Q : C_K, head = 2 * (u.pn & 1) + (wc >> 1);
            const float ksc0 = (u.pn >= 4) ? K_SCALE : 1.0f;
            const int rowu = u.pm * BM + wr * 64, dcolu = sec + head * 128 + 32 * (wc & 1);
            const unsigned toff = (unsigned)(fr * 64 + 8 * fq), ooff = (unsigned)(fr * ldc + 8 * fq);
#pragma unroll
            for (int am = 0; am < 8; am += 2) {
                f32x4 cs[2][4];
#pragma unroll
                for (int j = 0; j < 2; ++j) { const size_t tr = (size_t)(t0 + rowu + ((am + j) >> 2) * HALF + ((am + j) & 3) * 16) * 64 + 32 * (wc & 1); const float* cp = cosT + tr; const float* sp = sinT + tr;
                    cs[j][0] = *(const f32x4*)(cp + toff); cs[j][1] = *(const f32x4*)(cp + toff + 4); cs[j][2] = *(const f32x4*)(sp + toff); cs[j][3] = *(const f32x4*)(sp + toff + 4); }
                __builtin_amdgcn_sched_barrier(0);
#pragma unroll
                for (int j = 0; j < 2; ++j) { const int ai = (am + j) >> 2, m = (am + j) & 3;
                    const float ksc = ksc0 * pr.rs[ai][m];
                    const f32x4 c0 = cs[j][0], c1 = cs[j][1], s0 = cs[j][2], s1 = cs[j][3];
                    const f32x4 a0 = acc[ai][0][m][0], a1 = acc[ai][0][m][1], b0 = acc[ai][1][m][0], b1 = acc[ai][1][m][1];
                    const f32x4 o10 = (a0 * c0 - b0 * s0) * ksc, o11 = (a1 * c1 - b1 * s1) * ksc, o20 = (b0 * c0 + a0 * s0) * ksc, o21 = (b1 * c1 + a1 * s1) * ksc;
                    bf16_t* rowp = O + (size_t)(rowu + ai * HALF + m * 16) * ldc + dcolu;
                    u32x4 w1, w2; w1.x = cvtpk(o10[0], o10[1]); w1.y = cvtpk(o10[2], o10[3]); w1.z = cvtpk(o11[0], o11[1]); w1.w = cvtpk(o11[2], o11[3]);
                    w2.x = cvtpk(o20[0], o20[1]); w2.y = cvtpk(o20[2], o20[3]); w2.z = cvtpk(o21[0], o21[1]); w2.w = cvtpk(o21[2], o21[3]);
                    *(u32x4*)(rowp + ooff) = w1; *(u32x4*)(rowp + ooff + 64) = w2;
                }
                __builtin_amdgcn_sched_barrier(0); }
            return pre_finish(pre_load(un, wr, fr, fq));
        }
        int cbase = u.pn * BM; float sc = 1.0f;
        if (MODE == 2) { const int pn = u.pn; if (pn < 2) cbase = 256 * pn; else if (pn < 10) cbase = C_V + 256 * (pn - 6); else if (pn < 14) cbase = C_G + 256 * (pn - 10); else { cbase = C_XQ + 256 * (pn - 14); sc = XQ_SCALE; } }
        const unsigned loff = (unsigned)(fr * ldc + 8 * fq);
        const Raw raw = pre_load(un, wr, fr, fq);
        const bool inv = u.pn < 4;
        Pre pn;
#pragma unroll
        for (int ai = 0; ai < 2; ++ai) {
            u32x4 w[4][2];
#pragma unroll
            for (int m = 0; m < 4; ++m)
#pragma unroll
                for (int bj = 0; bj < 2; ++bj) { f32x4 v0 = acc[ai][bj][m][0], v1 = acc[ai][bj][m][1];
                    { const float f = (MODE == 3 ? -LOG2E : sc) * pr.rs[ai][m]; v0 = v0 * f; v1 = v1 * f; }
                    if (MODE == 3) {
#pragma unroll
                        for (int e = 0; e < 4; ++e) { v0[e] = 1.0f + __builtin_amdgcn_exp2f(fminf(fmaxf(v0[e], -80.f), 80.f)); v1[e] = 1.0f + __builtin_amdgcn_exp2f(fminf(fmaxf(v1[e], -80.f), 80.f)); }
                        if (inv) {
#pragma unroll
                            for (int e = 0; e < 4; ++e) { v0[e] = __builtin_amdgcn_rcpf(v0[e]); v1[e] = __builtin_amdgcn_rcpf(v1[e]); } } }
                    if (MODE == 1) { v0 = __builtin_elementwise_max(v0, (f32x4){0.f, 0.f, 0.f, 0.f}); v1 = __builtin_elementwise_max(v1, (f32x4){0.f, 0.f, 0.f, 0.f}); v0 = v0 * v0; v1 = v1 * v1; }
                    w[m][bj].x = cvtpk(v0[0], v0[1]); w[m][bj].y = cvtpk(v0[2], v0[3]); w[m][bj].z = cvtpk(v1[0], v1[1]); w[m][bj].w = cvtpk(v1[2], v1[3]); }
            if (ai == 0) pn = pre_finish(raw);
            __builtin_amdgcn_sched_barrier(0);
#pragma unroll
            for (int m = 0; m < 4; ++m) { bf16_t* rowu = O + (size_t)(u.pm * BM + wr * 64 + ai * HALF + m * 16) * ldc + cbase + wc * 32;
#pragma unroll
                for (int bj = 0; bj < 2; ++bj) *(u32x4*)(rowu + loff + bj * HALF) = w[m][bj]; }
            __builtin_amdgcn_sched_barrier(0); }
        return pn;
    }
};
struct EpiRes {
    static constexpr bool PERM = true, AFTER_DRAIN = false, HOOK = false, EARLY_PRE = false;
    struct Pre {}; struct Raw {};
    __device__ __forceinline__ Raw pre_load(const Unit&, int, int, int) const { return Raw{}; }
    __device__ __forceinline__ Pre pre_finish(const Raw&) const { return Pre{}; }
    bf16_t* X; float* ssp; bf16_t* dummy;
    __device__ __forceinline__ void hook(Acc&, const Unit&, int, int, int, int, int) const {}
    __device__ __forceinline__ Pre operator()(const Acc& acc, const Unit& u, const Unit&, int wr, int wc, int fr, int fq, const Pre&) const {
        const unsigned loff = (unsigned)((wr * 64 + fr) * 1024 + u.pn * BM + wc * 32 + 8 * fq);
        const bf16_t* Xu = X + (size_t)u.pm * BM * 1024; bf16_t* Yu = (dummy ? dummy : X) + (size_t)u.pm * BM * 1024;
        u32x4 xb[2][4][2];
#pragma unroll
        for (int ai = 0; ai < 2; ++ai)
#pragma unroll
            for (int m = 0; m < 4; ++m)
#pragma unroll
                for (int bj = 0; bj < 2; ++bj) xb[ai][m][bj] = *(const u32x4*)(Xu + (size_t)(ai * HALF + m * 16) * 1024 + loff + bj * HALF);
        __builtin_amdgcn_sched_barrier(0);
#pragma unroll
        for (int ai = 0; ai < 2; ++ai)
#pragma unroll
            for (int m = 0; m < 4; ++m) { float q = 0.f;
#pragma unroll
                for (int bj = 0; bj < 2; ++bj) { const u32x4 b = xb[ai][m][bj];
                    f32x4 x0 = acc[ai][bj][m][0], x1 = acc[ai][bj][m][1];
                    x0[0] += bflo(b[0]); x0[1] += bfhi(b[0]); x0[2] += bflo(b[1]); x0[3] += bfhi(b[1]); x1[0] += bflo(b[2]); x1[1] += bfhi(b[2]); x1[2] += bflo(b[3]); x1[3] += bfhi(b[3]);
                    q += ((x0[0] * x0[0] + x0[1] * x0[1]) + (x0[2] * x0[2] + x0[3] * x0[3])) + ((x1[0] * x1[0] + x1[1] * x1[1]) + (x1[2] * x1[2] + x1[3] * x1[3]));
                    u32x4 w; w.x = cvtpk(x0[0], x0[1]); w.y = cvtpk(x0[2], x0[3]); w.z = cvtpk(x1[0], x1[1]); w.w = cvtpk(x1[2], x1[3]);
                    *(u32x4*)(Yu + (size_t)(ai * HALF + m * 16) * 1024 + loff + bj * HALF) = w; }
                q = add_xor16(q); q = add_xor32(q);
                if (fq == 0 && !dummy) ssp[(size_t)(u.pm * BM + wr * 64 + fr + ai * HALF + m * 16) * 16 + 4 * u.pn + wc] = q; }
        return Pre{};
    }
};
struct EpiUp {
    static constexpr bool PERM = true, AFTER_DRAIN = false, HOOK = true, EARLY_PRE = false;
    struct Pre {}; struct Raw {};
    __device__ __forceinline__ Raw pre_load(const Unit&, int, int, int) const { return Raw{}; }
    __device__ __forceinline__ Pre pre_finish(const Raw&) const { return Pre{}; }
    bf16_t* O; const bf16_t* G;
    __device__ __forceinline__ void hook(Acc& acc, const Unit& u, int t, int wr, int wc, int fr, int fq) const {
        if (t != 8 && t != 24) return;
        const int gsel = (t == 8) ? 0 : 1024;
        int fr_ = fr, fq_ = fq; asm volatile("" : "+v"(fr_), "+v"(fq_));
        const int row0 = u.pm * BM + wr * 64 + fr_, col0 = u.pn * BM + wc * 32 + 8 * fq_;
        const bf16_t* gbase = G + (size_t)row0 * 3072 + gsel + col0;
        u32x4 ga[4][2], gb[4][2];
#pragma unroll
        for (int m = 0; m < 4; ++m)
#pragma unroll
            for (int bj = 0; bj < 2; ++bj) { const bf16_t* gp = gbase + (size_t)(m * 16) * 3072 + bj * HALF; ga[m][bj] = *(const u32x4*)gp; gb[m][bj] = *(const u32x4*)(gp + 1024); }
        __builtin_amdgcn_sched_barrier(0);
#pragma unroll
        for (int ai = 0; ai < 2; ++ai)
#pragma unroll
            for (int m = 0; m < 4; ++m)
#pragma unroll
                for (int bj = 0; bj < 2; ++bj) { float r[8];
#pragma unroll
                    for (int e = 0; e < 4; ++e) { const float a0 = bflo(ga[m][bj][e]), a1 = bfhi(ga[m][bj][e]), b0 = bflo(gb[m][bj][e]), b1 = bfhi(gb[m][bj][e]);
                        if (t == 8) { r[2 * e] = a0 * b0; r[2 * e + 1] = a1 * b1; }
                        else { r[2 * e] = b0 * __builtin_amdgcn_rcpf(a0); r[2 * e + 1] = b1 * __builtin_amdgcn_rcpf(a1); } }
                    if (ai == 0) { const bf16_t* gp = gbase + (size_t)(HALF + m * 16) * 3072 + bj * HALF; ga[m][bj] = *(const u32x4*)gp; gb[m][bj] = *(const u32x4*)(gp + 1024); }
                    f32x4 v0 = acc[ai][bj][m][0], v1 = acc[ai][bj][m][1];
                    v0[0] *= r[0]; v0[1] *= r[1]; v0[2] *= r[2]; v0[3] *= r[3]; v1[0] *= r[4]; v1[1] *= r[5]; v1[2] *= r[6]; v1[3] *= r[7];
                    acc[ai][bj][m][0] = v0; acc[ai][bj][m][1] = v1;
                    __builtin_amdgcn_sched_barrier(0); }
    }
    __device__ __forceinline__ Pre operator()(const Acc& acc, const Unit& u, const Unit&, int wr, int wc, int fr, int fq, const Pre&) const {
        const int row0 = u.pm * BM + wr * 64 + fr, col0 = u.pn * BM + wc * 32 + 8 * fq;
        u32x4 g3[2][4][2];
#pragma unroll
        for (int ai = 0; ai < 2; ++ai)
#pragma unroll
            for (int m = 0; m < 4; ++m)
#pragma unroll
                for (int bj = 0; bj < 2; ++bj) g3[ai][m][bj] = *(const u32x4*)(G + (size_t)(row0 + ai * HALF + m * 16) * 3072 + 2048 + col0 + bj * HALF);
        __builtin_amdgcn_sched_barrier(0);
#pragma unroll
        for (int ai = 0; ai < 2; ++ai)
#pragma unroll
            for (int m = 0; m < 4; ++m) { const int row = row0 + ai * HALF + m * 16; bf16_t* rowp = O + (size_t)row * 1024 + col0;
#pragma unroll
                for (int bj = 0; bj < 2; ++bj) { const u32x4 gc = g3[ai][m][bj];
                    const f32x4 v0 = acc[ai][bj][m][0], v1 = acc[ai][bj][m][1];
#define UP_S3(x) __builtin_amdgcn_rcpf(x)
                    u32x4 w; w.x = cvtpk(v0[0] * UP_S3(bflo(gc[0])), v0[1] * UP_S3(bfhi(gc[0]))); w.y = cvtpk(v0[2] * UP_S3(bflo(gc[1])), v0[3] * UP_S3(bfhi(gc[1])));
                    w.z = cvtpk(v1[0] * UP_S3(bflo(gc[2])), v1[1] * UP_S3(bfhi(gc[2]))); w.w = cvtpk(v1[2] * UP_S3(bflo(gc[3])), v1[3] * UP_S3(bfhi(gc[3])));
#undef UP_S3
                    *(u32x4*)(rowp + bj * HALF) = w; } }
        return Pre{};
    }
};

template <int K, int LDA, int LDB, class Epi, class Sched, bool ALIGN_EPI = true>
__device__ __forceinline__ void gemm_phase(PG8_LAS unsigned char* lds, const Gemm g, const Sched& S, const Epi& E) {
    int tid_ = threadIdx.x; asm volatile("" : "+v"(tid_));
    const int tid = tid_, wid = __builtin_amdgcn_readfirstlane(tid >> 6), lane = tid & 63, wr = wid >> 2, wc = wid & 3, fr = lane & 15, fq = lane >> 4;
    constexpr int nt = K / BK;
    unsigned voffA[2], voffB[2];
#pragma unroll
    for (int i = 0; i < 2; ++i) { int R, C; stage_rc(tid * 16 + i * 8192, R, C); const int Rb = Epi::PERM ? ((R & ~31) + perm32(R & 31)) : R;
        voffA[i] = (unsigned)(R * LDA + C) * 2u; voffB[i] = (unsigned)(Rb * LDB + C) * 2u; }
    constexpr size_t kstep = (size_t)(BK * 2);
    constexpr size_t hstepA = (size_t)HALF * LDA * 2, hstepB = (size_t)HALF * LDB * 2;
    constexpr size_t tstepA = 2 * hstepA, tstepB = 2 * hstepB;
    const unsigned ldsw = (unsigned)wid * 1024u;
    const int aoff = lds_byte(wr * 64 + fr, fq * 8), boff = lds_byte(wc * 32 + fr, fq * 8);
#define PG8_SA(b, h) (((b) * 2 + (h)) * HTB)
#define PG8_SB(b, h) ((4 + (b) * 2 + (h)) * HTB)
#define PG8_STAGE(bufoff, gbase, voff) do { _Pragma("unroll") for (int _i = 0; _i < 2; ++_i) \
        __builtin_amdgcn_global_load_lds((const unsigned*)((const char*)(gbase) + (voff)[_i]), (PG8_LAS unsigned*)(lds + (bufoff) + ldsw + _i * 8192), 16, 0, 0); } while (0)
#define PG8_LDA(dst, b, h) do { _Pragma("unroll") for (int m = 0; m < 4; ++m) _Pragma("unroll") for (int k = 0; k < 2; ++k) dst[m][k] = *(const PG8_LAS bf16x8*)(lds + PG8_SA(b, h) + aoff + m * 2048 + k * 1024); } while (0)
#define PG8_LDB(dst, b, h) do { _Pragma("unroll") for (int n = 0; n < 2; ++n) _Pragma("unroll") for (int k = 0; k < 2; ++k) dst[n][k] = *(const PG8_LAS bf16x8*)(lds + PG8_SB(b, h) + boff + n * 2048 + k * 1024); } while (0)
#define PG8_MMA(ai, bj, At, Bt) do { __builtin_amdgcn_s_setprio(1); _Pragma("unroll") for (int m = 0; m < 4; ++m) _Pragma("unroll") for (int n = 0; n < 2; ++n) _Pragma("unroll") for (int k = 0; k < 2; ++k) \
        acc[ai][bj][m][n] = __builtin_amdgcn_mfma_f32_16x16x32_bf16(Bt[n][k], At[m][k], acc[ai][bj][m][n], 0, 0, 0); __builtin_amdgcn_s_setprio(0); } while (0)
#define PG8_WAIT_V(n) asm volatile("s_waitcnt vmcnt(" #n ")" ::: "memory")
#define PG8_WAIT_L(n) asm volatile("s_waitcnt lgkmcnt(" #n ")" ::: "memory")
#define PG8_BAR __builtin_amdgcn_s_barrier()
#define PG8_SCHED __builtin_amdgcn_sched_barrier(0)
    Unit cur, nxt; int ui = 0;
    if (!S.next(0, cur)) return;
    Acc acc;
#pragma unroll
    for (int a = 0; a < 2; ++a)
#pragma unroll
        for (int b = 0; b < 2; ++b)
#pragma unroll
            for (int m = 0; m < 4; ++m)
#pragma unroll
                for (int n = 0; n < 2; ++n) acc[a][b][m][n] = (f32x4){0.f, 0.f, 0.f, 0.f};
    bf16x8 At[4][2], B0[2][2], B1[2][2];
    const char* cA = (const char*)g.A + (size_t)cur.pm * tstepA; const char* cB = (const char*)g.Bt + (size_t)cur.pn * tstepB;
    S.a_ready(cur);
    PG8_SCHED;
    const typename Epi::Raw raw0 = E.pre_load(cur, wr, fr, fq);
    PG8_STAGE(PG8_SB(0, 0), cB, voffB); PG8_STAGE(PG8_SB(0, 1), cB + hstepB, voffB); PG8_STAGE(PG8_SA(0, 0), cA, voffA); PG8_STAGE(PG8_SA(0, 1), cA + hstepA, voffA);
    PG8_SCHED; typename Epi::Pre pre = E.pre_finish(raw0); PG8_SCHED;
    if (wr == 1) PG8_BAR;
    PG8_WAIT_V(2); PG8_BAR;
    PG8_STAGE(PG8_SB(1, 0), cB + kstep, voffB); PG8_STAGE(PG8_SA(1, 0), cA + kstep, voffA); PG8_STAGE(PG8_SB(1, 1), cB + hstepB + kstep, voffB);
    PG8_WAIT_V(6); PG8_BAR;
    for (;;) {
        const bool has_next = S.next(ui + 1, nxt);
        const char* nA = has_next ? (const char*)g.A + (size_t)nxt.pm * tstepA : cA; const char* nB = has_next ? (const char*)g.Bt + (size_t)nxt.pn * tstepB : cB;
        for (int t = 0; t < nt; t += 2) {
            const bool last = (t == nt - 2);
            const char* a1 = cA + (size_t)(t + 1) * kstep;
            const char* a2 = last ? nA : cA + (size_t)(t + 2) * kstep; const char* b2 = last ? nB : cB + (size_t)(t + 2) * kstep;
            const char* a3 = a2 + kstep; const char* b3 = b2 + kstep;
            if (last && has_next) S.a_ready(nxt);
            if constexpr (Epi::HOOK) { E.hook(acc, cur, t, wr, wc, fr, fq); PG8_SCHED; }
            PG8_LDB(B0, 0, 0); PG8_LDB(B1, 0, 1); PG8_SCHED; PG8_LDA(At, 0, 0); PG8_STAGE(PG8_SA(1, 1), a1 + hstepA, voffA);
            PG8_WAIT_V(8); PG8_WAIT_L(0); PG8_BAR; PG8_MMA(0, 0, At, B0); PG8_MMA(0, 1, At, B1); PG8_BAR; PG8_SCHED;
            PG8_LDA(At, 0, 1); PG8_STAGE(PG8_SB(0, 0), b2, voffB); PG8_STAGE(PG8_SB(0, 1), b2 + hstepB, voffB); PG8_STAGE(PG8_SA(0, 0), a2, voffA);
            PG8_WAIT_V(8); PG8_WAIT_L(0); PG8_BAR; PG8_MMA(1, 0, At, B0); PG8_MMA(1, 1, At, B1); PG8_BAR; PG8_SCHED;
            PG8_LDB(B0, 1, 0); PG8_LDB(B1, 1, 1); PG8_SCHED; PG8_LDA(At, 1, 0); PG8_STAGE(PG8_SA(0, 1), a2 + hstepA, voffA);
            PG8_WAIT_V(8); PG8_WAIT_L(0); PG8_BAR; PG8_MMA(0, 0, At, B0); PG8_MMA(0, 1, At, B1); PG8_BAR; PG8_SCHED;
            PG8_LDA(At, 1, 1); PG8_STAGE(PG8_SB(1, 0), b3, voffB); PG8_STAGE(PG8_SB(1, 1), b3 + hstepB, voffB); PG8_STAGE(PG8_SA(1, 0), a3, voffA);
            PG8_WAIT_V(8); PG8_WAIT_L(0); PG8_BAR; PG8_MMA(1, 0, At, B0); PG8_MMA(1, 1, At, B1); PG8_BAR; PG8_SCHED;
        }
        if constexpr (ALIGN_EPI) { if (wr == 0) PG8_BAR; }
        pre = E(acc, cur, has_next ? nxt : cur, wr, wc, fr, fq, pre); S.done(cur); PG8_SCHED;
        if (!has_next) break;
#pragma unroll
        for (int a = 0; a < 2; ++a)
#pragma unroll
            for (int b = 0; b < 2; ++b)
#pragma unroll
                for (int m = 0; m < 4; ++m)
#pragma unroll
                    for (int n = 0; n < 2; ++n) acc[a][b][m][n] = (f32x4){0.f, 0.f, 0.f, 0.f};
        cur = nxt; cA = nA; cB = nB; ++ui;
        if constexpr (ALIGN_EPI) { if (wr == 1) PG8_BAR; }
    }
    PG8_WAIT_V(0);
    if constexpr (!ALIGN_EPI) { if (wr == 0) PG8_BAR; }
    PG8_BAR;
#undef PG8_SA
#undef PG8_SB
#undef PG8_STAGE
#undef PG8_LDA
#undef PG8_LDB
#undef PG8_MMA
#undef PG8_WAIT_V
#undef PG8_WAIT_L
#undef PG8_BAR
#undef PG8_SCHED
}
}

#define XB_TMO      128
#define XB_XCNT(j)  (256  + 64 * (j))
#define XB_XSUB(j)  (1280 + 64 * (j))
#define XB_XGEN(j)  (2304 + 64 * (j))
#define XB_TOP      3328
#define XB_TOPGEN   3392
#define XCD_BAR_WORDS 3456
#define XB_SPIN_CAP (1u << 18)
__device__ __forceinline__ unsigned xb_ld(unsigned* p)              { return __hip_atomic_load(p, __ATOMIC_RELAXED, __HIP_MEMORY_SCOPE_AGENT); }
__device__ __forceinline__ unsigned xb_add(unsigned* p, unsigned v) { return __hip_atomic_fetch_add(p, v, __ATOMIC_RELAXED, __HIP_MEMORY_SCOPE_AGENT); }
__device__ __forceinline__ unsigned xb_xcc_id() { return (unsigned)__builtin_amdgcn_s_getreg((3 << 11) | 20) & 0xFu; }
#define XB_SPIN(cond, bar) do { unsigned _sp = 0; while (cond) { __builtin_amdgcn_s_sleep(1); \
    if ((++_sp & 255u) == 0u) { if (xb_ld(&(bar)[XB_TMO])) break; if (_sp > XB_SPIN_CAP) { atomicAdd(&(bar)[XB_TMO], 1u); break; } } } } while (0)
struct XcdBarrier { unsigned* bar; unsigned x; volatile LAS unsigned* st; };
__device__ __forceinline__ XcdBarrier xcd_barrier_post(unsigned* bar, volatile LAS unsigned* st) {
    XcdBarrier b; b.bar = bar; b.x = xb_xcc_id(); b.st = st;
    if (threadIdx.x == 0) (void)xb_add(&bar[XB_XCNT(b.x)], 1u);
    return b;
}
__device__ __forceinline__ void xcd_barrier_complete(unsigned* bar, unsigned x, unsigned& nloc, unsigned& nx) {
    const unsigned G = gridDim.x * gridDim.y * gridDim.z;
    unsigned sum, cnt, mine, sp = 0u;
    for (;;) {
        sum = 0u; cnt = 0u; mine = 0u;
#pragma unroll
        for (unsigned j = 0; j < 16; ++j) { const unsigned c = xb_ld(&bar[XB_XCNT(j)]); sum += c; cnt += (c > 0u) ? 1u : 0u; mine = (j == x) ? c : mine; }
        if (sum == G) break;
        __builtin_amdgcn_s_sleep(1);
        if ((++sp & 255u) == 0u) { if (xb_ld(&bar[XB_TMO])) break; if (sp > XB_SPIN_CAP) { atomicAdd(&bar[XB_TMO], 1u); break; } }
    }
    nloc = mine > 0u ? mine : 1u; nx = cnt > 0u ? cnt : 1u;
}
__device__ __forceinline__ void xcd_barrier(const XcdBarrier& b) {
    asm volatile("s_waitcnt vmcnt(0)" ::: "memory");
    __syncthreads();
    if (threadIdx.x == 0) {
        unsigned* bar = b.bar;
        __builtin_amdgcn_s_waitcnt(0);
        unsigned nloc = b.st[0], nx = b.st[1];
        if (nloc == 0u) { xcd_barrier_complete(bar, b.x, nloc, nx); b.st[0] = nloc; b.st[1] = nx; }
        const unsigned old = xb_add(&bar[XB_XSUB(b.x)], 1u);
        const unsigned gen = old / nloc;
        if (old + 1u == (gen + 1u) * nloc) {
            __builtin_amdgcn_fence(__ATOMIC_RELEASE, "agent");
            asm volatile("s_waitcnt vmcnt(0)" ::: "memory");
            const unsigned og = xb_add(&bar[XB_TOP], 1u);
            const unsigned tg = og / nx;
            if (og + 1u == (tg + 1u) * nx) xb_add(&bar[XB_TOPGEN], 1u);
            else XB_SPIN(xb_ld(&bar[XB_TOPGEN]) == tg, bar);
            __builtin_amdgcn_fence(__ATOMIC_ACQUIRE, "agent");
            xb_add(&bar[XB_XGEN(b.x)], 1u);
            asm volatile("s_waitcnt vmcnt(0)" ::: "memory");
        } else {
            XB_SPIN(xb_ld(&bar[XB_XGEN(b.x)]) == gen, bar);
            __builtin_amdgcn_fence(__ATOMIC_ACQUIRE, "agent");
            asm volatile("s_waitcnt vmcnt(0)" ::: "memory");
        }
    }
    __syncthreads();
}

struct Args { const float* in[18]; float* out; unsigned char* ws; int ph_lo, ph_hi; };
struct Frame {
    LAS unsigned char* lds;
    int vcu, G;
    unsigned char* ws;
};
__device__ __forceinline__ int opaque_tid() { int t = threadIdx.x; asm volatile("" : "+v"(t)); return t; }
#define TID ((int)threadIdx.x)
#define WSP(T_, off) ((T_*)(F.ws + (off)))
#define LDS_WAIT() asm volatile("s_waitcnt lgkmcnt(0)" ::: "memory")

struct TrDesc { const float* W; const float* gain; bf16* dst; int Nsrc, srccol0, k0, Kdst; };
__device__ __forceinline__ void tr_load(const TrDesc& d, f32x4 (&v)[16], int lane) {
#pragma unroll
    for (int i = 0; i < 16; ++i) v[i] = *(const f32x4*)(d.W + (size_t)(d.k0 + 4 * i + (lane >> 4)) * d.Nsrc + d.srccol0 + 4 * (lane & 15));
}
__device__ __forceinline__ void tr_finish(const TrDesc& d, const f32x4 (&v)[16], LAS float* scr, int lane) {
#pragma unroll
    for (int i = 0; i < 16; ++i) { const int kk = 4 * i + (lane >> 4); f32x4 x = v[i]; if (d.gain) x = x * d.gain[d.k0 + kk]; *(LAS f32x4*)(scr + kk * 68 + 4 * (lane & 15)) = x; }
    LDS_WAIT(); asm volatile("" ::: "memory");
    const int c = lane & 7;
#pragma unroll
    for (int j = 0; j < 8; ++j) { const int n = (lane >> 3) + 8 * j; const LAS float* sp = scr + (8 * c) * 68 + n;
        u32x4 o; o.x = cvtpk(sp[0 * 68], sp[1 * 68]); o.y = cvtpk(sp[2 * 68], sp[3 * 68]); o.z = cvtpk(sp[4 * 68], sp[5 * 68]); o.w = cvtpk(sp[6 * 68], sp[7 * 68]);
        *(u32x4*)(d.dst + (size_t)n * d.Kdst + d.k0 + 8 * c) = o; }
    LDS_WAIT(); asm volatile("" ::: "memory");
}
__device__ __forceinline__ int in_srccol(int n0) {
    if (n0 < C_Q || n0 >= C_V) return n0;
    const int tile = n0 >> 8, within = n0 & 255, bj = within >> 7, w = within & 127, sec = (tile < 4) ? C_Q : C_K;
    return sec + (2 * (tile & 1) + (w >> 6)) * 128 + (w & 63) + 64 * bj;
}
__device__ __forceinline__ void rms_row_bf16(const float* xrow, bf16* orow, int lane) {
    const f32x4* xr = (const f32x4*)xrow + lane; f32x4 v[4]; float s = 0.f;
#pragma unroll
    for (int j = 0; j < 4; ++j) { v[j] = xr[64 * j]; s += (v[j].x * v[j].x + v[j].y * v[j].y) + (v[j].z * v[j].z + v[j].w * v[j].w); }
    const float r = rsqrtf(wave_sum(s) * (1.0f / DM) + EPS);
    u32x2* o = (u32x2*)orow + lane;
#pragma unroll
    for (int j = 0; j < 4; ++j) { u32x2 w; w.x = cvtpk(v[j].x * r, v[j].y * r); w.y = cvtpk(v[j].z * r, v[j].w * r); o[64 * j] = w; }
}
__device__ __forceinline__ void norm_rows(Frame& F, const float* X, bf16* XB, int nrows) {
    const int tid = opaque_tid(), lane = tid & 63, wave = __builtin_amdgcn_readfirstlane(tid >> 6), fr = lane & 15, fq = lane >> 4; (void)tid; (void)lane; (void)wave; (void)fr; (void)fq;
    const int gw = F.vcu * 8 + wave, NGW = F.G * 8;
    for (int m = gw; m < nrows; m += NGW) rms_row_bf16(X + (size_t)m * DM, XB + (size_t)m * DM, lane);
}
__device__ __forceinline__ void final_norm(Frame& F, float* out, const float* g) {
    const int tid = opaque_tid(), lane = tid & 63, wave = __builtin_amdgcn_readfirstlane(tid >> 6);
    const int gw = F.vcu * 8 + wave, NGW = F.G * 8;
    f32x4 gg[4];
#pragma unroll
    for (int j = 0; j < 4; ++j) gg[j] = *((const f32x4*)g + lane + 64 * j);
    for (int m = gw * 4; m < T; m += NGW * 4) {
        float p = WSP(float, WS_SSP)[(size_t)m * 16 + lane];
        u32x2 v[4][4];
#pragma unroll
        for (int r = 0; r < 4; ++r)
#pragma unroll
            for (int j = 0; j < 4; ++j) v[r][j] = ((const u32x2*)(WSP(bf16, WS_XB) + (size_t)(m + r) * DM) + lane)[64 * j];
        __builtin_amdgcn_sched_barrier(0);
        p += __int_as_float(__builtin_amdgcn_ds_swizzle(__float_as_int(p), SWZ_XOR(1)));
        p += __int_as_float(__builtin_amdgcn_ds_swizzle(__float_as_int(p), SWZ_XOR(2)));
        p += __int_as_float(__builtin_amdgcn_ds_swizzle(__float_as_int(p), SWZ_XOR(4)));
        p += __int_as_float(__builtin_amdgcn_ds_swizzle(__float_as_int(p), SWZ_XOR(8)));
        const float rinv = rsqrtf(p * (1.0f / DM) + EPS);
#pragma unroll
        for (int r = 0; r < 4; ++r) { const float rr = __int_as_float(__builtin_amdgcn_readlane(__float_as_int(rinv), 16 * r)); f32x4* o = (f32x4*)(out + (size_t)(m + r) * DM) + lane;
#pragma unroll
            for (int j = 0; j < 4; ++j) { const u32x2 x = v[r][j]; o[64 * j] = (f32x4){bflo(x.x) * rr * gg[j].x, bfhi(x.x) * rr * gg[j].y, bflo(x.y) * rr * gg[j].z, bfhi(x.y) * rr * gg[j].w}; } }
    }
}

__device__ __forceinline__ void p0_prologue(Frame& F, const Args& A) {
    const int tid = opaque_tid(), lane = tid & 63, wave = __builtin_amdgcn_readfirstlane(tid >> 6);
    LAS float* scr = (LAS float*)(F.lds + wave * 17408);
    const int gw = F.vcu * 8 + wave, NGW = F.G * 8;
    constexpr int I_IN = 16 * 112, I_MKV = 16 * 16, I_UR = 16 * 16, I_UM = 8 * 16, I_OUT = 16 * 16, I_1 = 16 * 64, I_2 = 64 * 16;
    constexpr int PER_L = I_IN + I_MKV + I_UR + I_UM + I_OUT + I_1 + I_2;
#define TR_DESC(d, it_) do { const int l_ = (it_) / PER_L; int r_ = (it_) % PER_L; unsigned char* wl_ = F.ws + WS_W + (size_t)l_ * W_LAYER; \
        if (r_ < I_IN) { const int kb = r_ / 112, nb = r_ % 112; d = TrDesc{A.in[4] + (size_t)l_ * DM * INC, A.in[3] + l_ * DM, (bf16*)(wl_ + WO_IN) + (size_t)(64 * nb) * DM, INC, in_srccol(64 * nb), 64 * kb, DM}; } \
        else if ((r_ -= I_IN) < I_MKV) { const int kb = r_ / 16, nb = r_ % 16; d = TrDesc{A.in[9] + (size_t)l_ * DM * 1024, A.in[8] + l_ * DM, (bf16*)(wl_ + WO_MKV) + (size_t)(64 * nb) * DM, 1024, 64 * nb, 64 * kb, DM}; } \
        else if ((r_ -= I_MKV) < I_UR) { const int kb = r_ / 16, nb = r_ % 16; d = TrDesc{A.in[11] + (size_t)l_ * 1024 * DM, A.in[7] + l_ * 1024, (bf16*)(wl_ + WO_UP) + (size_t)(64 * nb) * 2048 + 512, DM, 64 * nb, 64 * kb, 2048}; } \
        else if ((r_ -= I_UR) < I_UM) { const int kb = r_ / 16, nb = r_ % 16; d = TrDesc{A.in[12] + (size_t)l_ * 512 * DM, nullptr, (bf16*)(wl_ + WO_UP) + (size_t)(64 * nb) * 2048 + 1536, DM, 64 * nb, 64 * kb, 2048}; } \
        else if ((r_ -= I_UM) < I_OUT) { const int kb = r_ / 16, nb = r_ % 16; d = TrDesc{A.in[13] + (size_t)l_ * DM * DM, nullptr, (bf16*)(wl_ + WO_OUT) + (size_t)(64 * nb) * DM, DM, 64 * nb, 64 * kb, DM}; } \
        else if ((r_ -= I_OUT) < I_1) { const int kb = r_ / 64, nb = r_ % 64; d = TrDesc{A.in[15] + (size_t)l_ * DM * DFF, A.in[14] + l_ * DM, (bf16*)(wl_ + WO_1) + (size_t)(64 * nb) * DM, DFF, 64 * nb, 64 * kb, DM}; } \
        else { r_ -= I_1; const int kb = r_ / 16, nb = r_ % 16; d = TrDesc{A.in[16] + (size_t)l_ * DFF * DM, nullptr, (bf16*)(wl_ + WO_2) + (size_t)(64 * nb) * DFF, DM, 64 * nb, 64 * kb, DFF}; } } while (0)
    {
        TrDesc dA, dB; f32x4 vA[16], vB[16];
        int it = gw;
        if (it < 2 * PER_L) { TR_DESC(dA, it); tr_load(dA, vA, lane); }
        while (it < 2 * PER_L) {
            const int itB = it + NGW;
            if (itB < 2 * PER_L) { TR_DESC(dB, itB); tr_load(dB, vB, lane); }
            tr_finish(dA, vA, scr, lane);
            if (itB >= 2 * PER_L) break;
            const int itA = itB + NGW;
            if (itA < 2 * PER_L) { TR_DESC(dA, itA); tr_load(dA, vA, lane); }
            tr_finish(dB, vB, scr, lane);
            it = itA;
        }
    }
#undef TR_DESC
    const int gt = F.vcu * 512 + tid, NT = F.G * 512;
    {
        const float inv = (float)exp2(-(double)(gt & 63) * (13.287712379549449 / 64.0));
        const int* pos = (const int*)A.in[2];
        for (int i = gt; i < T * 64; i += NT) {
            const float a = (float)pos[i >> 6] * inv;
            const double ad = (double)a, k = rint(ad * 0.15915494309189535), rr = ad - k * 6.283185307179586;
            const float rf = (float)rr;
            WSP(float, WS_COS)[i] = cosf(rf); WSP(float, WS_SIN)[i] = sinf(rf);
        }
    }
    for (int m = gw * 4; m < T; m += NGW * 4) {
        f32x4 v[4][4];
#pragma unroll
        for (int r = 0; r < 4; ++r) { const f32x4* xr = (const f32x4*)(A.in[0] + (size_t)(m + r) * DM) + 2 * lane;
#pragma unroll
            for (int j = 0; j < 2; ++j) { v[r][2 * j] = xr[128 * j]; v[r][2 * j + 1] = xr[128 * j + 1]; } }
        __builtin_amdgcn_sched_barrier(0);
#pragma unroll
        for (int r = 0; r < 4; ++r) { float q = 0.f; u32x4* o = (u32x4*)(WSP(bf16, WS_XB) + (size_t)(m + r) * DM) + lane;
#pragma unroll
            for (int j = 0; j < 2; ++j) { const f32x4 a = v[r][2 * j], b2 = v[r][2 * j + 1]; q += ((a.x * a.x + a.y * a.y) + (a.z * a.z + a.w * a.w)) + ((b2.x * b2.x + b2.y * b2.y) + (b2.z * b2.z + b2.w * b2.w));
                u32x4 w; w.x = cvtpk(a.x, a.y); w.y = cvtpk(a.z, a.w); w.z = cvtpk(b2.x, b2.y); w.w = cvtpk(b2.z, b2.w); o[64 * j] = w; }
            q = wave_sum(q);
            if (lane < 16) WSP(float, WS_SSP)[(size_t)(m + r) * 16 + lane] = (lane == 0) ? q : 0.f; }
    }
    norm_rows(F, A.in[1], WSP(bf16, WS_MEMN), NB * NMEM);
    __syncthreads();
    LAS float* PW = (LAS float*)F.lds;
    LAS float* WU = (LAS float*)(F.lds + 128 * 129 * 4);
    for (int it = F.vcu; it < 2 * 4 * 32; it += F.G) {
        const int l = it >> 7, g = (it >> 5) & 3, n0 = (it & 31) * 32;
        const float* pw = A.in[5] + ((size_t)l * 512 + g * 128) * 128; const float* ps = A.in[6] + l * 512 + g * 128; const float* wu = A.in[10] + ((size_t)l * 512 + g * 128) * DM + n0;
        for (int i = tid; i < 128 * 128; i += 512) { const int c = i >> 7, cp = i & 127; PW[c * 129 + cp] = pw[i] * ps[cp]; }
        for (int i = tid; i < 128 * 8; i += 512) { const int cp = i >> 3, q = i & 7; *(LAS f32x4*)(WU + cp * 32 + 4 * q) = *(const f32x4*)(wu + (size_t)cp * DM + 4 * q); }
        __syncthreads();
        const int c = tid & 127, nq = tid >> 7;
        f32x4 s0 = {0.f, 0.f, 0.f, 0.f}, s1 = {0.f, 0.f, 0.f, 0.f};
#pragma unroll 8
        for (int cp = 0; cp < 128; ++cp) { const float p = PW[c * 129 + cp]; s0 += p * *(LAS f32x4*)(WU + cp * 32 + 8 * nq); s1 += p * *(LAS f32x4*)(WU + cp * 32 + 8 * nq + 4); }
        bf16* dst = (bf16*)(F.ws + WS_W + (size_t)l * W_LAYER + WO_UP) + (size_t)(n0 + 8 * nq) * 2048 + g * 128 + c;
#pragma unroll
        for (int j = 0; j < 4; ++j) { dst[(size_t)j * 2048] = (bf16)(cvtpk(s0[j], 0.f) & 0xffffu); dst[(size_t)(4 + j) * 2048] = (bf16)(cvtpk(s1[j], 0.f) & 0xffffu); }
        __syncthreads();
    }
}

__device__ __forceinline__ bf16x8 frag_tr(LAS unsigned char* Tt, int ldb, int rowA, int rowB, int col0, int fr) {
#if USE_TR
    const int q = fr >> 2, p = fr & 3;
    const s16x4 lo = __builtin_bit_cast(s16x4, __builtin_amdgcn_ds_read_tr16_b64_v4i16((LAS v4i16_t*)(Tt + (rowA + q) * ldb + (col0 + 4 * p) * 2)));
    const s16x4 hi = __builtin_bit_cast(s16x4, __builtin_amdgcn_ds_read_tr16_b64_v4i16((LAS v4i16_t*)(Tt + (rowB + q) * ldb + (col0 + 4 * p) * 2)));
    return __builtin_shufflevector(lo, hi, 0, 1, 2, 3, 4, 5, 6, 7);
#else
    bf16x8 f;
#pragma unroll
    for (int e = 0; e < 4; ++e) { f[e] = *(LAS short*)(Tt + (rowA + e) * ldb + (col0 + fr) * 2); f[4 + e] = *(LAS short*)(Tt + (rowB + e) * ldb + (col0 + fr) * 2); }
    return f;
#endif
}
__device__ __forceinline__ bf16x8 pack8(const f32x4& a, const f32x4& b) { u32x4 w; w.x = cvtpk(a[0], a[1]); w.y = cvtpk(a[2], a[3]); w.z = cvtpk(b[0], b[1]); w.w = cvtpk(b[2], b[3]); return __builtin_bit_cast(bf16x8, w); }
__device__ __forceinline__ float log2gamma(int h) { return log2f(1.0f - exp2f(-5.0f - (float)h)); }

__device__ __forceinline__ void mem_kv_proj(Frame& F) {
    const int tid = opaque_tid(), lane = tid & 63, wave = __builtin_amdgcn_readfirstlane(tid >> 6), fr = lane & 15, fq = lane >> 4;
    LAS unsigned char* As = F.lds; LAS unsigned char* Bs = F.lds + 33792;
    const int wm = wave & 3, wn = wave >> 2;
    for (int it = F.vcu; it < 512; it += F.G) {
        const int l = it >> 8, tm = (it >> 4) & 15, tn = it & 15;
        const bf16* Ag = WSP(bf16, WS_MEMN) + (size_t)(tm * 64) * DM; const bf16* Bg = WSP(bf16, WS_W + (size_t)l * W_LAYER + WO_MKV) + (size_t)(tn * 64) * DM;
        f32x4 acc[2]; acc[0] = (f32x4){0.f, 0.f, 0.f, 0.f}; acc[1] = (f32x4){0.f, 0.f, 0.f, 0.f};
        for (int kc = 0; kc < 4; ++kc) {
            __syncthreads();
#pragma unroll
            for (int k = 0; k < 4; ++k) { const int c = tid + 512 * k, r = c >> 5, ch = c & 31;
                *(LAS u32x4*)(As + r * 528 + ch * 16) = *(const u32x4*)(Ag + (size_t)r * DM + kc * 256 + ch * 8);
                *(LAS u32x4*)(Bs + r * 528 + ch * 16) = *(const u32x4*)(Bg + (size_t)r * DM + kc * 256 + ch * 8); }
            __syncthreads();
#pragma unroll
            for (int ks = 0; ks < 8; ++ks) { const bf16x8 af = *(LAS bf16x8*)(As + (16 * wm + fr) * 528 + (32 * ks + 8 * fq) * 2);
#pragma unroll
                for (int c = 0; c < 2; ++c) acc[c] = mfma16(*(LAS bf16x8*)(Bs + (32 * wn + 16 * c + fr) * 528 + (32 * ks + 8 * fq) * 2), af, acc[c]); }
        }
        bf16* dst = WSP(bf16, WS_KVMEM) + (size_t)l * 1024 * 1024 + (size_t)(tm * 64 + 16 * wm + fr) * 1024 + tn * 64 + 32 * wn + 4 * fq;
#pragma unroll
        for (int c = 0; c < 2; ++c) { u32x2 w; w.x = cvtpk(acc[c][0], acc[c][1]); w.y = cvtpk(acc[c][2], acc[c][3]); *(u32x2*)(dst + 16 * c) = w; }
    }
    __syncthreads();
}

template <int W> __device__ __forceinline__ void pool_item(bf16* P, int tl0, int c0) {
    const int pos0 = tl0 & (SEQ - 1);
    u32x4 r[W + 7];
#pragma unroll
    for (int i = 0; i < W + 7; ++i) { r[i] = (u32x4){0u, 0u, 0u, 0u}; if (pos0 - (W - 1) + i >= 0) r[i] = *(const u32x4*)(P + (size_t)(tl0 - (W - 1) + i) * PLD + c0); }
    float s[8];
#pragma unroll
    for (int e = 0; e < 8; ++e) s[e] = 0.f;
#pragma unroll
    for (int i = 0; i < W - 1; ++i)
#pragma unroll
        for (int e = 0; e < 4; ++e) { s[2 * e] += bflo(r[i][e]); s[2 * e + 1] += bfhi(r[i][e]); }
#pragma unroll
    for (int tt = 0; tt < 8; ++tt) {
        const int pos = pos0 + tt; const float rc = 1.0f / (float)((pos + 1 < W) ? pos + 1 : W);
        float d[8];
#pragma unroll
        for (int e = 0; e < 4; ++e) { const float u0 = bflo(r[W - 1 + tt][e]), u1 = bfhi(r[W - 1 + tt][e]); s[2 * e] += u0; s[2 * e + 1] += u1; d[2 * e] = s[2 * e] * rc - u0; d[2 * e + 1] = s[2 * e + 1] * rc - u1; }
        u32x4 o; o.x = cvtpk(d[0], d[1]); o.y = cvtpk(d[2], d[3]); o.z = cvtpk(d[4], d[5]); o.w = cvtpk(d[6], d[7]);
        *(u32x4*)(P + (size_t)(tl0 + tt) * PLD + C_DP + c0) = o;
#pragma unroll
        for (int e = 0; e < 4; ++e) { s[2 * e] -= bflo(r[tt][e]); s[2 * e + 1] -= bfhi(r[tt][e]); }
    }
}
__device__ __forceinline__ void mix_pool(Frame& F) {
    const int tid = opaque_tid(), lane = tid & 63, wave = __builtin_amdgcn_readfirstlane(tid >> 6);
    bf16* P = WSP(bf16, WS_PROJ);
    const int gw = F.vcu * 8 + wave, NGW = F.G * 8;
    for (int it = gw; it < 4 * (TH / 32); it += NGW) {
        const int g = it & 3, tl0 = (it >> 2) * 32 + (lane >> 4) * 8, c0 = g * 128 + (lane & 15) * 8;
        if (g == 0) pool_item<2>(P, tl0, c0); else if (g == 1) pool_item<4>(P, tl0, c0); else if (g == 2) pool_item<8>(P, tl0, c0); else pool_item<16>(P, tl0, c0);
    }
}

__device__ __forceinline__ void mix_mem(Frame& F, int l, int hf, bool dummy) {
    const int tid = opaque_tid(), lane = tid & 63, wave = __builtin_amdgcn_readfirstlane(tid >> 6), fr = lane & 15, fq = lane >> 4; (void)tid; (void)lane; (void)wave; (void)fr; (void)fq;
    bf16* P = WSP(bf16, WS_PROJ);
    LAS unsigned char* Kt = F.lds; LAS unsigned char* Vt = F.lds + 69632;
    const int items = 8 * 64, ipw = (items + F.G - 1) / F.G;
    const int it_lo = F.vcu * ipw, it_hi = (it_lo + ipw < items) ? it_lo + ipw : items;
    int loaded = -1;
    for (int it = it_lo; it < it_hi; ++it) {
        const int combo = it >> 6, qt = it & 63, bl = combo >> 2, h = combo & 3;
        if (combo != loaded) {
            __syncthreads();
            const bf16* src = WSP(bf16, WS_KVMEM) + (size_t)l * 1024 * 1024 + (size_t)((2 * hf + bl) * NMEM) * 1024 + h * 128;
            for (int c = tid; c < 4096; c += 512) { const int key = c >> 4, ch = c & 15;
                *(LAS u32x4*)(Kt + key * 272 + ch * 16) = *(const u32x4*)(src + (size_t)key * 1024 + ch * 8);
                *(LAS u32x4*)(Vt + key * 272 + ch * 16) = *(const u32x4*)(src + (size_t)key * 1024 + 512 + ch * 8); }
            __syncthreads(); loaded = combo;
        }
        bf16* qp = P + (size_t)(bl * SEQ + qt * 128 + wave * 16 + fr) * PLD + C_XQ + h * 128;
        bf16x8 bq[4];
#pragma unroll
        for (int ks = 0; ks < 4; ++ks) bq[ks] = *(const bf16x8*)(qp + ks * 32 + fq * 8);
        f32x4 s[16];
#pragma unroll
        for (int kt = 0; kt < 16; ++kt) { s[kt] = (f32x4){0.f, 0.f, 0.f, 0.f};
#pragma unroll
            for (int ks = 0; ks < 4; ++ks) s[kt] = mfma16(*(LAS bf16x8*)(Kt + (16 * kt + fr) * 272 + (32 * ks + 8 * fq) * 2), bq[ks], s[kt]); }
        float mx = -3.0e38f;
#pragma unroll
        for (int kt = 0; kt < 16; ++kt) mx = fmaxf(fmaxf(fmaxf(s[kt][0], s[kt][1]), fmaxf(s[kt][2], s[kt][3])), mx);
        mx = max_xor16(mx); mx = max_xor32(mx);
        float lsum = 0.f;
#pragma unroll
        for (int kt = 0; kt < 16; ++kt)
#pragma unroll
            for (int r = 0; r < 4; ++r) { const float p = exp2f(s[kt][r] - mx); s[kt][r] = p; lsum += p; }
        lsum = add_xor16(lsum); lsum = add_xor32(lsum);
        const float rl = 1.0f / lsum;
        f32x4 o[8];
#pragma unroll
        for (int dt = 0; dt < 8; ++dt) o[dt] = (f32x4){0.f, 0.f, 0.f, 0.f};
#pragma unroll
        for (int kp = 0; kp < 8; ++kp) { const bf16x8 pf = pack8(s[2 * kp], s[2 * kp + 1]);
#pragma unroll
            for (int dt = 0; dt < 8; ++dt) o[dt] = mfma16(frag_tr(Vt, 272, 32 * kp + 4 * fq, 32 * kp + 16 + 4 * fq, 16 * dt, fr), pf, o[dt]); }
        bf16* op = (dummy ? WSP(bf16, WS_MERGED) + (size_t)(bl * SEQ + qt * 128 + wave * 16 + fr) * 512 + h * 128 : qp) + 16 * (fq & 1) + 4 * (fq & 2);
#pragma unroll
        for (int p = 0; p < 4; ++p) { const unsigned ax = cvtpk(o[2 * p][0] * rl, o[2 * p][1] * rl), ay = cvtpk(o[2 * p][2] * rl, o[2 * p][3] * rl), bx_ = cvtpk(o[2 * p + 1][0] * rl, o[2 * p + 1][1] * rl), by = cvtpk(o[2 * p + 1][2] * rl, o[2 * p + 1][3] * rl);
            auto rx = __builtin_amdgcn_permlane16_swap(ax, bx_, false, false); auto ry = __builtin_amdgcn_permlane16_swap(ay, by, false, false);
            u32x4 w; w.x = rx[0]; w.y = ry[0]; w.z = rx[1]; w.w = ry[1]; *(u32x4*)(op + 32 * p) = w; }
    }
    __syncthreads();
}

__device__ __forceinline__ void mix_kv(Frame& F) {
    const int tid = opaque_tid(), lane = tid & 63, wave = __builtin_amdgcn_readfirstlane(tid >> 6), fr = lane & 15, fq = lane >> 4; (void)tid; (void)lane; (void)wave; (void)fr; (void)fq;
    bf16* P = WSP(bf16, WS_PROJ);
    LAS unsigned char* Kd = F.lds; LAS unsigned char* Vt = F.lds + 34816;
    for (int un = F.vcu; un < 512; un += F.G) {
        const int h = un & 3, n = (un >> 2) & 63, bl = un >> 8; const size_t row0 = (size_t)bl * SEQ + n * 128; const float lg = log2gamma(h);
        __syncthreads();
        for (int c = tid; c < 2048; c += 512) { const int j = c >> 4, ch = c & 15; const u32x4 v = *(const u32x4*)(P + (row0 + j) * PLD + C_K + h * 128 + ch * 8); const float f = exp2f((float)(127 - j) * lg);
            u32x4 o; o.x = cvtpk(bflo(v.x) * f, bfhi(v.x) * f); o.y = cvtpk(bflo(v.y) * f, bfhi(v.y) * f); o.z = cvtpk(bflo(v.z) * f, bfhi(v.z) * f); o.w = cvtpk(bflo(v.w) * f, bfhi(v.w) * f);
            *(LAS u32x4*)(Kd + j * 272 + ch * 16) = o; }
        for (int c = tid; c < 4096; c += 512) { const int j = c >> 5, ch = c & 31; *(LAS u32x4*)(Vt + j * 528 + ch * 16) = *(const u32x4*)(P + (row0 + j) * PLD + C_V + h * 256 + ch * 8); }
        __syncthreads();
        f32x4 acc[8][2];
#pragma unroll
        for (int dt = 0; dt < 8; ++dt) { acc[dt][0] = (f32x4){0.f, 0.f, 0.f, 0.f}; acc[dt][1] = (f32x4){0.f, 0.f, 0.f, 0.f}; }
#pragma unroll
        for (int ks = 0; ks < 4; ++ks) { const int rA = 32 * ks + 8 * fq, rB = rA + 4;
            const bf16x8 bv0 = frag_tr(Vt, 528, rA, rB, 16 * (2 * wave), fr), bv1 = frag_tr(Vt, 528, rA, rB, 16 * (2 * wave + 1), fr);
#pragma unroll
            for (int dt = 0; dt < 8; ++dt) { const bf16x8 ad = frag_tr(Kd, 272, rA, rB, 16 * dt, fr); acc[dt][0] = mfma16(ad, bv0, acc[dt][0]); acc[dt][1] = mfma16(ad, bv1, acc[dt][1]); } }
        bf16* dst = WSP(bf16, WS_KVN) + (size_t)un * 32768 + 16 * (fq & 1) + 4 * (fq & 2);
#pragma unroll
        for (int vi = 0; vi < 2; ++vi)
#pragma unroll
            for (int p = 0; p < 4; ++p) { const f32x4 a = acc[2 * p][vi], b = acc[2 * p + 1][vi];
                const unsigned ax = cvtpk(a[0], a[1]), ay = cvtpk(a[2], a[3]), bx_ = cvtpk(b[0], b[1]), by = cvtpk(b[2], b[3]);
                auto rx = __builtin_amdgcn_permlane16_swap(ax, bx_, false, false); auto ry = __builtin_amdgcn_permlane16_swap(ay, by, false, false);
                u32x4 o; o.x = rx[0]; o.y = ry[0]; o.z = rx[1]; o.w = ry[1];
                *(u32x4*)(dst + (size_t)(16 * (2 * wave + vi) + fr) * 128 + 32 * p) = o; }
    }
    __syncthreads();
}

__device__ __forceinline__ void scan_states(Frame& F) {
    const int tid = opaque_tid(), lane = tid & 63, wave = __builtin_amdgcn_readfirstlane(tid >> 6), fr = lane & 15, fq = lane >> 4; (void)tid; (void)lane; (void)wave; (void)fr; (void)fq;
    const bf16* KV = WSP(bf16, WS_KVN); bf16* SP = WSP(bf16, WS_SPREV);
    if (tid < 256)
    for (int p = F.vcu * 256 + tid; p < 8 * 8192; p += F.G * 256) {
        const int blk = p >> 13, bl = blk >> 2, h = blk & 3, off = (p & 8191) * 4; const float cd = exp2f(128.0f * log2gamma(h));
        f32x4 st = {0.f, 0.f, 0.f, 0.f};
        for (int n0 = 0; n0 < 64; n0 += 8) {
            u32x2 kv[8];
#pragma unroll
            for (int j = 0; j < 8; ++j) kv[j] = *(const u32x2*)(KV + (size_t)((bl * 64 + n0 + j) * 4 + h) * 32768 + off);
#pragma unroll
            for (int j = 0; j < 8; ++j) { u32x2 w; w.x = cvtpk(st[0], st[1]); w.y = cvtpk(st[2], st[3]); *(u32x2*)(SP + (size_t)((bl * 64 + n0 + j) * 4 + h) * 32768 + off) = w;
                st = st * cd + (f32x4){bflo(kv[j].x), bfhi(kv[j].x), bflo(kv[j].y), bfhi(kv[j].y)}; }
        }
    }
}

__device__ __forceinline__ void ret_out(Frame& F, bool dummy) {
    const int tid = opaque_tid(), lane = tid & 63, wave = __builtin_amdgcn_readfirstlane(tid >> 6), fr = lane & 15, fq = lane >> 4; (void)tid; (void)lane; (void)wave; (void)fr; (void)fq;
    bf16* P = WSP(bf16, WS_PROJ);
    LAS unsigned char* Kt = F.lds; LAS unsigned char* Vt = F.lds + 34816; LAS unsigned char* Sp = F.lds + 102400;
    for (int un = F.vcu; un < 512; un += F.G) {
        const int h = un & 3, n = (un >> 2) & 63, bl = un >> 8; const size_t row0 = (size_t)bl * SEQ + n * 128; const float lg = log2gamma(h);
        const bf16* spg = WSP(bf16, WS_SPREV) + (size_t)un * 32768;
        const int i = wave * 16 + fr; const size_t trow = row0 + i;
        bf16x8 bq[4];
#pragma unroll
        for (int ks = 0; ks < 4; ++ks) bq[ks] = *(const bf16x8*)(P + trow * PLD + C_Q + h * 128 + ks * 32 + fq * 8);
        bf16* gp = P + trow * PLD + C_G + h * 256 + 4 * fq;
        __syncthreads();
        for (int c = tid; c < 2048; c += 512) { const int j = c >> 4, ch = c & 15;
            *(LAS u32x4*)(Kt + j * 272 + ch * 16) = *(const u32x4*)(P + (row0 + j) * PLD + C_K + h * 128 + ch * 8);
            *(LAS u32x4*)(Sp + j * 272 + ch * 16) = *(const u32x4*)(spg + (size_t)j * 128 + ch * 8); }
        for (int c = tid; c < 4096; c += 512) { const int j = c >> 5, ch = c & 31; *(LAS u32x4*)(Vt + j * 528 + ch * 16) = *(const u32x4*)(P + (row0 + j) * PLD + C_V + h * 256 + ch * 8); }
        u32x4 sp1[4];
#pragma unroll
        for (int k = 0; k < 4; ++k) { const int c = tid + 512 * k, j = c >> 4, ch = c & 15; sp1[k] = *(const u32x4*)(spg + (size_t)(128 + j) * 128 + ch * 8); }
        __syncthreads();
        f32x4 acc[16];
#pragma unroll
        for (int vt = 0; vt < 8; ++vt) { acc[vt] = (f32x4){0.f, 0.f, 0.f, 0.f};
#pragma unroll
            for (int ks = 0; ks < 4; ++ks) acc[vt] = mfma16(*(LAS bf16x8*)(Sp + (16 * vt + fr) * 272 + (32 * ks + 8 * fq) * 2), bq[ks], acc[vt]); }
        __syncthreads();
#pragma unroll
        for (int k = 0; k < 4; ++k) { const int c = tid + 512 * k, j = c >> 4, ch = c & 15; *(LAS u32x4*)(Sp + j * 272 + ch * 16) = sp1[k]; }
        __syncthreads();
#pragma unroll
        for (int vt = 8; vt < 16; ++vt) { acc[vt] = (f32x4){0.f, 0.f, 0.f, 0.f};
#pragma unroll
            for (int ks = 0; ks < 4; ++ks) acc[vt] = mfma16(*(LAS bf16x8*)(Sp + (16 * (vt - 8) + fr) * 272 + (32 * ks + 8 * fq) * 2), bq[ks], acc[vt]); }
        bf16* gq = P + trow * PLD + C_G + h * 256 + 16 * (fq & 1) + 4 * (fq & 2);
        u32x4 gl[8];
#pragma unroll
        for (int p = 0; p < 8; ++p) gl[p] = *(const u32x4*)(gq + 32 * p);
        const float fac = exp2f((float)(i + 1) * lg);
#pragma unroll
        for (int vt = 0; vt < 16; ++vt) acc[vt] = acc[vt] * fac;
        f32x4 s[8];
#pragma unroll
        for (int kt = 0; kt < 8; ++kt) { s[kt] = (f32x4){0.f, 0.f, 0.f, 0.f};
            if (kt <= wave) {
#pragma unroll
                for (int ks = 0; ks < 4; ++ks) s[kt] = mfma16(*(LAS bf16x8*)(Kt + (16 * kt + fr) * 272 + (32 * ks + 8 * fq) * 2), bq[ks], s[kt]);
#pragma unroll
                for (int r = 0; r < 4; ++r) { const int key = 16 * kt + 4 * fq + r; s[kt][r] = (key <= i) ? s[kt][r] * exp2f((float)(i - key) * lg) : 0.f; } } }
#pragma unroll
        for (int kp = 0; kp < 4; ++kp) if (2 * kp <= wave) { const bf16x8 pf = pack8(s[2 * kp], s[2 * kp + 1]);
#pragma unroll
            for (int vt = 0; vt < 16; ++vt) acc[vt] = mfma16(frag_tr(Vt, 528, 32 * kp + 4 * fq, 32 * kp + 16 + 4 * fq, 16 * vt, fr), pf, acc[vt]); }
        float ss = 0.f;
#pragma unroll
        for (int vt = 0; vt < 16; ++vt) ss += (acc[vt][0] * acc[vt][0] + acc[vt][1] * acc[vt][1]) + (acc[vt][2] * acc[vt][2] + acc[vt][3] * acc[vt][3]);
        ss = add_xor16(ss); ss = add_xor32(ss);
        const float rinv = rsqrtf(ss * (1.0f / 256.0f) + EPS);
#pragma unroll
        for (int p = 0; p < 8; ++p) {
            u32x2 g[2];
            { auto rx = __builtin_amdgcn_permlane16_swap(gl[p][0], gl[p][2], false, false); auto ry = __builtin_amdgcn_permlane16_swap(gl[p][1], gl[p][3], false, false);
              g[0].x = rx[0]; g[0].y = ry[0]; g[1].x = rx[1]; g[1].y = ry[1]; }
            u32x2 w[2];
#pragma unroll
            for (int j = 0; j < 2; ++j) { const int vt = 2 * p + j; const float g0 = bflo(g[j].x), g1 = bfhi(g[j].x), g2 = bflo(g[j].y), g3 = bfhi(g[j].y);
                w[j].x = cvtpk(acc[vt][0] * rinv * g0 * sigmoidf_(g0), acc[vt][1] * rinv * g1 * sigmoidf_(g1)); w[j].y = cvtpk(acc[vt][2] * rinv * g2 * sigmoidf_(g2), acc[vt][3] * rinv * g3 * sigmoidf_(g3)); }
            u32x4 o;
            { auto rx = __builtin_amdgcn_permlane16_swap(w[0].x, w[1].x, false, false); auto ry = __builtin_amdgcn_permlane16_swap(w[0].y, w[1].y, false, false);
              o.x = rx[0]; o.y = ry[0]; o.z = rx[1]; o.w = ry[1]; }
            *(u32x4*)((dummy ? WSP(bf16, WS_MERGED) + trow * 1024 + h * 256 + 16 * (fq & 1) + 4 * (fq & 2) : gq) + 32 * p) = o; }
    }
    __syncthreads();
}

constexpr int N_PHASES = 2 + 2 * 16 + 1;
__global__ void __launch_bounds__(512, 2) fwd_kernel(Args args) {
    extern __shared__ __attribute__((aligned(16))) unsigned char lds_raw[];
    Frame F;
    F.lds = (LAS unsigned char*)lds_raw;
    F.G = gridDim.x; { const int bx = blockIdx.x; F.vcu = (F.G % 8 == 0) ? (bx % 8) * (F.G / 8) + bx / 8 : bx; }
    F.ws = args.ws;
    const Args& A = args;
    for (int u = TID; u < (LDS_BYTES - LDSCTL_OFF) / 4; u += 512) ((LAS unsigned*)(F.lds + LDSCTL_OFF))[u] = 0u;
    __syncthreads();
    const int lo = args.ph_lo, hi = args.ph_hi;
    XcdBarrier bar; bar.bar = WSP(unsigned, WS_CTL) + CW_BAR; bar.x = 0; bar.st = nullptr;
    if (hi - lo > 1) bar = xcd_barrier_post(WSP(unsigned, WS_CTL) + CW_BAR, (volatile LAS unsigned*)(F.lds + MISC_OFF) + 8);
    int ph = 0;
#define RUN() (lo <= ph && ph < hi)
#define END_PHASE() do { if (RUN() && ph + 1 < hi) xcd_barrier(bar); ++ph; } while (0)
    const int bx = (int)blockIdx.x;

    if (RUN()) for (int rep = 0; rep < REPS(10); ++rep) { if (rep) xcd_barrier(bar); p0_prologue(F, A); }
    END_PHASE();
    if (RUN()) for (int rep = 0; rep < REPS(11); ++rep) { if (rep) xcd_barrier(bar); mem_kv_proj(F); }
    END_PHASE();
#pragma unroll 1
    for (int l = 0; l < 2; ++l) {
        unsigned char* wl = F.ws + WS_W + (size_t)l * W_LAYER;
#pragma unroll 1
        for (int hf = 0; hf < 2; ++hf) {
            const int t0 = hf * TH;
            if (RUN()) for (int rep = 0; rep < REPS(0); ++rep) { if (rep) xcd_barrier(bar);
                pg8::Gemm g{WSP(bf16, WS_XB) + (size_t)t0 * DM, (const bf16*)(wl + WO_IN)};
                pg8::StaticOrder<TH, 4096> S; S.init(F.G, bx);
                pg8::EpiBf<2> E{WSP(bf16, WS_PROJ), PLD, WSP(float, WS_COS), WSP(float, WS_SIN), t0, WSP(float, WS_SSP)};
                pg8::gemm_phase<DM, DM, DM, pg8::EpiBf<2>, pg8::StaticOrder<TH, 4096>>(F.lds, g, S, E);
            }
            END_PHASE();
            if (RUN()) for (int rep = 0; rep < REPS(1); ++rep) { if (rep) xcd_barrier(bar); mix_pool(F); mix_mem(F, l, hf, rep != 0); mix_kv(F); }
            END_PHASE();
            if (RUN()) for (int rep = 0; rep < REPS(2); ++rep) { if (rep) xcd_barrier(bar); scan_states(F); }
            END_PHASE();
            if (RUN()) for (int rep = 0; rep < REPS(3); ++rep) { if (rep) xcd_barrier(bar); ret_out(F, rep != 0); }
            END_PHASE();
            if (RUN()) for (int rep = 0; rep < REPS(4); ++rep) { if (rep) xcd_barrier(bar);
                pg8::Gemm g{WSP(bf16, WS_XB) + (size_t)t0 * DM, (const bf16*)(wl + WO_IN) + (size_t)4096 * DM};
                pg8::StaticOrder<TH, 3072> S; S.init(F.G, bx);
                pg8::EpiBf<3> E{WSP(bf16, WS_GATES), 3072, nullptr, nullptr, t0, WSP(float, WS_SSP)};
                pg8::gemm_phase<DM, DM, DM, pg8::EpiBf<3>, pg8::StaticOrder<TH, 3072>>(F.lds, g, S, E);
            }
            END_PHASE();
            if (RUN()) for (int rep = 0; rep < REPS(5); ++rep) { if (rep) xcd_barrier(bar);
                pg8::Gemm g{WSP(bf16, WS_PROJ) + C_DP, (const bf16*)(wl + WO_UP)};
                pg8::StaticOrder<TH, DM> S; S.init(F.G, bx);
                pg8::EpiUp E{WSP(bf16, WS_MERGED), WSP(bf16, WS_GATES)};
                pg8::gemm_phase<2048, PLD, 2048, pg8::EpiUp, pg8::StaticOrder<TH, DM>>(F.lds, g, S, E);
            }
            END_PHASE();
            if (RUN()) for (int rep = 0; rep < REPS(6); ++rep) { if (rep) xcd_barrier(bar);
                pg8::Gemm g{WSP(bf16, WS_MERGED), (const bf16*)(wl + WO_OUT)};
                pg8::StaticOrder<TH, DM> S; S.init(F.G, bx);
                pg8::EpiRes E{WSP(bf16, WS_XB) + (size_t)t0 * DM, WSP(float, WS_SSP) + (size_t)t0 * 16, rep ? WSP(bf16, WS_KVN) : nullptr};
                pg8::gemm_phase<DM, DM, DM, pg8::EpiRes, pg8::StaticOrder<TH, DM>>(F.lds, g, S, E);
            }
            END_PHASE();
        }
        if (RUN()) for (int rep = 0; rep < REPS(8); ++rep) { if (rep) xcd_barrier(bar);
            pg8::Gemm g{WSP(bf16, WS_XB), (const bf16*)(wl + WO_1)};
            pg8::StaticOrder<T, DFF> S; S.init(F.G, bx);
            pg8::EpiBf<1> E{WSP(bf16, WS_U), DFF, nullptr, nullptr, 0, WSP(float, WS_SSP)};
            pg8::gemm_phase<DM, DM, DM, pg8::EpiBf<1>, pg8::StaticOrder<T, DFF>>(F.lds, g, S, E);
        }
        END_PHASE();
        if (RUN()) {
            pg8::Gemm g{WSP(bf16, WS_U), (const bf16*)(wl + WO_2)};
            pg8::StaticOrder<T, DM> S; S.init(F.G, bx);
            pg8::EpiRes E{WSP(bf16, WS_XB), WSP(float, WS_SSP), nullptr};
            pg8::gemm_phase<DFF, DFF, DFF, pg8::EpiRes, pg8::StaticOrder<T, DM>>(F.lds, g, S, E);
#if (PROBE_DUP >> 9) & 1
            xcd_barrier(bar);
            { pg8::StaticOrder<TH, DM> S2; S2.init(F.G, bx); pg8::EpiRes E2{WSP(bf16, WS_XB), WSP(float, WS_SSP), (bf16*)(F.ws + WS_END)};
              pg8::gemm_phase<DFF, DFF, DFF, pg8::EpiRes, pg8::StaticOrder<TH, DM>>(F.lds, g, S2, E2); }
#endif
        }
        END_PHASE();
        if (l == 1) { if (RUN()) final_norm(F, A.out, A.in[17]); END_PHASE(); }
#if (PROBE_DUP >> 12) & 1
        for (int rep = 0; rep < 8; ++rep) xcd_barrier(bar);
#endif
    }
#undef RUN
#undef END_PHASE
}

extern "C" void kernel_launch(void* const* d_in, const int* in_sizes, int n_in, void* d_out, int out_size, void* d_ws, size_t ws_size, hipStream_t stream) {
    static int grid = 0;
    if (grid == 0) {
        if (n_in != 18 || in_sizes[0] != T * DM || out_size != T * DM || ws_size < WS_END) { fprintf(stderr, "kernel_launch: unexpected shapes / workspace (n_in %d, ws %zu)\n", n_in, ws_size); grid = -1; return; }
        int dev = 0, cus = 0, per_cu = 0;
        if (hipGetDevice(&dev) != hipSuccess || hipDeviceGetAttribute(&cus, hipDeviceAttributeMultiprocessorCount, dev) != hipSuccess) { grid = -1; return; }
        if (hipFuncSetAttribute((const void*)fwd_kernel, hipFuncAttributeMaxDynamicSharedMemorySize, LDS_BYTES) != hipSuccess) { fprintf(stderr, "kernel_launch: hipFuncSetAttribute failed\n"); grid = -1; return; }
        if (hipOccupancyMaxActiveBlocksPerMultiprocessor(&per_cu, (const void*)fwd_kernel, 512, LDS_BYTES) != hipSuccess || per_cu < 1) { fprintf(stderr, "kernel_launch: occupancy query says %d\n", per_cu); (void)hipGetLastError(); grid = -1; return; }
        grid = cus;
    }
    if (grid < 0) return;
    (void)hipMemsetAsync((char*)d_ws + WS_CTL, 0, CTL_ZERO_BYTES, stream);
    Args a{};
    for (int i = 0; i < 18; ++i) a.in[i] = (const float*)d_in[i];
    a.out = (float*)d_out; a.ws = (unsigned char*)d_ws;
#if MK_SINGLE
    a.ph_lo = 0; a.ph_hi = N_PHASES;
    hipLaunchKernelGGL(fwd_kernel, dim3(grid), dim3(512), LDS_BYTES, stream, a);
#else
    for (int p = 0; p < N_PHASES; ++p) { a.ph_lo = p; a.ph_hi = p + 1; hipLaunchKernelGGL(fwd_kernel, dim3(grid), dim3(512), LDS_BYTES, stream, a); }
#endif
}
```

```cpp
#include <hip/hip_runtime.h>
#include <cstdio>
#include <cstdint>

#ifndef MK_SINGLE
#define MK_SINGLE 1
#endif
#ifndef PROBE_DUP
#define PROBE_DUP 0
#endif
#define REPS(k) (1 + ((PROBE_DUP >> (k)) & 1))
#ifndef USE_TR
#define USE_TR 1
#endif

#define LAS __attribute__((address_space(3)))
#define GAS __attribute__((address_space(1)))
typedef unsigned short bf16;
typedef short bf16x8 __attribute__((ext_vector_type(8)));
typedef short s16x4 __attribute__((ext_vector_type(4)));
typedef float f32x4 __attribute__((ext_vector_type(4)));
typedef float f32x2 __attribute__((ext_vector_type(2)));
typedef unsigned u32x4 __attribute__((ext_vector_type(4)));
typedef unsigned u32x2 __attribute__((ext_vector_type(2)));
typedef __bf16 bf16x2_t __attribute__((ext_vector_type(2)));
typedef short v4i16_t __attribute__((ext_vector_type(4)));

constexpr int DM = 1024, NB = 4, SEQ = 8192, T = NB * SEQ, TH = T / 2, NMEM = 256, DFF = 4096;
constexpr int INC = 7168;
constexpr int PLD = 4608;
constexpr int C_Q = 512, C_K = 1024, C_V = 1536, C_DP = 2560, C_G = 3072, C_XQ = 4096;
constexpr float EPS = 1e-6f;
constexpr float XQ_SCALE = 0.08838834764831845f * 1.4426950408889634f;
constexpr float LOG2E = 1.4426950408889634f;
constexpr float K_SCALE = 0.08838834764831845f;

constexpr size_t MiB = 1u << 20;
constexpr size_t WS_CTL = 0, CTL_ZERO_BYTES = 1 * MiB;
constexpr size_t WS_COS = 2 * MiB, WS_SIN = 10 * MiB;
constexpr size_t WS_SSP = 18 * MiB;
constexpr size_t WS_MEMN = 20 * MiB;
constexpr size_t WS_KVMEM = 24 * MiB;
constexpr size_t WS_W = 32 * MiB, W_LAYER = 38 * MiB;
constexpr size_t WO_IN = 0, WO_UP = 14 * MiB, WO_OUT = 18 * MiB, WO_1 = 20 * MiB, WO_2 = 28 * MiB, WO_MKV = 36 * MiB;
constexpr size_t WS_XB = 108 * MiB;
constexpr size_t WS_MERGED = 172 * MiB;
constexpr size_t WS_PROJ = 204 * MiB;
constexpr size_t WS_KVN = 348 * MiB;
constexpr size_t WS_SPREV = 412 * MiB;
constexpr size_t WS_GATES = 348 * MiB;
constexpr size_t WS_U = 172 * MiB;
constexpr size_t WS_END = 444 * MiB;
static_assert(WS_W + 2 * W_LAYER <= WS_XB && WS_U + (size_t)T * DFF * 2 <= WS_END && WS_PROJ + (size_t)TH * PLD * 2 <= WS_KVN, "ws map");
constexpr int CW_TMO = 0, CW_BAR = 4096;

constexpr int RING_BYTES = 131072, SCRATCH_BYTES = 147456, LDSCTL_OFF = SCRATCH_BYTES, MISC_OFF = LDSCTL_OFF + 320, LDS_BYTES = SCRATCH_BYTES + 1024;

__device__ __forceinline__ unsigned cvtpk(float lo, float hi) { f32x2 v = {lo, hi}; bf16x2_t b = __builtin_convertvector(v, bf16x2_t); return __builtin_bit_cast(unsigned, b); }
__device__ __forceinline__ float bflo(unsigned u) { return __uint_as_float(u << 16); }
__device__ __forceinline__ float bfhi(unsigned u) { return __uint_as_float(u & 0xffff0000u); }
__device__ __forceinline__ f32x4 mfma16(bf16x8 a, bf16x8 b, f32x4 c) { return __builtin_amdgcn_mfma_f32_16x16x32_bf16(a, b, c, 0, 0, 0); }
#define SWZ_XOR(m) (((m) << 10) | 0x1f)
__device__ __forceinline__ float wave_sum(float v) {
    v += __int_as_float(__builtin_amdgcn_ds_swizzle(__float_as_int(v), SWZ_XOR(1)));
    v += __int_as_float(__builtin_amdgcn_ds_swizzle(__float_as_int(v), SWZ_XOR(2)));
    v += __int_as_float(__builtin_amdgcn_ds_swizzle(__float_as_int(v), SWZ_XOR(4)));
    v += __int_as_float(__builtin_amdgcn_ds_swizzle(__float_as_int(v), SWZ_XOR(8)));
    { auto r = __builtin_amdgcn_permlane16_swap(__float_as_uint(v), __float_as_uint(v), false, false); v = __uint_as_float(r[0]) + __uint_as_float(r[1]); }
    { auto r = __builtin_amdgcn_permlane32_swap(__float_as_uint(v), __float_as_uint(v), false, false); v = __uint_as_float(r[0]) + __uint_as_float(r[1]); }
    return v;
}
__device__ __forceinline__ float add_xor16(float v) { auto r = __builtin_amdgcn_permlane16_swap(__float_as_uint(v), __float_as_uint(v), false, false); return __uint_as_float(r[0]) + __uint_as_float(r[1]); }
__device__ __forceinline__ float add_xor32(float v) { auto r = __builtin_amdgcn_permlane32_swap(__float_as_uint(v), __float_as_uint(v), false, false); return __uint_as_float(r[0]) + __uint_as_float(r[1]); }
__device__ __forceinline__ float max_xor16(float v) { auto r = __builtin_amdgcn_permlane16_swap(__float_as_uint(v), __float_as_uint(v), false, false); return fmaxf(__uint_as_float(r[0]), __uint_as_float(r[1])); }
__device__ __forceinline__ float max_xor32(float v) { auto r = __builtin_amdgcn_permlane32_swap(__float_as_uint(v), __float_as_uint(v), false, false); return fmaxf(__uint_as_float(r[0]), __uint_as_float(r[1])); }
__device__ __forceinline__ float sigmoidf_(float x) { return 1.0f / (1.0f + __expf(-x)); }

namespace pg8 {
#define PG8_LAS __attribute__((address_space(3)))
typedef unsigned short bf16_t;
constexpr int BM = 256, BK = 64, HALF = 128, HTB = HALF * BK * 2, STAGE_BYTES = 8 * HTB, NXCD = 8, WGM = 8;
__host__ __device__ __forceinline__ int lds_byte(int r, int c) { const int st = (r >> 4) * 2 + (c >> 5), rr = r & 15, cc = c & 31, ob = rr * 64 + cc * 2; return st * 1024 + (ob ^ (((ob >> 9) & 1) << 5)); }
__host__ __device__ __forceinline__ void stage_rc(int b, int& R, int& C) { const int st = b / 1024, sb = b % 1024, swz = sb ^ (((sb >> 9) & 1) << 5); R = (st >> 1) * 16 + swz / 64; C = (st & 1) * 32 + (swz % 64) / 2; }
__host__ __device__ __forceinline__ int perm32(int rho) { const int n = rho >> 4, i = rho & 15; return 8 * (i >> 2) + 4 * n + (i & 3); }

struct Unit { int pm, pn; };
struct Gemm { const bf16_t* A; const bf16_t* Bt; };

template <int M_, int N_> struct StaticOrder {
    static constexpr int nM = M_ / BM, nN = N_ / BM, nwg = nM * nN;
    int G, c;
    __host__ __device__ void init(int G_, int c_) { G = G_; c = c_; }
    __host__ __device__ bool next(int i, Unit& u) const {
        const long L = (long)i * G + c; if (L >= nwg) return false;
        int wgid = (int)L; { const int q = nwg / NXCD, r = nwg % NXCD, xcd = wgid % NXCD, off = wgid / NXCD; wgid = (xcd < r ? xcd * (q + 1) : r * (q + 1) + (xcd - r) * q) + off; }
        const int nig = WGM * nN, gid = wgid / nig, fm = gid * WGM, gsz = (nM - fm) < WGM ? (nM - fm) : WGM;
        u.pm = fm + ((wgid % nig) % gsz); u.pn = (wgid % nig) / gsz; return true;
    }
    __device__ __forceinline__ void a_ready(const Unit&) const {}
    __device__ __forceinline__ void done(const Unit&) const {}
};

typedef f32x4 Acc[2][2][4][2];

template <int MODE> struct EpiBf {
    static constexpr bool PERM = true, AFTER_DRAIN = false, HOOK = false, EARLY_PRE = (MODE != 2);
    bf16_t* O; int ldc; const float* cosT; const float* sinT; int t0; const float* ssp;
    __device__ __forceinline__ void hook(Acc&, const Unit&, int, int, int, int, int) const {}
    struct Pre { float rs[2][4]; };
    struct Raw { f32x4 v[2][4]; };
    __device__ __forceinline__ Raw pre_load(const Unit& u, int wr, int fr, int fq) const {
        Raw r; const float* p = ssp + (size_t)(t0 + u.pm * BM + wr * 64) * 16 + (unsigned)(fr * 16 + 4 * fq);
#pragma unroll
        for (int ai = 0; ai < 2; ++ai)
#pragma unroll
            for (int m = 0; m < 4; ++m) r.v[ai][m] = *(const f32x4*)(p + (size_t)(ai * HALF + m * 16) * 16);
        __builtin_amdgcn_sched_barrier(0);
        return r;
    }
    __device__ __forceinline__ Pre pre_finish(const Raw& r) const {
        Pre p;
#pragma unroll
        for (int ai = 0; ai < 2; ++ai)
#pragma unroll
            for (int m = 0; m < 4; ++m) { const f32x4 v = r.v[ai][m]; float q = (v[0] + v[1]) + (v[2] + v[3]); q = add_xor16(q); q = add_xor32(q); p.rs[ai][m] = rsqrtf(q * (1.0f / DM) + EPS); }
        return p;
    }
    __device__ __forceinline__ Pre operator()(const Acc& acc, const Unit& u, const Unit& un, int wr, int wc, int fr_in, int fq_in, const Pre& pr) const {
        int fr = fr_in, fq = fq_in; asm volatile("" : "+v"(fr), "+v"(fq));
        if (MODE == 2 && u.pn >= 2 && u.pn < 6) {
            const int sec = (u.pn < 4) ? C_Q : C_K, head = 2 * (u.pn & 1) + (wc >> 1);
            const float ksc0 = (u.pn >= 4) ? K_SCALE : 1.0f;
            const int rowu = u.pm * BM + wr * 64, dcolu = sec + head * 128 + 32 * (wc & 1);
            const unsigned toff = (unsigned)(fr * 64 + 8 * fq), ooff = (unsigned)(fr * ldc + 8 * fq);
#pragma unroll
            for (int am = 0; am < 8; am += 2) {
                f32x4 cs[2][4];
#pragma unroll
                for (int j = 0; j < 2; ++j) { const size_t tr = (size_t)(t0 + rowu + ((am + j) >> 2) * HALF + ((am + j) & 3) * 16) * 64 + 32 * (wc & 1); const float* cp = cosT + tr; const float* sp = sinT + tr;
                    cs[j][0] = *(const f32x4*)(cp + toff); cs[j][1] = *(const f32x4*)(cp + toff + 4); cs[j][2] = *(const f32x4*)(sp + toff); cs[j][3] = *(const f32x4*)(sp + toff + 4); }
                __builtin_amdgcn_sched_barrier(0);
#pragma unroll
                for (int j = 0; j < 2; ++j) { const int ai = (am + j) >> 2, m = (am + j) & 3;
                    const float ksc = ksc0 * pr.rs[ai][m];
                    const f32x4 c0 = cs[j][0], c1 = cs[j][1], s0 = cs[j][2], s1 = cs[j][3];
                    const f32x4 a0 = acc[ai][0][m][0], a1 = acc[ai][0][m][1], b0 = acc[ai][1][m][0], b1 = acc[ai][1][m][1];
                    const f32x4 o10 = (a0 * c0 - b0 * s0) * ksc, o11 = (a1 * c1 - b1 * s1) * ksc, o20 = (b0 * c0 + a0 * s0) * ksc, o21 = (b1 * c1 + a1 * s1) * ksc;
                    bf16_t* rowp = O + (size_t)(rowu + ai * HALF + m * 16) * ldc + dcolu;
                    u32x4 w1, w2; w1.x = cvtpk(o10[0], o10[1]); w1.y = cvtpk(o10[2], o10[3]); w1.z = cvtpk(o11[0], o11[1]); w1.w = cvtpk(o11[2], o11[3]);
                    w2.x = cvtpk(o20[0], o20[1]); w2.y = cvtpk(o20[2], o20[3]); w2.z = cvtpk(o21[0], o21[1]); w2.w = cvtpk(o21[2], o21[3]);
                    *(u32x4*)(rowp + ooff) = w1; *(u32x4*)(rowp + ooff + 64) = w2;
                }
                __builtin_amdgcn_sched_barrier(0); }
            return pre_finish(pre_load(un, wr, fr, fq));
        }
        int cbase = u.pn * BM; float sc = 1.0f;
        if (MODE == 2) { const int pn = u.pn; if (pn < 2) cbase = 256 * pn; else if (pn < 10) cbase = C_V + 256 * (pn - 6); else if (pn < 14) cbase = C_G + 256 * (pn - 10); else { cbase = C_XQ + 256 * (pn - 14); sc = XQ_SCALE; } }
        const unsigned loff = (unsigned)(fr * ldc + 8 * fq);
        const Raw raw = pre_load(un, wr, fr, fq);
        const bool inv = u.pn < 4;
        Pre pn;
#pragma unroll
        for (int ai = 0; ai < 2; ++ai) {
            u32x4 w[4][2];
#pragma unroll
            for (int m = 0; m < 4; ++m)
#pragma unroll
                for (int bj = 0; bj < 2; ++bj) { f32x4 v0 = acc[ai][bj][m][0], v1 = acc[ai][bj][m][1];
                    { const float f = (MODE == 3 ? -LOG2E : sc) * pr.rs[ai][m]; v0 = v0 * f; v1 = v1 * f; }
                    if (MODE == 3) {
#pragma unroll
                        for (int e = 0; e < 4; ++e) { v0[e] = 1.0f + __builtin_amdgcn_exp2f(fminf(fmaxf(v0[e], -80.f), 80.f)); v1[e] = 1.0f + __builtin_amdgcn_exp2f(fminf(fmaxf(v1[e], -80.f), 80.f)); }
                        if (inv) {
#pragma unroll
                            for (int e = 0; e < 4; ++e) { v0[e] = __builtin_amdgcn_rcpf(v0[e]); v1[e] = __builtin_amdgcn_rcpf(v1[e]); } } }
                    if (MODE == 1) { v0 = __builtin_elementwise_max(v0, (f32x4){0.f, 0.f, 0.f, 0.f}); v1 = __builtin_elementwise_max(v1, (f32x4){0.f, 0.f, 0.f, 0.f}); v0 = v0 * v0; v1 = v1 * v1; }
                    w[m][bj].x = cvtpk(v0[0], v0[1]); w[m][bj].y = cvtpk(v0[2], v0[3]); w[m][bj].z = cvtpk(v1[0], v1[1]); w[m][bj].w = cvtpk(v1[2], v1[3]); }
            if (ai == 0) pn = pre_finish(raw);
            __builtin_amdgcn_sched_barrier(0);
#pragma unroll
            for (int m = 0; m < 4; ++m) { bf16_t* rowu = O + (size_t)(u.pm * BM + wr * 64 + ai * HALF + m * 16) * ldc + cbase + wc * 32;
#pragma unroll
                for (int bj = 0; bj < 2; ++bj) *(u32x4*)(rowu + loff + bj * HALF) = w[m][bj]; }
            __builtin_amdgcn_sched_barrier(0); }
        return pn;
    }
};
struct EpiRes {
    static constexpr bool PERM = true, AFTER_DRAIN = false, HOOK = false, EARLY_PRE = false;
    struct Pre {}; struct Raw {};
    __device__ __forceinline__ Raw pre_load(const Unit&, int, int, int) const { return Raw{}; }
    __device__ __forceinline__ Pre pre_finish(const Raw&) const { return Pre{}; }
    bf16_t* X; float* ssp; bf16_t* dummy;
    __device__ __forceinline__ void hook(Acc&, const Unit&, int, int, int, int, int) const {}
    __device__ __forceinline__ Pre operator()(const Acc& acc, const Unit& u, const Unit&, int wr, int wc, int fr, int fq, const Pre&) const {
        const unsigned loff = (unsigned)((wr * 64 + fr) * 1024 + u.pn * BM + wc * 32 + 8 * fq);
        const bf16_t* Xu = X + (size_t)u.pm * BM * 1024; bf16_t* Yu = (dummy ? dummy : X) + (size_t)u.pm * BM * 1024;
        u32x4 xb[2][4][2];
#pragma unroll
        for (int ai = 0; ai < 2; ++ai)
#pragma unroll
            for (int m = 0; m < 4; ++m)
#pragma unroll
                for (int bj = 0; bj < 2; ++bj) xb[ai][m][bj] = *(const u32x4*)(Xu + (size_t)(ai * HALF + m * 16) * 1024 + loff + bj * HALF);
        __builtin_amdgcn_sched_barrier(0);
#pragma unroll
        for (int ai = 0; ai < 2; ++ai)
#pragma unroll
            for (int m = 0; m < 4; ++m) { float q = 0.f;
#pragma unroll
                for (int bj = 0; bj < 2; ++bj) { const u32x4 b = xb[ai][m][bj];
                    f32x4 x0 = acc[ai][bj][m][0], x1 = acc[ai][bj][m][1];
                    x0[0] += bflo(b[0]); x0[1] += bfhi(b[0]); x0[2] += bflo(b[1]); x0[3] += bfhi(b[1]); x1[0] += bflo(b[2]); x1[1] += bfhi(b[2]); x1[2] += bflo(b[3]); x1[3] += bfhi(b[3]);
                    q += ((x0[0] * x0[0] + x0[1] * x0[1]) + (x0[2] * x0[2] + x0[3] * x0[3])) + ((x1[0] * x1[0] + x1[1] * x1[1]) + (x1[2] * x1[2] + x1[3] * x1[3]));
                    u32x4 w; w.x = cvtpk(x0[0], x0[1]); w.y = cvtpk(x0[2], x0[3]); w.z = cvtpk(x1[0], x1[1]); w.w = cvtpk(x1[2], x1[3]);
                    *(u32x4*)(Yu + (size_t)(ai * HALF + m * 16) * 1024 + loff + bj * HALF) = w; }
                q = add_xor16(q); q = add_xor32(q);
                if (fq == 0 && !dummy) ssp[(size_t)(u.pm * BM + wr * 64 + fr + ai * HALF + m * 16) * 16 + 4 * u.pn + wc] = q; }
        return Pre{};
    }
};
struct EpiUp {
    static constexpr bool PERM = true, AFTER_DRAIN = false, HOOK = true, EARLY_PRE = false;
    struct Pre {}; struct Raw {};
    __device__ __forceinline__ Raw pre_load(const Unit&, int, int, int) const { return Raw{}; }
    __device__ __forceinline__ Pre pre_finish(const Raw&) const { return Pre{}; }
    bf16_t* O; const bf16_t* G;
    __device__ __forceinline__ void hook(Acc& acc, const Unit& u, int t, int wr, int wc, int fr, int fq) const {
        if (t != 8 && t != 24) return;
        const int gsel = (t == 8) ? 0 : 1024;
        int fr_ = fr, fq_ = fq; asm volatile("" : "+v"(fr_), "+v"(fq_));
        const int row0 = u.pm * BM + wr * 64 + fr_, col0 = u.pn * BM + wc * 32 + 8 * fq_;
        const bf16_t* gbase = G + (size_t)row0 * 3072 + gsel + col0;
        u32x4 ga[4][2], gb[4][2];
#pragma unroll
        for (int m = 0; m < 4; ++m)
#pragma unroll
            for (int bj = 0; bj < 2; ++bj) { const bf16_t* gp = gbase + (size_t)(m * 16) * 3072 + bj * HALF; ga[m][bj] = *(const u32x4*)gp; gb[m][bj] = *(const u32x4*)(gp + 1024); }
        __builtin_amdgcn_sched_barrier(0);
#pragma unroll
        for (int ai = 0; ai < 2; ++ai)
#pragma unroll
            for (int m = 0; m < 4; ++m)
#pragma unroll
                for (int bj = 0; bj < 2; ++bj) { float r[8];
#pragma unroll
                    for (int e = 0; e < 4; ++e) { const float a0 = bflo(ga[m][bj][e]), a1 = bfhi(ga[m][bj][e]), b0 = bflo(gb[m][bj][e]), b1 = bfhi(gb[m][bj][e]);
                        if (t == 8) { r[2 * e] = a0 * b0; r[2 * e + 1] = a1 * b1; }
                        else { r[2 * e] = b0 * __builtin_amdgcn_rcpf(a0); r[2 * e + 1] = b1 * __builtin_amdgcn_rcpf(a1); } }
                    if (ai == 0) { const bf16_t* gp = gbase + (size_t)(HALF + m * 16) * 3072 + bj * HALF; ga[m][bj] = *(const u32x4*)gp; gb[m][bj] = *(const u32x4*)(gp + 1024); }
                    f32x4 v0 = acc[ai][bj][m][0], v1 = acc[ai][bj][m][1];
                    v0[0] *= r[0]; v0[1] *= r[1]; v0[2] *= r[2]; v0[3] *= r[3]; v1[0] *= r[4]; v1[1] *= r[5]; v1[2] *= r[6]; v1[3] *= r[7];
                    acc[ai][bj][m][0] = v0; acc[ai][bj][m][1] = v1;
                    __builtin_amdgcn_sched_barrier(0); }
    }
    __device__ __forceinline__ Pre operator()(const Acc& acc, const Unit& u, const Unit&, int wr, int wc, int fr, int fq, const Pre&) const {
        const int row0 = u.pm * BM + wr * 64 + fr, col0 = u.pn * BM + wc * 32 + 8 * fq;
        u32x4 g3[2][4][2];
#pragma unroll
        for (int ai = 0; ai < 2; ++ai)
#pragma unroll
            for (int m = 0; m < 4; ++m)
#pragma unroll
                for (int bj = 0; bj < 2; ++bj) g3[ai][m][bj] = *(const u32x4*)(G + (size_t)(row0 + ai * HALF + m * 16) * 3072 + 2048 + col0 + bj * HALF);
        __builtin_amdgcn_sched_barrier(0);
#pragma unroll
        for (int ai = 0; ai < 2; ++ai)
#pragma unroll
            for (int m = 0; m < 4; ++m) { const int row = row0 + ai * HALF + m * 16; bf16_t* rowp = O + (size_t)row * 1024 + col0;
#pragma unroll
                for (int bj = 0; bj < 2; ++bj) { const u32x4 gc = g3[ai][m][bj];
                    const f32x4 v0 = acc[ai][bj][m][0], v1 = acc[ai][bj][m][1];
#define UP_S3(x) __builtin_amdgcn_rcpf(x)
                    u32x4 w; w.x = cvtpk(v0[0] * UP_S3(bflo(gc[0])), v0[1] * UP_S3(bfhi(gc[0]))); w.y = cvtpk(v0[2] * UP_S3(bflo(gc[1])), v0[3] * UP_S3(bfhi(gc[1])));
                    w.z = cvtpk(v1[0] * UP_S3(bflo(gc[2])), v1[1] * UP_S3(bfhi(gc[2]))); w.w = cvtpk(v1[2] * UP_S3(bflo(gc[3])), v1[3] * UP_S3(bfhi(gc[3])));
#undef UP_S3
                    *(u32x4*)(rowp + bj * HALF) = w; } }
        return Pre{};
    }
};

template <int K, int LDA, int LDB, class Epi, class Sched, bool ALIGN_EPI = true>
__device__ __forceinline__ void gemm_phase(PG8_LAS unsigned char* lds, const Gemm g, const Sched& S, const Epi& E) {
    int tid_ = threadIdx.x; asm volatile("" : "+v"(tid_));
    const int tid = tid_, wid = __builtin_amdgcn_readfirstlane(tid >> 6), lane = tid & 63, wr = wid >> 2, wc = wid & 3, fr = lane & 15, fq = lane >> 4;
    constexpr int nt = K / BK;
    unsigned voffA[2], voffB[2];
#pragma unroll
    for (int i = 0; i < 2; ++i) { int R, C; stage_rc(tid * 16 + i * 8192, R, C); const int Rb = Epi::PERM ? ((R & ~31) + perm32(R & 31)) : R;
        voffA[i] = (unsigned)(R * LDA + C) * 2u; voffB[i] = (unsigned)(Rb * LDB + C) * 2u; }
    constexpr size_t kstep = (size_t)(BK * 2);
    constexpr size_t hstepA = (size_t)HALF * LDA * 2, hstepB = (size_t)HALF * LDB * 2;
    constexpr size_t tstepA = 2 * hstepA, tstepB = 2 * hstepB;
    const unsigned ldsw = (unsigned)wid * 1024u;
    const int aoff = lds_byte(wr * 64 + fr, fq * 8), boff = lds_byte(wc * 32 + fr, fq * 8);
#define PG8_SA(b, h) (((b) * 2 + (h)) * HTB)
#define PG8_SB(b, h) ((4 + (b) * 2 + (h)) * HTB)
#define PG8_STAGE(bufoff, gbase, voff) do { _Pragma("unroll") for (int _i = 0; _i < 2; ++_i) \
        __builtin_amdgcn_global_load_lds((const unsigned*)((const char*)(gbase) + (voff)[_i]), (PG8_LAS unsigned*)(lds + (bufoff) + ldsw + _i * 8192), 16, 0, 0); } while (0)
#define PG8_LDA(dst, b, h) do { _Pragma("unroll") for (int m = 0; m < 4; ++m) _Pragma("unroll") for (int k = 0; k < 2; ++k) dst[m][k] = *(const PG8_LAS bf16x8*)(lds + PG8_SA(b, h) + aoff + m * 2048 + k * 1024); } while (0)
#define PG8_LDB(dst, b, h) do { _Pragma("unroll") for (int n = 0; n < 2; ++n) _Pragma("unroll") for (int k = 0; k < 2; ++k) dst[n][k] = *(const PG8_LAS bf16x8*)(lds + PG8_SB(b, h) + boff + n * 2048 + k * 1024); } while (0)
#define PG8_MMA(ai, bj, At, Bt) do { __builtin_amdgcn_s_setprio(1); _Pragma("unroll") for (int m = 0; m < 4; ++m) _Pragma("unroll") for (int n = 0; n < 2; ++n) _Pragma("unroll") for (int k = 0; k < 2; ++k) \
        acc[ai][bj][m][n] = __builtin_amdgcn_mfma_f32_16x16x32_bf16(Bt[n][k], At[m][k], acc[ai][bj][m][n], 0, 0, 0); __builtin_amdgcn_s_setprio(0); } while (0)
#define PG8_WAIT_V(n) asm volatile("s_waitcnt vmcnt(" #n ")" ::: "memory")
#define PG8_WAIT_L(n) asm volatile("s_waitcnt lgkmcnt(" #n ")" ::: "memory")
#define PG8_BAR __builtin_amdgcn_s_barrier()
#define PG8_SCHED __builtin_amdgcn_sched_barrier(0)
    Unit cur, nxt; int ui = 0;
    if (!S.next(0, cur)) return;
    Acc acc;
#pragma unroll
    for (int a = 0; a < 2; ++a)
#pragma unroll
        for (int b = 0; b < 2; ++b)
#pragma unroll
            for (int m = 0; m < 4; ++m)
#pragma unroll
                for (int n = 0; n < 2; ++n) acc[a][b][m][n] = (f32x4){0.f, 0.f, 0.f, 0.f};
    bf16x8 At[4][2], B0[2][2], B1[2][2];
    const char* cA = (const char*)g.A + (size_t)cur.pm * tstepA; const char* cB = (const char*)g.Bt + (size_t)cur.pn * tstepB;
    S.a_ready(cur);
    PG8_SCHED;
    const typename Epi::Raw raw0 = E.pre_load(cur, wr, fr, fq);
    PG8_STAGE(PG8_SB(0, 0), cB, voffB); PG8_STAGE(PG8_SB(0, 1), cB + hstepB, voffB); PG8_STAGE(PG8_SA(0, 0), cA, voffA); PG8_STAGE(PG8_SA(0, 1), cA + hstepA, voffA);
    PG8_SCHED; typename Epi::Pre pre = E.pre_finish(raw0); PG8_SCHED;
    if (wr == 1) PG8_BAR;
    PG8_WAIT_V(2); PG8_BAR;
    PG8_STAGE(PG8_SB(1, 0), cB + kstep, voffB); PG8_STAGE(PG8_SA(1, 0), cA + kstep, voffA); PG8_STAGE(PG8_SB(1, 1), cB + hstepB + kstep, voffB);
    PG8_WAIT_V(6); PG8_BAR;
    for (;;) {
        const bool has_next = S.next(ui + 1, nxt);
        const char* nA = has_next ? (const char*)g.A + (size_t)nxt.pm * tstepA : cA; const char* nB = has_next ? (const char*)g.Bt + (size_t)nxt.pn * tstepB : cB;
        for (int t = 0; t < nt; t += 2) {
            const bool last = (t == nt - 2);
            const char* a1 = cA + (size_t)(t + 1) * kstep;
            const char* a2 = last ? nA : cA + (size_t)(t + 2) * kstep; const char* b2 = last ? nB : cB + (size_t)(t + 2) * kstep;
            const char* a3 = a2 + kstep; const char* b3 = b2 + kstep;
            if (last && has_next) S.a_ready(nxt);
            if constexpr (Epi::HOOK) { E.hook(acc, cur, t, wr, wc, fr, fq); PG8_SCHED; }
            PG8_LDB(B0, 0, 0); PG8_LDB(B1, 0, 1); PG8_SCHED; PG8_LDA(At, 0, 0); PG8_STAGE(PG8_SA(1, 1), a1 + hstepA, voffA);
            PG8_WAIT_V(8); PG8_WAIT_L(0); PG8_BAR; PG8_MMA(0, 0, At, B0); PG8_MMA(0, 1, At, B1); PG8_BAR; PG8_SCHED;
            PG8_LDA(At, 0, 1); PG8_STAGE(PG8_SB(0, 0), b2, voffB); PG8_STAGE(PG8_SB(0, 1), b2 + hstepB, voffB); PG8_STAGE(PG8_SA(0, 0), a2, voffA);
            PG8_WAIT_V(8); PG8_WAIT_L(0); PG8_BAR; PG8_MMA(1, 0, At, B0); PG8_MMA(1, 1, At, B1); PG8_BAR; PG8_SCHED;
            PG8_LDB(B0, 1, 0); PG8_LDB(B1, 1, 1); PG8_SCHED; PG8_LDA(At, 1, 0); PG8_STAGE(PG8_SA(0, 1), a2 + hstepA, voffA);
            PG8_WAIT_V(8); PG8_WAIT_L(0); PG8_BAR; PG8_MMA(0, 0, At, B0); PG8_MMA(0, 1, At, B1); PG8_BAR; PG8_SCHED;
            PG8_LDA(At, 1, 1); PG8_STAGE(PG8_SB(1, 0), b3, voffB); PG8_STAGE(PG8_SB(1, 1), b3 + hstepB, voffB); PG8_STAGE(PG8_SA(1, 0), a3, voffA);
            PG8_WAIT_V(8); PG8_WAIT_L(0); PG8_BAR; PG8_MMA(1, 0, At, B0); PG8_MMA(1, 1, At, B1); PG8_BAR; PG8_SCHED;
        }
        if constexpr (ALIGN_EPI) { if (wr == 0) PG8_BAR; }
        pre = E(acc, cur, has_next ? nxt : cur, wr, wc, fr, fq, pre); S.done(cur); PG8_SCHED;
        if (!has_next) break;
#pragma unroll
        for (int a = 0; a < 2; ++a)
#pragma unroll
            for (int b = 0; b < 2; ++b)
#pragma unroll
                for (int m = 0; m < 4; ++m)
#pragma unroll
                    for (int n = 0; n < 2; ++n) acc[a][b][m][n] = (f32x4){0.f, 0.f, 0.f, 0.f};
        cur = nxt; cA = nA; cB = nB; ++ui;
        if constexpr (ALIGN_EPI) { if (wr == 1) PG8_BAR; }
    }
    PG8_WAIT_V(0);
    if constexpr (!ALIGN_EPI) { if (wr == 0) PG8_BAR; }
    PG8_BAR;
#undef PG8_SA
#undef PG8_SB
#undef PG8_STAGE
#undef PG8_LDA
#undef PG8_LDB
#undef PG8_MMA
#undef PG8_WAIT_V
#undef PG8_WAIT_L
#undef PG8_BAR
#undef PG8_SCHED
}
}

#define XB_TMO      128
#define XB_XCNT(j)  (256  + 64 * (j))
#define XB_XSUB(j)  (1280 + 64 * (j))
#define XB_XGEN(j)  (2304 + 64 * (j))
#define XB_TOP      3328
#define XB_TOPGEN   3392
#define XCD_BAR_WORDS 3456
#define XB_SPIN_CAP (1u << 18)
__device__ __forceinline__ unsigned xb_ld(unsigned* p)              { return __hip_atomic_load(p, __ATOMIC_RELAXED, __HIP_MEMORY_SCOPE_AGENT); }
__device__ __forceinline__ unsigned xb_add(unsigned* p, unsigned v) { return __hip_atomic_fetch_add(p, v, __ATOMIC_RELAXED, __HIP_MEMORY_SCOPE_AGENT); }
__device__ __forceinline__ unsigned xb_xcc_id() { return (unsigned)__builtin_amdgcn_s_getreg((3 << 11) | 20) & 0xFu; }
#define XB_SPIN(cond, bar) do { unsigned _sp = 0; while (cond) { __builtin_amdgcn_s_sleep(1); \
    if ((++_sp & 255u) == 0u) { if (xb_ld(&(bar)[XB_TMO])) break; if (_sp > XB_SPIN_CAP) { atomicAdd(&(bar)[XB_TMO], 1u); break; } } } } while (0)
struct XcdBarrier { unsigned* bar; unsigned x; volatile LAS unsigned* st; };
__device__ __forceinline__ XcdBarrier xcd_barrier_post(unsigned* bar, volatile LAS unsigned* st) {
    XcdBarrier b; b.bar = bar; b.x = xb_xcc_id(); b.st = st;
    if (threadIdx.x == 0) (void)xb_add(&bar[XB_XCNT(b.x)], 1u);
    return b;
}
__device__ __forceinline__ void xcd_barrier_complete(unsigned* bar, unsigned x, unsigned& nloc, unsigned& nx) {
    const unsigned G = gridDim.x * gridDim.y * gridDim.z;
    unsigned sum, cnt, mine, sp = 0u;
    for (;;) {
        sum = 0u; cnt = 0u; mine = 0u;
#pragma unroll
        for (unsigned j = 0; j < 16; ++j) { const unsigned c = xb_ld(&bar[XB_XCNT(j)]); sum += c; cnt += (c > 0u) ? 1u : 0u; mine = (j == x) ? c : mine; }
        if (sum == G) break;
        __builtin_amdgcn_s_sleep(1);
        if ((++sp & 255u) == 0u) { if (xb_ld(&bar[XB_TMO])) break; if (sp > XB_SPIN_CAP) { atomicAdd(&bar[XB_TMO], 1u); break; } }
    }
    nloc = mine > 0u ? mine : 1u; nx = cnt > 0u ? cnt : 1u;
}
__device__ __forceinline__ void xcd_barrier(const XcdBarrier& b) {
    asm volatile("s_waitcnt vmcnt(0)" ::: "memory");
    __syncthreads();
    if (threadIdx.x == 0) {
        unsigned* bar = b.bar;
        __builtin_amdgcn_s_waitcnt(0);
        unsigned nloc = b.st[0], nx = b.st[1];
        if (nloc == 0u) { xcd_barrier_complete(bar, b.x, nloc, nx); b.st[0] = nloc; b.st[1] = nx; }
        const unsigned old = xb_add(&bar[XB_XSUB(b.x)], 1u);
        const unsigned gen = old / nloc;
        if (old + 1u == (gen + 1u) * nloc) {
            __builtin_amdgcn_fence(__ATOMIC_RELEASE, "agent");
            asm volatile("s_waitcnt vmcnt(0)" ::: "memory");
            const unsigned og = xb_add(&bar[XB_TOP], 1u);
            const unsigned tg = og / nx;
            if (og + 1u == (tg + 1u) * nx) xb_add(&bar[XB_TOPGEN], 1u);
            else XB_SPIN(xb_ld(&bar[XB_TOPGEN]) == tg, bar);
            __builtin_amdgcn_fence(__ATOMIC_ACQUIRE, "agent");
            xb_add(&bar[XB_XGEN(b.x)], 1u);
            asm volatile("s_waitcnt vmcnt(0)" ::: "memory");
        } else {
            XB_SPIN(xb_ld(&bar[XB_XGEN(b.x)]) == gen, bar);
            __builtin_amdgcn_fence(__ATOMIC_ACQUIRE, "agent");
            asm volatile("s_waitcnt vmcnt(0)" ::: "memory");
        }
    }
    __syncthreads();
}

struct Args { const float* in[18]; float* out; unsigned char* ws; int ph_lo, ph_hi; };
struct Frame {
    LAS unsigned char* lds;
    int vcu, G;
    unsigned char* ws;
};
__device__ __forceinline__ int opaque_tid() { int t = threadIdx.x; asm volatile("" : "+v"(t)); return t; }
#define TID ((int)threadIdx.x)
#define WSP(T_, off) ((T_*)(F.ws + (off)))
#define LDS_WAIT() asm volatile("s_waitcnt lgkmcnt(0)" ::: "memory")

struct TrDesc { const float* W; const float* gain; bf16* dst; int Nsrc, srccol0, k0, Kdst; };
__device__ __forceinline__ void tr_load(const TrDesc& d, f32x4 (&v)[16], int lane) {
#pragma unroll
    for (int i = 0; i < 16; ++i) v[i] = *(const f32x4*)(d.W + (size_t)(d.k0 + 4 * i + (lane >> 4)) * d.Nsrc + d.srccol0 + 4 * (lane & 15));
}
__device__ __forceinline__ void tr_finish(const TrDesc& d, const f32x4 (&v)[16], LAS float* scr, int lane) {
#pragma unroll
    for (int i = 0; i < 16; ++i) { const int kk = 4 * i + (lane >> 4); f32x4 x = v[i]; if (d.gain) x = x * d.gain[d.k0 + kk]; *(LAS f32x4*)(scr + kk * 68 + 4 * (lane & 15)) = x; }
    LDS_WAIT(); asm volatile("" ::: "memory");
    const int c = lane & 7;
#pragma unroll
    for (int j = 0; j < 8; ++j) { const int n = (lane >> 3) + 8 * j; const LAS float* sp = scr + (8 * c) * 68 + n;
        u32x4 o; o.x = cvtpk(sp[0 * 68], sp[1 * 68]); o.y = cvtpk(sp[2 * 68], sp[3 * 68]); o.z = cvtpk(sp[4 * 68], sp[5 * 68]); o.w = cvtpk(sp[6 * 68], sp[7 * 68]);
        *(u32x4*)(d.dst + (size_t)n * d.Kdst + d.k0 + 8 * c) = o; }
    LDS_WAIT(); asm volatile("" ::: "memory");
}
__device__ __forceinline__ int in_srccol(int n0) {
    if (n0 < C_Q || n0 >= C_V) return n0;
    const int tile = n0 >> 8, within = n0 & 255, bj = within >> 7, w = within & 127, sec = (tile < 4) ? C_Q : C_K;
    return sec + (2 * (tile & 1) + (w >> 6)) * 128 + (w & 63) + 64 * bj;
}
__device__ __forceinline__ void rms_row_bf16(const float* xrow, bf16* orow, int lane) {
    const f32x4* xr = (const f32x4*)xrow + lane; f32x4 v[4]; float s = 0.f;
#pragma unroll
    for (int j = 0; j < 4; ++j) { v[j] = xr[64 * j]; s += (v[j].x * v[j].x + v[j].y * v[j].y) + (v[j].z * v[j].z + v[j].w * v[j].w); }
    const float r = rsqrtf(wave_sum(s) * (1.0f / DM) + EPS);
    u32x2* o = (u32x2*)orow + lane;
#pragma unroll
    for (int j = 0; j < 4; ++j) { u32x2 w; w.x = cvtpk(v[j].x * r, v[j].y * r); w.y = cvtpk(v[j].z * r, v[j].w * r); o[64 * j] = w; }
}
__device__ __forceinline__ void norm_rows(Frame& F, const float* X, bf16* XB, int nrows) {
    const int tid = opaque_tid(), lane = tid & 63, wave = __builtin_amdgcn_readfirstlane(tid >> 6), fr = lane & 15, fq = lane >> 4; (void)tid; (void)lane; (void)wave; (void)fr; (void)fq;
    const int gw = F.vcu * 8 + wave, NGW = F.G * 8;
    for (int m = gw; m < nrows; m += NGW) rms_row_bf16(X + (size_t)m * DM, XB + (size_t)m * DM, lane);
}
__device__ __forceinline__ void final_norm(Frame& F, float* out, const float* g) {
    const int tid = opaque_tid(), lane = tid & 63, wave = __builtin_amdgcn_readfirstlane(tid >> 6);
    const int gw = F.vcu * 8 + wave, NGW = F.G * 8;
    f32x4 gg[4];
#pragma unroll
    for (int j = 0; j < 4; ++j) gg[j] = *((const f32x4*)g + lane + 64 * j);
    for (int m = gw * 4; m < T; m += NGW * 4) {
        float p = WSP(float, WS_SSP)[(size_t)m * 16 + lane];
        u32x2 v[4][4];
#pragma unroll
        for (int r = 0; r < 4; ++r)
#pragma unroll
            for (int j = 0; j < 4; ++j) v[r][j] = ((const u32x2*)(WSP(bf16, WS_XB) + (size_t)(m + r) * DM) + lane)[64 * j];
        __builtin_amdgcn_sched_barrier(0);
        p += __int_as_float(__builtin_amdgcn_ds_swizzle(__float_as_int(p), SWZ_XOR(1)));
        p += __int_as_float(__builtin_amdgcn_ds_swizzle(__float_as_int(p), SWZ_XOR(2)));
        p += __int_as_float(__builtin_amdgcn_ds_swizzle(__float_as_int(p), SWZ_XOR(4)));
        p += __int_as_float(__builtin_amdgcn_ds_swizzle(__float_as_int(p), SWZ_XOR(8)));
        const float rinv = rsqrtf(p * (1.0f / DM) + EPS);
#pragma unroll
        for (int r = 0; r < 4; ++r) { const float rr = __int_as_float(__builtin_amdgcn_readlane(__float_as_int(rinv), 16 * r)); f32x4* o = (f32x4*)(out + (size_t)(m + r) * DM) + lane;
#pragma unroll
            for (int j = 0; j < 4; ++j) { const u32x2 x = v[r][j]; o[64 * j] = (f32x4){bflo(x.x) * rr * gg[j].x, bfhi(x.x) * rr * gg[j].y, bflo(x.y) * rr * gg[j].z, bfhi(x.y) * rr * gg[j].w}; } }
    }
}

__device__ __forceinline__ void p0_prologue(Frame& F, const Args& A) {
    const int tid = opaque_tid(), lane = tid & 63, wave = __builtin_amdgcn_readfirstlane(tid >> 6);
    LAS float* scr = (LAS float*)(F.lds + wave * 17408);
    const int gw = F.vcu * 8 + wave, NGW = F.G * 8;
    constexpr int I_IN = 16 * 112, I_MKV = 16 * 16, I_UR = 16 * 16, I_UM = 8 * 16, I_OUT = 16 * 16, I_1 = 16 * 64, I_2 = 64 * 16;
    constexpr int PER_L = I_IN + I_MKV + I_UR + I_UM + I_OUT + I_1 + I_2;
#define TR_DESC(d, it_) do { const int l_ = (it_) / PER_L; int r_ = (it_) % PER_L; unsigned char* wl_ = F.ws + WS_W + (size_t)l_ * W_LAYER; \
        if (r_ < I_IN) { const int kb = r_ / 112, nb = r_ % 112; d = TrDesc{A.in[4] + (size_t)l_ * DM * INC, A.in[3] + l_ * DM, (bf16*)(wl_ + WO_IN) + (size_t)(64 * nb) * DM, INC, in_srccol(64 * nb), 64 * kb, DM}; } \
        else if ((r_ -= I_IN) < I_MKV) { const int kb = r_ / 16, nb = r_ % 16; d = TrDesc{A.in[9] + (size_t)l_ * DM * 1024, A.in[8] + l_ * DM, (bf16*)(wl_ + WO_MKV) + (size_t)(64 * nb) * DM, 1024, 64 * nb, 64 * kb, DM}; } \
        else if ((r_ -= I_MKV) < I_UR) { const int kb = r_ / 16, nb = r_ % 16; d = TrDesc{A.in[11] + (size_t)l_ * 1024 * DM, A.in[7] + l_ * 1024, (bf16*)(wl_ + WO_UP) + (size_t)(64 * nb) * 2048 + 512, DM, 64 * nb, 64 * kb, 2048}; } \
        else if ((r_ -= I_UR) < I_UM) { const int kb = r_ / 16, nb = r_ % 16; d = TrDesc{A.in[12] + (size_t)l_ * 512 * DM, nullptr, (bf16*)(wl_ + WO_UP) + (size_t)(64 * nb) * 2048 + 1536, DM, 64 * nb, 64 * kb, 2048}; } \
        else if ((r_ -= I_UM) < I_OUT) { const int kb = r_ / 16, nb = r_ % 16; d = TrDesc{A.in[13] + (size_t)l_ * DM * DM, nullptr, (bf16*)(wl_ + WO_OUT) + (size_t)(64 * nb) * DM, DM, 64 * nb, 64 * kb, DM}; } \
        else if ((r_ -= I_OUT) < I_1) { const int kb = r_ / 64, nb = r_ % 64; d = TrDesc{A.in[15] + (size_t)l_ * DM * DFF, A.in[14] + l_ * DM, (bf16*)(wl_ + WO_1) + (size_t)(64 * nb) * DM, DFF, 64 * nb, 64 * kb, DM}; } \
        else { r_ -= I_1; const int kb = r_ / 16, nb = r_ % 16; d = TrDesc{A.in[16] + (size_t)l_ * DFF * DM, nullptr, (bf16*)(wl_ + WO_2) + (size_t)(64 * nb) * DFF, DM, 64 * nb, 64 * kb, DFF}; } } while (0)
    {
        TrDesc dA, dB; f32x4 vA[16], vB[16];
        int it = gw;
        if (it < 2 * PER_L) { TR_DESC(dA, it); tr_load(dA, vA, lane); }
        while (it < 2 * PER_L) {
            const int itB = it + NGW;
            if (itB < 2 * PER_L) { TR_DESC(dB, itB); tr_load(dB, vB, lane); }
            tr_finish(dA, vA, scr, lane);
            if (itB >= 2 * PER_L) break;
            const int itA = itB + NGW;
            if (itA < 2 * PER_L) { TR_DESC(dA, itA); tr_load(dA, vA, lane); }
            tr_finish(dB, vB, scr, lane);
            it = itA;
        }
    }
#undef TR_DESC
    const int gt = F.vcu * 512 + tid, NT = F.G * 512;
    {
        const float inv = (float)exp2(-(double)(gt & 63) * (13.287712379549449 / 64.0));
        const int* pos = (const int*)A.in[2];
        for (int i = gt; i < T * 64; i += NT) {
            const float a = (float)pos[i >> 6] * inv;
            const double ad = (double)a, k = rint(ad * 0.15915494309189535), rr = ad - k * 6.283185307179586;
            const float rf = (float)rr;
            WSP(float, WS_COS)[i] = cosf(rf); WSP(float, WS_SIN)[i] = sinf(rf);
        }
    }
    for (int m = gw * 4; m < T; m += NGW * 4) {
        f32x4 v[4][4];
#pragma unroll
        for (int r = 0; r < 4; ++r) { const f32x4* xr = (const f32x4*)(A.in[0] + (size_t)(m + r) * DM) + 2 * lane;
#pragma unroll
            for (int j = 0; j < 2; ++j) { v[r][2 * j] = xr[128 * j]; v[r][2 * j + 1] = xr[128 * j + 1]; } }
        __builtin_amdgcn_sched_barrier(0);
#pragma unroll
        for (int r = 0; r < 4; ++r) { float q = 0.f; u32x4* o = (u32x4*)(WSP(bf16, WS_XB) + (size_t)(m + r) * DM) + lane;
#pragma unroll
            for (int j = 0; j < 2; ++j) { const f32x4 a = v[r][2 * j], b2 = v[r][2 * j + 1]; q += ((a.x * a.x + a.y * a.y) + (a.z * a.z + a.w * a.w)) + ((b2.x * b2.x + b2.y * b2.y) + (b2.z * b2.z + b2.w * b2.w));
                u32x4 w; w.x = cvtpk(a.x, a.y); w.y = cvtpk(a.z, a.w); w.z = cvtpk(b2.x, b2.y); w.w = cvtpk(b2.z, b2.w); o[64 * j] = w; }
            q = wave_sum(q);
            if (lane < 16) WSP(float, WS_SSP)[(size_t)(m + r) * 16 + lane] = (lane == 0) ? q : 0.f; }
    }
    norm_rows(F, A.in[1], WSP(bf16, WS_MEMN), NB * NMEM);
    __syncthreads();
    LAS float* PW = (LAS float*)F.lds;
    LAS float* WU = (LAS float*)(F.lds + 128 * 129 * 4);
    for (int it = F.vcu; it < 2 * 4 * 32; it += F.G) {
        const int l = it >> 7, g = (it >> 5) & 3, n0 = (it & 31) * 32;
        const float* pw = A.in[5] + ((size_t)l * 512 + g * 128) * 128; const float* ps = A.in[6] + l * 512 + g * 128; const float* wu = A.in[10] + ((size_t)l * 512 + g * 128) * DM + n0;
        for (int i = tid; i < 128 * 128; i += 512) { const int c = i >> 7, cp = i & 127; PW[c * 129 + cp] = pw[i] * ps[cp]; }
        for (int i = tid; i < 128 * 8; i += 512) { const int cp = i >> 3, q = i & 7; *(LAS f32x4*)(WU + cp * 32 + 4 * q) = *(const f32x4*)(wu + (size_t)cp * DM + 4 * q); }
        __syncthreads();
        const int c = tid & 127, nq = tid >> 7;
        f32x4 s0 = {0.f, 0.f, 0.f, 0.f}, s1 = {0.f, 0.f, 0.f, 0.f};
#pragma unroll 8
        for (int cp = 0; cp < 128; ++cp) { const float p = PW[c * 129 + cp]; s0 += p * *(LAS f32x4*)(WU + cp * 32 + 8 * nq); s1 += p * *(LAS f32x4*)(WU + cp * 32 + 8 * nq + 4); }
        bf16* dst = (bf16*)(F.ws + WS_W + (size_t)l * W_LAYER + WO_UP) + (size_t)(n0 + 8 * nq) * 2048 + g * 128 + c;
#pragma unroll
        for (int j = 0; j < 4; ++j) { dst[(size_t)j * 2048] = (bf16)(cvtpk(s0[j], 0.f) & 0xffffu); dst[(size_t)(4 + j) * 2048] = (bf16)(cvtpk(s1[j], 0.f) & 0xffffu); }
        __syncthreads();
    }
}

__device__ __forceinline__ bf16x8 frag_tr(LAS unsigned char* Tt, int ldb, int rowA, int rowB, int col0, int fr) {
#if USE_TR
    const int q = fr >> 2, p = fr & 3;
    const s16x4 lo = __builtin_bit_cast(s16x4, __builtin_amdgcn_ds_read_tr16_b64_v4i16((LAS v4i16_t*)(Tt + (rowA + q) * ldb + (col0 + 4 * p) * 2)));
    const s16x4 hi = __builtin_bit_cast(s16x4, __builtin_amdgcn_ds_read_tr16_b64_v4i16((LAS v4i16_t*)(Tt + (rowB + q) * ldb + (col0 + 4 * p) * 2)));
    return __builtin_shufflevector(lo, hi, 0, 1, 2, 3, 4, 5, 6, 7);
#else
    bf16x8 f;
#pragma unroll
    for (int e = 0; e < 4; ++e) { f[e] = *(LAS short*)(Tt + (rowA + e) * ldb + (col0 + fr) * 2); f[4 + e] = *(LAS short*)(Tt + (rowB + e) * ldb + (col0 + fr) * 2); }
    return f;
#endif
}
__device__ __forceinline__ bf16x8 pack8(const f32x4& a, const f32x4& b) { u32x4 w; w.x = cvtpk(a[0], a[1]); w.y = cvtpk(a[2], a[3]); w.z = cvtpk(b[0], b[1]); w.w = cvtpk(b[2], b[3]); return __builtin_bit_cast(bf16x8, w); }
template <int NT> __device__ __forceinline__ void mm_rows4(f32x4* acc, LAS unsigned char* T, int pitch, const bf16x8 (&b)[4], int fr, int fq) {
    LAS unsigned char* p = T + fr * pitch + fq * 16;
    bf16x8 f[3][4];
#pragma unroll
    for (int t = 0; t < 2 && t < NT; ++t)
#pragma unroll
        for (int ks = 0; ks < 4; ++ks) f[t][ks] = *(LAS bf16x8*)(p + 16 * t * pitch + ks * 64);
#pragma unroll
    for (int t = 0; t < NT; ++t) {
        if (t + 2 < NT) {
#pragma unroll
            for (int ks = 0; ks < 4; ++ks) f[(t + 2) % 3][ks] = *(LAS bf16x8*)(p + 16 * (t + 2) * pitch + ks * 64); }
        __builtin_amdgcn_sched_barrier(0);
        f32x4 a = {0.f, 0.f, 0.f, 0.f};
#pragma unroll
        for (int ks = 0; ks < 4; ++ks) a = mfma16(f[t % 3][ks], b[ks], a);
        acc[t] = a;
        __builtin_amdgcn_sched_barrier(0);
    }
}
template <int NT, int D> __device__ __forceinline__ void mm_tr(f32x4* acc, LAS unsigned char* Vt, int pitch, int rowA, int rowB, const bf16x8 pf, int fr) {
    bf16x8 g[D + 1];
#pragma unroll
    for (int t = 0; t < D && t < NT; ++t) g[t] = frag_tr(Vt, pitch, rowA, rowB, 16 * t, fr);
#pragma unroll
    for (int t = 0; t < NT; ++t) {
        if (t + D < NT) g[(t + D) % (D + 1)] = frag_tr(Vt, pitch, rowA, rowB, 16 * (t + D), fr);
        __builtin_amdgcn_sched_barrier(0);
        acc[t] = mfma16(g[t % (D + 1)], pf, acc[t]);
        __builtin_amdgcn_sched_barrier(0);
    }
}
__device__ __forceinline__ float log2gamma(int h) { return log2f(1.0f - exp2f(-5.0f - (float)h)); }

__device__ __forceinline__ void mem_kv_proj(Frame& F) {
    const int tid = opaque_tid(), lane = tid & 63, wave = __builtin_amdgcn_readfirstlane(tid >> 6), fr = lane & 15, fq = lane >> 4;
    LAS unsigned char* As = F.lds; LAS unsigned char* Bs = F.lds + 33792;
    const int wm = wave & 3, wn = wave >> 2;
    for (int it = F.vcu; it < 512; it += F.G) {
        const int l = it >> 8, tm = (it >> 4) & 15, tn = it & 15;
        const bf16* Ag = WSP(bf16, WS_MEMN) + (size_t)(tm * 64) * DM; const bf16* Bg = WSP(bf16, WS_W + (size_t)l * W_LAYER + WO_MKV) + (size_t)(tn * 64) * DM;
        f32x4 acc[2]; acc[0] = (f32x4){0.f, 0.f, 0.f, 0.f}; acc[1] = (f32x4){0.f, 0.f, 0.f, 0.f};
        for (int kc = 0; kc < 4; ++kc) {
            __syncthreads();
#pragma unroll
            for (int k = 0; k < 4; ++k) { const int c = tid + 512 * k, r = c >> 5, ch = c & 31;
                *(LAS u32x4*)(As + r * 528 + ch * 16) = *(const u32x4*)(Ag + (size_t)r * DM + kc * 256 + ch * 8);
                *(LAS u32x4*)(Bs + r * 528 + ch * 16) = *(const u32x4*)(Bg + (size_t)r * DM + kc * 256 + ch * 8); }
            __syncthreads();
#pragma unroll
            for (int ks = 0; ks < 8; ++ks) { const bf16x8 af = *(LAS bf16x8*)(As + (16 * wm + fr) * 528 + (32 * ks + 8 * fq) * 2);
#pragma unroll
                for (int c = 0; c < 2; ++c) acc[c] = mfma16(*(LAS bf16x8*)(Bs + (32 * wn + 16 * c + fr) * 528 + (32 * ks + 8 * fq) * 2), af, acc[c]); }
        }
        bf16* dst = WSP(bf16, WS_KVMEM) + (size_t)l * 1024 * 1024 + (size_t)(tm * 64 + 16 * wm + fr) * 1024 + tn * 64 + 32 * wn + 4 * fq;
#pragma unroll
        for (int c = 0; c < 2; ++c) { u32x2 w; w.x = cvtpk(acc[c][0], acc[c][1]); w.y = cvtpk(acc[c][2], acc[c][3]); *(u32x2*)(dst + 16 * c) = w; }
    }
    __syncthreads();
}

template <int W> __device__ __forceinline__ void pool_item(bf16* P, int tl0, int c0) {
    const int pos0 = tl0 & (SEQ - 1);
    u32x4 r[W + 7];
#pragma unroll
    for (int i = 0; i < W + 7; ++i) { r[i] = (u32x4){0u, 0u, 0u, 0u}; if (pos0 - (W - 1) + i >= 0) r[i] = *(const u32x4*)(P + (size_t)(tl0 - (W - 1) + i) * PLD + c0); }
    float s[8];
#pragma unroll
    for (int e = 0; e < 8; ++e) s[e] = 0.f;
#pragma unroll
    for (int i = 0; i < W - 1; ++i)
#pragma unroll
        for (int e = 0; e < 4; ++e) { s[2 * e] += bflo(r[i][e]); s[2 * e + 1] += bfhi(r[i][e]); }
#pragma unroll
    for (int tt = 0; tt < 8; ++tt) {
        const int pos = pos0 + tt; const float rc = 1.0f / (float)((pos + 1 < W) ? pos + 1 : W);
        float d[8];
#pragma unroll
        for (int e = 0; e < 4; ++e) { const float u0 = bflo(r[W - 1 + tt][e]), u1 = bfhi(r[W - 1 + tt][e]); s[2 * e] += u0; s[2 * e + 1] += u1; d[2 * e] = s[2 * e] * rc - u0; d[2 * e + 1] = s[2 * e + 1] * rc - u1; }
        u32x4 o; o.x = cvtpk(d[0], d[1]); o.y = cvtpk(d[2], d[3]); o.z = cvtpk(d[4], d[5]); o.w = cvtpk(d[6], d[7]);
        *(u32x4*)(P + (size_t)(tl0 + tt) * PLD + C_DP + c0) = o;
#pragma unroll
        for (int e = 0; e < 4; ++e) { s[2 * e] -= bflo(r[tt][e]); s[2 * e + 1] -= bfhi(r[tt][e]); }
    }
}
__device__ __forceinline__ void mix_pool(Frame& F) {
    const int tid = opaque_tid(), lane = tid & 63, wave = __builtin_amdgcn_readfirstlane(tid >> 6);
    bf16* P = WSP(bf16, WS_PROJ);
    const int gw = F.vcu * 8 + wave, NGW = F.G * 8;
    for (int it = gw; it < 4 * (TH / 32); it += NGW) {
        const int g = it & 3, tl0 = (it >> 2) * 32 + (lane >> 4) * 8, c0 = g * 128 + (lane & 15) * 8;
        if (g == 0) pool_item<2>(P, tl0, c0); else if (g == 1) pool_item<4>(P, tl0, c0); else if (g == 2) pool_item<8>(P, tl0, c0); else pool_item<16>(P, tl0, c0);
    }
}

__device__ __forceinline__ void mix_mem(Frame& F, int l, int hf, bool dummy) {
    const int tid = opaque_tid(), lane = tid & 63, wave = __builtin_amdgcn_readfirstlane(tid >> 6), fr = lane & 15, fq = lane >> 4; (void)tid; (void)lane; (void)wave; (void)fr; (void)fq;
    bf16* P = WSP(bf16, WS_PROJ);
    LAS unsigned char* Kt = F.lds; LAS unsigned char* Vt = F.lds + 69632;
    const int items = 8 * 64, ipw = (items + F.G - 1) / F.G;
    const int it_lo = F.vcu * ipw, it_hi = (it_lo + ipw < items) ? it_lo + ipw : items;
    int loaded = -1;
    for (int it = it_lo; it < it_hi; ++it) {
        const int combo = it >> 6, qt = it & 63, bl = combo >> 2, h = combo & 3;
        if (combo != loaded) {
            const bf16* src = WSP(bf16, WS_KVMEM) + (size_t)l * 1024 * 1024 + (size_t)((2 * hf + bl) * NMEM) * 1024 + h * 128;
            u32x4 stK[8], stV[8];
#pragma unroll
            for (int k = 0; k < 8; ++k) { const int c = tid + 512 * k, key = c >> 4, ch = c & 15; stK[k] = *(const u32x4*)(src + (size_t)key * 1024 + ch * 8); stV[k] = *(const u32x4*)(src + (size_t)key * 1024 + 512 + ch * 8); }
            __builtin_amdgcn_sched_barrier(0);
            __syncthreads();
#pragma unroll
            for (int k = 0; k < 8; ++k) { const int c = tid + 512 * k, key = c >> 4, ch = c & 15; *(LAS u32x4*)(Kt + key * 272 + ch * 16) = stK[k]; *(LAS u32x4*)(Vt + key * 272 + ch * 16) = stV[k]; }
            __syncthreads(); loaded = combo;
        }
        bf16* qp = P + (size_t)(bl * SEQ + qt * 128 + wave * 16 + fr) * PLD + C_XQ + h * 128;
        bf16x8 bq[4];
#pragma unroll
        for (int ks = 0; ks < 4; ++ks) bq[ks] = *(const bf16x8*)(qp + ks * 32 + fq * 8);
        f32x4 s[16];
        mm_rows4<16>(s, Kt, 272, bq, fr, fq);
        float mx = -3.0e38f;
#pragma unroll
        for (int kt = 0; kt < 16; ++kt) mx = fmaxf(fmaxf(fmaxf(s[kt][0], s[kt][1]), fmaxf(s[kt][2], s[kt][3])), mx);
        mx = max_xor16(mx); mx = max_xor32(mx);
        float lsum = 0.f;
#pragma unroll
        for (int kt = 0; kt < 16; ++kt)
#pragma unroll
            for (int r = 0; r < 4; ++r) { const float p = exp2f(s[kt][r] - mx); s[kt][r] = p; lsum += p; }
        lsum = add_xor16(lsum); lsum = add_xor32(lsum);
        const float rl = 1.0f / lsum;
        f32x4 o[8];
#pragma unroll
        for (int dt = 0; dt < 8; ++dt) o[dt] = (f32x4){0.f, 0.f, 0.f, 0.f};
#pragma unroll
        for (int kp = 0; kp < 8; ++kp) { const bf16x8 pf = pack8(s[2 * kp], s[2 * kp + 1]); mm_tr<8, 4>(o, Vt, 272, 32 * kp + 4 * fq, 32 * kp + 16 + 4 * fq, pf, fr); }
        bf16* op = (dummy ? WSP(bf16, WS_MERGED) + (size_t)(bl * SEQ + qt * 128 + wave * 16 + fr) * 512 + h * 128 : qp) + 16 * (fq & 1) + 4 * (fq & 2);
#pragma unroll
        for (int p = 0; p < 4; ++p) { const unsigned ax = cvtpk(o[2 * p][0] * rl, o[2 * p][1] * rl), ay = cvtpk(o[2 * p][2] * rl, o[2 * p][3] * rl), bx_ = cvtpk(o[2 * p + 1][0] * rl, o[2 * p + 1][1] * rl), by = cvtpk(o[2 * p + 1][2] * rl, o[2 * p + 1][3] * rl);
            auto rx = __builtin_amdgcn_permlane16_swap(ax, bx_, false, false); auto ry = __builtin_amdgcn_permlane16_swap(ay, by, false, false);
            u32x4 w; w.x = rx[0]; w.y = ry[0]; w.z = rx[1]; w.w = ry[1]; *(u32x4*)(op + 32 * p) = w; }
    }
    __syncthreads();
}

__device__ __forceinline__ void mix_kv(Frame& F) {
    const int tid = opaque_tid(), lane = tid & 63, wave = __builtin_amdgcn_readfirstlane(tid >> 6), fr = lane & 15, fq = lane >> 4; (void)tid; (void)lane; (void)wave; (void)fr; (void)fq;
    bf16* P = WSP(bf16, WS_PROJ);
    LAS unsigned char* Kd = F.lds; LAS unsigned char* Vt = F.lds + 34816;
    for (int un = F.vcu; un < 512; un += F.G) {
        const int h = un & 3, n = (un >> 2) & 63, bl = un >> 8; const size_t row0 = (size_t)bl * SEQ + n * 128; const float lg = log2gamma(h);
        u32x4 stK[4], stV[8];
#pragma unroll
        for (int k = 0; k < 4; ++k) { const int c = tid + 512 * k, j = c >> 4, ch = c & 15; stK[k] = *(const u32x4*)(P + (row0 + j) * PLD + C_K + h * 128 + ch * 8); }
#pragma unroll
        for (int k = 0; k < 8; ++k) { const int c = tid + 512 * k, j = c >> 5, ch = c & 31; stV[k] = *(const u32x4*)(P + (row0 + j) * PLD + C_V + h * 256 + ch * 8); }
        __builtin_amdgcn_sched_barrier(0);
        __syncthreads();
#pragma unroll
        for (int k = 0; k < 4; ++k) { const int c = tid + 512 * k, j = c >> 4, ch = c & 15; const u32x4 v = stK[k]; const float f = exp2f((float)(127 - j) * lg);
            u32x4 o; o.x = cvtpk(bflo(v.x) * f, bfhi(v.x) * f); o.y = cvtpk(bflo(v.y) * f, bfhi(v.y) * f); o.z = cvtpk(bflo(v.z) * f, bfhi(v.z) * f); o.w = cvtpk(bflo(v.w) * f, bfhi(v.w) * f);
            *(LAS u32x4*)(Kd + j * 272 + ch * 16) = o; }
#pragma unroll
        for (int k = 0; k < 8; ++k) { const int c = tid + 512 * k, j = c >> 5, ch = c & 31; *(LAS u32x4*)(Vt + j * 528 + ch * 16) = stV[k]; }
        __syncthreads();
        f32x4 acc[8][2];
#pragma unroll
        for (int dt = 0; dt < 8; ++dt) { acc[dt][0] = (f32x4){0.f, 0.f, 0.f, 0.f}; acc[dt][1] = (f32x4){0.f, 0.f, 0.f, 0.f}; }
#pragma unroll
        for (int ks = 0; ks < 4; ++ks) { const int rA = 32 * ks + 8 * fq, rB = rA + 4;
            const bf16x8 bv0 = frag_tr(Vt, 528, rA, rB, 16 * (2 * wave), fr), bv1 = frag_tr(Vt, 528, rA, rB, 16 * (2 * wave + 1), fr);
#pragma unroll
            for (int dt = 0; dt < 8; ++dt) { const bf16x8 ad = frag_tr(Kd, 272, rA, rB, 16 * dt, fr); acc[dt][0] = mfma16(ad, bv0, acc[dt][0]); acc[dt][1] = mfma16(ad, bv1, acc[dt][1]); } }
        bf16* dst = WSP(bf16, WS_KVN) + (size_t)un * 32768 + 16 * (fq & 1) + 4 * (fq & 2);
#pragma unroll
        for (int vi = 0; vi < 2; ++vi)
#pragma unroll
            for (int p = 0; p < 4; ++p) { const f32x4 a = acc[2 * p][vi], b = acc[2 * p + 1][vi];
                const unsigned ax = cvtpk(a[0], a[1]), ay = cvtpk(a[2], a[3]), bx_ = cvtpk(b[0], b[1]), by = cvtpk(b[2], b[3]);
                auto rx = __builtin_amdgcn_permlane16_swap(ax, bx_, false, false); auto ry = __builtin_amdgcn_permlane16_swap(ay, by, false, false);
                u32x4 o; o.x = rx[0]; o.y = ry[0]; o.z = rx[1]; o.w = ry[1];
                *(u32x4*)(dst + (size_t)(16 * (2 * wave + vi) + fr) * 128 + 32 * p) = o; }
    }
    __syncthreads();
}

__device__ __forceinline__ void scan_states(Frame& F) {
    const int tid = opaque_tid(), lane = tid & 63, wave = __builtin_amdgcn_readfirstlane(tid >> 6), fr = lane & 15, fq = lane >> 4; (void)tid; (void)lane; (void)wave; (void)fr; (void)fq;
    const bf16* KV = WSP(bf16, WS_KVN); bf16* SP = WSP(bf16, WS_SPREV);
    if (tid < 256)
    for (int p = F.vcu * 256 + tid; p < 8 * 8192; p += F.G * 256) {
        const int blk = p >> 13, bl = blk >> 2, h = blk & 3, off = (p & 8191) * 4; const float cd = exp2f(128.0f * log2gamma(h));
        f32x4 st = {0.f, 0.f, 0.f, 0.f};
        for (int n0 = 0; n0 < 64; n0 += 8) {
            u32x2 kv[8];
#pragma unroll
            for (int j = 0; j < 8; ++j) kv[j] = *(const u32x2*)(KV + (size_t)((bl * 64 + n0 + j) * 4 + h) * 32768 + off);
#pragma unroll
            for (int j = 0; j < 8; ++j) { u32x2 w; w.x = cvtpk(st[0], st[1]); w.y = cvtpk(st[2], st[3]); *(u32x2*)(SP + (size_t)((bl * 64 + n0 + j) * 4 + h) * 32768 + off) = w;
                st = st * cd + (f32x4){bflo(kv[j].x), bfhi(kv[j].x), bflo(kv[j].y), bfhi(kv[j].y)}; }
        }
    }
}

__device__ __forceinline__ void ret_out(Frame& F, bool dummy) {
    const int tid = opaque_tid(), lane = tid & 63, wave = __builtin_amdgcn_readfirstlane(tid >> 6), fr = lane & 15, fq = lane >> 4; (void)tid; (void)lane; (void)wave; (void)fr; (void)fq;
    bf16* P = WSP(bf16, WS_PROJ);
    LAS unsigned char* Kt = F.lds; LAS unsigned char* Vt = F.lds + 34816; LAS unsigned char* Sp = F.lds + 102400;
    for (int un = F.vcu; un < 512; un += F.G) {
        const int h = un & 3, n = (un >> 2) & 63, bl = un >> 8; const size_t row0 = (size_t)bl * SEQ + n * 128; const float lg = log2gamma(h);
        const bf16* spg = WSP(bf16, WS_SPREV) + (size_t)un * 32768;
        const int i = wave * 16 + fr; const size_t trow = row0 + i;
        bf16x8 bq[4];
#pragma unroll
        for (int ks = 0; ks < 4; ++ks) bq[ks] = *(const bf16x8*)(P + trow * PLD + C_Q + h * 128 + ks * 32 + fq * 8);
        bf16* gp = P + trow * PLD + C_G + h * 256 + 4 * fq;
        u32x4 stK[4], stS[4], stV[8], sp1[4];
        int tq = tid; asm volatile("" : "+v"(tq));
        { const bf16* pk = P + row0 * PLD + C_K + h * 128 + (size_t)(tq >> 4) * PLD + (tq & 15) * 8; const bf16* ps = spg + (size_t)(tq >> 4) * 128 + (tq & 15) * 8;
#pragma unroll
          for (int k = 0; k < 4; ++k) { stK[k] = *(const u32x4*)(pk + (size_t)(32 * k) * PLD); stS[k] = *(const u32x4*)(ps + (size_t)(32 * k) * 128); }
          const bf16* pv = P + row0 * PLD + C_V + h * 256 + (size_t)(tq >> 5) * PLD + (tq & 31) * 8;
#pragma unroll
          for (int k = 0; k < 8; ++k) stV[k] = *(const u32x4*)(pv + (size_t)(16 * k) * PLD);
#pragma unroll
          for (int k = 0; k < 4; ++k) sp1[k] = *(const u32x4*)(ps + (size_t)(128 + 32 * k) * 128); }
        __builtin_amdgcn_sched_barrier(0);
        __syncthreads();
#pragma unroll
        for (int k = 0; k < 4; ++k) { const int j = (tq >> 4) + 32 * k, ch = tq & 15; *(LAS u32x4*)(Kt + j * 272 + ch * 16) = stK[k]; *(LAS u32x4*)(Sp + j * 272 + ch * 16) = stS[k]; }
#pragma unroll
        for (int k = 0; k < 8; ++k) { const int j = (tq >> 5) + 16 * k, ch = tq & 31; *(LAS u32x4*)(Vt + j * 528 + ch * 16) = stV[k]; }
        __syncthreads();
        f32x4 acc[16];
        mm_rows4<8>(acc, Sp, 272, bq, fr, fq);
        __syncthreads();
#pragma unroll
        for (int k = 0; k < 4; ++k) { const int j = (tq >> 4) + 32 * k, ch = tq & 15; *(LAS u32x4*)(Sp + j * 272 + ch * 16) = sp1[k]; }
        __syncthreads();
        mm_rows4<8>(acc + 8, Sp, 272, bq, fr, fq);
        bf16* gq = P + trow * PLD + C_G + h * 256 + 16 * (fq & 1) + 4 * (fq & 2);
        u32x4 gl[8];
#pragma unroll
        for (int p = 0; p < 8; ++p) gl[p] = *(const u32x4*)(gq + 32 * p);
        const float fac = exp2f((float)(i + 1) * lg);
#pragma unroll
        for (int vt = 0; vt < 16; ++vt) acc[vt] = acc[vt] * fac;
        f32x4 s[8];
        int io = i; asm volatile("" : "+v"(io));
        bf16x8 kf[2][4];
        { LAS unsigned char* kp0 = Kt + fr * 272 + fq * 16;
#pragma unroll
          for (int ks = 0; ks < 4; ++ks) kf[0][ks] = *(LAS bf16x8*)(kp0 + ks * 64); }
#pragma unroll
        for (int kt = 0; kt < 8; ++kt) { s[kt] = (f32x4){0.f, 0.f, 0.f, 0.f};
            if (kt <= wave) {
                if (kt + 1 < 8 && kt + 1 <= wave) { LAS unsigned char* kp1 = Kt + (16 * (kt + 1) + fr) * 272 + fq * 16;
#pragma unroll
                    for (int ks = 0; ks < 4; ++ks) kf[(kt + 1) & 1][ks] = *(LAS bf16x8*)(kp1 + ks * 64); }
                __builtin_amdgcn_sched_barrier(0);
#pragma unroll
                for (int ks = 0; ks < 4; ++ks) s[kt] = mfma16(kf[kt & 1][ks], bq[ks], s[kt]);
#pragma unroll
                for (int r = 0; r < 4; ++r) { const int key = 16 * kt + 4 * fq + r; s[kt][r] = (key <= io) ? s[kt][r] * exp2f((float)(io - key) * lg) : 0.f; } } }
#pragma unroll
        for (int kp = 0; kp < 4; ++kp) if (2 * kp <= wave) { const bf16x8 pf = pack8(s[2 * kp], s[2 * kp + 1]); mm_tr<16, 4>(acc, Vt, 528, 32 * kp + 4 * fq, 32 * kp + 16 + 4 * fq, pf, fr); }
        float ss = 0.f;
#pragma unroll
        for (int vt = 0; vt < 16; ++vt) ss += (acc[vt][0] * acc[vt][0] + acc[vt][1] * acc[vt][1]) + (acc[vt][2] * acc[vt][2] + acc[vt][3] * acc[vt][3]);
        ss = add_xor16(ss); ss = add_xor32(ss);
        const float rinv = rsqrtf(ss * (1.0f / 256.0f) + EPS);
#pragma unroll
        for (int p = 0; p < 8; ++p) {
            u32x2 g[2];
            { auto rx = __builtin_amdgcn_permlane16_swap(gl[p][0], gl[p][2], false, false); auto ry = __builtin_amdgcn_permlane16_swap(gl[p][1], gl[p][3], false, false);
              g[0].x = rx[0]; g[0].y = ry[0]; g[1].x = rx[1]; g[1].y = ry[1]; }
            u32x2 w[2];
#pragma unroll
            for (int j = 0; j < 2; ++j) { const int vt = 2 * p + j; const float g0 = bflo(g[j].x), g1 = bfhi(g[j].x), g2 = bflo(g[j].y), g3 = bfhi(g[j].y);
                w[j].x = cvtpk(acc[vt][0] * rinv * g0 * sigmoidf_(g0), acc[vt][1] * rinv * g1 * sigmoidf_(g1)); w[j].y = cvtpk(acc[vt][2] * rinv * g2 * sigmoidf_(g2), acc[vt][3] * rinv * g3 * sigmoidf_(g3)); }
            u32x4 o;
            { auto rx = __builtin_amdgcn_permlane16_swap(w[0].x, w[1].x, false, false); auto ry = __builtin_amdgcn_permlane16_swap(w[0].y, w[1].y, false, false);
              o.x = rx[0]; o.y = ry[0]; o.z = rx[1]; o.w = ry[1]; }
            *(u32x4*)((dummy ? WSP(bf16, WS_MERGED) + trow * 1024 + h * 256 + 16 * (fq & 1) + 4 * (fq & 2) : gq) + 32 * p) = o; }
    }
    __syncthreads();
}

constexpr int N_PHASES = 2 + 2 * 16 + 1;
__global__ void __launch_bounds__(512, 2) fwd_kernel(Args args) {
    extern __shared__ __attribute__((aligned(16))) unsigned char lds_raw[];
    Frame F;
    F.lds = (LAS unsigned char*)lds_raw;
    F.G = gridDim.x; { const int bx = blockIdx.x; F.vcu = (F.G % 8 == 0) ? (bx % 8) * (F.G / 8) + bx / 8 : bx; }
    F.ws = args.ws;
    const Args& A = args;
    for (int u = TID; u < (LDS_BYTES - LDSCTL_OFF) / 4; u += 512) ((LAS unsigned*)(F.lds + LDSCTL_OFF))[u] = 0u;
    __syncthreads();
    const int lo = args.ph_lo, hi = args.ph_hi;
    XcdBarrier bar; bar.bar = WSP(unsigned, WS_CTL) + CW_BAR; bar.x = 0; bar.st = nullptr;
    if (hi - lo > 1) bar = xcd_barrier_post(WSP(unsigned, WS_CTL) + CW_BAR, (volatile LAS unsigned*)(F.lds + MISC_OFF) + 8);
    int ph = 0;
#define RUN() (lo <= ph && ph < hi)
#define END_PHASE() do { if (RUN() && ph + 1 < hi) xcd_barrier(bar); ++ph; } while (0)
    const int bx = (int)blockIdx.x;

    if (RUN()) for (int rep = 0; rep < REPS(10); ++rep) { if (rep) xcd_barrier(bar); p0_prologue(F, A); }
    END_PHASE();
    if (RUN()) for (int rep = 0; rep < REPS(11); ++rep) { if (rep) xcd_barrier(bar); mem_kv_proj(F); }
    END_PHASE();
#pragma unroll 1
    for (int l = 0; l < 2; ++l) {
        unsigned char* wl = F.ws + WS_W + (size_t)l * W_LAYER;
#pragma unroll 1
        for (int hf = 0; hf < 2; ++hf) {
            const int t0 = hf * TH;
            if (RUN()) for (int rep = 0; rep < REPS(0); ++rep) { if (rep) xcd_barrier(bar);
                pg8::Gemm g{WSP(bf16, WS_XB) + (size_t)t0 * DM, (const bf16*)(wl + WO_IN)};
                pg8::StaticOrder<TH, 4096> S; S.init(F.G, bx);
                pg8::EpiBf<2> E{WSP(bf16, WS_PROJ), PLD, WSP(float, WS_COS), WSP(float, WS_SIN), t0, WSP(float, WS_SSP)};
                pg8::gemm_phase<DM, DM, DM, pg8::EpiBf<2>, pg8::StaticOrder<TH, 4096>>(F.lds, g, S, E);
            }
            END_PHASE();
            if (RUN()) for (int rep = 0; rep < REPS(1); ++rep) { if (rep) xcd_barrier(bar); mix_pool(F); mix_mem(F, l, hf, rep != 0); mix_kv(F); }
            END_PHASE();
            if (RUN()) for (int rep = 0; rep < REPS(2); ++rep) { if (rep) xcd_barrier(bar); scan_states(F); }
            END_PHASE();
            if (RUN()) for (int rep = 0; rep < REPS(3); ++rep) { if (rep) xcd_barrier(bar); ret_out(F, rep != 0); }
            END_PHASE();
            if (RUN()) for (int rep = 0; rep < REPS(4); ++rep) { if (rep) xcd_barrier(bar);
                pg8::Gemm g{WSP(bf16, WS_XB) + (size_t)t0 * DM, (const bf16*)(wl + WO_IN) + (size_t)4096 * DM};
                pg8::StaticOrder<TH, 3072> S; S.init(F.G, bx);
                pg8::EpiBf<3> E{WSP(bf16, WS_GATES), 3072, nullptr, nullptr, t0, WSP(float, WS_SSP)};
                pg8::gemm_phase<DM, DM, DM, pg8::EpiBf<3>, pg8::StaticOrder<TH, 3072>>(F.lds, g, S, E);
            }
            END_PHASE();
            if (RUN()) for (int rep = 0; rep < REPS(5); ++rep) { if (rep) xcd_barrier(bar);
                pg8::Gemm g{WSP(bf16, WS_PROJ) + C_DP, (const bf16*)(wl + WO_UP)};
                pg8::StaticOrder<TH, DM> S; S.init(F.G, bx);
                pg8::EpiUp E{WSP(bf16, WS_MERGED), WSP(bf16, WS_GATES)};
                pg8::gemm_phase<2048, PLD, 2048, pg8::EpiUp, pg8::StaticOrder<TH, DM>>(F.lds, g, S, E);
            }
            END_PHASE();
            if (RUN()) for (int rep = 0; rep < REPS(6); ++rep) { if (rep) xcd_barrier(bar);
                pg8::Gemm g{WSP(bf16, WS_MERGED), (const bf16*)(wl + WO_OUT)};
                pg8::StaticOrder<TH, DM> S; S.init(F.G, bx);
                pg8::EpiRes E{WSP(bf16, WS_XB) + (size_t)t0 * DM, WSP(float, WS_SSP) + (size_t)t0 * 16, rep ? WSP(bf16, WS_KVN) : nullptr};
                pg8::gemm_phase<DM, DM, DM, pg8::EpiRes, pg8::StaticOrder<TH, DM>>(F.lds, g, S, E);
            }
            END_PHASE();
        }
        if (RUN()) for (int rep = 0; rep < REPS(8); ++rep) { if (rep) xcd_barrier(bar);
            pg8::Gemm g{WSP(bf16, WS_XB), (const bf16*)(wl + WO_1)};
            pg8::StaticOrder<T, DFF> S; S.init(F.G, bx);
            pg8::EpiBf<1> E{WSP(bf16, WS_U), DFF, nullptr, nullptr, 0, WSP(float, WS_SSP)};
            pg8::gemm_phase<DM, DM, DM, pg8::EpiBf<1>, pg8::StaticOrder<T, DFF>>(F.lds, g, S, E);
        }
        END_PHASE();
        if (RUN()) {
            pg8::Gemm g{WSP(bf16, WS_U), (const bf16*)(wl + WO_2)};
            pg8::StaticOrder<T, DM> S; S.init(F.G, bx);
            pg8::EpiRes E{WSP(bf16, WS_XB), WSP(float, WS_SSP), nullptr};
            pg8::gemm_phase<DFF, DFF, DFF, pg8::EpiRes, pg8::StaticOrder<T, DM>>(F.lds, g, S, E);
#if (PROBE_DUP >> 9) & 1
            xcd_barrier(bar);
            { pg8::StaticOrder<TH, DM> S2; S2.init(F.G, bx); pg8::EpiRes E2{WSP(bf16, WS_XB), WSP(float, WS_SSP), (bf16*)(F.ws + WS_END)};
              pg8::gemm_phase<DFF, DFF, DFF, pg8::EpiRes, pg8::StaticOrder<TH, DM>>(F.lds, g, S2, E2); }
#endif
        }
        END_PHASE();
        if (l == 1) { if (RUN()) final_norm(F, A.out, A.in[17]); END_PHASE(); }
#if (PROBE_DUP >> 12) & 1
        for (int rep = 0; rep < 8; ++rep) xcd_barrier(bar);
#endif
    }
#undef RUN
#undef END_PHASE
}

extern "C" void kernel_launch(void* const* d_in, const int* in_sizes, int n_in, void* d_out, int out_size, void* d_ws, size_t ws_size, hipStream_t stream) {
    static int grid = 0;
    if (grid == 0) {
        if (n_in != 18 || in_sizes[0] != T * DM || out_size != T * DM || ws_size < WS_END) { fprintf(stderr, "kernel_launch: unexpected shapes / workspace (n_in %d, ws %zu)\n", n_in, ws_size); grid = -1; return; }
        int dev = 0, cus = 0, per_cu = 0;
        if (hipGetDevice(&dev) != hipSuccess || hipDeviceGetAttribute(&cus, hipDeviceAttributeMultiprocessorCount, dev) != hipSuccess) { grid = -1; return; }
        if (hipFuncSetAttribute((const void*)fwd_kernel, hipFuncAttributeMaxDynamicSharedMemorySize, LDS_BYTES) != hipSuccess) { fprintf(stderr, "kernel_launch: hipFuncSetAttribute failed\n"); grid = -1; return; }
        if (hipOccupancyMaxActiveBlocksPerMultiprocessor(&per_cu, (const void*)fwd_kernel, 512, LDS_BYTES) != hipSuccess || per_cu < 1) { fprintf(stderr, "kernel_launch: occupancy query says %d\n", per_cu); (void)hipGetLastError(); grid = -1; return; }
        grid = cus;
    }
    if (grid < 0) return;
    (void)hipMemsetAsync((char*)d_ws + WS_CTL, 0, CTL_ZERO_BYTES, stream);
    Args a{};
    for (int i = 0; i < 18; ++i) a.in[i] = (const float*)d_in[i];
    a.out = (float*)d_out; a.ws = (unsigned char*)d_ws;
#if MK_SINGLE
    a.ph_lo = 0; a.ph_hi = N_PHASES;
    hipLaunchKernelGGL(fwd_kernel, dim3(grid), dim3(512), LDS_BYTES, stream, a);
#else
    for (int p = 0; p < N_PHASES; ++p) { a.ph_lo = p; a.ph_hi = p + 1; hipLaunchKernelGGL(fwd_kernel, dim3(grid), dim3(512), LDS_BYTES, stream, a); }
#endif
}
```

```cpp
#include <hip/hip_runtime.h>
#include <cstdio>
#include <cstdint>

#ifndef MK_SINGLE
#define MK_SINGLE 1
#endif
#ifndef PROBE_DUP
#define PROBE_DUP 0
#endif
#define REPS(k) (1 + ((PROBE_DUP >> (k)) & 1))
#ifndef USE_TR
#define USE_TR 1
#endif

#define LAS __attribute__((address_space(3)))
#define GAS __attribute__((address_space(1)))
typedef unsigned short bf16;
typedef short bf16x8 __attribute__((ext_vector_type(8)));
typedef short s16x4 __attribute__((ext_vector_type(4)));
typedef float f32x4 __attribute__((ext_vector_type(4)));
typedef float f32x2 __attribute__((ext_vector_type(2)));
typedef unsigned u32x4 __attribute__((ext_vector_type(4)));
typedef unsigned u32x2 __attribute__((ext_vector_type(2)));
typedef __bf16 bf16x2_t __attribute__((ext_vector_type(2)));
typedef short v4i16_t __attribute__((ext_vector_type(4)));

constexpr int DM = 1024, NB = 4, SEQ = 8192, T = NB * SEQ, TH = T / 2, NMEM = 256, DFF = 4096;
constexpr int INC = 7168;
constexpr int PLD = 4608;
constexpr int C_Q = 512, C_K = 1024, C_V = 1536, C_DP = 2560, C_G = 3072, C_XQ = 4096;
constexpr float EPS = 1e-6f;
constexpr float XQ_SCALE = 0.08838834764831845f * 1.4426950408889634f;
constexpr float LOG2E = 1.4426950408889634f;
constexpr float K_SCALE = 0.08838834764831845f;

constexpr size_t MiB = 1u << 20;
constexpr size_t WS_CTL = 0, CTL_ZERO_BYTES = 1 * MiB;
constexpr size_t WS_COS = 2 * MiB, WS_SIN = 10 * MiB;
constexpr size_t WS_SSP = 18 * MiB;
constexpr size_t WS_MEMN = 20 * MiB;
constexpr size_t WS_KVMEM = 24 * MiB;
constexpr size_t WS_W = 32 * MiB, W_LAYER = 38 * MiB;
constexpr size_t WO_IN = 0, WO_UP = 14 * MiB, WO_OUT = 18 * MiB, WO_1 = 20 * MiB, WO_2 = 28 * MiB, WO_MKV = 36 * MiB;
constexpr size_t WS_XB = 108 * MiB;
constexpr size_t WS_MERGED = 172 * MiB;
constexpr size_t WS_PROJ = 204 * MiB;
constexpr size_t WS_KVN = 348 * MiB;
constexpr size_t WS_SPREV = 412 * MiB;
constexpr size_t WS_GATES = 348 * MiB;
constexpr size_t WS_U = 172 * MiB;
constexpr size_t WS_END = 444 * MiB;
static_assert(WS_W + 2 * W_LAYER <= WS_XB && WS_U + (size_t)T * DFF * 2 <= WS_END && WS_PROJ + (size_t)TH * PLD * 2 <= WS_KVN, "ws map");
constexpr int CW_TMO = 0, CW_BAR = 4096;

constexpr int RING_BYTES = 131072, SCRATCH_BYTES = 147456, LDSCTL_OFF = SCRATCH_BYTES, MISC_OFF = LDSCTL_OFF + 320, LDS_BYTES = SCRATCH_BYTES + 1024;

__device__ __forceinline__ unsigned cvtpk(float lo, float hi) { f32x2 v = {lo, hi}; bf16x2_t b = __builtin_convertvector(v, bf16x2_t); return __builtin_bit_cast(unsigned, b); }
__device__ __forceinline__ float bflo(unsigned u) { return __uint_as_float(u << 16); }
__device__ __forceinline__ float bfhi(unsigned u) { return __uint_as_float(u & 0xffff0000u); }
__device__ __forceinline__ f32x4 mfma16(bf16x8 a, bf16x8 b, f32x4 c) { return __builtin_amdgcn_mfma_f32_16x16x32_bf16(a, b, c, 0, 0, 0); }
#define SWZ_XOR(m) (((m) << 10) | 0x1f)
__device__ __forceinline__ float wave_sum(float v) {
    v += __int_as_float(__builtin_amdgcn_ds_swizzle(__float_as_int(v), SWZ_XOR(1)));
    v += __int_as_float(__builtin_amdgcn_ds_swizzle(__float_as_int(v), SWZ_XOR(2)));
    v += __int_as_float(__builtin_amdgcn_ds_swizzle(__float_as_int(v), SWZ_XOR(4)));
    v += __int_as_float(__builtin_amdgcn_ds_swizzle(__float_as_int(v), SWZ_XOR(8)));
    { auto r = __builtin_amdgcn_permlane16_swap(__float_as_uint(v), __float_as_uint(v), false, false); v = __uint_as_float(r[0]) + __uint_as_float(r[1]); }
    { auto r = __builtin_amdgcn_permlane32_swap(__float_as_uint(v), __float_as_uint(v), false, false); v = __uint_as_float(r[0]) + __uint_as_float(r[1]); }
    return v;
}
__device__ __forceinline__ float add_xor16(float v) { auto r = __builtin_amdgcn_permlane16_swap(__float_as_uint(v), __float_as_uint(v), false, false); return __uint_as_float(r[0]) + __uint_as_float(r[1]); }
__device__ __forceinline__ float add_xor32(float v) { auto r = __builtin_amdgcn_permlane32_swap(__float_as_uint(v), __float_as_uint(v), false, false); return __uint_as_float(r[0]) + __uint_as_float(r[1]); }
__device__ __forceinline__ float max_xor16(float v) { auto r = __builtin_amdgcn_permlane16_swap(__float_as_uint(v), __float_as_uint(v), false, false); return fmaxf(__uint_as_float(r[0]), __uint_as_float(r[1])); }
__device__ __forceinline__ float max_xor32(float v) { auto r = __builtin_amdgcn_permlane32_swap(__float_as_uint(v), __float_as_uint(v), false, false); return fmaxf(__uint_as_float(r[0]), __uint_as_float(r[1])); }
__device__ __forceinline__ float sigmoidf_(float x) { return 1.0f / (1.0f + __expf(-x)); }

namespace pg8 {
#define PG8_LAS __attribute__((address_space(3)))
typedef unsigned short bf16_t;
constexpr int BM = 256, BK = 64, HALF = 128, HTB = HALF * BK * 2, STAGE_BYTES = 8 * HTB, NXCD = 8, WGM = 8;
__host__ __device__ __forceinline__ int lds_byte(int r, int c) { const int st = (r >> 4) * 2 + (c >> 5), rr = r & 15, cc = c & 31, ob = rr * 64 + cc * 2; return st * 1024 + (ob ^ (((ob >> 9) & 1) << 5)); }
__host__ __device__ __forceinline__ void stage_rc(int b, int& R, int& C) { const int st = b / 1024, sb = b % 1024, swz = sb ^ (((sb >> 9) & 1) << 5); R = (st >> 1) * 16 + swz / 64; C = (st & 1) * 32 + (swz % 64) / 2; }
__host__ __device__ __forceinline__ int perm32(int rho) { const int n = rho >> 4, i = rho & 15; return 8 * (i >> 2) + 4 * n + (i & 3); }

struct Unit { int pm, pn; };
struct Gemm { const bf16_t* A; const bf16_t* Bt; };

template <int M_, int N_> struct StaticOrder {
    static constexpr int nM = M_ / BM, nN = N_ / BM, nwg = nM * nN;
    int G, c;
    __host__ __device__ void init(int G_, int c_) { G = G_; c = c_; }
    __host__ __device__ bool next(int i, Unit& u) const {
        const long L = (long)i * G + c; if (L >= nwg) return false;
        int wgid = (int)L; { const int q = nwg / NXCD, r = nwg % NXCD, xcd = wgid % NXCD, off = wgid / NXCD; wgid = (xcd < r ? xcd * (q + 1) : r * (q + 1) + (xcd - r) * q) + off; }
        const int nig = WGM * nN, gid = wgid / nig, fm = gid * WGM, gsz = (nM - fm) < WGM ? (nM - fm) : WGM;
        u.pm = fm + ((wgid % nig) % gsz); u.pn = (wgid % nig) / gsz; return true;
    }
    __device__ __forceinline__ void a_ready(const Unit&) const {}
    __device__ __forceinline__ void done(const Unit&) const {}
};

template <int M_> struct GateOrder {
    StaticOrder<M_, 1024> S;
    __host__ __device__ void init(int G_, int c_) { S.init(G_, c_); }
    __host__ __device__ bool next(int i, Unit& u) const { Unit b; if (!S.next(i / 3, b)) return false; u.pm = b.pm; u.pn = b.pn + 4 * (i % 3); return true; }
    __device__ __forceinline__ void a_ready(const Unit&) const {}
    __device__ __forceinline__ void done(const Unit&) const {}
};

typedef f32x4 Acc[2][2][4][2];

template <int MODE> struct EpiBf {
    static constexpr bool PERM = true, AFTER_DRAIN = false, HOOK = false, EARLY_PRE = (MODE != 2);
    bf16_t* O; int ldc; const float* cosT; const float* sinT; int t0; const float* ssp;
    __device__ __forceinline__ void hook(Acc&, const Unit&, int, int, int, int, int) const {}
    struct Pre { float rs[2][4]; };
    struct Raw { f32x4 v[2][4]; };
    __device__ __forceinline__ Raw pre_load(const Unit& u, int wr, int fr, int fq) const {
        Raw r; const float* p = ssp + (size_t)(t0 + u.pm * BM + wr * 64) * 16 + (unsigned)(fr * 16 + 4 * fq);
#pragma unroll
        for (int ai = 0; ai < 2; ++ai)
#pragma unroll
            for (int m = 0; m < 4; ++m) r.v[ai][m] = *(const f32x4*)(p + (size_t)(ai * HALF + m * 16) * 16);
        __builtin_amdgcn_sched_barrier(0);
        return r;
    }
    __device__ __forceinline__ Pre pre_finish(const Raw& r) const {
        Pre p;
#pragma unroll
        for (int ai = 0; ai < 2; ++ai)
#pragma unroll
            for (int m = 0; m < 4; ++m) { const f32x4 v = r.v[ai][m]; float q = (v[0] + v[1]) + (v[2] + v[3]); q = add_xor16(q); q = add_xor32(q); p.rs[ai][m] = rsqrtf(q * (1.0f / DM) + EPS); }
        return p;
    }
    __device__ __forceinline__ Pre operator()(const Acc& acc, const Unit& u, const Unit& un, int wr, int wc, int fr_in, int fq_in, const Pre& pr) const {
        int fr = fr_in, fq = fq_in; asm volatile("" : "+v"(fr), "+v"(fq));
        if (MODE == 2 && u.pn >= 2 && u.pn < 6) {
            const int sec = (u.pn < 4) ? C_Q : C_K, head = 2 * (u.pn & 1) + (wc >> 1);
            const float ksc0 = (u.pn >= 4) ? K_SCALE : 1.0f;
            const int rowu = u.pm * BM + wr * 64, dcolu = sec + head * 128 + 32 * (wc & 1);
            const unsigned toff = (unsigned)(fr * 64 + 8 * fq), ooff = (unsigned)(fr * ldc + 8 * fq);
#pragma unroll
            for (int am = 0; am < 8; am += 2) {
                f32x4 cs[2][4];
#pragma unroll
                for (int j = 0; j < 2; ++j) { const size_t tr = (size_t)(t0 + rowu + ((am + j) >> 2) * HALF + ((am + j) & 3) * 16) * 64 + 32 * (wc & 1); const float* cp = cosT + tr; const float* sp = sinT + tr;
                    cs[j][0] = *(const f32x4*)(cp + toff); cs[j][1] = *(const f32x4*)(cp + toff + 4); cs[j][2] = *(const f32x4*)(sp + toff); cs[j][3] = *(const f32x4*)(sp + toff + 4); }
                __builtin_amdgcn_sched_barrier(0);
#pragma unroll
                for (int j = 0; j < 2; ++j) { const int ai = (am + j) >> 2, m = (am + j) & 3;
                    const float ksc = ksc0 * pr.rs[ai][m];
                    const f32x4 c0 = cs[j][0], c1 = cs[j][1], s0 = cs[j][2], s1 = cs[j][3];
                    const f32x4 a0 = acc[ai][0][m][0], a1 = acc[ai][0][m][1], b0 = acc[ai][1][m][0], b1 = acc[ai][1][m][1];
                    const f32x4 o10 = (a0 * c0 - b0 * s0) * ksc, o11 = (a1 * c1 - b1 * s1) * ksc, o20 = (b0 * c0 + a0 * s0) * ksc, o21 = (b1 * c1 + a1 * s1) * ksc;
                    bf16_t* rowp = O + (size_t)(rowu + ai * HALF + m * 16) * ldc + dcolu;
                    u32x4 w1, w2; w1.x = cvtpk(o10[0], o10[1]); w1.y = cvtpk(o10[2], o10[3]); w1.z = cvtpk(o11[0], o11[1]); w1.w = cvtpk(o11[2], o11[3]);
                    w2.x = cvtpk(o20[0], o20[1]); w2.y = cvtpk(o20[2], o20[3]); w2.z = cvtpk(o21[0], o21[1]); w2.w = cvtpk(o21[2], o21[3]);
                    *(u32x4*)(rowp + ooff) = w1; *(u32x4*)(rowp + ooff + 64) = w2;
                }
                __builtin_amdgcn_sched_barrier(0); }
            return pre_finish(pre_load(un, wr, fr, fq));
        }
        int cbase = u.pn * BM; float sc = 1.0f;
        if (MODE == 2) { const int pn = u.pn; if (pn < 2) cbase = 256 * pn; else if (pn < 10) cbase = C_V + 256 * (pn - 6); else if (pn < 14) cbase = C_G + 256 * (pn - 10); else { cbase = C_XQ + 256 * (pn - 14); sc = XQ_SCALE; } }
        const unsigned loff = (unsigned)(fr * ldc + 8 * fq);
        const Raw raw = pre_load(un, wr, fr, fq);
        const bool inv = u.pn < 4;
        Pre pn;
#pragma unroll
        for (int ai = 0; ai < 2; ++ai) {
            u32x4 w[4][2];
#pragma unroll
            for (int m = 0; m < 4; ++m)
#pragma unroll
                for (int bj = 0; bj < 2; ++bj) { f32x4 v0 = acc[ai][bj][m][0], v1 = acc[ai][bj][m][1];
                    { const float f = (MODE == 3 ? -LOG2E : sc) * pr.rs[ai][m]; v0 = v0 * f; v1 = v1 * f; }
                    if (MODE == 3) {
#pragma unroll
                        for (int e = 0; e < 4; ++e) { v0[e] = 1.0f + __builtin_amdgcn_exp2f(fminf(fmaxf(v0[e], -80.f), 80.f)); v1[e] = 1.0f + __builtin_amdgcn_exp2f(fminf(fmaxf(v1[e], -80.f), 80.f)); }
                        if (inv) {
#pragma unroll
                            for (int e = 0; e < 4; ++e) { v0[e] = __builtin_amdgcn_rcpf(v0[e]); v1[e] = __builtin_amdgcn_rcpf(v1[e]); } } }
                    if (MODE == 1) { v0 = __builtin_elementwise_max(v0, (f32x4){0.f, 0.f, 0.f, 0.f}); v1 = __builtin_elementwise_max(v1, (f32x4){0.f, 0.f, 0.f, 0.f}); v0 = v0 * v0; v1 = v1 * v1; }
                    w[m][bj].x = cvtpk(v0[0], v0[1]); w[m][bj].y = cvtpk(v0[2], v0[3]); w[m][bj].z = cvtpk(v1[0], v1[1]); w[m][bj].w = cvtpk(v1[2], v1[3]); }
            if (ai == 0) pn = pre_finish(raw);
            __builtin_amdgcn_sched_barrier(0);
#pragma unroll
            for (int m = 0; m < 4; ++m) { bf16_t* rowu = O + (size_t)(u.pm * BM + wr * 64 + ai * HALF + m * 16) * ldc + cbase + wc * 32;
#pragma unroll
                for (int bj = 0; bj < 2; ++bj) *(u32x4*)(rowu + loff + bj * HALF) = w[m][bj]; }
            __builtin_amdgcn_sched_barrier(0); }
        return pn;
    }
};
struct EpiRes {
    static constexpr bool PERM = true, AFTER_DRAIN = false, HOOK = false, EARLY_PRE = false;
    struct Pre {}; struct Raw {};
    __device__ __forceinline__ Raw pre_load(const Unit&, int, int, int) const { return Raw{}; }
    __device__ __forceinline__ Pre pre_finish(const Raw&) const { return Pre{}; }
    bf16_t* X; float* ssp; bf16_t* dummy;
    __device__ __forceinline__ void hook(Acc&, const Unit&, int, int, int, int, int) const {}
    __device__ __forceinline__ Pre operator()(const Acc& acc, const Unit& u, const Unit&, int wr, int wc, int fr, int fq, const Pre&) const {
        const unsigned loff = (unsigned)((wr * 64 + fr) * 1024 + u.pn * BM + wc * 32 + 8 * fq);
        const bf16_t* Xu = X + (size_t)u.pm * BM * 1024; bf16_t* Yu = (dummy ? dummy : X) + (size_t)u.pm * BM * 1024;
        u32x4 xb[2][4][2];
#pragma unroll
        for (int ai = 0; ai < 2; ++ai)
#pragma unroll
            for (int m = 0; m < 4; ++m)
#pragma unroll
                for (int bj = 0; bj < 2; ++bj) xb[ai][m][bj] = *(const u32x4*)(Xu + (size_t)(ai * HALF + m * 16) * 1024 + loff + bj * HALF);
        __builtin_amdgcn_sched_barrier(0);
#pragma unroll
        for (int ai = 0; ai < 2; ++ai)
#pragma unroll
            for (int m = 0; m < 4; ++m) { float q = 0.f;
#pragma unroll
                for (int bj = 0; bj < 2; ++bj) { const u32x4 b = xb[ai][m][bj];
                    f32x4 x0 = acc[ai][bj][m][0], x1 = acc[ai][bj][m][1];
                    x0[0] += bflo(b[0]); x0[1] += bfhi(b[0]); x0[2] += bflo(b[1]); x0[3] += bfhi(b[1]); x1[0] += bflo(b[2]); x1[1] += bfhi(b[2]); x1[2] += bflo(b[3]); x1[3] += bfhi(b[3]);
                    q += ((x0[0] * x0[0] + x0[1] * x0[1]) + (x0[2] * x0[2] + x0[3] * x0[3])) + ((x1[0] * x1[0] + x1[1] * x1[1]) + (x1[2] * x1[2] + x1[3] * x1[3]));
                    u32x4 w; w.x = cvtpk(x0[0], x0[1]); w.y = cvtpk(x0[2], x0[3]); w.z = cvtpk(x1[0], x1[1]); w.w = cvtpk(x1[2], x1[3]);
                    *(u32x4*)(Yu + (size_t)(ai * HALF + m * 16) * 1024 + loff + bj * HALF) = w; }
                q = add_xor16(q); q = add_xor32(q);
                if (fq == 0 && !dummy) ssp[(size_t)(u.pm * BM + wr * 64 + fr + ai * HALF + m * 16) * 16 + 4 * u.pn + wc] = q; }
        return Pre{};
    }
};
struct EpiUp {
    static constexpr bool PERM = true, AFTER_DRAIN = false, HOOK = true, EARLY_PRE = false;
    struct Pre {}; struct Raw {};
    __device__ __forceinline__ Raw pre_load(const Unit&, int, int, int) const { return Raw{}; }
    __device__ __forceinline__ Pre pre_finish(const Raw&) const { return Pre{}; }
    bf16_t* O; const bf16_t* G;
    __device__ __forceinline__ void hook(Acc& acc, const Unit& u, int t, int wr, int wc, int fr, int fq) const {
        if (t != 8 && t != 24) return;
        const int gsel = (t == 8) ? 0 : 1024;
        int fr_ = fr, fq_ = fq; asm volatile("" : "+v"(fr_), "+v"(fq_));
        const int row0 = u.pm * BM + wr * 64 + fr_, col0 = u.pn * BM + wc * 32 + 8 * fq_;
        const bf16_t* gbase = G + (size_t)row0 * 3072 + gsel + col0;
        u32x4 ga[4][2], gb[4][2];
#pragma unroll
        for (int m = 0; m < 4; ++m)
#pragma unroll
            for (int bj = 0; bj < 2; ++bj) { const bf16_t* gp = gbase + (size_t)(m * 16) * 3072 + bj * HALF; ga[m][bj] = *(const u32x4*)gp; gb[m][bj] = *(const u32x4*)(gp + 1024); }
        __builtin_amdgcn_sched_barrier(0);
#pragma unroll
        for (int ai = 0; ai < 2; ++ai)
#pragma unroll
            for (int m = 0; m < 4; ++m)
#pragma unroll
                for (int bj = 0; bj < 2; ++bj) { float r[8];
#pragma unroll
                    for (int e = 0; e < 4; ++e) { const float a0 = bflo(ga[m][bj][e]), a1 = bfhi(ga[m][bj][e]), b0 = bflo(gb[m][bj][e]), b1 = bfhi(gb[m][bj][e]);
                        if (t == 8) { r[2 * e] = a0 * b0; r[2 * e + 1] = a1 * b1; }
                        else { r[2 * e] = b0 * __builtin_amdgcn_rcpf(a0); r[2 * e + 1] = b1 * __builtin_amdgcn_rcpf(a1); } }
                    if (ai == 0) { const bf16_t* gp = gbase + (size_t)(HALF + m * 16) * 3072 + bj * HALF; ga[m][bj] = *(const u32x4*)gp; gb[m][bj] = *(const u32x4*)(gp + 1024); }
                    f32x4 v0 = acc[ai][bj][m][0], v1 = acc[ai][bj][m][1];
                    v0[0] *= r[0]; v0[1] *= r[1]; v0[2] *= r[2]; v0[3] *= r[3]; v1[0] *= r[4]; v1[1] *= r[5]; v1[2] *= r[6]; v1[3] *= r[7];
                    acc[ai][bj][m][0] = v0; acc[ai][bj][m][1] = v1;
                    __builtin_amdgcn_sched_barrier(0); }
    }
    __device__ __forceinline__ Pre operator()(const Acc& acc, const Unit& u, const Unit&, int wr, int wc, int fr, int fq, const Pre&) const {
        const int row0 = u.pm * BM + wr * 64 + fr, col0 = u.pn * BM + wc * 32 + 8 * fq;
        u32x4 g3[2][4][2];
#pragma unroll
        for (int ai = 0; ai < 2; ++ai)
#pragma unroll
            for (int m = 0; m < 4; ++m)
#pragma unroll
                for (int bj = 0; bj < 2; ++bj) g3[ai][m][bj] = *(const u32x4*)(G + (size_t)(row0 + ai * HALF + m * 16) * 3072 + 2048 + col0 + bj * HALF);
        __builtin_amdgcn_sched_barrier(0);
#pragma unroll
        for (int ai = 0; ai < 2; ++ai)
#pragma unroll
            for (int m = 0; m < 4; ++m) { const int row = row0 + ai * HALF + m * 16; bf16_t* rowp = O + (size_t)row * 1024 + col0;
#pragma unroll
                for (int bj = 0; bj < 2; ++bj) { const u32x4 gc = g3[ai][m][bj];
                    const f32x4 v0 = acc[ai][bj][m][0], v1 = acc[ai][bj][m][1];
#define UP_S3(x) __builtin_amdgcn_rcpf(x)
                    u32x4 w; w.x = cvtpk(v0[0] * UP_S3(bflo(gc[0])), v0[1] * UP_S3(bfhi(gc[0]))); w.y = cvtpk(v0[2] * UP_S3(bflo(gc[1])), v0[3] * UP_S3(bfhi(gc[1])));
                    w.z = cvtpk(v1[0] * UP_S3(bflo(gc[2])), v1[1] * UP_S3(bfhi(gc[2]))); w.w = cvtpk(v1[2] * UP_S3(bflo(gc[3])), v1[3] * UP_S3(bfhi(gc[3])));
#undef UP_S3
                    *(u32x4*)(rowp + bj * HALF) = w; } }
        return Pre{};
    }
};

template <int K, int LDA, int LDB, class Epi, class Sched, bool ALIGN_EPI = true>
__device__ __forceinline__ void gemm_phase(PG8_LAS unsigned char* lds, const Gemm g, const Sched& S, const Epi& E) {
    int tid_ = threadIdx.x; asm volatile("" : "+v"(tid_));
    const int tid = tid_, wid = __builtin_amdgcn_readfirstlane(tid >> 6), lane = tid & 63, wr = wid >> 2, wc = wid & 3, fr = lane & 15, fq = lane >> 4;
    constexpr int nt = K / BK;
    unsigned voffA[2], voffB[2];
#pragma unroll
    for (int i = 0; i < 2; ++i) { int R, C; stage_rc(tid * 16 + i * 8192, R, C); const int Rb = Epi::PERM ? ((R & ~31) + perm32(R & 31)) : R;
        voffA[i] = (unsigned)(R * LDA + C) * 2u; voffB[i] = (unsigned)(Rb * LDB + C) * 2u; }
    constexpr size_t kstep = (size_t)(BK * 2);
    constexpr size_t hstepA = (size_t)HALF * LDA * 2, hstepB = (size_t)HALF * LDB * 2;
    constexpr size_t tstepA = 2 * hstepA, tstepB = 2 * hstepB;
    const unsigned ldsw = (unsigned)wid * 1024u;
    const int aoff = lds_byte(wr * 64 + fr, fq * 8), boff = lds_byte(wc * 32 + fr, fq * 8);
#define PG8_SA(b, h) (((b) * 2 + (h)) * HTB)
#define PG8_SB(b, h) ((4 + (b) * 2 + (h)) * HTB)
#define PG8_STAGE(bufoff, gbase, voff) do { _Pragma("unroll") for (int _i = 0; _i < 2; ++_i) \
        __builtin_amdgcn_global_load_lds((const unsigned*)((const char*)(gbase) + (voff)[_i]), (PG8_LAS unsigned*)(lds + (bufoff) + ldsw + _i * 8192), 16, 0, 0); } while (0)
#define PG8_LDA(dst, b, h) do { _Pragma("unroll") for (int m = 0; m < 4; ++m) _Pragma("unroll") for (int k = 0; k < 2; ++k) dst[m][k] = *(const PG8_LAS bf16x8*)(lds + PG8_SA(b, h) + aoff + m * 2048 + k * 1024); } while (0)
#define PG8_LDB(dst, b, h) do { _Pragma("unroll") for (int n = 0; n < 2; ++n) _Pragma("unroll") for (int k = 0; k < 2; ++k) dst[n][k] = *(const PG8_LAS bf16x8*)(lds + PG8_SB(b, h) + boff + n * 2048 + k * 1024); } while (0)
#define PG8_MMA(ai, bj, At, Bt) do { __builtin_amdgcn_s_setprio(1); _Pragma("unroll") for (int m = 0; m < 4; ++m) _Pragma("unroll") for (int n = 0; n < 2; ++n) _Pragma("unroll") for (int k = 0; k < 2; ++k) \
        acc[ai][bj][m][n] = __builtin_amdgcn_mfma_f32_16x16x32_bf16(Bt[n][k], At[m][k], acc[ai][bj][m][n], 0, 0, 0); __builtin_amdgcn_s_setprio(0); } while (0)
#define PG8_WAIT_V(n) asm volatile("s_waitcnt vmcnt(" #n ")" ::: "memory")
#define PG8_WAIT_L(n) asm volatile("s_waitcnt lgkmcnt(" #n ")" ::: "memory")
#define PG8_BAR __builtin_amdgcn_s_barrier()
#define PG8_SCHED __builtin_amdgcn_sched_barrier(0)
    Unit cur, nxt; int ui = 0;
    if (!S.next(0, cur)) return;
    Acc acc;
#pragma unroll
    for (int a = 0; a < 2; ++a)
#pragma unroll
        for (int b = 0; b < 2; ++b)
#pragma unroll
            for (int m = 0; m < 4; ++m)
#pragma unroll
                for (int n = 0; n < 2; ++n) acc[a][b][m][n] = (f32x4){0.f, 0.f, 0.f, 0.f};
    bf16x8 At[4][2], B0[2][2], B1[2][2];
    const char* cA = (const char*)g.A + (size_t)cur.pm * tstepA; const char* cB = (const char*)g.Bt + (size_t)cur.pn * tstepB;
    S.a_ready(cur);
    PG8_SCHED;
    const typename Epi::Raw raw0 = E.pre_load(cur, wr, fr, fq);
    PG8_STAGE(PG8_SB(0, 0), cB, voffB); PG8_STAGE(PG8_SB(0, 1), cB + hstepB, voffB); PG8_STAGE(PG8_SA(0, 0), cA, voffA); PG8_STAGE(PG8_SA(0, 1), cA + hstepA, voffA);
    PG8_SCHED; typename Epi::Pre pre = E.pre_finish(raw0); PG8_SCHED;
    if (wr == 1) PG8_BAR;
    PG8_WAIT_V(2); PG8_BAR;
    PG8_STAGE(PG8_SB(1, 0), cB + kstep, voffB); PG8_STAGE(PG8_SA(1, 0), cA + kstep, voffA); PG8_STAGE(PG8_SB(1, 1), cB + hstepB + kstep, voffB);
    PG8_WAIT_V(6); PG8_BAR;
    for (;;) {
        const bool has_next = S.next(ui + 1, nxt);
        const char* nA = has_next ? (const char*)g.A + (size_t)nxt.pm * tstepA : cA; const char* nB = has_next ? (const char*)g.Bt + (size_t)nxt.pn * tstepB : cB;
        for (int t = 0; t < nt; t += 2) {
            const bool last = (t == nt - 2);
            const char* a1 = cA + (size_t)(t + 1) * kstep;
            const char* a2 = last ? nA : cA + (size_t)(t + 2) * kstep; const char* b2 = last ? nB : cB + (size_t)(t + 2) * kstep;
            const char* a3 = a2 + kstep; const char* b3 = b2 + kstep;
            if (last && has_next) S.a_ready(nxt);
            if constexpr (Epi::HOOK) { E.hook(acc, cur, t, wr, wc, fr, fq); PG8_SCHED; }
            PG8_LDB(B0, 0, 0); PG8_LDB(B1, 0, 1); PG8_SCHED; PG8_LDA(At, 0, 0); PG8_STAGE(PG8_SA(1, 1), a1 + hstepA, voffA);
            PG8_WAIT_V(8); PG8_WAIT_L(0); PG8_BAR; PG8_MMA(0, 0, At, B0); PG8_MMA(0, 1, At, B1); PG8_BAR; PG8_SCHED;
            PG8_LDA(At, 0, 1); PG8_STAGE(PG8_SB(0, 0), b2, voffB); PG8_STAGE(PG8_SB(0, 1), b2 + hstepB, voffB); PG8_STAGE(PG8_SA(0, 0), a2, voffA);
            PG8_WAIT_V(8); PG8_WAIT_L(0); PG8_BAR; PG8_MMA(1, 0, At, B0); PG8_MMA(1, 1, At, B1); PG8_BAR; PG8_SCHED;
            PG8_LDB(B0, 1, 0); PG8_LDB(B1, 1, 1); PG8_SCHED; PG8_LDA(At, 1, 0); PG8_STAGE(PG8_SA(0, 1), a2 + hstepA, voffA);
            PG8_WAIT_V(8); PG8_WAIT_L(0); PG8_BAR; PG8_MMA(0, 0, At, B0); PG8_MMA(0, 1, At, B1); PG8_BAR; PG8_SCHED;
            PG8_LDA(At, 1, 1); PG8_STAGE(PG8_SB(1, 0), b3, voffB); PG8_STAGE(PG8_SB(1, 1), b3 + hstepB, voffB); PG8_STAGE(PG8_SA(1, 0), a3, voffA);
            PG8_WAIT_V(8); PG8_WAIT_L(0); PG8_BAR; PG8_MMA(1, 0, At, B0); PG8_MMA(1, 1, At, B1); PG8_BAR; PG8_SCHED;
        }
        if constexpr (ALIGN_EPI) { if (wr == 0) PG8_BAR; }
        pre = E(acc, cur, has_next ? nxt : cur, wr, wc, fr, fq, pre); S.done(cur); PG8_SCHED;
        if (!has_next) break;
#pragma unroll
        for (int a = 0; a < 2; ++a)
#pragma unroll
            for (int b = 0; b < 2; ++b)
#pragma unroll
                for (int m = 0; m < 4; ++m)
#pragma unroll
                    for (int n = 0; n < 2; ++n) acc[a][b][m][n] = (f32x4){0.f, 0.f, 0.f, 0.f};
        cur = nxt; cA = nA; cB = nB; ++ui;
        if constexpr (ALIGN_EPI) { if (wr == 1) PG8_BAR; }
    }
    PG8_WAIT_V(0);
    if constexpr (!ALIGN_EPI) { if (wr == 0) PG8_BAR; }
    PG8_BAR;
#undef PG8_SA
#undef PG8_SB
#undef PG8_STAGE
#undef PG8_LDA
#undef PG8_LDB
#undef PG8_MMA
#undef PG8_WAIT_V
#undef PG8_WAIT_L
#undef PG8_BAR
#undef PG8_SCHED
}
}

#define XB_TMO      128
#define XB_XCNT(j)  (256  + 64 * (j))
#define XB_XSUB(j)  (1280 + 64 * (j))
#define XB_XGEN(j)  (2304 + 64 * (j))
#define XB_TOP      3328
#define XB_TOPGEN   3392
#define XCD_BAR_WORDS 3456
#define XB_SPIN_CAP (1u << 18)
__device__ __forceinline__ unsigned xb_ld(unsigned* p)              { return __hip_atomic_load(p, __ATOMIC_RELAXED, __HIP_MEMORY_SCOPE_AGENT); }
__device__ __forceinline__ unsigned xb_add(unsigned* p, unsigned v) { return __hip_atomic_fetch_add(p, v, __ATOMIC_RELAXED, __HIP_MEMORY_SCOPE_AGENT); }
__device__ __forceinline__ unsigned xb_xcc_id() { return (unsigned)__builtin_amdgcn_s_getreg((3 << 11) | 20) & 0xFu; }
#define XB_SPIN(cond, bar) do { unsigned _sp = 0; while (cond) { __builtin_amdgcn_s_sleep(1); \
    if ((++_sp & 255u) == 0u) { if (xb_ld(&(bar)[XB_TMO])) break; if (_sp > XB_SPIN_CAP) { atomicAdd(&(bar)[XB_TMO], 1u); break; } } } } while (0)
struct XcdBarrier { unsigned* bar; unsigned x; volatile LAS unsigned* st; };
__device__ __forceinline__ XcdBarrier xcd_barrier_post(unsigned* bar, volatile LAS unsigned* st) {
    XcdBarrier b; b.bar = bar; b.x = xb_xcc_id(); b.st = st;
    if (threadIdx.x == 0) (void)xb_add(&bar[XB_XCNT(b.x)], 1u);
    return b;
}
__device__ __forceinline__ void xcd_barrier_complete(unsigned* bar, unsigned x, unsigned& nloc, unsigned& nx) {
    const unsigned G = gridDim.x * gridDim.y * gridDim.z;
    unsigned sum, cnt, mine, sp = 0u;
    for (;;) {
        sum = 0u; cnt = 0u; mine = 0u;
#pragma unroll
        for (unsigned j = 0; j < 16; ++j) { const unsigned c = xb_ld(&bar[XB_XCNT(j)]); sum += c; cnt += (c > 0u) ? 1u : 0u; mine = (j == x) ? c : mine; }
        if (sum == G) break;
        __builtin_amdgcn_s_sleep(1);
        if ((++sp & 255u) == 0u) { if (xb_ld(&bar[XB_TMO])) break; if (sp > XB_SPIN_CAP) { atomicAdd(&bar[XB_TMO], 1u); break; } }
    }
    nloc = mine > 0u ? mine : 1u; nx = cnt > 0u ? cnt : 1u;
}
__device__ __forceinline__ void xcd_barrier(const XcdBarrier& b) {
    asm volatile("s_waitcnt vmcnt(0)" ::: "memory");
    __syncthreads();
    if (threadIdx.x == 0) {
        unsigned* bar = b.bar;
        __builtin_amdgcn_s_waitcnt(0);
        unsigned nloc = b.st[0], nx = b.st[1];
        if (nloc == 0u) { xcd_barrier_complete(bar, b.x, nloc, nx); b.st[0] = nloc; b.st[1] = nx; }
        const unsigned old = xb_add(&bar[XB_XSUB(b.x)], 1u);
        const unsigned gen = old / nloc;
        if (old + 1u == (gen + 1u) * nloc) {
            __builtin_amdgcn_fence(__ATOMIC_RELEASE, "agent");
            asm volatile("s_waitcnt vmcnt(0)" ::: "memory");
            const unsigned og = xb_add(&bar[XB_TOP], 1u);
            const unsigned tg = og / nx;
            if (og + 1u == (tg + 1u) * nx) xb_add(&bar[XB_TOPGEN], 1u);
            else XB_SPIN(xb_ld(&bar[XB_TOPGEN]) == tg, bar);
            __builtin_amdgcn_fence(__ATOMIC_ACQUIRE, "agent");
            xb_add(&bar[XB_XGEN(b.x)], 1u);
            asm volatile("s_waitcnt vmcnt(0)" ::: "memory");
        } else {
            XB_SPIN(xb_ld(&bar[XB_XGEN(b.x)]) == gen, bar);
            __builtin_amdgcn_fence(__ATOMIC_ACQUIRE, "agent");
            asm volatile("s_waitcnt vmcnt(0)" ::: "memory");
        }
    }
    __syncthreads();
}

struct Args { const float* in[18]; float* out; unsigned char* ws; int ph_lo, ph_hi; };
struct Frame {
    LAS unsigned char* lds;
    int vcu, G;
    unsigned char* ws;
};
__device__ __forceinline__ int opaque_tid() { int t = threadIdx.x; asm volatile("" : "+v"(t)); return t; }
#define TID ((int)threadIdx.x)
#define WSP(T_, off) ((T_*)(F.ws + (off)))
#define LDS_WAIT() asm volatile("s_waitcnt lgkmcnt(0)" ::: "memory")

struct TrDesc { const float* W; const float* gain; bf16* dst; int Nsrc, srccol0, k0, Kdst; };
__device__ __forceinline__ void tr_load(const TrDesc& d, f32x4 (&v)[16], int lane) {
#pragma unroll
    for (int i = 0; i < 16; ++i) v[i] = *(const f32x4*)(d.W + (size_t)(d.k0 + 4 * i + (lane >> 4)) * d.Nsrc + d.srccol0 + 4 * (lane & 15));
}
__device__ __forceinline__ void tr_finish(const TrDesc& d, const f32x4 (&v)[16], LAS float* scr, int lane) {
#pragma unroll
    for (int i = 0; i < 16; ++i) { const int kk = 4 * i + (lane >> 4); f32x4 x = v[i]; if (d.gain) x = x * d.gain[d.k0 + kk]; *(LAS f32x4*)(scr + kk * 68 + 4 * (lane & 15)) = x; }
    LDS_WAIT(); asm volatile("" ::: "memory");
    const int c = lane & 7;
#pragma unroll
    for (int j = 0; j < 8; ++j) { const int n = (lane >> 3) + 8 * j; const LAS float* sp = scr + (8 * c) * 68 + n;
        u32x4 o; o.x = cvtpk(sp[0 * 68], sp[1 * 68]); o.y = cvtpk(sp[2 * 68], sp[3 * 68]); o.z = cvtpk(sp[4 * 68], sp[5 * 68]); o.w = cvtpk(sp[6 * 68], sp[7 * 68]);
        *(u32x4*)(d.dst + (size_t)n * d.Kdst + d.k0 + 8 * c) = o; }
    LDS_WAIT(); asm volatile("" ::: "memory");
}
__device__ __forceinline__ int in_srccol(int n0) {
    if (n0 < C_Q || n0 >= C_V) return n0;
    const int tile = n0 >> 8, within = n0 & 255, bj = within >> 7, w = within & 127, sec = (tile < 4) ? C_Q : C_K;
    return sec + (2 * (tile & 1) + (w >> 6)) * 128 + (w & 63) + 64 * bj;
}
__device__ __forceinline__ void rms_row_bf16(const float* xrow, bf16* orow, int lane) {
    const f32x4* xr = (const f32x4*)xrow + lane; f32x4 v[4]; float s = 0.f;
#pragma unroll
    for (int j = 0; j < 4; ++j) { v[j] = xr[64 * j]; s += (v[j].x * v[j].x + v[j].y * v[j].y) + (v[j].z * v[j].z + v[j].w * v[j].w); }
    const float r = rsqrtf(wave_sum(s) * (1.0f / DM) + EPS);
    u32x2* o = (u32x2*)orow + lane;
#pragma unroll
    for (int j = 0; j < 4; ++j) { u32x2 w; w.x = cvtpk(v[j].x * r, v[j].y * r); w.y = cvtpk(v[j].z * r, v[j].w * r); o[64 * j] = w; }
}
__device__ __forceinline__ void norm_rows(Frame& F, const float* X, bf16* XB, int nrows) {
    const int tid = opaque_tid(), lane = tid & 63, wave = __builtin_amdgcn_readfirstlane(tid >> 6), fr = lane & 15, fq = lane >> 4; (void)tid; (void)lane; (void)wave; (void)fr; (void)fq;
    const int gw = F.vcu * 8 + wave, NGW = F.G * 8;
    for (int m = gw; m < nrows; m += NGW) rms_row_bf16(X + (size_t)m * DM, XB + (size_t)m * DM, lane);
}
__device__ __forceinline__ void final_norm(Frame& F, float* out, const float* g) {
    const int tid = opaque_tid(), lane = tid & 63, wave = __builtin_amdgcn_readfirstlane(tid >> 6);
    const int gw = F.vcu * 8 + wave, NGW = F.G * 8;
    f32x4 gg[4];
#pragma unroll
    for (int j = 0; j < 4; ++j) gg[j] = *((const f32x4*)g + lane + 64 * j);
    for (int m = gw * 4; m < T; m += NGW * 4) {
        float p = WSP(float, WS_SSP)[(size_t)m * 16 + lane];
        u32x2 v[4][4];
#pragma unroll
        for (int r = 0; r < 4; ++r)
#pragma unroll
            for (int j = 0; j < 4; ++j) v[r][j] = ((const u32x2*)(WSP(bf16, WS_XB) + (size_t)(m + r) * DM) + lane)[64 * j];
        __builtin_amdgcn_sched_barrier(0);
        p += __int_as_float(__builtin_amdgcn_ds_swizzle(__float_as_int(p), SWZ_XOR(1)));
        p += __int_as_float(__builtin_amdgcn_ds_swizzle(__float_as_int(p), SWZ_XOR(2)));
        p += __int_as_float(__builtin_amdgcn_ds_swizzle(__float_as_int(p), SWZ_XOR(4)));
        p += __int_as_float(__builtin_amdgcn_ds_swizzle(__float_as_int(p), SWZ_XOR(8)));
        const float rinv = rsqrtf(p * (1.0f / DM) + EPS);
#pragma unroll
        for (int r = 0; r < 4; ++r) { const float rr = __int_as_float(__builtin_amdgcn_readlane(__float_as_int(rinv), 16 * r)); f32x4* o = (f32x4*)(out + (size_t)(m + r) * DM) + lane;
#pragma unroll
            for (int j = 0; j < 4; ++j) { const u32x2 x = v[r][j]; o[64 * j] = (f32x4){bflo(x.x) * rr * gg[j].x, bfhi(x.x) * rr * gg[j].y, bflo(x.y) * rr * gg[j].z, bfhi(x.y) * rr * gg[j].w}; } }
    }
}

__device__ __forceinline__ void p0_prologue(Frame& F, const Args& A) {
    const int tid = opaque_tid(), lane = tid & 63, wave = __builtin_amdgcn_readfirstlane(tid >> 6);
    LAS float* scr = (LAS float*)(F.lds + wave * 17408);
    const int gw = F.vcu * 8 + wave, NGW = F.G * 8;
    constexpr int I_IN = 16 * 112, I_MKV = 16 * 16, I_UR = 16 * 16, I_UM = 8 * 16, I_OUT = 16 * 16, I_1 = 16 * 64, I_2 = 64 * 16;
    constexpr int PER_L = I_IN + I_MKV + I_UR + I_UM + I_OUT + I_1 + I_2;
#define TR_DESC(d, it_) do { const int l_ = (it_) / PER_L; int r_ = (it_) % PER_L; unsigned char* wl_ = F.ws + WS_W + (size_t)l_ * W_LAYER; \
        if (r_ < I_IN) { const int kb = r_ / 112, nb = r_ % 112; d = TrDesc{A.in[4] + (size_t)l_ * DM * INC, A.in[3] + l_ * DM, (bf16*)(wl_ + WO_IN) + (size_t)(64 * nb) * DM, INC, in_srccol(64 * nb), 64 * kb, DM}; } \
        else if ((r_ -= I_IN) < I_MKV) { const int kb = r_ / 16, nb = r_ % 16; d = TrDesc{A.in[9] + (size_t)l_ * DM * 1024, A.in[8] + l_ * DM, (bf16*)(wl_ + WO_MKV) + (size_t)(64 * nb) * DM, 1024, 64 * nb, 64 * kb, DM}; } \
        else if ((r_ -= I_MKV) < I_UR) { const int kb = r_ / 16, nb = r_ % 16; d = TrDesc{A.in[11] + (size_t)l_ * 1024 * DM, A.in[7] + l_ * 1024, (bf16*)(wl_ + WO_UP) + (size_t)(64 * nb) * 2048 + 512, DM, 64 * nb, 64 * kb, 2048}; } \
        else if ((r_ -= I_UR) < I_UM) { const int kb = r_ / 16, nb = r_ % 16; d = TrDesc{A.in[12] + (size_t)l_ * 512 * DM, nullptr, (bf16*)(wl_ + WO_UP) + (size_t)(64 * nb) * 2048 + 1536, DM, 64 * nb, 64 * kb, 2048}; } \
        else if ((r_ -= I_UM) < I_OUT) { const int kb = r_ / 16, nb = r_ % 16; d = TrDesc{A.in[13] + (size_t)l_ * DM * DM, nullptr, (bf16*)(wl_ + WO_OUT) + (size_t)(64 * nb) * DM, DM, 64 * nb, 64 * kb, DM}; } \
        else if ((r_ -= I_OUT) < I_1) { const int kb = r_ / 64, nb = r_ % 64; d = TrDesc{A.in[15] + (size_t)l_ * DM * DFF, A.in[14] + l_ * DM, (bf16*)(wl_ + WO_1) + (size_t)(64 * nb) * DM, DFF, 64 * nb, 64 * kb, DM}; } \
        else { r_ -= I_1; const int kb = r_ / 16, nb = r_ % 16; d = TrDesc{A.in[16] + (size_t)l_ * DFF * DM, nullptr, (bf16*)(wl_ + WO_2) + (size_t)(64 * nb) * DFF, DM, 64 * nb, 64 * kb, DFF}; } } while (0)
    {
        TrDesc dA, dB; f32x4 vA[16], vB[16];
        int it = gw;
        if (it < 2 * PER_L) { TR_DESC(dA, it); tr_load(dA, vA, lane); }
        while (it < 2 * PER_L) {
            const int itB = it + NGW;
            if (itB < 2 * PER_L) { TR_DESC(dB, itB); tr_load(dB, vB, lane); }
            tr_finish(dA, vA, scr, lane);
            if (itB >= 2 * PER_L) break;
            const int itA = itB + NGW;
            if (itA < 2 * PER_L) { TR_DESC(dA, itA); tr_load(dA, vA, lane); }
            tr_finish(dB, vB, scr, lane);
            it = itA;
        }
    }
#undef TR_DESC
    const int gt = F.vcu * 512 + tid, NT = F.G * 512;
    {
        const float inv = (float)exp2(-(double)(gt & 63) * (13.287712379549449 / 64.0));
        const int* pos = (const int*)A.in[2];
        for (int i = gt; i < T * 64; i += NT) {
            const float a = (float)pos[i >> 6] * inv;
            const double ad = (double)a, k = rint(ad * 0.15915494309189535), rr = ad - k * 6.283185307179586;
            const float rf = (float)rr;
            WSP(float, WS_COS)[i] = cosf(rf); WSP(float, WS_SIN)[i] = sinf(rf);
        }
    }
    for (int m = gw * 4; m < T; m += NGW * 4) {
        f32x4 v[4][4];
#pragma unroll
        for (int r = 0; r < 4; ++r) { const f32x4* xr = (const f32x4*)(A.in[0] + (size_t)(m + r) * DM) + 2 * lane;
#pragma unroll
            for (int j = 0; j < 2; ++j) { v[r][2 * j] = xr[128 * j]; v[r][2 * j + 1] = xr[128 * j + 1]; } }
        __builtin_amdgcn_sched_barrier(0);
#pragma unroll
        for (int r = 0; r < 4; ++r) { float q = 0.f; u32x4* o = (u32x4*)(WSP(bf16, WS_XB) + (size_t)(m + r) * DM) + lane;
#pragma unroll
            for (int j = 0; j < 2; ++j) { const f32x4 a = v[r][2 * j], b2 = v[r][2 * j + 1]; q += ((a.x * a.x + a.y * a.y) + (a.z * a.z + a.w * a.w)) + ((b2.x * b2.x + b2.y * b2.y) + (b2.z * b2.z + b2.w * b2.w));
                u32x4 w; w.x = cvtpk(a.x, a.y); w.y = cvtpk(a.z, a.w); w.z = cvtpk(b2.x, b2.y); w.w = cvtpk(b2.z, b2.w); o[64 * j] = w; }
            q = wave_sum(q);
            if (lane < 16) WSP(float, WS_SSP)[(size_t)(m + r) * 16 + lane] = (lane == 0) ? q : 0.f; }
    }
    norm_rows(F, A.in[1], WSP(bf16, WS_MEMN), NB * NMEM);
    __syncthreads();
    LAS float* PW = (LAS float*)F.lds;
    LAS float* WU = (LAS float*)(F.lds + 128 * 129 * 4);
    for (int it = F.vcu; it < 2 * 4 * 32; it += F.G) {
        const int l = it >> 7, g = (it >> 5) & 3, n0 = (it & 31) * 32;
        const float* pw = A.in[5] + ((size_t)l * 512 + g * 128) * 128; const float* ps = A.in[6] + l * 512 + g * 128; const float* wu = A.in[10] + ((size_t)l * 512 + g * 128) * DM + n0;
        for (int i = tid; i < 128 * 128; i += 512) { const int c = i >> 7, cp = i & 127; PW[c * 129 + cp] = pw[i] * ps[cp]; }
        for (int i = tid; i < 128 * 8; i += 512) { const int cp = i >> 3, q = i & 7; *(LAS f32x4*)(WU + cp * 32 + 4 * q) = *(const f32x4*)(wu + (size_t)cp * DM + 4 * q); }
        __syncthreads();
        const int c = tid & 127, nq = tid >> 7;
        f32x4 s0 = {0.f, 0.f, 0.f, 0.f}, s1 = {0.f, 0.f, 0.f, 0.f};
#pragma unroll 8
        for (int cp = 0; cp < 128; ++cp) { const float p = PW[c * 129 + cp]; s0 += p * *(LAS f32x4*)(WU + cp * 32 + 8 * nq); s1 += p * *(LAS f32x4*)(WU + cp * 32 + 8 * nq + 4); }
        bf16* dst = (bf16*)(F.ws + WS_W + (size_t)l * W_LAYER + WO_UP) + (size_t)(n0 + 8 * nq) * 2048 + g * 128 + c;
#pragma unroll
        for (int j = 0; j < 4; ++j) { dst[(size_t)j * 2048] = (bf16)(cvtpk(s0[j], 0.f) & 0xffffu); dst[(size_t)(4 + j) * 2048] = (bf16)(cvtpk(s1[j], 0.f) & 0xffffu); }
        __syncthreads();
    }
}

__device__ __forceinline__ bf16x8 frag_tr(LAS unsigned char* Tt, int ldb, int rowA, int rowB, int col0, int fr) {
#if USE_TR
    const int q = fr >> 2, p = fr & 3;
    const s16x4 lo = __builtin_bit_cast(s16x4, __builtin_amdgcn_ds_read_tr16_b64_v4i16((LAS v4i16_t*)(Tt + (rowA + q) * ldb + (col0 + 4 * p) * 2)));
    const s16x4 hi = __builtin_bit_cast(s16x4, __builtin_amdgcn_ds_read_tr16_b64_v4i16((LAS v4i16_t*)(Tt + (rowB + q) * ldb + (col0 + 4 * p) * 2)));
    return __builtin_shufflevector(lo, hi, 0, 1, 2, 3, 4, 5, 6, 7);
#else
    bf16x8 f;
#pragma unroll
    for (int e = 0; e < 4; ++e) { f[e] = *(LAS short*)(Tt + (rowA + e) * ldb + (col0 + fr) * 2); f[4 + e] = *(LAS short*)(Tt + (rowB + e) * ldb + (col0 + fr) * 2); }
    return f;
#endif
}
__device__ __forceinline__ bf16x8 pack8(const f32x4& a, const f32x4& b) { u32x4 w; w.x = cvtpk(a[0], a[1]); w.y = cvtpk(a[2], a[3]); w.z = cvtpk(b[0], b[1]); w.w = cvtpk(b[2], b[3]); return __builtin_bit_cast(bf16x8, w); }
template <int NT> __device__ __forceinline__ void mm_rows4(f32x4* acc, LAS unsigned char* T, int pitch, const bf16x8 (&b)[4], int fr, int fq) {
    LAS unsigned char* p = T + fr * pitch + fq * 16;
    bf16x8 f[3][4];
#pragma unroll
    for (int t = 0; t < 2 && t < NT; ++t)
#pragma unroll
        for (int ks = 0; ks < 4; ++ks) f[t][ks] = *(LAS bf16x8*)(p + 16 * t * pitch + ks * 64);
#pragma unroll
    for (int t = 0; t < NT; ++t) {
        if (t + 2 < NT) {
#pragma unroll
            for (int ks = 0; ks < 4; ++ks) f[(t + 2) % 3][ks] = *(LAS bf16x8*)(p + 16 * (t + 2) * pitch + ks * 64); }
        __builtin_amdgcn_sched_barrier(0);
        f32x4 a = {0.f, 0.f, 0.f, 0.f};
#pragma unroll
        for (int ks = 0; ks < 4; ++ks) a = mfma16(f[t % 3][ks], b[ks], a);
        acc[t] = a;
        __builtin_amdgcn_sched_barrier(0);
    }
}
template <int NT, int D> __device__ __forceinline__ void mm_tr(f32x4* acc, LAS unsigned char* Vt, int pitch, int rowA, int rowB, const bf16x8 pf, int fr) {
    bf16x8 g[D + 1];
#pragma unroll
    for (int t = 0; t < D && t < NT; ++t) g[t] = frag_tr(Vt, pitch, rowA, rowB, 16 * t, fr);
#pragma unroll
    for (int t = 0; t < NT; ++t) {
        if (t + D < NT) g[(t + D) % (D + 1)] = frag_tr(Vt, pitch, rowA, rowB, 16 * (t + D), fr);
        __builtin_amdgcn_sched_barrier(0);
        acc[t] = mfma16(g[t % (D + 1)], pf, acc[t]);
        __builtin_amdgcn_sched_barrier(0);
    }
}
__device__ __forceinline__ float log2gamma(int h) { return log2f(1.0f - exp2f(-5.0f - (float)h)); }

__device__ __forceinline__ void mem_kv_proj(Frame& F) {
    const int tid = opaque_tid(), lane = tid & 63, wave = __builtin_amdgcn_readfirstlane(tid >> 6), fr = lane & 15, fq = lane >> 4;
    LAS unsigned char* As = F.lds; LAS unsigned char* Bs = F.lds + 33792;
    const int wm = wave & 3, wn = wave >> 2;
    for (int it = F.vcu; it < 512; it += F.G) {
        const int l = it >> 8, tm = (it >> 4) & 15, tn = it & 15;
        const bf16* Ag = WSP(bf16, WS_MEMN) + (size_t)(tm * 64) * DM; const bf16* Bg = WSP(bf16, WS_W + (size_t)l * W_LAYER + WO_MKV) + (size_t)(tn * 64) * DM;
        f32x4 acc[2]; acc[0] = (f32x4){0.f, 0.f, 0.f, 0.f}; acc[1] = (f32x4){0.f, 0.f, 0.f, 0.f};
        for (int kc = 0; kc < 4; ++kc) {
            __syncthreads();
#pragma unroll
            for (int k = 0; k < 4; ++k) { const int c = tid + 512 * k, r = c >> 5, ch = c & 31;
                *(LAS u32x4*)(As + r * 528 + ch * 16) = *(const u32x4*)(Ag + (size_t)r * DM + kc * 256 + ch * 8);
                *(LAS u32x4*)(Bs + r * 528 + ch * 16) = *(const u32x4*)(Bg + (size_t)r * DM + kc * 256 + ch * 8); }
            __syncthreads();
#pragma unroll
            for (int ks = 0; ks < 8; ++ks) { const bf16x8 af = *(LAS bf16x8*)(As + (16 * wm + fr) * 528 + (32 * ks + 8 * fq) * 2);
#pragma unroll
                for (int c = 0; c < 2; ++c) acc[c] = mfma16(*(LAS bf16x8*)(Bs + (32 * wn + 16 * c + fr) * 528 + (32 * ks + 8 * fq) * 2), af, acc[c]); }
        }
        bf16* dst = WSP(bf16, WS_KVMEM) + (size_t)l * 1024 * 1024 + (size_t)(tm * 64 + 16 * wm + fr) * 1024 + tn * 64 + 32 * wn + 4 * fq;
#pragma unroll
        for (int c = 0; c < 2; ++c) { u32x2 w; w.x = cvtpk(acc[c][0], acc[c][1]); w.y = cvtpk(acc[c][2], acc[c][3]); *(u32x2*)(dst + 16 * c) = w; }
    }
    __syncthreads();
}

template <int W> __device__ __forceinline__ void pool_item(bf16* P, int tl0, int c0) {
    const int pos0 = tl0 & (SEQ - 1);
    u32x4 r[W + 7];
#pragma unroll
    for (int i = 0; i < W + 7; ++i) { r[i] = (u32x4){0u, 0u, 0u, 0u}; if (pos0 - (W - 1) + i >= 0) r[i] = *(const u32x4*)(P + (size_t)(tl0 - (W - 1) + i) * PLD + c0); }
    float s[8];
#pragma unroll
    for (int e = 0; e < 8; ++e) s[e] = 0.f;
#pragma unroll
    for (int i = 0; i < W - 1; ++i)
#pragma unroll
        for (int e = 0; e < 4; ++e) { s[2 * e] += bflo(r[i][e]); s[2 * e + 1] += bfhi(r[i][e]); }
#pragma unroll
    for (int tt = 0; tt < 8; ++tt) {
        const int pos = pos0 + tt; const float rc = 1.0f / (float)((pos + 1 < W) ? pos + 1 : W);
        float d[8];
#pragma unroll
        for (int e = 0; e < 4; ++e) { const float u0 = bflo(r[W - 1 + tt][e]), u1 = bfhi(r[W - 1 + tt][e]); s[2 * e] += u0; s[2 * e + 1] += u1; d[2 * e] = s[2 * e] * rc - u0; d[2 * e + 1] = s[2 * e + 1] * rc - u1; }
        u32x4 o; o.x = cvtpk(d[0], d[1]); o.y = cvtpk(d[2], d[3]); o.z = cvtpk(d[4], d[5]); o.w = cvtpk(d[6], d[7]);
        *(u32x4*)(P + (size_t)(tl0 + tt) * PLD + C_DP + c0) = o;
#pragma unroll
        for (int e = 0; e < 4; ++e) { s[2 * e] -= bflo(r[tt][e]); s[2 * e + 1] -= bfhi(r[tt][e]); }
    }
}
__device__ __forceinline__ void mix_pool(Frame& F) {
    const int tid = opaque_tid(), lane = tid & 63, wave = __builtin_amdgcn_readfirstlane(tid >> 6);
    bf16* P = WSP(bf16, WS_PROJ);
    const int gw = F.vcu * 8 + wave, NGW = F.G * 8;
    for (int it = gw; it < 4 * (TH / 32); it += NGW) {
        const int g = it & 3, tl0 = (it >> 2) * 32 + (lane >> 4) * 8, c0 = g * 128 + (lane & 15) * 8;
        if (g == 0) pool_item<2>(P, tl0, c0); else if (g == 1) pool_item<4>(P, tl0, c0); else if (g == 2) pool_item<8>(P, tl0, c0); else pool_item<16>(P, tl0, c0);
    }
}

__device__ __forceinline__ void mix_mem(Frame& F, int l, int hf, bool dummy) {
    const int tid = opaque_tid(), lane = tid & 63, wave = __builtin_amdgcn_readfirstlane(tid >> 6), fr = lane & 15, fq = lane >> 4; (void)tid; (void)lane; (void)wave; (void)fr; (void)fq;
    bf16* P = WSP(bf16, WS_PROJ);
    LAS unsigned char* Kt = F.lds; LAS unsigned char* Vt = F.lds + 69632;
    const int items = 8 * 64, ipw = (items + F.G - 1) / F.G;
    const int it_lo = F.vcu * ipw, it_hi = (it_lo + ipw < items) ? it_lo + ipw : items;
    int loaded = -1;
    for (int it = it_lo; it < it_hi; ++it) {
        const int combo = it >> 6, qt = it & 63, bl = combo >> 2, h = combo & 3;
        if (combo != loaded) {
            const bf16* src = WSP(bf16, WS_KVMEM) + (size_t)l * 1024 * 1024 + (size_t)((2 * hf + bl) * NMEM) * 1024 + h * 128;
            u32x4 stK[8], stV[8];
#pragma unroll
            for (int k = 0; k < 8; ++k) { const int c = tid + 512 * k, key = c >> 4, ch = c & 15; stK[k] = *(const u32x4*)(src + (size_t)key * 1024 + ch * 8); stV[k] = *(const u32x4*)(src + (size_t)key * 1024 + 512 + ch * 8); }
            __builtin_amdgcn_sched_barrier(0);
            __syncthreads();
#pragma unroll
            for (int k = 0; k < 8; ++k) { const int c = tid + 512 * k, key = c >> 4, ch = c & 15; *(LAS u32x4*)(Kt + key * 272 + ch * 16) = stK[k]; *(LAS u32x4*)(Vt + key * 272 + ch * 16) = stV[k]; }
            __syncthreads(); loaded = combo;
        }
        bf16* qp = P + (size_t)(bl * SEQ + qt * 128 + wave * 16 + fr) * PLD + C_XQ + h * 128;
        bf16x8 bq[4];
#pragma unroll
        for (int ks = 0; ks < 4; ++ks) bq[ks] = *(const bf16x8*)(qp + ks * 32 + fq * 8);
        f32x4 s[16];
        mm_rows4<16>(s, Kt, 272, bq, fr, fq);
        float mx = -3.0e38f;
#pragma unroll
        for (int kt = 0; kt < 16; ++kt) mx = fmaxf(fmaxf(fmaxf(s[kt][0], s[kt][1]), fmaxf(s[kt][2], s[kt][3])), mx);
        mx = max_xor16(mx); mx = max_xor32(mx);
        float lsum = 0.f;
#pragma unroll
        for (int kt = 0; kt < 16; ++kt)
#pragma unroll
            for (int r = 0; r < 4; ++r) { const float p = exp2f(s[kt][r] - mx); s[kt][r] = p; lsum += p; }
        lsum = add_xor16(lsum); lsum = add_xor32(lsum);
        const float rl = 1.0f / lsum;
        f32x4 o[8];
#pragma unroll
        for (int dt = 0; dt < 8; ++dt) o[dt] = (f32x4){0.f, 0.f, 0.f, 0.f};
#pragma unroll
        for (int kp = 0; kp < 8; ++kp) { const bf16x8 pf = pack8(s[2 * kp], s[2 * kp + 1]); mm_tr<8, 4>(o, Vt, 272, 32 * kp + 4 * fq, 32 * kp + 16 + 4 * fq, pf, fr); }
        bf16* op = (dummy ? WSP(bf16, WS_MERGED) + (size_t)(bl * SEQ + qt * 128 + wave * 16 + fr) * 512 + h * 128 : qp) + 16 * (fq & 1) + 4 * (fq & 2);
#pragma unroll
        for (int p = 0; p < 4; ++p) { const unsigned ax = cvtpk(o[2 * p][0] * rl, o[2 * p][1] * rl), ay = cvtpk(o[2 * p][2] * rl, o[2 * p][3] * rl), bx_ = cvtpk(o[2 * p + 1][0] * rl, o[2 * p + 1][1] * rl), by = cvtpk(o[2 * p + 1][2] * rl, o[2 * p + 1][3] * rl);
            auto rx = __builtin_amdgcn_permlane16_swap(ax, bx_, false, false); auto ry = __builtin_amdgcn_permlane16_swap(ay, by, false, false);
            u32x4 w; w.x = rx[0]; w.y = ry[0]; w.z = rx[1]; w.w = ry[1]; *(u32x4*)(op + 32 * p) = w; }
    }
    __syncthreads();
}

__device__ __forceinline__ void mix_kv(Frame& F) {
    const int tid = opaque_tid(), lane = tid & 63, wave = __builtin_amdgcn_readfirstlane(tid >> 6), fr = lane & 15, fq = lane >> 4; (void)tid; (void)lane; (void)wave; (void)fr; (void)fq;
    bf16* P = WSP(bf16, WS_PROJ);
    LAS unsigned char* Kd = F.lds; LAS unsigned char* Vt = F.lds + 34816;
    for (int un = F.vcu; un < 512; un += F.G) {
        const int h = un & 3, n = (un >> 2) & 63, bl = un >> 8; const size_t row0 = (size_t)bl * SEQ + n * 128; const float lg = log2gamma(h);
        u32x4 stK[4], stV[8];
#pragma unroll
        for (int k = 0; k < 4; ++k) { const int c = tid + 512 * k, j = c >> 4, ch = c & 15; stK[k] = *(const u32x4*)(P + (row0 + j) * PLD + C_K + h * 128 + ch * 8); }
#pragma unroll
        for (int k = 0; k < 8; ++k) { const int c = tid + 512 * k, j = c >> 5, ch = c & 31; stV[k] = *(const u32x4*)(P + (row0 + j) * PLD + C_V + h * 256 + ch * 8); }
        __builtin_amdgcn_sched_barrier(0);
        __syncthreads();
#pragma unroll
        for (int k = 0; k < 4; ++k) { const int c = tid + 512 * k, j = c >> 4, ch = c & 15; const u32x4 v = stK[k]; const float f = exp2f((float)(127 - j) * lg);
            u32x4 o; o.x = cvtpk(bflo(v.x) * f, bfhi(v.x) * f); o.y = cvtpk(bflo(v.y) * f, bfhi(v.y) * f); o.z = cvtpk(bflo(v.z) * f, bfhi(v.z) * f); o.w = cvtpk(bflo(v.w) * f, bfhi(v.w) * f);
            *(LAS u32x4*)(Kd + j * 272 + ch * 16) = o; }
#pragma unroll
        for (int k = 0; k < 8; ++k) { const int c = tid + 512 * k, j = c >> 5, ch = c & 31; *(LAS u32x4*)(Vt + j * 528 + ch * 16) = stV[k]; }
        __syncthreads();
        f32x4 acc[8][2];
#pragma unroll
        for (int dt = 0; dt < 8; ++dt) { acc[dt][0] = (f32x4){0.f, 0.f, 0.f, 0.f}; acc[dt][1] = (f32x4){0.f, 0.f, 0.f, 0.f}; }
#pragma unroll
        for (int ks = 0; ks < 4; ++ks) { const int rA = 32 * ks + 8 * fq, rB = rA + 4;
            const bf16x8 bv0 = frag_tr(Vt, 528, rA, rB, 16 * (2 * wave), fr), bv1 = frag_tr(Vt, 528, rA, rB, 16 * (2 * wave + 1), fr);
#pragma unroll
            for (int dt = 0; dt < 8; ++dt) { const bf16x8 ad = frag_tr(Kd, 272, rA, rB, 16 * dt, fr); acc[dt][0] = mfma16(ad, bv0, acc[dt][0]); acc[dt][1] = mfma16(ad, bv1, acc[dt][1]); } }
        bf16* dst = WSP(bf16, WS_KVN) + (size_t)un * 32768 + 16 * (fq & 1) + 4 * (fq & 2);
#pragma unroll
        for (int vi = 0; vi < 2; ++vi)
#pragma unroll
            for (int p = 0; p < 4; ++p) { const f32x4 a = acc[2 * p][vi], b = acc[2 * p + 1][vi];
                const unsigned ax = cvtpk(a[0], a[1]), ay = cvtpk(a[2], a[3]), bx_ = cvtpk(b[0], b[1]), by = cvtpk(b[2], b[3]);
                auto rx = __builtin_amdgcn_permlane16_swap(ax, bx_, false, false); auto ry = __builtin_amdgcn_permlane16_swap(ay, by, false, false);
                u32x4 o; o.x = rx[0]; o.y = ry[0]; o.z = rx[1]; o.w = ry[1];
                *(u32x4*)(dst + (size_t)(16 * (2 * wave + vi) + fr) * 128 + 32 * p) = o; }
    }
    __syncthreads();
}

__device__ __forceinline__ void scan_states(Frame& F) {
    const int tid = opaque_tid(), lane = tid & 63, wave = __builtin_amdgcn_readfirstlane(tid >> 6), fr = lane & 15, fq = lane >> 4; (void)tid; (void)lane; (void)wave; (void)fr; (void)fq;
    const bf16* KV = WSP(bf16, WS_KVN); bf16* SP = WSP(bf16, WS_SPREV);
    if (tid < 256)
    for (int p = F.vcu * 256 + tid; p < 8 * 8192; p += F.G * 256) {
        const int blk = p >> 13, bl = blk >> 2, h = blk & 3, off = (p & 8191) * 4; const float cd = exp2f(128.0f * log2gamma(h));
        f32x4 st = {0.f, 0.f, 0.f, 0.f};
        for (int n0 = 0; n0 < 64; n0 += 8) {
            u32x2 kv[8];
#pragma unroll
            for (int j = 0; j < 8; ++j) kv[j] = *(const u32x2*)(KV + (size_t)((bl * 64 + n0 + j) * 4 + h) * 32768 + off);
#pragma unroll
            for (int j = 0; j < 8; ++j) { u32x2 w; w.x = cvtpk(st[0], st[1]); w.y = cvtpk(st[2], st[3]); *(u32x2*)(SP + (size_t)((bl * 64 + n0 + j) * 4 + h) * 32768 + off) = w;
                st = st * cd + (f32x4){bflo(kv[j].x), bfhi(kv[j].x), bflo(kv[j].y), bfhi(kv[j].y)}; }
        }
    }
}

__device__ __forceinline__ void ret_out(Frame& F, bool dummy) {
    const int tid = opaque_tid(), lane = tid & 63, wave = __builtin_amdgcn_readfirstlane(tid >> 6), fr = lane & 15, fq = lane >> 4; (void)tid; (void)lane; (void)wave; (void)fr; (void)fq;
    bf16* P = WSP(bf16, WS_PROJ);
    LAS unsigned char* Kt = F.lds; LAS unsigned char* Vt = F.lds + 34816; LAS unsigned char* Sp = F.lds + 102400;
    for (int un = F.vcu; un < 512; un += F.G) {
        const int h = un & 3, n = (un >> 2) & 63, bl = un >> 8; const size_t row0 = (size_t)bl * SEQ + n * 128; const float lg = log2gamma(h);
        const bf16* spg = WSP(bf16, WS_SPREV) + (size_t)un * 32768;
        const int i = wave * 16 + fr; const size_t trow = row0 + i;
        bf16x8 bq[4];
#pragma unroll
        for (int ks = 0; ks < 4; ++ks) bq[ks] = *(const bf16x8*)(P + trow * PLD + C_Q + h * 128 + ks * 32 + fq * 8);
        bf16* gp = P + trow * PLD + C_G + h * 256 + 4 * fq;
        u32x4 stK[4], stS[4], stV[8], sp1[4];
        int tq = tid; asm volatile("" : "+v"(tq));
        { const bf16* pk = P + row0 * PLD + C_K + h * 128 + (size_t)(tq >> 4) * PLD + (tq & 15) * 8; const bf16* ps = spg + (size_t)(tq >> 4) * 128 + (tq & 15) * 8;
#pragma unroll
          for (int k = 0; k < 4; ++k) { stK[k] = *(const u32x4*)(pk + (size_t)(32 * k) * PLD); stS[k] = *(const u32x4*)(ps + (size_t)(32 * k) * 128); }
          const bf16* pv = P + row0 * PLD + C_V + h * 256 + (size_t)(tq >> 5) * PLD + (tq & 31) * 8;
#pragma unroll
          for (int k = 0; k < 8; ++k) stV[k] = *(const u32x4*)(pv + (size_t)(16 * k) * PLD);
#pragma unroll
          for (int k = 0; k < 4; ++k) sp1[k] = *(const u32x4*)(ps + (size_t)(128 + 32 * k) * 128); }
        __builtin_amdgcn_sched_barrier(0);
        __syncthreads();
#pragma unroll
        for (int k = 0; k < 4; ++k) { const int j = (tq >> 4) + 32 * k, ch = tq & 15; *(LAS u32x4*)(Kt + j * 272 + ch * 16) = stK[k]; *(LAS u32x4*)(Sp + j * 272 + ch * 16) = stS[k]; }
#pragma unroll
        for (int k = 0; k < 8; ++k) { const int j = (tq >> 5) + 16 * k, ch = tq & 31; *(LAS u32x4*)(Vt + j * 528 + ch * 16) = stV[k]; }
        __syncthreads();
        f32x4 acc[16];
        mm_rows4<8>(acc, Sp, 272, bq, fr, fq);
        __syncthreads();
#pragma unroll
        for (int k = 0; k < 4; ++k) { const int j = (tq >> 4) + 32 * k, ch = tq & 15; *(LAS u32x4*)(Sp + j * 272 + ch * 16) = sp1[k]; }
        __syncthreads();
        mm_rows4<8>(acc + 8, Sp, 272, bq, fr, fq);
        bf16* gq = P + trow * PLD + C_G + h * 256 + 16 * (fq & 1) + 4 * (fq & 2);
        u32x4 gl[8];
#pragma unroll
        for (int p = 0; p < 8; ++p) gl[p] = *(const u32x4*)(gq + 32 * p);
        const float fac = exp2f((float)(i + 1) * lg);
#pragma unroll
        for (int vt = 0; vt < 16; ++vt) acc[vt] = acc[vt] * fac;
        f32x4 s[8];
        int io = i; asm volatile("" : "+v"(io));
        bf16x8 kf[2][4];
        { LAS unsigned char* kp0 = Kt + fr * 272 + fq * 16;
#pragma unroll
          for (int ks = 0; ks < 4; ++ks) kf[0][ks] = *(LAS bf16x8*)(kp0 + ks * 64); }
#pragma unroll
        for (int kt = 0; kt < 8; ++kt) { s[kt] = (f32x4){0.f, 0.f, 0.f, 0.f};
            if (kt <= wave) {
                if (kt + 1 < 8 && kt + 1 <= wave) { LAS unsigned char* kp1 = Kt + (16 * (kt + 1) + fr) * 272 + fq * 16;
#pragma unroll
                    for (int ks = 0; ks < 4; ++ks) kf[(kt + 1) & 1][ks] = *(LAS bf16x8*)(kp1 + ks * 64); }
                __builtin_amdgcn_sched_barrier(0);
#pragma unroll
                for (int ks = 0; ks < 4; ++ks) s[kt] = mfma16(kf[kt & 1][ks], bq[ks], s[kt]);
#pragma unroll
                for (int r = 0; r < 4; ++r) { const int key = 16 * kt + 4 * fq + r; s[kt][r] = (key <= io) ? s[kt][r] * exp2f((float)(io - key) * lg) : 0.f; } } }
#pragma unroll
        for (int kp = 0; kp < 4; ++kp) if (2 * kp <= wave) { const bf16x8 pf = pack8(s[2 * kp], s[2 * kp + 1]); mm_tr<16, 4>(acc, Vt, 528, 32 * kp + 4 * fq, 32 * kp + 16 + 4 * fq, pf, fr); }
        float ss = 0.f;
#pragma unroll
        for (int vt = 0; vt < 16; ++vt) ss += (acc[vt][0] * acc[vt][0] + acc[vt][1] * acc[vt][1]) + (acc[vt][2] * acc[vt][2] + acc[vt][3] * acc[vt][3]);
        ss = add_xor16(ss); ss = add_xor32(ss);
        const float rinv = rsqrtf(ss * (1.0f / 256.0f) + EPS);
#pragma unroll
        for (int p = 0; p < 8; ++p) {
            u32x2 g[2];
            { auto rx = __builtin_amdgcn_permlane16_swap(gl[p][0], gl[p][2], false, false); auto ry = __builtin_amdgcn_permlane16_swap(gl[p][1], gl[p][3], false, false);
              g[0].x = rx[0]; g[0].y = ry[0]; g[1].x = rx[1]; g[1].y = ry[1]; }
            u32x2 w[2];
#pragma unroll
            for (int j = 0; j < 2; ++j) { const int vt = 2 * p + j; const float g0 = bflo(g[j].x), g1 = bfhi(g[j].x), g2 = bflo(g[j].y), g3 = bfhi(g[j].y);
                w[j].x = cvtpk(acc[vt][0] * rinv * g0 * sigmoidf_(g0), acc[vt][1] * rinv * g1 * sigmoidf_(g1)); w[j].y = cvtpk(acc[vt][2] * rinv * g2 * sigmoidf_(g2), acc[vt][3] * rinv * g3 * sigmoidf_(g3)); }
            u32x4 o;
            { auto rx = __builtin_amdgcn_permlane16_swap(w[0].x, w[1].x, false, false); auto ry = __builtin_amdgcn_permlane16_swap(w[0].y, w[1].y, false, false);
              o.x = rx[0]; o.y = ry[0]; o.z = rx[1]; o.w = ry[1]; }
            *(u32x4*)((dummy ? WSP(bf16, WS_MERGED) + trow * 1024 + h * 256 + 16 * (fq & 1) + 4 * (fq & 2) : gq) + 32 * p) = o; }
    }
    __syncthreads();
}

constexpr int N_PHASES = 2 + 2 * 14 + 1;
__global__ void __launch_bounds__(512, 2) fwd_kernel(Args args) {
    extern __shared__ __attribute__((aligned(16))) unsigned char lds_raw[];
    Frame F;
    F.lds = (LAS unsigned char*)lds_raw;
    F.G = gridDim.x; { const int bx = blockIdx.x; F.vcu = (F.G % 8 == 0) ? (bx % 8) * (F.G / 8) + bx / 8 : bx; }
    F.ws = args.ws;
    const Args& A = args;
    for (int u = TID; u < (LDS_BYTES - LDSCTL_OFF) / 4; u += 512) ((LAS unsigned*)(F.lds + LDSCTL_OFF))[u] = 0u;
    __syncthreads();
    const int lo = args.ph_lo, hi = args.ph_hi;
    XcdBarrier bar; bar.bar = WSP(unsigned, WS_CTL) + CW_BAR; bar.x = 0; bar.st = nullptr;
    if (hi - lo > 1) bar = xcd_barrier_post(WSP(unsigned, WS_CTL) + CW_BAR, (volatile LAS unsigned*)(F.lds + MISC_OFF) + 8);
    int ph = 0;
#define RUN() (lo <= ph && ph < hi)
#define END_PHASE() do { if (RUN() && ph + 1 < hi) xcd_barrier(bar); ++ph; } while (0)
    const int bx = (int)blockIdx.x;

    if (RUN()) for (int rep = 0; rep < REPS(10); ++rep) { if (rep) xcd_barrier(bar); p0_prologue(F, A); }
    END_PHASE();
    if (RUN()) for (int rep = 0; rep < REPS(11); ++rep) { if (rep) xcd_barrier(bar); mem_kv_proj(F); }
    END_PHASE();
#pragma unroll 1
    for (int l = 0; l < 2; ++l) {
        unsigned char* wl = F.ws + WS_W + (size_t)l * W_LAYER;
#pragma unroll 1
        for (int hf = 0; hf < 2; ++hf) {
            const int t0 = hf * TH;
            if (RUN()) for (int rep = 0; rep < REPS(0); ++rep) { if (rep) xcd_barrier(bar);
                pg8::Gemm g{WSP(bf16, WS_XB) + (size_t)t0 * DM, (const bf16*)(wl + WO_IN)};
                pg8::StaticOrder<TH, 4096> S; S.init(F.G, bx);
                pg8::EpiBf<2> E{WSP(bf16, WS_PROJ), PLD, WSP(float, WS_COS), WSP(float, WS_SIN), t0, WSP(float, WS_SSP)};
                pg8::gemm_phase<DM, DM, DM, pg8::EpiBf<2>, pg8::StaticOrder<TH, 4096>>(F.lds, g, S, E);
            }
            END_PHASE();
            if (RUN()) for (int rep = 0; rep < REPS(1); ++rep) { if (rep) xcd_barrier(bar); mix_pool(F); mix_mem(F, l, hf, rep != 0); mix_kv(F); }
            END_PHASE();
            if (RUN()) for (int rep = 0; rep < REPS(2); ++rep) { if (rep) xcd_barrier(bar); scan_states(F); }
            END_PHASE();
            if (RUN()) for (int rep = 0; rep < REPS(3); ++rep) { if (rep) xcd_barrier(bar); ret_out(F, rep != 0); }
            END_PHASE();
            if (RUN()) for (int rep = 0; rep < REPS(4); ++rep) { if (rep) xcd_barrier(bar);
                pg8::Gemm g{WSP(bf16, WS_XB) + (size_t)t0 * DM, (const bf16*)(wl + WO_IN) + (size_t)4096 * DM};
                pg8::GateOrder<TH> S; S.init(F.G, bx);
                pg8::EpiBf<3> E{WSP(bf16, WS_GATES), 3072, nullptr, nullptr, t0, WSP(float, WS_SSP)};
                pg8::gemm_phase<DM, DM, DM, pg8::EpiBf<3>, pg8::GateOrder<TH>>(F.lds, g, S, E);
            }
            if (RUN()) for (int rep = 0; rep < REPS(5); ++rep) { if (rep) xcd_barrier(bar);
                pg8::Gemm g{WSP(bf16, WS_PROJ) + C_DP, (const bf16*)(wl + WO_UP)};
                pg8::StaticOrder<TH, DM> S; S.init(F.G, bx);
                pg8::EpiUp E{WSP(bf16, WS_MERGED), WSP(bf16, WS_GATES)};
                pg8::gemm_phase<2048, PLD, 2048, pg8::EpiUp, pg8::StaticOrder<TH, DM>>(F.lds, g, S, E);
            }
            END_PHASE();
            if (RUN()) for (int rep = 0; rep < REPS(6); ++rep) { if (rep) xcd_barrier(bar);
                pg8::Gemm g{WSP(bf16, WS_MERGED), (const bf16*)(wl + WO_OUT)};
                pg8::StaticOrder<TH, DM> S; S.init(F.G, bx);
                pg8::EpiRes E{WSP(bf16, WS_XB) + (size_t)t0 * DM, WSP(float, WS_SSP) + (size_t)t0 * 16, rep ? WSP(bf16, WS_KVN) : nullptr};
                pg8::gemm_phase<DM, DM, DM, pg8::EpiRes, pg8::StaticOrder<TH, DM>>(F.lds, g, S, E);
            }
            END_PHASE();
        }
        if (RUN()) for (int rep = 0; rep < REPS(8); ++rep) { if (rep) xcd_barrier(bar);
            pg8::Gemm g{WSP(bf16, WS_XB), (const bf16*)(wl + WO_1)};
            pg8::StaticOrder<T, DFF> S; S.init(F.G, bx);
            pg8::EpiBf<1> E{WSP(bf16, WS_U), DFF, nullptr, nullptr, 0, WSP(float, WS_SSP)};
            pg8::gemm_phase<DM, DM, DM, pg8::EpiBf<1>, pg8::StaticOrder<T, DFF>>(F.lds, g, S, E);
        }
        END_PHASE();
        if (RUN()) {
            pg8::Gemm g{WSP(bf16, WS_U), (const bf16*)(wl + WO_2)};
            pg8::StaticOrder<T, DM> S; S.init(F.G, bx);
            pg8::EpiRes E{WSP(bf16, WS_XB), WSP(float, WS_SSP), nullptr};
            pg8::gemm_phase<DFF, DFF, DFF, pg8::EpiRes, pg8::StaticOrder<T, DM>>(F.lds, g, S, E);
#if (PROBE_DUP >> 9) & 1
            xcd_barrier(bar);
            { pg8::StaticOrder<TH, DM> S2; S2.init(F.G, bx); pg8::EpiRes E2{WSP(bf16, WS_XB), WSP(float, WS_SSP), (bf16*)(F.ws + WS_END)};
              pg8::gemm_phase<DFF, DFF, DFF, pg8::EpiRes, pg8::StaticOrder<TH, DM>>(F.lds, g, S2, E2); }
#endif
        }
        END_PHASE();
        if (l == 1) { if (RUN()) final_norm(F, A.out, A.in[17]); END_PHASE(); }
#if (PROBE_DUP >> 12) & 1
        for (int rep = 0; rep < 8; ++rep) xcd_barrier(bar);
#endif
    }
#undef RUN
#undef END_PHASE
}

extern "C" void kernel_launch(void* const* d_in, const int* in_sizes, int n_in, void* d_out, int out_size, void* d_ws, size_t ws_size, hipStream_t stream) {
    static int grid = 0;
    if (grid == 0) {
        if (n_in != 18 || in_sizes[0] != T * DM || out_size != T * DM || ws_size < WS_END) { fprintf(stderr, "kernel_launch: unexpected shapes / workspace (n_in %d, ws %zu)\n", n_in, ws_size); grid = -1; return; }
        int dev = 0, cus = 0, per_cu = 0;
        if (hipGetDevice(&dev) != hipSuccess || hipDeviceGetAttribute(&cus, hipDeviceAttributeMultiprocessorCount, dev) != hipSuccess) { grid = -1; return; }
        if (hipFuncSetAttribute((const void*)fwd_kernel, hipFuncAttributeMaxDynamicSharedMemorySize, LDS_BYTES) != hipSuccess) { fprintf(stderr, "kernel_launch: hipFuncSetAttribute failed\n"); grid = -1; return; }
        if (hipOccupancyMaxActiveBlocksPerMultiprocessor(&per_cu, (const void*)fwd_kernel, 512, LDS_BYTES) != hipSuccess || per_cu < 1) { fprintf(stderr, "kernel_launch: occupancy query says %d\n", per_cu); (void)hipGetLastError(); grid = -1; return; }
        grid = cus;
    }
    if (grid < 0) return;
    (void)hipMemsetAsync((char*)d_ws + WS_CTL, 0, CTL_ZERO_BYTES, stream);
    Args a{};
    for (int i = 0; i < 18; ++i) a.in[i] = (const float*)d_in[i];
    a.out = (float*)d_out; a.ws = (unsigned char*)d_ws;
#if MK_SINGLE
    a.ph_lo = 0; a.ph_hi = N_PHASES;
    hipLaunchKernelGGL(fwd_kernel, dim3(grid), dim3(512), LDS_BYTES, stream, a);
#else
    for (int p = 0; p < N_PHASES; ++p) { a.ph_lo = p; a.ph_hi = p + 1; hipLaunchKernelGGL(fwd_kernel, dim3(grid), dim3(512), LDS_BYTES, stream, a); }
#endif
}
```

```cpp
#include <hip/hip_runtime.h>
#include <cstdio>
#include <cstdint>

#ifndef MK_SINGLE
#define MK_SINGLE 1
#endif
#ifndef PROBE_DUP
#define PROBE_DUP 0
#endif
#define REPS(k) (1 + ((PROBE_DUP >> (k)) & 1))
#ifndef USE_TR
#define USE_TR 1
#endif

#define LAS __attribute__((address_space(3)))
#define GAS __attribute__((address_space(1)))
typedef unsigned short bf16;
typedef short bf16x8 __attribute__((ext_vector_type(8)));
typedef short s16x4 __attribute__((ext_vector_type(4)));
typedef float f32x4 __attribute__((ext_vector_type(4)));
typedef float f32x2 __attribute__((ext_vector_type(2)));
typedef unsigned u32x4 __attribute__((ext_vector_type(4)));
typedef unsigned u32x2 __attribute__((ext_vector_type(2)));
typedef __bf16 bf16x2_t __attribute__((ext_vector_type(2)));
typedef short v4i16_t __attribute__((ext_vector_type(4)));

constexpr int DM = 1024, NB = 4, SEQ = 8192, T = NB * SEQ, TH = T / 2, NMEM = 256, DFF = 4096;
constexpr int INC = 7168;
constexpr int PLD = 4608;
constexpr int C_Q = 512, C_K = 1024, C_V = 1536, C_DP = 2560, C_G = 3072, C_XQ = 4096;
constexpr float EPS = 1e-6f;
constexpr float XQ_SCALE = 0.08838834764831845f * 1.4426950408889634f;
constexpr float LOG2E = 1.4426950408889634f;
constexpr float K_SCALE = 0.08838834764831845f;

constexpr size_t MiB = 1u << 20;
constexpr size_t WS_CTL = 0, CTL_ZERO_BYTES = 1 * MiB;
constexpr size_t WS_COS = 2 * MiB, WS_SIN = 10 * MiB;
constexpr size_t WS_SSP = 18 * MiB;
constexpr size_t WS_MEMN = 20 * MiB;
constexpr size_t WS_KVMEM = 24 * MiB;
constexpr size_t WS_W = 32 * MiB, W_LAYER = 38 * MiB;
constexpr size_t WO_IN = 0, WO_UP = 14 * MiB, WO_OUT = 18 * MiB, WO_1 = 20 * MiB, WO_2 = 28 * MiB, WO_MKV = 36 * MiB;
constexpr size_t WS_XB = 108 * MiB;
constexpr size_t WS_MERGED = 172 * MiB;
constexpr size_t WS_PROJ = 204 * MiB;
constexpr size_t WS_KVN = 348 * MiB;
constexpr size_t WS_SPREV = 412 * MiB;
constexpr size_t WS_GATES = 348 * MiB;
constexpr size_t WS_U = 172 * MiB;
constexpr size_t WS_END = 444 * MiB;
static_assert(WS_W + 2 * W_LAYER <= WS_XB && WS_U + (size_t)T * DFF * 2 <= WS_END && WS_PROJ + (size_t)TH * PLD * 2 <= WS_KVN, "ws map");
constexpr int CW_TMO = 0, CW_BAR = 4096;

constexpr int RING_BYTES = 131072, SCRATCH_BYTES = 147456, LDSCTL_OFF = SCRATCH_BYTES, MISC_OFF = LDSCTL_OFF + 320, LDS_BYTES = SCRATCH_BYTES + 1024;

__device__ __forceinline__ unsigned cvtpk(float lo, float hi) { f32x2 v = {lo, hi}; bf16x2_t b = __builtin_convertvector(v, bf16x2_t); return __builtin_bit_cast(unsigned, b); }
__device__ __forceinline__ float bflo(unsigned u) { return __uint_as_float(u << 16); }
__device__ __forceinline__ float bfhi(unsigned u) { return __uint_as_float(u & 0xffff0000u); }
__device__ __forceinline__ f32x4 mfma16(bf16x8 a, bf16x8 b, f32x4 c) { return __builtin_amdgcn_mfma_f32_16x16x32_bf16(a, b, c, 0, 0, 0); }
#define SWZ_XOR(m) (((m) << 10) | 0x1f)
__device__ __forceinline__ float wave_sum(float v) {
    v += __int_as_float(__builtin_amdgcn_ds_swizzle(__float_as_int(v), SWZ_XOR(1)));
    v += __int_as_float(__builtin_amdgcn_ds_swizzle(__float_as_int(v), SWZ_XOR(2)));
    v += __int_as_float(__builtin_amdgcn_ds_swizzle(__float_as_int(v), SWZ_XOR(4)));
    v += __int_as_float(__builtin_amdgcn_ds_swizzle(__float_as_int(v), SWZ_XOR(8)));
    { auto r = __builtin_amdgcn_permlane16_swap(__float_as_uint(v), __float_as_uint(v), false, false); v = __uint_as_float(r[0]) + __uint_as_float(r[1]); }
    { auto r = __builtin_amdgcn_permlane32_swap(__float_as_uint(v), __float_as_uint(v), false, false); v = __uint_as_float(r[0]) + __uint_as_float(r[1]); }
    return v;
}
__device__ __forceinline__ float add_xor16(float v) { auto r = __builtin_amdgcn_permlane16_swap(__float_as_uint(v), __float_as_uint(v), false, false); return __uint_as_float(r[0]) + __uint_as_float(r[1]); }
__device__ __forceinline__ float add_xor32(float v) { auto r = __builtin_amdgcn_permlane32_swap(__float_as_uint(v), __float_as_uint(v), false, false); return __uint_as_float(r[0]) + __uint_as_float(r[1]); }
__device__ __forceinline__ float max_xor16(float v) { auto r = __builtin_amdgcn_permlane16_swap(__float_as_uint(v), __float_as_uint(v), false, false); return fmaxf(__uint_as_float(r[0]), __uint_as_float(r[1])); }
__device__ __forceinline__ float max_xor32(float v) { auto r = __builtin_amdgcn_permlane32_swap(__float_as_uint(v), __float_as_uint(v), false, false); return fmaxf(__uint_as_float(r[0]), __uint_as_float(r[1])); }
__device__ __forceinline__ float sigmoidf_(float x) { return 1.0f / (1.0f + __expf(-x)); }

namespace pg8 {
#define PG8_LAS __attribute__((address_space(3)))
typedef unsigned short bf16_t;
constexpr int BM = 256, BK = 64, HALF = 128, HTB = HALF * BK * 2, STAGE_BYTES = 8 * HTB, NXCD = 8, WGM = 8;
__host__ __device__ __forceinline__ int lds_byte(int r, int c) { const int st = (r >> 4) * 2 + (c >> 5), rr = r & 15, cc = c & 31, ob = rr * 64 + cc * 2; return st * 1024 + (ob ^ (((ob >> 9) & 1) << 5)); }
__host__ __device__ __forceinline__ void stage_rc(int b, int& R, int& C) { const int st = b / 1024, sb = b % 1024, swz = sb ^ (((sb >> 9) & 1) << 5); R = (st >> 1) * 16 + swz / 64; C = (st & 1) * 32 + (swz % 64) / 2; }
__host__ __device__ __forceinline__ int perm32(int rho) { const int n = rho >> 4, i = rho & 15; return 8 * (i >> 2) + 4 * n + (i & 3); }

struct Unit { int pm, pn; };
struct Gemm { const bf16_t* A; const bf16_t* Bt; };

template <int M_, int N_> struct StaticOrder {
    static constexpr int nM = M_ / BM, nN = N_ / BM, nwg = nM * nN;
    int G, c;
    __host__ __device__ void init(int G_, int c_) { G = G_; c = c_; }
    __host__ __device__ bool next(int i, Unit& u) const {
        const long L = (long)i * G + c; if (L >= nwg) return false;
        int wgid = (int)L; { const int q = nwg / NXCD, r = nwg % NXCD, xcd = wgid % NXCD, off = wgid / NXCD; wgid = (xcd < r ? xcd * (q + 1) : r * (q + 1) + (xcd - r) * q) + off; }
        const int nig = WGM * nN, gid = wgid / nig, fm = gid * WGM, gsz = (nM - fm) < WGM ? (nM - fm) : WGM;
        u.pm = fm + ((wgid % nig) % gsz); u.pn = (wgid % nig) / gsz; return true;
    }
    __device__ __forceinline__ void a_ready(const Unit&) const {}
    __device__ __forceinline__ void done(const Unit&) const {}
};

template <int M_> struct GateOrder {
    StaticOrder<M_, 1024> S;
    __host__ __device__ void init(int G_, int c_) { S.init(G_, c_); }
    __host__ __device__ bool next(int i, Unit& u) const { Unit b; if (!S.next(i / 3, b)) return false; u.pm = b.pm; u.pn = b.pn + 4 * (i % 3); return true; }
    __device__ __forceinline__ void a_ready(const Unit&) const {}
    __device__ __forceinline__ void done(const Unit&) const {}
};

typedef f32x4 Acc[2][2][4][2];

template <int MODE> struct EpiBf {
    static constexpr bool PERM = true, AFTER_DRAIN = false, HOOK = false, EARLY_PRE = (MODE != 2);
    bf16_t* O; int ldc; const float* cosT; const float* sinT; int t0; const float* ssp;
    __device__ __forceinline__ void hook(Acc&, const Unit&, int, int, int, int, int) const {}
    struct Pre { float rs[2][4]; };
    struct Raw { f32x4 v[2][4]; };
    __device__ __forceinline__ Raw pre_load(const Unit& u, int wr, int fr, int fq) const {
        Raw r; const float* p = ssp + (size_t)(t0 + u.pm * BM + wr * 64) * 16 + (unsigned)(fr * 16 + 4 * fq);
#pragma unroll
        for (int ai = 0; ai < 2; ++ai)
#pragma unroll
            for (int m = 0; m < 4; ++m) r.v[ai][m] = *(const f32x4*)(p + (size_t)(ai * HALF + m * 16) * 16);
        __builtin_amdgcn_sched_barrier(0);
        return r;
    }
    __device__ __forceinline__ Pre pre_finish(const Raw& r) const {
        Pre p;
#pragma unroll
        for (int ai = 0; ai < 2; ++ai)
#pragma unroll
            for (int m = 0; m < 4; ++m) { const f32x4 v = r.v[ai][m]; float q = (v[0] + v[1]) + (v[2] + v[3]); q = add_xor16(q); q = add_xor32(q); p.rs[ai][m] = rsqrtf(q * (1.0f / DM) + EPS); }
        return p;
    }
    __device__ __forceinline__ Pre operator()(const Acc& acc, const Unit& u, const Unit& un, int wr, int wc, int fr_in, int fq_in, const Pre& pr) const {
        int fr = fr_in, fq = fq_in; asm volatile("" : "+v"(fr), "+v"(fq));
        if (MODE == 2 && u.pn >= 2 && u.pn < 6) {
            const int sec = (u.pn < 4) ? C_Q : C_K, head = 2 * (u.pn & 1) + (wc >> 1);
            const float ksc0 = (u.pn >= 4) ? K_SCALE : 1.0f;
            const int rowu = u.pm * BM + wr * 64, dcolu = sec + head * 128 + 32 * (wc & 1);
            const unsigned toff = (unsigned)(fr * 64 + 8 * fq), ooff = (unsigned)(fr * ldc + 8 * fq);
#pragma unroll
            for (int am = 0; am < 8; am += 2) {
                f32x4 cs[2][4];
#pragma unroll
                for (int j = 0; j < 2; ++j) { const size_t tr = (size_t)(t0 + rowu + ((am + j) >> 2) * HALF + ((am + j) & 3) * 16) * 64 + 32 * (wc & 1); const float* cp = cosT + tr; const float* sp = sinT + tr;
                    cs[j][0] = *(const f32x4*)(cp + toff); cs[j][1] = *(const f32x4*)(cp + toff + 4); cs[j][2] = *(const f32x4*)(sp + toff); cs[j][3] = *(const f32x4*)(sp + toff + 4); }
                __builtin_amdgcn_sched_barrier(0);
#pragma unroll
                for (int j = 0; j < 2; ++j) { const int ai = (am + j) >> 2, m = (am + j) & 3;
                    const float ksc = ksc0 * pr.rs[ai][m];
                    const f32x4 c0 = cs[j][0], c1 = cs[j][1], s0 = cs[j][2], s1 = cs[j][3];
                    const f32x4 a0 = acc[ai][0][m][0], a1 = acc[ai][0][m][1], b0 = acc[ai][1][m][0], b1 = acc[ai][1][m][1];
                    const f32x4 o10 = (a0 * c0 - b0 * s0) * ksc, o11 = (a1 * c1 - b1 * s1) * ksc, o20 = (b0 * c0 + a0 * s0) * ksc, o21 = (b1 * c1 + a1 * s1) * ksc;
                    bf16_t* rowp = O + (size_t)(rowu + ai * HALF + m * 16) * ldc + dcolu;
                    u32x4 w1, w2; w1.x = cvtpk(o10[0], o10[1]); w1.y = cvtpk(o10[2], o10[3]); w1.z = cvtpk(o11[0], o11[1]); w1.w = cvtpk(o11[2], o11[3]);
                    w2.x = cvtpk(o20[0], o20[1]); w2.y = cvtpk(o20[2], o20[3]); w2.z = cvtpk(o21[0], o21[1]); w2.w = cvtpk(o21[2], o21[3]);
                    *(u32x4*)(rowp + ooff) = w1; *(u32x4*)(rowp + ooff + 64) = w2;
                }
                __builtin_amdgcn_sched_barrier(0); }
            return pre_finish(pre_load(un, wr, fr, fq));
        }
        int cbase = u.pn * BM; float sc = 1.0f;
        if (MODE == 2) { const int pn = u.pn; if (pn < 2) cbase = 256 * pn; else if (pn < 10) cbase = C_V + 256 * (pn - 6); else if (pn < 14) cbase = C_G + 256 * (pn - 10); else { cbase = C_XQ + 256 * (pn - 14); sc = XQ_SCALE; } }
        const unsigned loff = (unsigned)(fr * ldc + 8 * fq);
        const Raw raw = pre_load(un, wr, fr, fq);
        const bool inv = u.pn < 4;
        Pre pn;
#pragma unroll
        for (int ai = 0; ai < 2; ++ai) {
            u32x4 w[4][2];
#pragma unroll
            for (int m = 0; m < 4; ++m)
#pragma unroll
                for (int bj = 0; bj < 2; ++bj) { f32x4 v0 = acc[ai][bj][m][0], v1 = acc[ai][bj][m][1];
                    { const float f = (MODE == 3 ? -LOG2E : sc) * pr.rs[ai][m]; v0 = v0 * f; v1 = v1 * f; }
                    if (MODE == 3) {
#pragma unroll
                        for (int e = 0; e < 4; ++e) { v0[e] = 1.0f + __builtin_amdgcn_exp2f(fminf(fmaxf(v0[e], -80.f), 80.f)); v1[e] = 1.0f + __builtin_amdgcn_exp2f(fminf(fmaxf(v1[e], -80.f), 80.f)); }
                        if (inv) {
#pragma unroll
                            for (int e = 0; e < 4; ++e) { v0[e] = __builtin_amdgcn_rcpf(v0[e]); v1[e] = __builtin_amdgcn_rcpf(v1[e]); } } }
                    if (MODE == 1) { v0 = __builtin_elementwise_max(v0, (f32x4){0.f, 0.f, 0.f, 0.f}); v1 = __builtin_elementwise_max(v1, (f32x4){0.f, 0.f, 0.f, 0.f}); v0 = v0 * v0; v1 = v1 * v1; }
                    w[m][bj].x = cvtpk(v0[0], v0[1]); w[m][bj].y = cvtpk(v0[2], v0[3]); w[m][bj].z = cvtpk(v1[0], v1[1]); w[m][bj].w = cvtpk(v1[2], v1[3]); }
            if (ai == 0) pn = pre_finish(raw);
            __builtin_amdgcn_sched_barrier(0);
#pragma unroll
            for (int m = 0; m < 4; ++m) { bf16_t* rowu = O + (size_t)(u.pm * BM + wr * 64 + ai * HALF + m * 16) * ldc + cbase + wc * 32;
#pragma unroll
                for (int bj = 0; bj < 2; ++bj) *(u32x4*)(rowu + loff + bj * HALF) = w[m][bj]; }
            __builtin_amdgcn_sched_barrier(0); }
        return pn;
    }
};
struct EpiRes {
    static constexpr bool PERM = true, AFTER_DRAIN = false, HOOK = false, EARLY_PRE = false;
    struct Pre {}; struct Raw {};
    __device__ __forceinline__ Raw pre_load(const Unit&, int, int, int) const { return Raw{}; }
    __device__ __forceinline__ Pre pre_finish(const Raw&) const { return Pre{}; }
    bf16_t* X; float* ssp; bf16_t* dummy;
    __device__ __forceinline__ void hook(Acc&, const Unit&, int, int, int, int, int) const {}
    __device__ __forceinline__ Pre operator()(const Acc& acc, const Unit& u, const Unit&, int wr, int wc, int fr, int fq, const Pre&) const {
        const unsigned loff = (unsigned)((wr * 64 + fr) * 1024 + u.pn * BM + wc * 32 + 8 * fq);
        const bf16_t* Xu = X + (size_t)u.pm * BM * 1024; bf16_t* Yu = (dummy ? dummy : X) + (size_t)u.pm * BM * 1024;
        u32x4 xb[2][4][2];
#pragma unroll
        for (int ai = 0; ai < 2; ++ai)
#pragma unroll
            for (int m = 0; m < 4; ++m)
#pragma unroll
                for (int bj = 0; bj < 2; ++bj) xb[ai][m][bj] = *(const u32x4*)(Xu + (size_t)(ai * HALF + m * 16) * 1024 + loff + bj * HALF);
        __builtin_amdgcn_sched_barrier(0);
#pragma unroll
        for (int ai = 0; ai < 2; ++ai)
#pragma unroll
            for (int m = 0; m < 4; ++m) { float q = 0.f;
#pragma unroll
                for (int bj = 0; bj < 2; ++bj) { const u32x4 b = xb[ai][m][bj];
                    f32x4 x0 = acc[ai][bj][m][0], x1 = acc[ai][bj][m][1];
                    x0[0] += bflo(b[0]); x0[1] += bfhi(b[0]); x0[2] += bflo(b[1]); x0[3] += bfhi(b[1]); x1[0] += bflo(b[2]); x1[1] += bfhi(b[2]); x1[2] += bflo(b[3]); x1[3] += bfhi(b[3]);
                    q += ((x0[0] * x0[0] + x0[1] * x0[1]) + (x0[2] * x0[2] + x0[3] * x0[3])) + ((x1[0] * x1[0] + x1[1] * x1[1]) + (x1[2] * x1[2] + x1[3] * x1[3]));
                    u32x4 w; w.x = cvtpk(x0[0], x0[1]); w.y = cvtpk(x0[2], x0[3]); w.z = cvtpk(x1[0], x1[1]); w.w = cvtpk(x1[2], x1[3]);
                    *(u32x4*)(Yu + (size_t)(ai * HALF + m * 16) * 1024 + loff + bj * HALF) = w; }
                q = add_xor16(q); q = add_xor32(q);
                if (fq == 0 && !dummy) ssp[(size_t)(u.pm * BM + wr * 64 + fr + ai * HALF + m * 16) * 16 + 4 * u.pn + wc] = q; }
        return Pre{};
    }
};
struct EpiUp {
    static constexpr bool PERM = true, AFTER_DRAIN = false, HOOK = true, EARLY_PRE = false;
    struct Pre {}; struct Raw {};
    __device__ __forceinline__ Raw pre_load(const Unit&, int, int, int) const { return Raw{}; }
    __device__ __forceinline__ Pre pre_finish(const Raw&) const { return Pre{}; }
    bf16_t* O; const bf16_t* G;
    __device__ __forceinline__ void hook(Acc& acc, const Unit& u, int t, int wr, int wc, int fr, int fq) const {
        if (t != 8 && t != 24) return;
        const int gsel = (t == 8) ? 0 : 1024;
        int fr_ = fr, fq_ = fq; asm volatile("" : "+v"(fr_), "+v"(fq_));
        const int row0 = u.pm * BM + wr * 64 + fr_, col0 = u.pn * BM + wc * 32 + 8 * fq_;
        const bf16_t* gbase = G + (size_t)row0 * 3072 + gsel + col0;
        u32x4 ga[4][2], gb[4][2];
#pragma unroll
        for (int m = 0; m < 4; ++m)
#pragma unroll
            for (int bj = 0; bj < 2; ++bj) { const bf16_t* gp = gbase + (size_t)(m * 16) * 3072 + bj * HALF; ga[m][bj] = *(const u32x4*)gp; gb[m][bj] = *(const u32x4*)(gp + 1024); }
        __builtin_amdgcn_sched_barrier(0);
#pragma unroll
        for (int ai = 0; ai < 2; ++ai)
#pragma unroll
            for (int m = 0; m < 4; ++m)
#pragma unroll
                for (int bj = 0; bj < 2; ++bj) { float r[8];
#pragma unroll
                    for (int e = 0; e < 4; ++e) { const float a0 = bflo(ga[m][bj][e]), a1 = bfhi(ga[m][bj][e]), b0 = bflo(gb[m][bj][e]), b1 = bfhi(gb[m][bj][e]);
                        if (t == 8) { r[2 * e] = a0 * b0; r[2 * e + 1] = a1 * b1; }
                        else { r[2 * e] = b0 * __builtin_amdgcn_rcpf(a0); r[2 * e + 1] = b1 * __builtin_amdgcn_rcpf(a1); } }
                    if (ai == 0) { const bf16_t* gp = gbase + (size_t)(HALF + m * 16) * 3072 + bj * HALF; ga[m][bj] = *(const u32x4*)gp; gb[m][bj] = *(const u32x4*)(gp + 1024); }
                    f32x4 v0 = acc[ai][bj][m][0], v1 = acc[ai][bj][m][1];
                    v0[0] *= r[0]; v0[1] *= r[1]; v0[2] *= r[2]; v0[3] *= r[3]; v1[0] *= r[4]; v1[1] *= r[5]; v1[2] *= r[6]; v1[3] *= r[7];
                    acc[ai][bj][m][0] = v0; acc[ai][bj][m][1] = v1;
                    __builtin_amdgcn_sched_barrier(0); }
    }
    __device__ __forceinline__ Pre operator()(const Acc& acc, const Unit& u, const Unit&, int wr, int wc, int fr, int fq, const Pre&) const {
        const int row0 = u.pm * BM + wr * 64 + fr, col0 = u.pn * BM + wc * 32 + 8 * fq;
        u32x4 g3[2][4][2];
#pragma unroll
        for (int ai = 0; ai < 2; ++ai)
#pragma unroll
            for (int m = 0; m < 4; ++m)
#pragma unroll
                for (int bj = 0; bj < 2; ++bj) g3[ai][m][bj] = *(const u32x4*)(G + (size_t)(row0 + ai * HALF + m * 16) * 3072 + 2048 + col0 + bj * HALF);
        __builtin_amdgcn_sched_barrier(0);
#pragma unroll
        for (int ai = 0; ai < 2; ++ai)
#pragma unroll
            for (int m = 0; m < 4; ++m) { const int row = row0 + ai * HALF + m * 16; bf16_t* rowp = O + (size_t)row * 1024 + col0;
#pragma unroll
                for (int bj = 0; bj < 2; ++bj) { const u32x4 gc = g3[ai][m][bj];
                    const f32x4 v0 = acc[ai][bj][m][0], v1 = acc[ai][bj][m][1];
#define UP_S3(x) __builtin_amdgcn_rcpf(x)
                    u32x4 w; w.x = cvtpk(v0[0] * UP_S3(bflo(gc[0])), v0[1] * UP_S3(bfhi(gc[0]))); w.y = cvtpk(v0[2] * UP_S3(bflo(gc[1])), v0[3] * UP_S3(bfhi(gc[1])));
                    w.z = cvtpk(v1[0] * UP_S3(bflo(gc[2])), v1[1] * UP_S3(bfhi(gc[2]))); w.w = cvtpk(v1[2] * UP_S3(bflo(gc[3])), v1[3] * UP_S3(bfhi(gc[3])));
#undef UP_S3
                    *(u32x4*)(rowp + bj * HALF) = w; } }
        return Pre{};
    }
};

template <int K, int LDA, int LDB, class Epi, class Sched, bool ALIGN_EPI = true>
__device__ __forceinline__ void gemm_phase(PG8_LAS unsigned char* lds, const Gemm g, const Sched& S, const Epi& E) {
    int tid_ = threadIdx.x; asm volatile("" : "+v"(tid_));
    const int tid = tid_, wid = __builtin_amdgcn_readfirstlane(tid >> 6), lane = tid & 63, wr = wid >> 2, wc = wid & 3, fr = lane & 15, fq = lane >> 4;
    constexpr int nt = K / BK;
    unsigned voffA[2], voffB[2];
#pragma unroll
    for (int i = 0; i < 2; ++i) { int R, C; stage_rc(tid * 16 + i * 8192, R, C); const int Rb = Epi::PERM ? ((R & ~31) + perm32(R & 31)) : R;
        voffA[i] = (unsigned)(R * LDA + C) * 2u; voffB[i] = (unsigned)(Rb * LDB + C) * 2u; }
    constexpr size_t kstep = (size_t)(BK * 2);
    constexpr size_t hstepA = (size_t)HALF * LDA * 2, hstepB = (size_t)HALF * LDB * 2;
    constexpr size_t tstepA = 2 * hstepA, tstepB = 2 * hstepB;
    const unsigned ldsw = (unsigned)wid * 1024u;
    const int aoff = lds_byte(wr * 64 + fr, fq * 8), boff = lds_byte(wc * 32 + fr, fq * 8);
#define PG8_SA(b, h) (((b) * 2 + (h)) * HTB)
#define PG8_SB(b, h) ((4 + (b) * 2 + (h)) * HTB)
#define PG8_STAGE(bufoff, gbase, voff) do { _Pragma("unroll") for (int _i = 0; _i < 2; ++_i) \
        __builtin_amdgcn_global_load_lds((const unsigned*)((const char*)(gbase) + (voff)[_i]), (PG8_LAS unsigned*)(lds + (bufoff) + ldsw + _i * 8192), 16, 0, 0); } while (0)
#define PG8_LDA(dst, b, h) do { _Pragma("unroll") for (int m = 0; m < 4; ++m) _Pragma("unroll") for (int k = 0; k < 2; ++k) dst[m][k] = *(const PG8_LAS bf16x8*)(lds + PG8_SA(b, h) + aoff + m * 2048 + k * 1024); } while (0)
#define PG8_LDB(dst, b, h) do { _Pragma("unroll") for (int n = 0; n < 2; ++n) _Pragma("unroll") for (int k = 0; k < 2; ++k) dst[n][k] = *(const PG8_LAS bf16x8*)(lds + PG8_SB(b, h) + boff + n * 2048 + k * 1024); } while (0)
#define PG8_MMA(ai, bj, At, Bt) do { __builtin_amdgcn_s_setprio(1); _Pragma("unroll") for (int m = 0; m < 4; ++m) _Pragma("unroll") for (int n = 0; n < 2; ++n) _Pragma("unroll") for (int k = 0; k < 2; ++k) \
        acc[ai][bj][m][n] = __builtin_amdgcn_mfma_f32_16x16x32_bf16(Bt[n][k], At[m][k], acc[ai][bj][m][n], 0, 0, 0); __builtin_amdgcn_s_setprio(0); } while (0)
#define PG8_WAIT_V(n) asm volatile("s_waitcnt vmcnt(" #n ")" ::: "memory")
#define PG8_WAIT_L(n) asm volatile("s_waitcnt lgkmcnt(" #n ")" ::: "memory")
#define PG8_BAR __builtin_amdgcn_s_barrier()
#define PG8_SCHED __builtin_amdgcn_sched_barrier(0)
    Unit cur, nxt; int ui = 0;
    if (!S.next(0, cur)) return;
    Acc acc;
#pragma unroll
    for (int a = 0; a < 2; ++a)
#pragma unroll
        for (int b = 0; b < 2; ++b)
#pragma unroll
            for (int m = 0; m < 4; ++m)
#pragma unroll
                for (int n = 0; n < 2; ++n) acc[a][b][m][n] = (f32x4){0.f, 0.f, 0.f, 0.f};
    bf16x8 At[4][2], B0[2][2], B1[2][2];
    const char* cA = (const char*)g.A + (size_t)cur.pm * tstepA; const char* cB = (const char*)g.Bt + (size_t)cur.pn * tstepB;
    S.a_ready(cur);
    PG8_SCHED;
    const typename Epi::Raw raw0 = E.pre_load(cur, wr, fr, fq);
    PG8_STAGE(PG8_SB(0, 0), cB, voffB); PG8_STAGE(PG8_SB(0, 1), cB + hstepB, voffB); PG8_STAGE(PG8_SA(0, 0), cA, voffA); PG8_STAGE(PG8_SA(0, 1), cA + hstepA, voffA);
    PG8_SCHED; typename Epi::Pre pre = E.pre_finish(raw0); PG8_SCHED;
    if (wr == 1) PG8_BAR;
    PG8_WAIT_V(2); PG8_BAR;
    PG8_STAGE(PG8_SB(1, 0), cB + kstep, voffB); PG8_STAGE(PG8_SA(1, 0), cA + kstep, voffA); PG8_STAGE(PG8_SB(1, 1), cB + hstepB + kstep, voffB);
    PG8_WAIT_V(6); PG8_BAR;
    for (;;) {
        const bool has_next = S.next(ui + 1, nxt);
        const char* nA = has_next ? (const char*)g.A + (size_t)nxt.pm * tstepA : cA; const char* nB = has_next ? (const char*)g.Bt + (size_t)nxt.pn * tstepB : cB;
        for (int t = 0; t < nt; t += 2) {
            const bool last = (t == nt - 2);
            const char* a1 = cA + (size_t)(t + 1) * kstep;
            const char* a2 = last ? nA : cA + (size_t)(t + 2) * kstep; const char* b2 = last ? nB : cB + (size_t)(t + 2) * kstep;
            const char* a3 = a2 + kstep; const char* b3 = b2 + kstep;
            if (last && has_next) S.a_ready(nxt);
            if constexpr (Epi::HOOK) { E.hook(acc, cur, t, wr, wc, fr, fq); PG8_SCHED; }
            PG8_LDB(B0, 0, 0); PG8_LDB(B1, 0, 1); PG8_SCHED; PG8_LDA(At, 0, 0); PG8_STAGE(PG8_SA(1, 1), a1 + hstepA, voffA);
            PG8_WAIT_V(8); PG8_WAIT_L(0); PG8_BAR; PG8_MMA(0, 0, At, B0); PG8_MMA(0, 1, At, B1); PG8_BAR; PG8_SCHED;
            PG8_LDA(At, 0, 1); PG8_STAGE(PG8_SB(0, 0), b2, voffB); PG8_STAGE(PG8_SB(0, 1), b2 + hstepB, voffB); PG8_STAGE(PG8_SA(0, 0), a2, voffA);
            PG8_WAIT_V(8); PG8_WAIT_L(0); PG8_BAR; PG8_MMA(1, 0, At, B0); PG8_MMA(1, 1, At, B1); PG8_BAR; PG8_SCHED;
            PG8_LDB(B0, 1, 0); PG8_LDB(B1, 1, 1); PG8_SCHED; PG8_LDA(At, 1, 0); PG8_STAGE(PG8_SA(0, 1), a2 + hstepA, voffA);
            PG8_WAIT_V(8); PG8_WAIT_L(0); PG8_BAR; PG8_MMA(0, 0, At, B0); PG8_MMA(0, 1, At, B1); PG8_BAR; PG8_SCHED;
            PG8_LDA(At, 1, 1); PG8_STAGE(PG8_SB(1, 0), b3, voffB); PG8_STAGE(PG8_SB(1, 1), b3 + hstepB, voffB); PG8_STAGE(PG8_SA(1, 0), a3, voffA);
            PG8_WAIT_V(8); PG8_WAIT_L(0); PG8_BAR; PG8_MMA(1, 0, At, B0); PG8_MMA(1, 1, At, B1); PG8_BAR; PG8_SCHED;
        }
        if constexpr (ALIGN_EPI) { if (wr == 0) PG8_BAR; }
        pre = E(acc, cur, has_next ? nxt : cur, wr, wc, fr, fq, pre); S.done(cur); PG8_SCHED;
        if (!has_next) break;
#pragma unroll
        for (int a = 0; a < 2; ++a)
#pragma unroll
            for (int b = 0; b < 2; ++b)
#pragma unroll
                for (int m = 0; m < 4; ++m)
#pragma unroll
                    for (int n = 0; n < 2; ++n) acc[a][b][m][n] = (f32x4){0.f, 0.f, 0.f, 0.f};
        cur = nxt; cA = nA; cB = nB; ++ui;
        if constexpr (ALIGN_EPI) { if (wr == 1) PG8_BAR; }
    }
    PG8_WAIT_V(0);
    if constexpr (!ALIGN_EPI) { if (wr == 0) PG8_BAR; }
    PG8_BAR;
#undef PG8_SA
#undef PG8_SB
#undef PG8_STAGE
#undef PG8_LDA
#undef PG8_LDB
#undef PG8_MMA
#undef PG8_WAIT_V
#undef PG8_WAIT_L
#undef PG8_BAR
#undef PG8_SCHED
}
}

#define XB_TMO      128
#define XB_XCNT(j)  (256  + 64 * (j))
#define XB_XSUB(j)  (1280 + 64 * (j))
#define XB_XGEN(j)  (2304 + 64 * (j))
#define XB_TOP      3328
#define XB_TOPGEN   3392
#define XCD_BAR_WORDS 3456
#define XB_SPIN_CAP (1u << 18)
__device__ __forceinline__ unsigned xb_ld(unsigned* p)              { return __hip_atomic_load(p, __ATOMIC_RELAXED, __HIP_MEMORY_SCOPE_AGENT); }
__device__ __forceinline__ unsigned xb_add(unsigned* p, unsigned v) { return __hip_atomic_fetch_add(p, v, __ATOMIC_RELAXED, __HIP_MEMORY_SCOPE_AGENT); }
__device__ __forceinline__ unsigned xb_xcc_id() { return (unsigned)__builtin_amdgcn_s_getreg((3 << 11) | 20) & 0xFu; }
#define XB_SPIN(cond, bar) do { unsigned _sp = 0; while (cond) { __builtin_amdgcn_s_sleep(1); \
    if ((++_sp & 255u) == 0u) { if (xb_ld(&(bar)[XB_TMO])) break; if (_sp > XB_SPIN_CAP) { atomicAdd(&(bar)[XB_TMO], 1u); break; } } } } while (0)
struct XcdBarrier { unsigned* bar; unsigned x; volatile LAS unsigned* st; };
__device__ __forceinline__ XcdBarrier xcd_barrier_post(unsigned* bar, volatile LAS unsigned* st) {
    XcdBarrier b; b.bar = bar; b.x = xb_xcc_id(); b.st = st;
    if (threadIdx.x == 0) (void)xb_add(&bar[XB_XCNT(b.x)], 1u);
    return b;
}
__device__ __forceinline__ void xcd_barrier_complete(unsigned* bar, unsigned x, unsigned& nloc, unsigned& nx) {
    const unsigned G = gridDim.x * gridDim.y * gridDim.z;
    unsigned sum, cnt, mine, sp = 0u;
    for (;;) {
        sum = 0u; cnt = 0u; mine = 0u;
#pragma unroll
        for (unsigned j = 0; j < 16; ++j) { const unsigned c = xb_ld(&bar[XB_XCNT(j)]); sum += c; cnt += (c > 0u) ? 1u : 0u; mine = (j == x) ? c : mine; }
        if (sum == G) break;
        __builtin_amdgcn_s_sleep(1);
        if ((++sp & 255u) == 0u) { if (xb_ld(&bar[XB_TMO])) break; if (sp > XB_SPIN_CAP) { atomicAdd(&bar[XB_TMO], 1u); break; } }
    }
    nloc = mine > 0u ? mine : 1u; nx = cnt > 0u ? cnt : 1u;
}
__device__ __forceinline__ void xcd_barrier(const XcdBarrier& b) {
    asm volatile("s_waitcnt vmcnt(0)" ::: "memory");
    __syncthreads();
    if (threadIdx.x == 0) {
        unsigned* bar = b.bar;
        __builtin_amdgcn_s_waitcnt(0);
        unsigned nloc = b.st[0], nx = b.st[1];
        if (nloc == 0u) { xcd_barrier_complete(bar, b.x, nloc, nx); b.st[0] = nloc; b.st[1] = nx; }
        const unsigned old = xb_add(&bar[XB_XSUB(b.x)], 1u);
        const unsigned gen = old / nloc;
        if (old + 1u == (gen + 1u) * nloc) {
            __builtin_amdgcn_fence(__ATOMIC_RELEASE, "agent");
            asm volatile("s_waitcnt vmcnt(0)" ::: "memory");
            const unsigned og = xb_add(&bar[XB_TOP], 1u);
            const unsigned tg = og / nx;
            if (og + 1u == (tg + 1u) * nx) xb_add(&bar[XB_TOPGEN], 1u);
            else XB_SPIN(xb_ld(&bar[XB_TOPGEN]) == tg, bar);
            __builtin_amdgcn_fence(__ATOMIC_ACQUIRE, "agent");
            xb_add(&bar[XB_XGEN(b.x)], 1u);
            asm volatile("s_waitcnt vmcnt(0)" ::: "memory");
        } else {
            XB_SPIN(xb_ld(&bar[XB_XGEN(b.x)]) == gen, bar);
            __builtin_amdgcn_fence(__ATOMIC_ACQUIRE, "agent");
            asm volatile("s_waitcnt vmcnt(0)" ::: "memory");
        }
    }
    __syncthreads();
}

struct Args { const float* in[18]; float* out; unsigned char* ws; int ph_lo, ph_hi; };
struct Frame {
    LAS unsigned char* lds;
    int vcu, G;
    unsigned char* ws;
};
__device__ __forceinline__ int opaque_tid() { int t = threadIdx.x; asm volatile("" : "+v"(t)); return t; }
#define TID ((int)threadIdx.x)
#define WSP(T_, off) ((T_*)(F.ws + (off)))
#define LDS_WAIT() asm volatile("s_waitcnt lgkmcnt(0)" ::: "memory")

struct TrDesc { const float* W; const float* gain; bf16* dst; int Nsrc, srccol0, k0, Kdst; };
__device__ __forceinline__ void tr_load(const TrDesc& d, f32x4 (&v)[16], int lane) {
#pragma unroll
    for (int i = 0; i < 16; ++i) v[i] = *(const f32x4*)(d.W + (size_t)(d.k0 + 4 * i + (lane >> 4)) * d.Nsrc + d.srccol0 + 4 * (lane & 15));
}
__device__ __forceinline__ void tr_finish(const TrDesc& d, const f32x4 (&v)[16], LAS float* scr, int lane) {
#pragma unroll
    for (int i = 0; i < 16; ++i) { const int kk = 4 * i + (lane >> 4); f32x4 x = v[i]; if (d.gain) x = x * d.gain[d.k0 + kk]; *(LAS f32x4*)(scr + kk * 68 + 4 * (lane & 15)) = x; }
    LDS_WAIT(); asm volatile("" ::: "memory");
    const int c = lane & 7;
#pragma unroll
    for (int j = 0; j < 8; ++j) { const int n = (lane >> 3) + 8 * j; const LAS float* sp = scr + (8 * c) * 68 + n;
        u32x4 o; o.x = cvtpk(sp[0 * 68], sp[1 * 68]); o.y = cvtpk(sp[2 * 68], sp[3 * 68]); o.z = cvtpk(sp[4 * 68], sp[5 * 68]); o.w = cvtpk(sp[6 * 68], sp[7 * 68]);
        *(u32x4*)(d.dst + (size_t)n * d.Kdst + d.k0 + 8 * c) = o; }
    LDS_WAIT(); asm volatile("" ::: "memory");
}
__device__ __forceinline__ int in_srccol(int n0) {
    if (n0 < C_Q || n0 >= C_V) return n0;
    const int tile = n0 >> 8, within = n0 & 255, bj = within >> 7, w = within & 127, sec = (tile < 4) ? C_Q : C_K;
    return sec + (2 * (tile & 1) + (w >> 6)) * 128 + (w & 63) + 64 * bj;
}
__device__ __forceinline__ void rms_row_bf16(const float* xrow, bf16* orow, int lane) {
    const f32x4* xr = (const f32x4*)xrow + lane; f32x4 v[4]; float s = 0.f;
#pragma unroll
    for (int j = 0; j < 4; ++j) { v[j] = xr[64 * j]; s += (v[j].x * v[j].x + v[j].y * v[j].y) + (v[j].z * v[j].z + v[j].w * v[j].w); }
    const float r = rsqrtf(wave_sum(s) * (1.0f / DM) + EPS);
    u32x2* o = (u32x2*)orow + lane;
#pragma unroll
    for (int j = 0; j < 4; ++j) { u32x2 w; w.x = cvtpk(v[j].x * r, v[j].y * r); w.y = cvtpk(v[j].z * r, v[j].w * r); o[64 * j] = w; }
}
__device__ __forceinline__ void norm_rows(Frame& F, const float* X, bf16* XB, int nrows) {
    const int tid = opaque_tid(), lane = tid & 63, wave = __builtin_amdgcn_readfirstlane(tid >> 6), fr = lane & 15, fq = lane >> 4; (void)tid; (void)lane; (void)wave; (void)fr; (void)fq;
    const int gw = F.vcu * 8 + wave, NGW = F.G * 8;
    for (int m = gw; m < nrows; m += NGW) rms_row_bf16(X + (size_t)m * DM, XB + (size_t)m * DM, lane);
}
__device__ __forceinline__ void final_norm(Frame& F, float* out, const float* g) {
    const int tid = opaque_tid(), lane = tid & 63, wave = __builtin_amdgcn_readfirstlane(tid >> 6);
    const int gw = F.vcu * 8 + wave, NGW = F.G * 8;
    f32x4 gg[4];
#pragma unroll
    for (int j = 0; j < 4; ++j) gg[j] = *((const f32x4*)g + lane + 64 * j);
    for (int m = gw * 4; m < T; m += NGW * 4) {
        float p = WSP(float, WS_SSP)[(size_t)m * 16 + lane];
        u32x2 v[4][4];
#pragma unroll
        for (int r = 0; r < 4; ++r)
#pragma unroll
            for (int j = 0; j < 4; ++j) v[r][j] = ((const u32x2*)(WSP(bf16, WS_XB) + (size_t)(m + r) * DM) + lane)[64 * j];
        __builtin_amdgcn_sched_barrier(0);
        p += __int_as_float(__builtin_amdgcn_ds_swizzle(__float_as_int(p), SWZ_XOR(1)));
        p += __int_as_float(__builtin_amdgcn_ds_swizzle(__float_as_int(p), SWZ_XOR(2)));
        p += __int_as_float(__builtin_amdgcn_ds_swizzle(__float_as_int(p), SWZ_XOR(4)));
        p += __int_as_float(__builtin_amdgcn_ds_swizzle(__float_as_int(p), SWZ_XOR(8)));
        const float rinv = rsqrtf(p * (1.0f / DM) + EPS);
#pragma unroll
        for (int r = 0; r < 4; ++r) { const float rr = __int_as_float(__builtin_amdgcn_readlane(__float_as_int(rinv), 16 * r)); f32x4* o = (f32x4*)(out + (size_t)(m + r) * DM) + lane;
#pragma unroll
            for (int j = 0; j < 4; ++j) { const u32x2 x = v[r][j]; o[64 * j] = (f32x4){bflo(x.x) * rr * gg[j].x, bfhi(x.x) * rr * gg[j].y, bflo(x.y) * rr * gg[j].z, bfhi(x.y) * rr * gg[j].w}; } }
    }
}

__device__ __forceinline__ void p0_prologue(Frame& F, const Args& A) {
    const int tid = opaque_tid(), lane = tid & 63, wave = __builtin_amdgcn_readfirstlane(tid >> 6);
    LAS float* scr = (LAS float*)(F.lds + wave * 17408);
    const int gw = F.vcu * 8 + wave, NGW = F.G * 8;
    constexpr int I_IN = 16 * 112, I_MKV = 16 * 16, I_UR = 16 * 16, I_UM = 8 * 16, I_OUT = 16 * 16, I_1 = 16 * 64, I_2 = 64 * 16;
    constexpr int PER_L = I_IN + I_MKV + I_UR + I_UM + I_OUT + I_1 + I_2;
#define TR_DESC(d, it_) do { const int l_ = (it_) / PER_L; int r_ = (it_) % PER_L; unsigned char* wl_ = F.ws + WS_W + (size_t)l_ * W_LAYER; \
        if (r_ < I_IN) { const int kb = r_ / 112, nb = r_ % 112; d = TrDesc{A.in[4] + (size_t)l_ * DM * INC, A.in[3] + l_ * DM, (bf16*)(wl_ + WO_IN) + (size_t)(64 * nb) * DM, INC, in_srccol(64 * nb), 64 * kb, DM}; } \
        else if ((r_ -= I_IN) < I_MKV) { const int kb = r_ / 16, nb = r_ % 16; d = TrDesc{A.in[9] + (size_t)l_ * DM * 1024, A.in[8] + l_ * DM, (bf16*)(wl_ + WO_MKV) + (size_t)(64 * nb) * DM, 1024, 64 * nb, 64 * kb, DM}; } \
        else if ((r_ -= I_MKV) < I_UR) { const int kb = r_ / 16, nb = r_ % 16; d = TrDesc{A.in[11] + (size_t)l_ * 1024 * DM, A.in[7] + l_ * 1024, (bf16*)(wl_ + WO_UP) + (size_t)(64 * nb) * 2048 + 512, DM, 64 * nb, 64 * kb, 2048}; } \
        else if ((r_ -= I_UR) < I_UM) { const int kb = r_ / 16, nb = r_ % 16; d = TrDesc{A.in[12] + (size_t)l_ * 512 * DM, nullptr, (bf16*)(wl_ + WO_UP) + (size_t)(64 * nb) * 2048 + 1536, DM, 64 * nb, 64 * kb, 2048}; } \
        else if ((r_ -= I_UM) < I_OUT) { const int kb = r_ / 16, nb = r_ % 16; d = TrDesc{A.in[13] + (size_t)l_ * DM * DM, nullptr, (bf16*)(wl_ + WO_OUT) + (size_t)(64 * nb) * DM, DM, 64 * nb, 64 * kb, DM}; } \
        else if ((r_ -= I_OUT) < I_1) { const int kb = r_ / 64, nb = r_ % 64; d = TrDesc{A.in[15] + (size_t)l_ * DM * DFF, A.in[14] + l_ * DM, (bf16*)(wl_ + WO_1) + (size_t)(64 * nb) * DM, DFF, 64 * nb, 64 * kb, DM}; } \
        else { r_ -= I_1; const int kb = r_ / 16, nb = r_ % 16; d = TrDesc{A.in[16] + (size_t)l_ * DFF * DM, nullptr, (bf16*)(wl_ + WO_2) + (size_t)(64 * nb) * DFF, DM, 64 * nb, 64 * kb, DFF}; } } while (0)
    {
        TrDesc dA, dB; f32x4 vA[16], vB[16];
        int it = gw;
        if (it < 2 * PER_L) { TR_DESC(dA, it); tr_load(dA, vA, lane); }
        while (it < 2 * PER_L) {
            const int itB = it + NGW;
            if (itB < 2 * PER_L) { TR_DESC(dB, itB); tr_load(dB, vB, lane); }
            tr_finish(dA, vA, scr, lane);
            if (itB >= 2 * PER_L) break;
            const int itA = itB + NGW;
            if (itA < 2 * PER_L) { TR_DESC(dA, itA); tr_load(dA, vA, lane); }
            tr_finish(dB, vB, scr, lane);
            it = itA;
        }
    }
#undef TR_DESC
    const int gt = F.vcu * 512 + tid, NT = F.G * 512;
    {
        const float inv = (float)exp2(-(double)(gt & 63) * (13.287712379549449 / 64.0));
        const int* pos = (const int*)A.in[2];
        for (int i = gt; i < T * 64; i += NT) {
            const float a = (float)pos[i >> 6] * inv;
            const double ad = (double)a, k = rint(ad * 0.15915494309189535), rr = ad - k * 6.283185307179586;
            const float rf = (float)rr;
            WSP(float, WS_COS)[i] = cosf(rf); WSP(float, WS_SIN)[i] = sinf(rf);
        }
    }
    for (int m = gw * 4; m < T; m += NGW * 4) {
        f32x4 v[4][4];
#pragma unroll
        for (int r = 0; r < 4; ++r) { const f32x4* xr = (const f32x4*)(A.in[0] + (size_t)(m + r) * DM) + 2 * lane;
#pragma unroll
            for (int j = 0; j < 2; ++j) { v[r][2 * j] = xr[128 * j]; v[r][2 * j + 1] = xr[128 * j + 1]; } }
        __builtin_amdgcn_sched_barrier(0);
#pragma unroll
        for (int r = 0; r < 4; ++r) { float q = 0.f; u32x4* o = (u32x4*)(WSP(bf16, WS_XB) + (size_t)(m + r) * DM) + lane;
#pragma unroll
            for (int j = 0; j < 2; ++j) { const f32x4 a = v[r][2 * j], b2 = v[r][2 * j + 1]; q += ((a.x * a.x + a.y * a.y) + (a.z * a.z + a.w * a.w)) + ((b2.x * b2.x + b2.y * b2.y) + (b2.z * b2.z + b2.w * b2.w));
                u32x4 w; w.x = cvtpk(a.x, a.y); w.y = cvtpk(a.z, a.w); w.z = cvtpk(b2.x, b2.y); w.w = cvtpk(b2.z, b2.w); o[64 * j] = w; }
            q = wave_sum(q);
            if (lane < 16) WSP(float, WS_SSP)[(size_t)(m + r) * 16 + lane] = (lane == 0) ? q : 0.f; }
    }
    norm_rows(F, A.in[1], WSP(bf16, WS_MEMN), NB * NMEM);
    __syncthreads();
    LAS float* PW = (LAS float*)F.lds;
    LAS float* WU = (LAS float*)(F.lds + 128 * 129 * 4);
    for (int it = F.vcu; it < 2 * 4 * 32; it += F.G) {
        const int l = it >> 7, g = (it >> 5) & 3, n0 = (it & 31) * 32;
        const float* pw = A.in[5] + ((size_t)l * 512 + g * 128) * 128; const float* ps = A.in[6] + l * 512 + g * 128; const float* wu = A.in[10] + ((size_t)l * 512 + g * 128) * DM + n0;
        for (int i = tid; i < 128 * 128; i += 512) { const int c = i >> 7, cp = i & 127; PW[c * 129 + cp] = pw[i] * ps[cp]; }
        for (int i = tid; i < 128 * 8; i += 512) { const int cp = i >> 3, q = i & 7; *(LAS f32x4*)(WU + cp * 32 + 4 * q) = *(const f32x4*)(wu + (size_t)cp * DM + 4 * q); }
        __syncthreads();
        const int c = tid & 127, nq = tid >> 7;
        f32x4 s0 = {0.f, 0.f, 0.f, 0.f}, s1 = {0.f, 0.f, 0.f, 0.f};
#pragma unroll 8
        for (int cp = 0; cp < 128; ++cp) { const float p = PW[c * 129 + cp]; s0 += p * *(LAS f32x4*)(WU + cp * 32 + 8 * nq); s1 += p * *(LAS f32x4*)(WU + cp * 32 + 8 * nq + 4); }
        bf16* dst = (bf16*)(F.ws + WS_W + (size_t)l * W_LAYER + WO_UP) + (size_t)(n0 + 8 * nq) * 2048 + g * 128 + c;
#pragma unroll
        for (int j = 0; j < 4; ++j) { dst[(size_t)j * 2048] = (bf16)(cvtpk(s0[j], 0.f) & 0xffffu); dst[(size_t)(4 + j) * 2048] = (bf16)(cvtpk(s1[j], 0.f) & 0xffffu); }
        __syncthreads();
    }
}

__device__ __forceinline__ bf16x8 frag_tr(LAS unsigned char* Tt, int ldb, int rowA, int rowB, int col0, int fr) {
#if USE_TR
    const int q = fr >> 2, p = fr & 3;
    const s16x4 lo = __builtin_bit_cast(s16x4, __builtin_amdgcn_ds_read_tr16_b64_v4i16((LAS v4i16_t*)(Tt + (rowA + q) * ldb + (col0 + 4 * p) * 2)));
    const s16x4 hi = __builtin_bit_cast(s16x4, __builtin_amdgcn_ds_read_tr16_b64_v4i16((LAS v4i16_t*)(Tt + (rowB + q) * ldb + (col0 + 4 * p) * 2)));
    return __builtin_shufflevector(lo, hi, 0, 1, 2, 3, 4, 5, 6, 7);
#else
    bf16x8 f;
#pragma unroll
    for (int e = 0; e < 4; ++e) { f[e] = *(LAS short*)(Tt + (rowA + e) * ldb + (col0 + fr) * 2); f[4 + e] = *(LAS short*)(Tt + (rowB + e) * ldb + (col0 + fr) * 2); }
    return f;
#endif
}
__device__ __forceinline__ bf16x8 pack8(const f32x4& a, const f32x4& b) { u32x4 w; w.x = cvtpk(a[0], a[1]); w.y = cvtpk(a[2], a[3]); w.z = cvtpk(b[0], b[1]); w.w = cvtpk(b[2], b[3]); return __builtin_bit_cast(bf16x8, w); }
template <int NT> __device__ __forceinline__ void mm_rows4(f32x4* acc, LAS unsigned char* T, int pitch, const bf16x8 (&b)[4], int fr, int fq) {
    LAS unsigned char* p = T + fr * pitch + fq * 16;
    bf16x8 f[3][4];
#pragma unroll
    for (int t = 0; t < 2 && t < NT; ++t)
#pragma unroll
        for (int ks = 0; ks < 4; ++ks) f[t][ks] = *(LAS bf16x8*)(p + 16 * t * pitch + ks * 64);
#pragma unroll
    for (int t = 0; t < NT; ++t) {
        if (t + 2 < NT) {
#pragma unroll
            for (int ks = 0; ks < 4; ++ks) f[(t + 2) % 3][ks] = *(LAS bf16x8*)(p + 16 * (t + 2) * pitch + ks * 64); }
        __builtin_amdgcn_sched_barrier(0);
        f32x4 a = {0.f, 0.f, 0.f, 0.f};
#pragma unroll
        for (int ks = 0; ks < 4; ++ks) a = mfma16(f[t % 3][ks], b[ks], a);
        acc[t] = a;
        __builtin_amdgcn_sched_barrier(0);
    }
}
template <int NT, int D> __device__ __forceinline__ void mm_tr(f32x4* acc, LAS unsigned char* Vt, int pitch, int rowA, int rowB, const bf16x8 pf, int fr) {
    bf16x8 g[D + 1];
#pragma unroll
    for (int t = 0; t < D && t < NT; ++t) g[t] = frag_tr(Vt, pitch, rowA, rowB, 16 * t, fr);
#pragma unroll
    for (int t = 0; t < NT; ++t) {
        if (t + D < NT) g[(t + D) % (D + 1)] = frag_tr(Vt, pitch, rowA, rowB, 16 * (t + D), fr);
        __builtin_amdgcn_sched_barrier(0);
        acc[t] = mfma16(g[t % (D + 1)], pf, acc[t]);
        __builtin_amdgcn_sched_barrier(0);
    }
}
__device__ __forceinline__ float log2gamma(int h) { return log2f(1.0f - exp2f(-5.0f - (float)h)); }

__device__ __forceinline__ void mem_kv_proj(Frame& F) {
    const int tid = opaque_tid(), lane = tid & 63, wave = __builtin_amdgcn_readfirstlane(tid >> 6), fr = lane & 15, fq = lane >> 4;
    LAS unsigned char* As = F.lds; LAS unsigned char* Bs = F.lds + 33792;
    const int wm = wave & 3, wn = wave >> 2;
    for (int it = F.vcu; it < 512; it += F.G) {
        const int l = it >> 8, tm = (it >> 4) & 15, tn = it & 15;
        const bf16* Ag = WSP(bf16, WS_MEMN) + (size_t)(tm * 64) * DM; const bf16* Bg = WSP(bf16, WS_W + (size_t)l * W_LAYER + WO_MKV) + (size_t)(tn * 64) * DM;
        f32x4 acc[2]; acc[0] = (f32x4){0.f, 0.f, 0.f, 0.f}; acc[1] = (f32x4){0.f, 0.f, 0.f, 0.f};
        for (int kc = 0; kc < 4; ++kc) {
            __syncthreads();
#pragma unroll
            for (int k = 0; k < 4; ++k) { const int c = tid + 512 * k, r = c >> 5, ch = c & 31;
                *(LAS u32x4*)(As + r * 528 + ch * 16) = *(const u32x4*)(Ag + (size_t)r * DM + kc * 256 + ch * 8);
                *(LAS u32x4*)(Bs + r * 528 + ch * 16) = *(const u32x4*)(Bg + (size_t)r * DM + kc * 256 + ch * 8); }
            __syncthreads();
#pragma unroll
            for (int ks = 0; ks < 8; ++ks) { const bf16x8 af = *(LAS bf16x8*)(As + (16 * wm + fr) * 528 + (32 * ks + 8 * fq) * 2);
#pragma unroll
                for (int c = 0; c < 2; ++c) acc[c] = mfma16(*(LAS bf16x8*)(Bs + (32 * wn + 16 * c + fr) * 528 + (32 * ks + 8 * fq) * 2), af, acc[c]); }
        }
        bf16* dst = WSP(bf16, WS_KVMEM) + (size_t)l * 1024 * 1024 + (size_t)(tm * 64 + 16 * wm + fr) * 1024 + tn * 64 + 32 * wn + 4 * fq;
#pragma unroll
        for (int c = 0; c < 2; ++c) { u32x2 w; w.x = cvtpk(acc[c][0], acc[c][1]); w.y = cvtpk(acc[c][2], acc[c][3]); *(u32x2*)(dst + 16 * c) = w; }
    }
    __syncthreads();
}

template <int W> __device__ __forceinline__ void pool_item(bf16* P, int tl0, int c0) {
    const int pos0 = tl0 & (SEQ - 1);
    u32x4 r[W + 7];
#pragma unroll
    for (int i = 0; i < W + 7; ++i) { r[i] = (u32x4){0u, 0u, 0u, 0u}; if (pos0 - (W - 1) + i >= 0) r[i] = *(const u32x4*)(P + (size_t)(tl0 - (W - 1) + i) * PLD + c0); }
    float s[8];
#pragma unroll
    for (int e = 0; e < 8; ++e) s[e] = 0.f;
#pragma unroll
    for (int i = 0; i < W - 1; ++i)
#pragma unroll
        for (int e = 0; e < 4; ++e) { s[2 * e] += bflo(r[i][e]); s[2 * e + 1] += bfhi(r[i][e]); }
#pragma unroll
    for (int tt = 0; tt < 8; ++tt) {
        const int pos = pos0 + tt; const float rc = 1.0f / (float)((pos + 1 < W) ? pos + 1 : W);
        float d[8];
#pragma unroll
        for (int e = 0; e < 4; ++e) { const float u0 = bflo(r[W - 1 + tt][e]), u1 = bfhi(r[W - 1 + tt][e]); s[2 * e] += u0; s[2 * e + 1] += u1; d[2 * e] = s[2 * e] * rc - u0; d[2 * e + 1] = s[2 * e + 1] * rc - u1; }
        u32x4 o; o.x = cvtpk(d[0], d[1]); o.y = cvtpk(d[2], d[3]); o.z = cvtpk(d[4], d[5]); o.w = cvtpk(d[6], d[7]);
        *(u32x4*)(P + (size_t)(tl0 + tt) * PLD + C_DP + c0) = o;
#pragma unroll
        for (int e = 0; e < 4; ++e) { s[2 * e] -= bflo(r[tt][e]); s[2 * e + 1] -= bfhi(r[tt][e]); }
    }
}
__device__ __forceinline__ void mix_pool(Frame& F) {
    const int tid = opaque_tid(), lane = tid & 63, wave = __builtin_amdgcn_readfirstlane(tid >> 6);
    bf16* P = WSP(bf16, WS_PROJ);
    const int gw = F.vcu * 8 + wave, NGW = F.G * 8;
    for (int it = gw; it < 4 * (TH / 32); it += NGW) {
        const int g = it & 3, tl0 = (it >> 2) * 32 + (lane >> 4) * 8, c0 = g * 128 + (lane & 15) * 8;
        if (g == 0) pool_item<2>(P, tl0, c0); else if (g == 1) pool_item<4>(P, tl0, c0); else if (g == 2) pool_item<8>(P, tl0, c0); else pool_item<16>(P, tl0, c0);
    }
}

__device__ __forceinline__ void mix_mem(Frame& F, int l, int hf, bool dummy) {
    const int tid = opaque_tid(), lane = tid & 63, wave = __builtin_amdgcn_readfirstlane(tid >> 6), fr = lane & 15, fq = lane >> 4; (void)tid; (void)lane; (void)wave; (void)fr; (void)fq;
    bf16* P = WSP(bf16, WS_PROJ);
    LAS unsigned char* Kt = F.lds; LAS unsigned char* Vt = F.lds + 69632;
    const int items = 8 * 64, ipw = (items + F.G - 1) / F.G;
    const int it_lo = F.vcu * ipw, it_hi = (it_lo + ipw < items) ? it_lo + ipw : items;
    int loaded = -1;
    for (int it = it_lo; it < it_hi; ++it) {
        const int combo = it >> 6, qt = it & 63, bl = combo >> 2, h = combo & 3;
        if (combo != loaded) {
            const bf16* src = WSP(bf16, WS_KVMEM) + (size_t)l * 1024 * 1024 + (size_t)((2 * hf + bl) * NMEM) * 1024 + h * 128;
            u32x4 stK[8], stV[8];
#pragma unroll
            for (int k = 0; k < 8; ++k) { const int c = tid + 512 * k, key = c >> 4, ch = c & 15; stK[k] = *(const u32x4*)(src + (size_t)key * 1024 + ch * 8); stV[k] = *(const u32x4*)(src + (size_t)key * 1024 + 512 + ch * 8); }
            __builtin_amdgcn_sched_barrier(0);
            __syncthreads();
#pragma unroll
            for (int k = 0; k < 8; ++k) { const int c = tid + 512 * k, key = c >> 4, ch = c & 15; *(LAS u32x4*)(Kt + key * 272 + ch * 16) = stK[k]; *(LAS u32x4*)(Vt + key * 272 + ch * 16) = stV[k]; }
            __syncthreads(); loaded = combo;
        }
        bf16* qp = P + (size_t)(bl * SEQ + qt * 128 + wave * 16 + fr) * PLD + C_XQ + h * 128;
        bf16x8 bq[4];
#pragma unroll
        for (int ks = 0; ks < 4; ++ks) bq[ks] = *(const bf16x8*)(qp + ks * 32 + fq * 8);
        f32x4 s[16];
        mm_rows4<16>(s, Kt, 272, bq, fr, fq);
        float mx = -3.0e38f;
#pragma unroll
        for (int kt = 0; kt < 16; ++kt) mx = fmaxf(fmaxf(fmaxf(s[kt][0], s[kt][1]), fmaxf(s[kt][2], s[kt][3])), mx);
        mx = max_xor16(mx); mx = max_xor32(mx);
        float lsum = 0.f;
#pragma unroll
        for (int kt = 0; kt < 16; ++kt)
#pragma unroll
            for (int r = 0; r < 4; ++r) { const float p = exp2f(s[kt][r] - mx); s[kt][r] = p; lsum += p; }
        lsum = add_xor16(lsum); lsum = add_xor32(lsum);
        const float rl = 1.0f / lsum;
        f32x4 o[8];
#pragma unroll
        for (int dt = 0; dt < 8; ++dt) o[dt] = (f32x4){0.f, 0.f, 0.f, 0.f};
#pragma unroll
        for (int kp = 0; kp < 8; ++kp) { const bf16x8 pf = pack8(s[2 * kp], s[2 * kp + 1]); mm_tr<8, 4>(o, Vt, 272, 32 * kp + 4 * fq, 32 * kp + 16 + 4 * fq, pf, fr); }
        bf16* op = (dummy ? WSP(bf16, WS_MERGED) + (size_t)(bl * SEQ + qt * 128 + wave * 16 + fr) * 512 + h * 128 : qp) + 16 * (fq & 1) + 4 * (fq & 2);
#pragma unroll
        for (int p = 0; p < 4; ++p) { const unsigned ax = cvtpk(o[2 * p][0] * rl, o[2 * p][1] * rl), ay = cvtpk(o[2 * p][2] * rl, o[2 * p][3] * rl), bx_ = cvtpk(o[2 * p + 1][0] * rl, o[2 * p + 1][1] * rl), by = cvtpk(o[2 * p + 1][2] * rl, o[2 * p + 1][3] * rl);
            auto rx = __builtin_amdgcn_permlane16_swap(ax, bx_, false, false); auto ry = __builtin_amdgcn_permlane16_swap(ay, by, false, false);
            u32x4 w; w.x = rx[0]; w.y = ry[0]; w.z = rx[1]; w.w = ry[1]; *(u32x4*)(op + 32 * p) = w; }
    }
    __syncthreads();
}

__device__ __forceinline__ void mix_kv(Frame& F) {
    const int tid = opaque_tid(), lane = tid & 63, wave = __builtin_amdgcn_readfirstlane(tid >> 6), fr = lane & 15, fq = lane >> 4; (void)tid; (void)lane; (void)wave; (void)fr; (void)fq;
    bf16* P = WSP(bf16, WS_PROJ);
    LAS unsigned char* Kd = F.lds; LAS unsigned char* Vt = F.lds + 34816;
    for (int un = F.vcu; un < 512; un += F.G) {
        const int h = un & 3, n = (un >> 2) & 63, bl = un >> 8; const size_t row0 = (size_t)bl * SEQ + n * 128; const float lg = log2gamma(h);
        u32x4 stK[4], stV[8];
#pragma unroll
        for (int k = 0; k < 4; ++k) { const int c = tid + 512 * k, j = c >> 4, ch = c & 15; stK[k] = *(const u32x4*)(P + (row0 + j) * PLD + C_K + h * 128 + ch * 8); }
#pragma unroll
        for (int k = 0; k < 8; ++k) { const int c = tid + 512 * k, j = c >> 5, ch = c & 31; stV[k] = *(const u32x4*)(P + (row0 + j) * PLD + C_V + h * 256 + ch * 8); }
        __builtin_amdgcn_sched_barrier(0);
        __syncthreads();
#pragma unroll
        for (int k = 0; k < 4; ++k) { const int c = tid + 512 * k, j = c >> 4, ch = c & 15; const u32x4 v = stK[k]; const float f = exp2f((float)(127 - j) * lg);
            u32x4 o; o.x = cvtpk(bflo(v.x) * f, bfhi(v.x) * f); o.y = cvtpk(bflo(v.y) * f, bfhi(v.y) * f); o.z = cvtpk(bflo(v.z) * f, bfhi(v.z) * f); o.w = cvtpk(bflo(v.w) * f, bfhi(v.w) * f);
            *(LAS u32x4*)(Kd + j * 272 + ch * 16) = o; }
#pragma unroll
        for (int k = 0; k < 8; ++k) { const int c = tid + 512 * k, j = c >> 5, ch = c & 31; *(LAS u32x4*)(Vt + j * 528 + ch * 16) = stV[k]; }
        __syncthreads();
        f32x4 acc[8][2];
#pragma unroll
        for (int dt = 0; dt < 8; ++dt) { acc[dt][0] = (f32x4){0.f, 0.f, 0.f, 0.f}; acc[dt][1] = (f32x4){0.f, 0.f, 0.f, 0.f}; }
#pragma unroll
        for (int ks = 0; ks < 4; ++ks) { const int rA = 32 * ks + 8 * fq, rB = rA + 4;
            const bf16x8 bv0 = frag_tr(Vt, 528, rA, rB, 16 * (2 * wave), fr), bv1 = frag_tr(Vt, 528, rA, rB, 16 * (2 * wave + 1), fr);
#pragma unroll
            for (int dt = 0; dt < 8; ++dt) { const bf16x8 ad = frag_tr(Kd, 272, rA, rB, 16 * dt, fr); acc[dt][0] = mfma16(ad, bv0, acc[dt][0]); acc[dt][1] = mfma16(ad, bv1, acc[dt][1]); } }
        bf16* dst = WSP(bf16, WS_KVN) + (size_t)un * 32768 + 16 * (fq & 1) + 4 * (fq & 2);
#pragma unroll
        for (int vi = 0; vi < 2; ++vi)
#pragma unroll
            for (int p = 0; p < 4; ++p) { const f32x4 a = acc[2 * p][vi], b = acc[2 * p + 1][vi];
                const unsigned ax = cvtpk(a[0], a[1]), ay = cvtpk(a[2], a[3]), bx_ = cvtpk(b[0], b[1]), by = cvtpk(b[2], b[3]);
                auto rx = __builtin_amdgcn_permlane16_swap(ax, bx_, false, false); auto ry = __builtin_amdgcn_permlane16_swap(ay, by, false, false);
                u32x4 o; o.x = rx[0]; o.y = ry[0]; o.z = rx[1]; o.w = ry[1];
                *(u32x4*)(dst + (size_t)(16 * (2 * wave + vi) + fr) * 128 + 32 * p) = o; }
    }
    __syncthreads();
}

__device__ __forceinline__ void scan_states(Frame& F) {
    const int tid = opaque_tid(), lane = tid & 63, wave = __builtin_amdgcn_readfirstlane(tid >> 6), fr = lane & 15, fq = lane >> 4; (void)tid; (void)lane; (void)wave; (void)fr; (void)fq;
    const bf16* KV = WSP(bf16, WS_KVN); bf16* SP = WSP(bf16, WS_SPREV);
    if (tid < 256)
    for (int p = F.vcu * 256 + tid; p < 8 * 8192; p += F.G * 256) {
        const int blk = p >> 13, bl = blk >> 2, h = blk & 3, off = (p & 8191) * 4; const float cd = exp2f(128.0f * log2gamma(h));
        f32x4 st = {0.f, 0.f, 0.f, 0.f};
        for (int n0 = 0; n0 < 64; n0 += 8) {
            u32x2 kv[8];
#pragma unroll
            for (int j = 0; j < 8; ++j) kv[j] = *(const u32x2*)(KV + (size_t)((bl * 64 + n0 + j) * 4 + h) * 32768 + off);
#pragma unroll
            for (int j = 0; j < 8; ++j) { u32x2 w; w.x = cvtpk(st[0], st[1]); w.y = cvtpk(st[2], st[3]); *(u32x2*)(SP + (size_t)((bl * 64 + n0 + j) * 4 + h) * 32768 + off) = w;
                st = st * cd + (f32x4){bflo(kv[j].x), bfhi(kv[j].x), bflo(kv[j].y), bfhi(kv[j].y)}; }
        }
    }
}

__device__ __forceinline__ void ret_out(Frame& F, bool dummy) {
    const int tid = opaque_tid(), lane = tid & 63, wave = __builtin_amdgcn_readfirstlane(tid >> 6), fr = lane & 15, fq = lane >> 4; (void)tid; (void)lane; (void)wave; (void)fr; (void)fq;
    bf16* P = WSP(bf16, WS_PROJ);
    LAS unsigned char* Kt = F.lds; LAS unsigned char* Vt = F.lds + 34816; LAS unsigned char* Sp = F.lds + 102400;
    for (int un = F.vcu; un < 512; un += F.G) {
        const int h = un & 3, n = (un >> 2) & 63, bl = un >> 8; const size_t row0 = (size_t)bl * SEQ + n * 128; const float lg = log2gamma(h);
        const bf16* spg = WSP(bf16, WS_SPREV) + (size_t)un * 32768;
        const int i = wave * 16 + fr; const size_t trow = row0 + i;
        bf16x8 bq[4];
#pragma unroll
        for (int ks = 0; ks < 4; ++ks) bq[ks] = *(const bf16x8*)(P + trow * PLD + C_Q + h * 128 + ks * 32 + fq * 8);
        bf16* gp = P + trow * PLD + C_G + h * 256 + 4 * fq;
        u32x4 stK[4], stS[4], stV[8], sp1[4];
        int tq = tid; asm volatile("" : "+v"(tq));
        { const bf16* pk = P + row0 * PLD + C_K + h * 128 + (size_t)(tq >> 4) * PLD + (tq & 15) * 8; const bf16* ps = spg + (size_t)(tq >> 4) * 128 + (tq & 15) * 8;
#pragma unroll
          for (int k = 0; k < 4; ++k) { stK[k] = *(const u32x4*)(pk + (size_t)(32 * k) * PLD); stS[k] = *(const u32x4*)(ps + (size_t)(32 * k) * 128); }
          const bf16* pv = P + row0 * PLD + C_V + h * 256 + (size_t)(tq >> 5) * PLD + (tq & 31) * 8;
#pragma unroll
          for (int k = 0; k < 8; ++k) stV[k] = *(const u32x4*)(pv + (size_t)(16 * k) * PLD);
#pragma unroll
          for (int k = 0; k < 4; ++k) sp1[k] = *(const u32x4*)(ps + (size_t)(128 + 32 * k) * 128); }
        __builtin_amdgcn_sched_barrier(0);
        __syncthreads();
#pragma unroll
        for (int k = 0; k < 4; ++k) { const int j = (tq >> 4) + 32 * k, ch = tq & 15; *(LAS u32x4*)(Kt + j * 272 + ch * 16) = stK[k]; *(LAS u32x4*)(Sp + j * 272 + ch * 16) = stS[k]; }
#pragma unroll
        for (int k = 0; k < 8; ++k) { const int j = (tq >> 5) + 16 * k, ch = tq & 31; *(LAS u32x4*)(Vt + j * 528 + ch * 16) = stV[k]; }
        __syncthreads();
        f32x4 acc[16];
        mm_rows4<8>(acc, Sp, 272, bq, fr, fq);
        __syncthreads();
#pragma unroll
        for (int k = 0; k < 4; ++k) { const int j = (tq >> 4) + 32 * k, ch = tq & 15; *(LAS u32x4*)(Sp + j * 272 + ch * 16) = sp1[k]; }
        __syncthreads();
        mm_rows4<8>(acc + 8, Sp, 272, bq, fr, fq);
        bf16* gq = P + trow * PLD + C_G + h * 256 + 16 * (fq & 1) + 4 * (fq & 2);
        u32x4 gl[8];
#pragma unroll
        for (int p = 0; p < 8; ++p) gl[p] = *(const u32x4*)(gq + 32 * p);
        const float fac = exp2f((float)(i + 1) * lg);
#pragma unroll
        for (int vt = 0; vt < 16; ++vt) acc[vt] = acc[vt] * fac;
        f32x4 s[8];
        int io = i; asm volatile("" : "+v"(io));
        bf16x8 kf[2][4];
        { LAS unsigned char* kp0 = Kt + fr * 272 + fq * 16;
#pragma unroll
          for (int ks = 0; ks < 4; ++ks) kf[0][ks] = *(LAS bf16x8*)(kp0 + ks * 64); }
#pragma unroll
        for (int kt = 0; kt < 8; ++kt) { s[kt] = (f32x4){0.f, 0.f, 0.f, 0.f};
            if (kt <= wave) {
                if (kt + 1 < 8 && kt + 1 <= wave) { LAS unsigned char* kp1 = Kt + (16 * (kt + 1) + fr) * 272 + fq * 16;
#pragma unroll
                    for (int ks = 0; ks < 4; ++ks) kf[(kt + 1) & 1][ks] = *(LAS bf16x8*)(kp1 + ks * 64); }
                __builtin_amdgcn_sched_barrier(0);
#pragma unroll
                for (int ks = 0; ks < 4; ++ks) s[kt] = mfma16(kf[kt & 1][ks], bq[ks], s[kt]);
#pragma unroll
                for (int r = 0; r < 4; ++r) { const int key = 16 * kt + 4 * fq + r; s[kt][r] = (key <= io) ? s[kt][r] * exp2f((float)(io - key) * lg) : 0.f; } } }
#pragma unroll
        for (int kp = 0; kp < 4; ++kp) if (2 * kp <= wave) { const bf16x8 pf = pack8(s[2 * kp], s[2 * kp + 1]); mm_tr<16, 4>(acc, Vt, 528, 32 * kp + 4 * fq, 32 * kp + 16 + 4 * fq, pf, fr); }
        float ss = 0.f;
#pragma unroll
        for (int vt = 0; vt < 16; ++vt) ss += (acc[vt][0] * acc[vt][0] + acc[vt][1] * acc[vt][1]) + (acc[vt][2] * acc[vt][2] + acc[vt][3] * acc[vt][3]);
        ss = add_xor16(ss); ss = add_xor32(ss);
        const float rinv = rsqrtf(ss * (1.0f / 256.0f) + EPS);
#pragma unroll
        for (int p = 0; p < 8; ++p) {
            u32x2 g[2];
            { auto rx = __builtin_amdgcn_permlane16_swap(gl[p][0], gl[p][2], false, false); auto ry = __builtin_amdgcn_permlane16_swap(gl[p][1], gl[p][3], false, false);
              g[0].x = rx[0]; g[0].y = ry[0]; g[1].x = rx[1]; g[1].y = ry[1]; }
            u32x2 w[2];
#pragma unroll
            for (int j = 0; j < 2; ++j) { const int vt = 2 * p + j; const float g0 = bflo(g[j].x), g1 = bfhi(g[j].x), g2 = bflo(g[j].y), g3 = bfhi(g[j].y);
                w[j].x = cvtpk(acc[vt][0] * rinv * g0 * sigmoidf_(g0), acc[vt][1] * rinv * g1 * sigmoidf_(g1)); w[j].y = cvtpk(acc[vt][2] * rinv * g2 * sigmoidf_(g2), acc[vt][3] * rinv * g3 * sigmoidf_(g3)); }
            u32x4 o;
            { auto rx = __builtin_amdgcn_permlane16_swap(w[0].x, w[1].x, false, false); auto ry = __builtin_amdgcn_permlane16_swap(w[0].y, w[1].y, false, false);
              o.x = rx[0]; o.y = ry[0]; o.z = rx[1]; o.w = ry[1]; }
            *(u32x4*)((dummy ? WSP(bf16, WS_MERGED) + trow * 1024 + h * 256 + 16 * (fq & 1) + 4 * (fq & 2) : gq) + 32 * p) = o; }
    }
    __syncthreads();
}

constexpr int N_PHASES = 2 + 2 * 13 + 1;
__global__ void __launch_bounds__(512, 2) fwd_kernel(Args args) {
    extern __shared__ __attribute__((aligned(16))) unsigned char lds_raw[];
    Frame F;
    F.lds = (LAS unsigned char*)lds_raw;
    F.G = gridDim.x; { const int bx = blockIdx.x; F.vcu = (F.G % 8 == 0) ? (bx % 8) * (F.G / 8) + bx / 8 : bx; }
    F.ws = args.ws;
    const Args& A = args;
    for (int u = TID; u < (LDS_BYTES - LDSCTL_OFF) / 4; u += 512) ((LAS unsigned*)(F.lds + LDSCTL_OFF))[u] = 0u;
    __syncthreads();
    const int lo = args.ph_lo, hi = args.ph_hi;
    XcdBarrier bar; bar.bar = WSP(unsigned, WS_CTL) + CW_BAR; bar.x = 0; bar.st = nullptr;
    if (hi - lo > 1) bar = xcd_barrier_post(WSP(unsigned, WS_CTL) + CW_BAR, (volatile LAS unsigned*)(F.lds + MISC_OFF) + 8);
    int ph = 0;
#define RUN() (lo <= ph && ph < hi)
#define END_PHASE() do { if (RUN() && ph + 1 < hi) xcd_barrier(bar); ++ph; } while (0)
    const int bx = (int)blockIdx.x;

    if (RUN()) for (int rep = 0; rep < REPS(10); ++rep) { if (rep) xcd_barrier(bar); p0_prologue(F, A); }
    END_PHASE();
    if (RUN()) for (int rep = 0; rep < REPS(11); ++rep) { if (rep) xcd_barrier(bar); mem_kv_proj(F); }
    END_PHASE();
#pragma unroll 1
    for (int l = 0; l < 2; ++l) {
        unsigned char* wl = F.ws + WS_W + (size_t)l * W_LAYER;
#pragma unroll 1
        for (int hf = 0; hf < 2; ++hf) {
            const int t0 = hf * TH;
            if (RUN()) for (int rep = 0; rep < REPS(0); ++rep) { if (rep) xcd_barrier(bar);
                pg8::Gemm g{WSP(bf16, WS_XB) + (size_t)t0 * DM, (const bf16*)(wl + WO_IN)};
                pg8::StaticOrder<TH, 4096> S; S.init(F.G, bx);
                pg8::EpiBf<2> E{WSP(bf16, WS_PROJ), PLD, WSP(float, WS_COS), WSP(float, WS_SIN), t0, WSP(float, WS_SSP)};
                pg8::gemm_phase<DM, DM, DM, pg8::EpiBf<2>, pg8::StaticOrder<TH, 4096>>(F.lds, g, S, E);
            }
            END_PHASE();
            if (RUN()) for (int rep = 0; rep < REPS(1); ++rep) { if (rep) xcd_barrier(bar); mix_pool(F); mix_mem(F, l, hf, rep != 0); mix_kv(F); }
            END_PHASE();
            if (RUN()) for (int rep = 0; rep < REPS(2); ++rep) { if (rep) xcd_barrier(bar); scan_states(F); }
            END_PHASE();
            if (RUN()) for (int rep = 0; rep < REPS(3); ++rep) { if (rep) xcd_barrier(bar); ret_out(F, rep != 0); }
            END_PHASE();
            if (RUN()) for (int rep = 0; rep < REPS(4); ++rep) { if (rep) xcd_barrier(bar);
                pg8::Gemm g{WSP(bf16, WS_XB) + (size_t)t0 * DM, (const bf16*)(wl + WO_IN) + (size_t)4096 * DM};
                pg8::GateOrder<TH> S; S.init(F.G, bx);
                pg8::EpiBf<3> E{WSP(bf16, WS_GATES), 3072, nullptr, nullptr, t0, WSP(float, WS_SSP)};
                pg8::gemm_phase<DM, DM, DM, pg8::EpiBf<3>, pg8::GateOrder<TH>>(F.lds, g, S, E);
            }
            if (RUN()) for (int rep = 0; rep < REPS(5); ++rep) { if (rep) xcd_barrier(bar);
                pg8::Gemm g{WSP(bf16, WS_PROJ) + C_DP, (const bf16*)(wl + WO_UP)};
                pg8::StaticOrder<TH, DM> S; S.init(F.G, bx);
                pg8::EpiUp E{WSP(bf16, WS_MERGED), WSP(bf16, WS_GATES)};
                pg8::gemm_phase<2048, PLD, 2048, pg8::EpiUp, pg8::StaticOrder<TH, DM>>(F.lds, g, S, E);
            }
            END_PHASE();
            if (RUN()) for (int rep = 0; rep < REPS(6); ++rep) { if (rep) xcd_barrier(bar);
                pg8::Gemm g{WSP(bf16, WS_MERGED), (const bf16*)(wl + WO_OUT)};
                pg8::StaticOrder<TH, DM> S; S.init(F.G, bx);
                pg8::EpiRes E{WSP(bf16, WS_XB) + (size_t)t0 * DM, WSP(float, WS_SSP) + (size_t)t0 * 16, rep ? WSP(bf16, WS_KVN) : nullptr};
                pg8::gemm_phase<DM, DM, DM, pg8::EpiRes, pg8::StaticOrder<TH, DM>>(F.lds, g, S, E);
            }
            if (hf == 1) END_PHASE();
        }
        if (RUN()) for (int rep = 0; rep < REPS(8); ++rep) { if (rep) xcd_barrier(bar);
            pg8::Gemm g{WSP(bf16, WS_XB), (const bf16*)(wl + WO_1)};
            pg8::StaticOrder<T, DFF> S; S.init(F.G, bx);
            pg8::EpiBf<1> E{WSP(bf16, WS_U), DFF, nullptr, nullptr, 0, WSP(float, WS_SSP)};
            pg8::gemm_phase<DM, DM, DM, pg8::EpiBf<1>, pg8::StaticOrder<T, DFF>>(F.lds, g, S, E);
        }
        END_PHASE();
        if (RUN()) {
            pg8::Gemm g{WSP(bf16, WS_U), (const bf16*)(wl + WO_2)};
            pg8::StaticOrder<T, DM> S; S.init(F.G, bx);
            pg8::EpiRes E{WSP(bf16, WS_XB), WSP(float, WS_SSP), nullptr};
            pg8::gemm_phase<DFF, DFF, DFF, pg8::EpiRes, pg8::StaticOrder<T, DM>>(F.lds, g, S, E);
#if (PROBE_DUP >> 9) & 1
            xcd_barrier(bar);
            { pg8::StaticOrder<TH, DM> S2; S2.init(F.G, bx); pg8::EpiRes E2{WSP(bf16, WS_XB), WSP(float, WS_SSP), (bf16*)(F.ws + WS_END)};
              pg8::gemm_phase<DFF, DFF, DFF, pg8::EpiRes, pg8::StaticOrder<TH, DM>>(F.lds, g, S2, E2); }
#endif
        }
        END_PHASE();
        if (l == 1) { if (RUN()) final_norm(F, A.out, A.in[17]); END_PHASE(); }
#if (PROBE_DUP >> 12) & 1
        for (int rep = 0; rep < 8; ++rep) xcd_barrier(bar);
#endif
    }
#undef RUN
#undef END_PHASE
}

extern "C" void kernel_launch(void* const* d_in, const int* in_sizes, int n_in, void* d_out, int out_size, void* d_ws, size_t ws_size, hipStream_t stream) {
    static int grid = 0;
    if (grid == 0) {
        if (n_in != 18 || in_sizes[0] != T * DM || out_size != T * DM || ws_size < WS_END) { fprintf(stderr, "kernel_launch: unexpected shapes / workspace (n_in %d, ws %zu)\n", n_in, ws_size); grid = -1; return; }
        int dev = 0, cus = 0, per_cu = 0;
        if (hipGetDevice(&dev) != hipSuccess || hipDeviceGetAttribute(&cus, hipDeviceAttributeMultiprocessorCount, dev) != hipSuccess) { grid = -1; return; }
        if (hipFuncSetAttribute((const void*)fwd_kernel, hipFuncAttributeMaxDynamicSharedMemorySize, LDS_BYTES) != hipSuccess) { fprintf(stderr, "kernel_launch: hipFuncSetAttribute failed\n"); grid = -1; return; }
        if (hipOccupancyMaxActiveBlocksPerMultiprocessor(&per_cu, (const void*)fwd_kernel, 512, LDS_BYTES) != hipSuccess || per_cu < 1) { fprintf(stderr, "kernel_launch: occupancy query says %d\n", per_cu); (void)hipGetLastError(); grid = -1; return; }
        grid = cus;
    }
    if (grid < 0) return;
    (void)hipMemsetAsync((char*)d_ws + WS_CTL, 0, CTL_ZERO_BYTES, stream);
    Args a{};
    for (int i = 0; i < 18; ++i) a.in[i] = (const float*)d_in[i];
    a.out = (float*)d_out; a.ws = (unsigned char*)d_ws;
#if MK_SINGLE
    a.ph_lo = 0; a.ph_hi = N_PHASES;
    hipLaunchKernelGGL(fwd_kernel, dim3(grid), dim3(512), LDS_BYTES, stream, a);
#else
    for (int p = 0; p < N_PHASES; ++p) { a.ph_lo = p; a.ph_hi = p + 1; hipLaunchKernelGGL(fwd_kernel, dim3(grid), dim3(512), LDS_BYTES, stream, a); }
#endif
}
```
